# Optimizing an MI355X kernel written in HIP

```python
import jax, jax.numpy as jnp
from jax import lax
import numpy as np

D_MODEL = 2048
BATCH = 2
SEQ = 8192
DEPTH = 2

CTX_LEN = 256
GRID_W = 64
EPS = 1e-6
ROPE_BASE = 10000.0

GROUP_WIDTH = D_MODEL // 4
HEAD_DIM = 64
NA_HEADS = GROUP_WIDTH // HEAD_DIM
NA_ROWS = 8
NA_COLS = 16
RET_HEADS = 4
RET_DK = GROUP_WIDTH // RET_HEADS
RET_DV = GROUP_WIDTH // RET_HEADS
GLA_HEADS = 4
GLA_DV = GROUP_WIDTH // GLA_HEADS
GLA_DK = GLA_DV // 2
GLA_RANK = 16
GLA_TAU = 16.0
SWA_HEADS = GROUP_WIDTH // HEAD_DIM
SWA_KV_HEADS = SWA_HEADS // 4
SWA_WINDOW = 128
SWA_BLOCK = 128
SCAN_CHUNK = 64
PEER_HEADS = 8
PEER_N_KEYS = 128
PEER_N_EXPERTS = PEER_N_KEYS * PEER_N_KEYS
PEER_DK = 256
PEER_TOPK = 16
PEER_TOKEN_BLOCK = 128

PROJ_WIDTHS = (
    NA_HEADS * HEAD_DIM, NA_HEADS * HEAD_DIM, NA_HEADS * HEAD_DIM,
    RET_HEADS * RET_DK, RET_HEADS * RET_DK, RET_HEADS * RET_DV, RET_HEADS * RET_DV,
    GLA_HEADS * GLA_DK, GLA_HEADS * GLA_DK, GLA_HEADS * GLA_DV, GLA_HEADS * GLA_DV,
    GLA_RANK, GLA_RANK,
    SWA_HEADS * HEAD_DIM, SWA_KV_HEADS * HEAD_DIM, SWA_KV_HEADS * HEAD_DIM,
)
D_IN = sum(PROJ_WIDTHS)

kernel_name = "hybrid_dit_na_ret_gla_swa_peer"


def rms_norm(x, g):
    xf = x.astype(jnp.float32)
    y = xf * lax.rsqrt(jnp.mean(xf * xf, axis=-1, keepdims=True) + EPS)
    return (y * g.astype(jnp.float32)).astype(x.dtype)


def modulate(x, g, shift, scale):
    return rms_norm(x, g) * (1.0 + scale) + shift


def split_heads(t, n):
    b, l, _ = t.shape
    return t.reshape(b, l, n, -1).transpose(0, 2, 1, 3)


def merge_heads(t):
    b, h, l, d = t.shape
    return t.transpose(0, 2, 1, 3).reshape(b, l, h * d)


def split_columns(p):
    offsets = np.cumsum(PROJ_WIDTHS)[:-1].tolist()
    return jnp.split(p, offsets, axis=-1)


def rope_2d_tables(length, dh):
    t = jnp.arange(length)
    pos = jnp.stack([t // GRID_W, t % GRID_W], axis=-1).astype(jnp.float32)
    quarter = dh // 4
    inv = ROPE_BASE ** (-jnp.arange(quarter, dtype=jnp.float32) / quarter)
    ang = pos[:, :, None] * inv
    return jnp.cos(ang), jnp.sin(ang)


def apply_rope_2d(x, cos, sin):
    shp = x.shape
    xs = x.astype(jnp.float32).reshape(*shp[:-1], 2, 2, shp[-1] // 4)
    x1, x2 = xs[..., 0, :], xs[..., 1, :]
    out = jnp.stack([x1 * cos - x2 * sin, x2 * cos + x1 * sin], axis=-2)
    return out.reshape(shp).astype(x.dtype)


def head_layer_norm(y):
    yf = y.astype(jnp.float32)
    mu = jnp.mean(yf, axis=-1, keepdims=True)
    var = jnp.mean(jnp.square(yf - mu), axis=-1, keepdims=True)
    return ((yf - mu) * lax.rsqrt(var + EPS)).astype(y.dtype)


def head_rms_norm(y, g):
    yf = y.astype(jnp.float32)
    out = yf * lax.rsqrt(jnp.mean(yf * yf, axis=-1, keepdims=True) + EPS) * g.astype(jnp.float32)
    return out.astype(y.dtype)


def context_attention(q, k, v, sink):
    lc = k.shape[2]
    s = jnp.einsum('bkgqd,bkcd->bkgqc', q, k).astype(jnp.float32) * (q.shape[-1] ** -0.5)
    if sink is not None:
        sink_col = jnp.broadcast_to(sink.astype(jnp.float32)[None, :, :, None, None], s.shape[:-1] + (1,))
        s = jnp.concatenate([s, sink_col], axis=-1)
    p = jax.nn.softmax(s, axis=-1)[..., :lc]
    return jnp.einsum('bkgqc,bkcd->bkgqd', p.astype(v.dtype), v)


def neighbourhood_attention(qx, kx, vx, qz, kz, vz, rpb, with_ctx_out):
    b, h, s_len, dh = qx.shape
    rows = s_len // GRID_W
    kh = min(NA_ROWS, rows)
    grid = lambda t: t.reshape(b, h, rows, GRID_W, dh)
    q = grid(qx) * (dh ** -0.5)
    r = jnp.arange(rows)
    row_idx = jnp.clip(r - kh // 2, 0, rows - kh)[:, None] + jnp.arange(kh)
    k_band = grid(kx)[:, :, row_idx]
    v_band = grid(vx)[:, :, row_idx]
    s_nb = jnp.einsum('bhrqd,bhrjwd->bhrqjw', q, k_band).astype(jnp.float32)
    col = jnp.arange(GRID_W)
    col_start = jnp.clip(col - NA_COLS // 2, 0, GRID_W - NA_COLS)
    col_ok = (col[None, :] >= col_start[:, None]) & (col[None, :] < col_start[:, None] + NA_COLS)
    d_row = row_idx - r[:, None] + NA_ROWS - 1
    d_col = jnp.clip(col[None, :] - col[:, None], -(NA_COLS - 1), NA_COLS - 1) + NA_COLS - 1
    bias = rpb.astype(jnp.float32)[:, d_row][..., d_col].transpose(0, 1, 3, 2, 4)
    s_nb = jnp.where(col_ok[:, None, :], s_nb + bias[None], -jnp.inf)
    n_nb = kh * GRID_W
    s_ctx = jnp.einsum('bhrqd,bhcd->bhrqc', q, kz).astype(jnp.float32)
    p = jax.nn.softmax(jnp.concatenate([s_nb.reshape(b, h, rows, GRID_W, n_nb), s_ctx], axis=-1), axis=-1)
    p_nb = p[..., :n_nb].reshape(b, h, rows, GRID_W, kh, GRID_W).astype(vx.dtype)
    o = (jnp.einsum('bhrqjw,bhrjwd->bhrqd', p_nb, v_band)
         + jnp.einsum('bhrqc,bhcd->bhrqd', p[..., n_nb:].astype(vx.dtype), vz))
    ox = o.reshape(b, h, s_len, dh)
    oz = context_attention(qz[:, :, None], kz, vz, None)[:, :, 0] if with_ctx_out else None
    return oz, ox


def sliding_window_attention(qx, kx, vx, qz, kz, vz, sink, with_ctx_out):
    b, hq, s_len, dh = qx.shape
    hk = kx.shape[1]
    g = hq // hk
    nb = s_len // SWA_BLOCK
    q = (qx * (dh ** -0.5)).reshape(b, hk, g, nb, SWA_BLOCK, dh)
    pad = lambda t: jnp.pad(t, ((0, 0), (0, 0), (SWA_BLOCK, SWA_BLOCK), (0, 0))).reshape(b, hk, nb + 2, SWA_BLOCK, dh)
    band = lambda t: jnp.concatenate([t[:, :, :-2], t[:, :, 1:-1], t[:, :, 2:]], axis=3)
    kb, vb = band(pad(kx)), band(pad(vx))
    blk = jnp.arange(nb)[:, None]
    qpos = blk * SWA_BLOCK + jnp.arange(SWA_BLOCK)
    kpos = (blk - 1) * SWA_BLOCK + jnp.arange(3 * SWA_BLOCK)
    ok = ((jnp.abs(qpos[:, :, None] - kpos[:, None, :]) <= SWA_WINDOW)
          & (kpos[:, None, :] >= 0) & (kpos[:, None, :] < s_len))
    s_win = jnp.where(ok, jnp.einsum('bkgnqd,bkncd->bkgnqc', q, kb).astype(jnp.float32), -jnp.inf)
    s_ctx = jnp.einsum('bkgnqd,bkcd->bkgnqc', q, kz).astype(jnp.float32)
    sink_hg = sink.reshape(hk, g)
    s_sink = jnp.broadcast_to(sink_hg.astype(jnp.float32)[None, :, :, None, None, None], s_win.shape[:-1] + (1,))
    p = jax.nn.softmax(jnp.concatenate([s_win, s_ctx, s_sink], axis=-1), axis=-1).astype(vx.dtype)
    nw = 3 * SWA_BLOCK
    lc = kz.shape[2]
    o = (jnp.einsum('bkgnqc,bkncd->bkgnqd', p[..., :nw], vb)
         + jnp.einsum('bkgnqc,bkcd->bkgnqd', p[..., nw:nw + lc], vz))
    ox = o.reshape(b, hq, s_len, dh)
    oz = None
    if with_ctx_out:
        lz = qz.shape[2]
        oz = context_attention(qz.reshape(b, hk, g, lz, dh), kz, vz, sink_hg).reshape(b, hq, lz, dh)
    return oz, ox


def gated_chunk_scan(q, k, v, log_a, s0, inclusive):
    b, h, l, dk = q.shape
    dv = v.shape[-1]
    n = l // SCAN_CHUNK
    f32 = jnp.float32
    qc = q.astype(f32).reshape(b, h, n, SCAN_CHUNK, dk)
    kc = k.astype(f32).reshape(b, h, n, SCAN_CHUNK, dk)
    vc = v.astype(f32).reshape(b, h, n, SCAN_CHUNK, dv)
    gcum = jnp.cumsum(log_a.astype(f32).reshape(b, h, n, SCAN_CHUNK, dk), axis=3)
    g_last = gcum[:, :, :, -1:, :]
    q_rel = qc * jnp.exp(gcum - g_last)
    k_rel = kc * jnp.exp(g_last - gcum)
    a = jnp.einsum('bhnid,bhnjd->bhnij', q_rel, k_rel)
    tri = jnp.tril(jnp.ones((SCAN_CHUNK, SCAN_CHUNK), dtype=bool), 0 if inclusive else -1)
    o_intra = jnp.einsum('bhnij,bhnjv->bhniv', jnp.where(tri, a, 0.0), vc)
    inc = jnp.einsum('bhnjd,bhnjv->nbhdv', k_rel, vc)
    dec = jnp.moveaxis(jnp.exp(g_last[:, :, :, 0, :]), 2, 0)[..., None]

    def step(s, xs):
        d, u = xs
        return d * s + u, s

    s_final, s_prev = lax.scan(step, s0.astype(f32), (dec, inc))
    o_inter = jnp.einsum('bhnid,nbhdv->bhniv', qc * jnp.exp(gcum), s_prev)
    o = (o_intra + o_inter).reshape(b, h, l, dv).astype(v.dtype)
    return o, s_final


def bidirectional_scan(qz, kz, vz, gz_f, gz_b, qx, kx, vx, gx_f, gx_b):
    b, h, _, dk = qz.shape
    dv = vz.shape[-1]
    flip = lambda t: jnp.flip(t, axis=2)
    s0 = jnp.zeros((b, h, dk, dv), jnp.float32)
    oz_f, sz_f = gated_chunk_scan(qz, kz, vz, gz_f, s0, True)
    oz_b, sz_b = gated_chunk_scan(flip(qz), flip(kz), flip(vz), flip(gz_b), s0, False)
    ox_f, _ = gated_chunk_scan(qx, kx, vx, gx_f, sz_f, True)
    ox_b, _ = gated_chunk_scan(flip(qx), flip(kx), flip(vx), flip(gx_b), sz_b, False)
    return oz_f + flip(oz_b), ox_f + flip(ox_b)


def token_mixers(hx, hz, w_in, w_out, na_rpb, ret_log_gamma, gla_w_gate_up, gla_b_gate, gla_norm_g,
                 swa_sink, rope_hd, rope_ret, with_ctx_out):
    (na_qx, na_kx, na_vx, rt_qx, rt_kx, rt_vx, rt_gx, gl_qx, gl_kx, gl_vx, gl_gx, gl_dfx, gl_dbx,
     sw_qx, sw_kx, sw_vx) = split_columns(hx @ w_in)
    (na_qz, na_kz, na_vz, rt_qz, rt_kz, rt_vz, rt_gz, gl_qz, gl_kz, gl_vz, gl_gz, gl_dfz, gl_dbz,
     sw_qz, sw_kz, sw_vz) = split_columns(hz @ w_in)
    cos_h, sin_h = rope_hd
    cos_r, sin_r = rope_ret

    na_z, na_x = neighbourhood_attention(
        split_heads(na_qx, NA_HEADS), split_heads(na_kx, NA_HEADS), split_heads(na_vx, NA_HEADS),
        split_heads(na_qz, NA_HEADS), split_heads(na_kz, NA_HEADS), split_heads(na_vz, NA_HEADS),
        na_rpb, with_ctx_out)

    rt_scale = RET_DK ** -0.5
    rq_x = apply_rope_2d(split_heads(rt_qx, RET_HEADS), cos_r, sin_r)
    rk_x = apply_rope_2d(split_heads(rt_kx, RET_HEADS), cos_r, sin_r) * rt_scale
    rq_z = split_heads(rt_qz, RET_HEADS)
    rk_z = split_heads(rt_kz, RET_HEADS) * rt_scale
    gam = lambda ref, d: jnp.broadcast_to(ret_log_gamma[d][None, :, None, None], ref.shape)
    ry_z, ry_x = bidirectional_scan(
        rq_z, rk_z, split_heads(rt_vz, RET_HEADS), gam(rq_z, 0), gam(rq_z, 1),
        rq_x, rk_x, split_heads(rt_vx, RET_HEADS), gam(rq_x, 0), gam(rq_x, 1))

    def gla_gate(d_low, direction):
        pre = d_low @ gla_w_gate_up[direction] + gla_b_gate[direction]
        return split_heads(jax.nn.log_sigmoid(pre.astype(jnp.float32)) / GLA_TAU, GLA_HEADS)

    gq = lambda t: split_heads(t, GLA_HEADS) * (GLA_DK ** -0.5)
    gy_z, gy_x = bidirectional_scan(
        gq(gl_qz), split_heads(gl_kz, GLA_HEADS), split_heads(gl_vz, GLA_HEADS),
        gla_gate(gl_dfz, 0), gla_gate(gl_dbz, 1),
        gq(gl_qx), split_heads(gl_kx, GLA_HEADS), split_heads(gl_vx, GLA_HEADS),
        gla_gate(gl_dfx, 0), gla_gate(gl_dbx, 1))

    sw_z, sw_x = sliding_window_attention(
        apply_rope_2d(split_heads(sw_qx, SWA_HEADS), cos_h, sin_h),
        apply_rope_2d(split_heads(sw_kx, SWA_KV_HEADS), cos_h, sin_h),
        split_heads(sw_vx, SWA_KV_HEADS),
        split_heads(sw_qz, SWA_HEADS), split_heads(sw_kz, SWA_KV_HEADS), split_heads(sw_vz, SWA_KV_HEADS),
        swa_sink, with_ctx_out)

    ret_x = merge_heads(head_layer_norm(ry_x)) * jax.nn.silu(rt_gx)
    gla_x = merge_heads(head_rms_norm(gy_x, gla_norm_g)) * jax.nn.silu(gl_gx)
    out_x = jnp.concatenate([merge_heads(na_x), ret_x, gla_x, merge_heads(sw_x)], axis=-1) @ w_out
    if not with_ctx_out:
        return out_x, None
    ret_z = merge_heads(head_layer_norm(ry_z)) * jax.nn.silu(rt_gz)
    gla_z = merge_heads(head_rms_norm(gy_z, gla_norm_g)) * jax.nn.silu(gl_gz)
    out_z = jnp.concatenate([merge_heads(na_z), ret_z, gla_z, merge_heads(sw_z)], axis=-1) @ w_out
    return out_x, out_z


def peer_ffn(h, w_q, sub_keys, expert_u, expert_v):
    b, l, d = h.shape
    n = PEER_TOKEN_BLOCK
    ht = h.reshape(b * l // n, n, d)

    def block(hb):
        q = (hb @ w_q).reshape(n, PEER_HEADS, 2, PEER_DK // 2)
        s = jnp.einsum('thpd,phkd->thpk', q, sub_keys).astype(jnp.float32)
        top_s, top_i = lax.top_k(s, PEER_TOPK)
        cand_s = (top_s[:, :, 0, :, None] + top_s[:, :, 1, None, :]).reshape(n, PEER_HEADS, -1)
        cand_i = (top_i[:, :, 0, :, None] * PEER_N_KEYS + top_i[:, :, 1, None, :]).reshape(n, PEER_HEADS, -1)
        best_s, best_pos = lax.top_k(cand_s, PEER_TOPK)
        idx = jnp.take_along_axis(cand_i, best_pos, axis=-1)
        gate = jax.nn.softmax(best_s, axis=-1)
        act = jax.nn.gelu(jnp.einsum('td,thkd->thk', hb, expert_u[idx]).astype(jnp.float32), approximate=False)
        return jnp.einsum('thk,thkd->td', (gate * act).astype(hb.dtype), expert_v[idx])

    return lax.map(block, ht).reshape(b, l, d)


def setup_inputs(seed: int = 0) -> dict:
    key = jax.random.key(seed)
    ks = jax.random.split(key, 24)
    f32 = jnp.float32
    nrm = lambda k, shape, scale: jax.random.normal(k, shape, f32) * scale
    L, D = DEPTH, D_MODEL
    ret_base = jnp.log1p(-(2.0 ** (-5.0 - jnp.arange(RET_HEADS, dtype=f32))))
    return {
        "x": nrm(ks[0], (BATCH, SEQ, D), 1.0),
        "c": nrm(ks[1], (BATCH, D), 1.0),
        "ctx": nrm(ks[2], (BATCH, CTX_LEN, D), 1.0),
        "c_ctx": nrm(ks[3], (D,), 1.0),
        "w_ada": nrm(ks[4], (L, D, 6 * D), 0.2 * D ** -0.5),
        "b_ada": nrm(ks[5], (L, 6 * D), 0.02),
        "norm_attn_g": 1.0 + nrm(ks[6], (L, D), 0.02),
        "norm_ffn_g": 1.0 + nrm(ks[7], (L, D), 0.02),
        "w_in": nrm(ks[8], (L, D, D_IN), D ** -0.5),
        "na_rpb": nrm(ks[9], (L, NA_HEADS, 2 * NA_ROWS - 1, 2 * NA_COLS - 1), 0.1),
        "ret_log_gamma": ret_base * (1.0 + nrm(ks[10], (L, 2, RET_HEADS), 0.05)),
        "gla_w_gate_up": nrm(ks[11], (L, 2, GLA_RANK, GLA_HEADS * GLA_DK), GLA_RANK ** -0.5),
        "gla_b_gate": nrm(ks[12], (L, 2, GLA_HEADS * GLA_DK), 0.1),
        "gla_norm_g": 1.0 + nrm(ks[13], (L, GLA_DV), 0.02),
        "swa_sink": nrm(ks[14], (L, SWA_HEADS), 0.5),
        "w_out": nrm(ks[15], (L, D, D), D ** -0.5),
        "peer_w_q": nrm(ks[16], (L, D, PEER_HEADS * PEER_DK), D ** -0.5),
        "peer_sub_keys": nrm(ks[17], (L, 2, PEER_HEADS, PEER_N_KEYS, PEER_DK // 2), (PEER_DK // 2) ** -0.5),
        "peer_u": nrm(ks[18], (L, PEER_N_EXPERTS, D), D ** -0.5),
        "peer_v": nrm(ks[19], (L, PEER_N_EXPERTS, D), PEER_HEADS ** -0.5),
        "final_g": 1.0 + nrm(ks[20], (D,), 0.02),
    }


def reference(x, c, ctx, c_ctx, w_ada, b_ada, norm_attn_g, norm_ffn_g, w_in, na_rpb, ret_log_gamma,
              gla_w_gate_up, gla_b_gate, gla_norm_g, swa_sink, w_out, peer_w_q, peer_sub_keys,
              peer_u, peer_v, final_g):
    s_len = x.shape[1]
    rope_hd = rope_2d_tables(s_len, HEAD_DIM)
    rope_ret = rope_2d_tables(s_len, RET_DK)
    z = ctx
    for layer in range(DEPTH):
        has_next = layer < DEPTH - 1
        mx = jnp.split((jax.nn.silu(c) @ w_ada[layer] + b_ada[layer])[:, None, :], 6, axis=-1)
        mz = jnp.split(jax.nn.silu(c_ctx) @ w_ada[layer] + b_ada[layer], 6, axis=-1)
        hx = modulate(x, norm_attn_g[layer], mx[0], mx[1])
        hz = modulate(z, norm_attn_g[layer], mz[0], mz[1])
        ox, oz = token_mixers(hx, hz, w_in[layer], w_out[layer], na_rpb[layer], ret_log_gamma[layer],
                              gla_w_gate_up[layer], gla_b_gate[layer], gla_norm_g[layer], swa_sink[layer],
                              rope_hd, rope_ret, has_next)
        x = x + mx[2] * ox
        hx = modulate(x, norm_ffn_g[layer], mx[3], mx[4])
        x = x + mx[5] * peer_ffn(hx, peer_w_q[layer], peer_sub_keys[layer], peer_u[layer], peer_v[layer])
        if has_next:
            z = z + mz[2] * oz
            hz = modulate(z, norm_ffn_g[layer], mz[3], mz[4])
            z = z + mz[5] * peer_ffn(hz, peer_w_q[layer], peer_sub_keys[layer], peer_u[layer], peer_v[layer])
    return rms_norm(x, final_g)
```

```cpp
#include <hip/hip_runtime.h>
#include <hip/hip_cooperative_groups.h>
#include <cstdio>
namespace cg = cooperative_groups;

#ifndef MULTI_LAUNCH
#define MULTI_LAUNCH 0
#endif

typedef unsigned short bfr;
typedef __attribute__((ext_vector_type(8))) short bf16x8;
typedef __attribute__((ext_vector_type(4))) float f32x4;
typedef __attribute__((ext_vector_type(4))) unsigned int u4;

constexpr int D = 2048;
constexpr int S = 8192;
constexpr int MX = 16384;
constexpr int MT = 16896;
constexpr int DIN = 5920;
constexpr int DINP = 6016;
constexpr int NTHR = 512;
constexpr float EPS = 1e-6f;
constexpr int SMEM_BYTES = 149504;

constexpr int C_NAQ = 0, C_NAK = 512, C_NAV = 1024;
constexpr int C_RTQ = 1536, C_RTK = 2048, C_RTV = 2560, C_RTG = 3072;
constexpr int C_GLQ = 3584, C_GLK = 3840, C_GLV = 4096, C_GLG = 4608, C_GLD = 5120;
constexpr int C_SWQ = 5152, C_SWK = 5664, C_SWV = 5792;

struct Params {
  const float *x, *c, *ctx, *c_ctx, *w_ada, *b_ada, *g_attn, *g_ffn, *w_in, *rpb, *ret_lg, *gla_wu, *gla_b,
      *gla_g, *sink, *w_out, *w_q, *sub_keys, *pu, *pv, *final_g;
  float* out;
  bfr *wt_in, *wt_out, *wt_q, *sk_bf;
  unsigned char *u8, *v8;
  float *uscl, *vscl;
  float *mod, *rope, *xcur;
  bfr *h, *proj, *mix;
  bfr *st_ret, *st_gla;
  float *dec_ret, *dec_gla;
  bfr* q;
  float* scores;
  int* pidx;
  float* pgate;
  unsigned* bar;
};

__device__ __forceinline__ int get_tid() { int t = threadIdx.x; asm volatile("" : "+v"(t)); return t; }
__device__ __forceinline__ int get_bid() { int t = blockIdx.x; asm volatile("" : "+s"(t)); return t; }
__device__ __forceinline__ float bf2f(bfr u) { return __uint_as_float(((unsigned)u) << 16); }
__device__ __forceinline__ bfr f2bf(float f) {
  unsigned u = __float_as_uint(f);
  u += 0x7fffu + ((u >> 16) & 1u);
  return (bfr)(u >> 16);
}
__device__ __forceinline__ unsigned pack2(float a, float b) { return (unsigned)f2bf(a) | ((unsigned)f2bf(b) << 16); }
__device__ __forceinline__ float lo16(unsigned w) { return __uint_as_float(w << 16); }
__device__ __forceinline__ float hi16(unsigned w) { return __uint_as_float(w & 0xffff0000u); }
__device__ __forceinline__ float wave_sum(float v) {
#pragma unroll
  for (int o = 32; o; o >>= 1) v += __shfl_xor(v, o);
  return v;
}
__device__ __forceinline__ float wave_max(float v) {
#pragma unroll
  for (int o = 32; o; o >>= 1) v = fmaxf(v, __shfl_xor(v, o));
  return v;
}
__device__ __forceinline__ float silu_f(float x) { return x / (1.f + __expf(-x)); }
__device__ __forceinline__ float gelu_f(float x) { return 0.5f * x * (1.f + erff(x * 0.70710678118654752f)); }
__device__ __forceinline__ float logsig_f(float x) { return fminf(x, 0.f) - log1pf(__expf(-fabsf(x))); }
__device__ __forceinline__ void unpack8(const u4 w, float* f) {
  f[0] = lo16(w.x); f[1] = hi16(w.x); f[2] = lo16(w.y); f[3] = hi16(w.y);
  f[4] = lo16(w.z); f[5] = hi16(w.z); f[6] = lo16(w.w); f[7] = hi16(w.w);
}

__device__ void transpose_cvt(const float* __restrict__ W, int K, int N, int Npad, bfr* __restrict__ Wt, int item,
                              float* tile) {
  const int nkt = K >> 6;
  const int kt = item % nkt, nt = item / nkt;
  const int tid = get_tid();
  __syncthreads();
#pragma unroll
  for (int i = 0; i < 2; ++i) {
    int kk = (tid >> 4) + 32 * i, nn = (tid & 15) * 4;
    int n = nt * 64 + nn;
    float4 v = make_float4(0.f, 0.f, 0.f, 0.f);
    if (n < N) v = *(const float4*)(W + (size_t)(kt * 64 + kk) * N + n);
    tile[kk * 65 + nn + 0] = v.x; tile[kk * 65 + nn + 1] = v.y; tile[kk * 65 + nn + 2] = v.z; tile[kk * 65 + nn + 3] = v.w;
  }
  __syncthreads();
  {
    int nl = tid >> 3, kc = (tid & 7) * 8;
    u4 o;
    o.x = pack2(tile[(kc + 0) * 65 + nl], tile[(kc + 1) * 65 + nl]);
    o.y = pack2(tile[(kc + 2) * 65 + nl], tile[(kc + 3) * 65 + nl]);
    o.z = pack2(tile[(kc + 4) * 65 + nl], tile[(kc + 5) * 65 + nl]);
    o.w = pack2(tile[(kc + 6) * 65 + nl], tile[(kc + 7) * 65 + nl]);
    *(u4*)(Wt + (size_t)(nt * 64 + nl) * K + kt * 64 + kc) = o;
  }
}

__device__ void cvt_linear(const float* __restrict__ src, bfr* __restrict__ dst, size_t n8) {
  for (size_t i = (size_t)get_bid() * NTHR + get_tid(); i < n8; i += (size_t)gridDim.x * NTHR) {
    float4 a = *(const float4*)(src + i * 8), b = *(const float4*)(src + i * 8 + 4);
    u4 o;
    o.x = pack2(a.x, a.y); o.y = pack2(a.z, a.w); o.z = pack2(b.x, b.y); o.w = pack2(b.z, b.w);
    *(u4*)(dst + i * 8) = o;
  }
}

__device__ void cvt_fp8_rows(const float* __restrict__ src, unsigned char* __restrict__ dst, float* __restrict__ scl, int nrows) {
  const int lane = get_tid() & 63;
  const int wave = get_bid() * 8 + (get_tid() >> 6), nw = gridDim.x * 8;
  for (int row = wave; row < nrows; row += nw) {
    const float* sp = src + (size_t)row * D + lane * 16;
    float4 v[8];
    float amax = 0.f;
#pragma unroll
    for (int i = 0; i < 2; ++i)
#pragma unroll
      for (int k = 0; k < 4; ++k) {
        float4 t = *(const float4*)(sp + i * 1024 + k * 4);
        v[i * 4 + k] = t;
        amax = fmaxf(amax, fmaxf(fmaxf(fabsf(t.x), fabsf(t.y)), fmaxf(fabsf(t.z), fabsf(t.w))));
      }
    amax = wave_max(amax);
    const float sc = amax > 0.f ? 256.f / amax : 1.f;
#pragma unroll
    for (int i = 0; i < 2; ++i) {
      u4 o;
      int w;
      w = __builtin_amdgcn_cvt_pk_fp8_f32(v[i * 4 + 0].x * sc, v[i * 4 + 0].y * sc, 0, false);
      w = __builtin_amdgcn_cvt_pk_fp8_f32(v[i * 4 + 0].z * sc, v[i * 4 + 0].w * sc, w, true); o.x = (unsigned)w;
      w = __builtin_amdgcn_cvt_pk_fp8_f32(v[i * 4 + 1].x * sc, v[i * 4 + 1].y * sc, 0, false);
      w = __builtin_amdgcn_cvt_pk_fp8_f32(v[i * 4 + 1].z * sc, v[i * 4 + 1].w * sc, w, true); o.y = (unsigned)w;
      w = __builtin_amdgcn_cvt_pk_fp8_f32(v[i * 4 + 2].x * sc, v[i * 4 + 2].y * sc, 0, false);
      w = __builtin_amdgcn_cvt_pk_fp8_f32(v[i * 4 + 2].z * sc, v[i * 4 + 2].w * sc, w, true); o.z = (unsigned)w;
      w = __builtin_amdgcn_cvt_pk_fp8_f32(v[i * 4 + 3].x * sc, v[i * 4 + 3].y * sc, 0, false);
      w = __builtin_amdgcn_cvt_pk_fp8_f32(v[i * 4 + 3].z * sc, v[i * 4 + 3].w * sc, w, true); o.w = (unsigned)w;
      *(u4*)(dst + (size_t)row * D + i * 1024 + lane * 16) = o;
    }
    if (lane == 0) scl[row] = amax > 0.f ? amax * (1.f / 256.f) : 1.f;
  }
}

__device__ void sincos_d(double a, float& s, float& c) {
  double k = rint(a * 0.63661977236758134308);
  double r = a - k * 1.57079632679489661923;
  double r2 = r * r;
  double sn = r * (1.0 + r2 * (-1.0 / 6 + r2 * (1.0 / 120 + r2 * (-1.0 / 5040 + r2 * (1.0 / 362880 + r2 * (-1.0 / 39916800 + r2 * (1.0 / 6227020800.0)))))));
  double cs = 1.0 + r2 * (-0.5 + r2 * (1.0 / 24 + r2 * (-1.0 / 720 + r2 * (1.0 / 40320 + r2 * (-1.0 / 3628800 + r2 * (1.0 / 479001600.0))))));
  int q = ((int)k) & 3;
  double so = (q == 0) ? sn : (q == 1) ? cs : (q == 2) ? -sn : -cs;
  double co = (q == 0) ? cs : (q == 1) ? -sn : (q == 2) ? -cs : sn;
  s = (float)so; c = (float)co;
}

__device__ void phase0(const Params& p, char* smem) {
  const int tid = get_tid(), bid = get_bid(), nb = gridDim.x;
  float* fs = (float*)smem;
  if (bid == 0) {
    for (int e = tid; e < 128 * 16 + 128 * 32; e += NTHR) {
      int F, pos, f, base;
      if (e < 2048) { F = 16; pos = e >> 4; f = e & 15; base = 0; }
      else { int e2 = e - 2048; F = 32; pos = e2 >> 5; f = e2 & 31; base = 4096; }
      double bb = (F == 16) ? 0.56234132519034908 : 0.74989420933245582;
      double inv = 1.0;
      for (int i = 0; i < f; ++i) inv *= bb;
      float invf = (float)inv;
      float ang = (float)pos * invf;
      float sn, cs;
      sincos_d((double)ang, sn, cs);
      p.rope[base + pos * F + f] = cs;
      p.rope[base + 128 * F + pos * F + f] = sn;
    }
  }
  for (int it = bid; it < 384; it += nb) {
    int layer = it / 192, r = it % 192, kc = r / 6, nc = r % 6;
    __syncthreads();
    if (tid < 192) {
      int v = tid >> 6, kk = tid & 63;
      float cv = (v < 2) ? p.c[v * D + kc * 64 + kk] : p.c_ctx[kc * 64 + kk];
      fs[tid] = silu_f(cv);
    }
    __syncthreads();
    int n = nc * 2048 + tid * 4;
    float4 a0 = make_float4(0, 0, 0, 0), a1 = a0, a2 = a0;
    if (kc == 0) { a0 = *(const float4*)(p.b_ada + layer * 12288 + n); a1 = a0; a2 = a0; }
    const float* w = p.w_ada + (size_t)layer * D * 12288 + (size_t)(kc * 64) * 12288 + n;
#pragma unroll 8
    for (int kk = 0; kk < 64; ++kk) {
      float4 wv = *(const float4*)(w + (size_t)kk * 12288);
      float s0 = fs[kk], s1 = fs[64 + kk], s2 = fs[128 + kk];
      a0.x += s0 * wv.x; a0.y += s0 * wv.y; a0.z += s0 * wv.z; a0.w += s0 * wv.w;
      a1.x += s1 * wv.x; a1.y += s1 * wv.y; a1.z += s1 * wv.z; a1.w += s1 * wv.w;
      a2.x += s2 * wv.x; a2.y += s2 * wv.y; a2.z += s2 * wv.z; a2.w += s2 * wv.w;
    }
    float* m0 = p.mod + (layer * 3 + 0) * 12288 + n;
    float* m1 = p.mod + (layer * 3 + 1) * 12288 + n;
    float* m2 = p.mod + (layer * 3 + 2) * 12288 + n;
    atomicAdd(m0 + 0, a0.x); atomicAdd(m0 + 1, a0.y); atomicAdd(m0 + 2, a0.z); atomicAdd(m0 + 3, a0.w);
    atomicAdd(m1 + 0, a1.x); atomicAdd(m1 + 1, a1.y); atomicAdd(m1 + 2, a1.z); atomicAdd(m1 + 3, a1.w);
    atomicAdd(m2 + 0, a2.x); atomicAdd(m2 + 1, a2.y); atomicAdd(m2 + 2, a2.z); atomicAdd(m2 + 3, a2.w);
  }
  for (int layer = 0; layer < 2; ++layer) {
    for (int it = bid; it < 32 * 94; it += nb)
      transpose_cvt(p.w_in + (size_t)layer * D * DIN, D, DIN, DINP, p.wt_in + (size_t)layer * DINP * D, it, fs);
    for (int it = bid; it < 32 * 32; it += nb)
      transpose_cvt(p.w_out + (size_t)layer * D * D, D, D, D, p.wt_out + (size_t)layer * D * D, it, fs);
    for (int it = bid; it < 32 * 32; it += nb)
      transpose_cvt(p.w_q + (size_t)layer * D * D, D, D, D, p.wt_q + (size_t)layer * D * D, it, fs);
  }
  cvt_linear(p.sub_keys, p.sk_bf, (size_t)524288 / 8);
  cvt_fp8_rows(p.pu, p.u8, p.uscl, 2 * 16384);
  cvt_fp8_rows(p.pv, p.v8, p.vscl, 2 * 16384);
}

__device__ void modulate_phase(const Params& p, int layer, int which, int nrows) {
  const int lane = get_tid() & 63;
  const int wave = get_bid() * 8 + (get_tid() >> 6), nw = gridDim.x * 8;
  const float* g = (which == 0 ? p.g_attn : p.g_ffn) + layer * D;
  for (int m = wave; m < nrows; m += nw) {
    const float* src;
    if (layer == 0 && which == 0) src = (m < MX) ? p.x + (size_t)m * D : p.ctx + (size_t)(m - MX) * D;
    else src = p.xcur + (size_t)m * D;
    int vec = m < S ? 0 : (m < MX ? 1 : 2);
    const float* modl = p.mod + (layer * 3 + vec) * 12288 + which * 3 * D;
    float4 v[8];
    float ss = 0.f;
#pragma unroll
    for (int i = 0; i < 8; ++i) {
      v[i] = *(const float4*)(src + i * 256 + lane * 4);
      ss += v[i].x * v[i].x + v[i].y * v[i].y + v[i].z * v[i].z + v[i].w * v[i].w;
    }
    ss = wave_sum(ss);
    float rstd = rsqrtf(ss * (1.f / D) + EPS);
#pragma unroll
    for (int i = 0; i < 8; ++i) {
      int col = i * 256 + lane * 4;
      float4 gg = *(const float4*)(g + col);
      float4 sh = *(const float4*)(modl + col);
      float4 sc = *(const float4*)(modl + D + col);
      float y0 = v[i].x * rstd * gg.x * (1.f + sc.x) + sh.x;
      float y1 = v[i].y * rstd * gg.y * (1.f + sc.y) + sh.y;
      float y2 = v[i].z * rstd * gg.z * (1.f + sc.z) + sh.z;
      float y3 = v[i].w * rstd * gg.w * (1.f + sc.w) + sh.w;
      uint2 o; o.x = pack2(y0, y1); o.y = pack2(y2, y3);
      *(uint2*)(p.h + (size_t)m * D + col) = o;
    }
  }
}

template <int EPI, bool BIG>
__device__ void gemm_tile(const bfr* __restrict__ A, int lda, const bfr* __restrict__ Bt, int ldb, int K, int m0,
                          int n0, void* Cout, int ldc, const Params& p, int layer, char* smem) {
  constexpr int BN = BIG ? 256 : 128;
  constexpr int MI = BIG ? 8 : 4;
  constexpr int NBL = BN / 64;
  bfr* As0 = (bfr*)smem;
  bfr* Bs0 = As0 + 2 * 256 * 72;
  const int tid = get_tid(), lane = tid & 63, w = tid >> 6;
  const int wm = BIG ? (w >> 2) : (w >> 1), wn = BIG ? (w & 3) : (w & 1);
  const int fr = lane & 15, fq = lane >> 4;
  f32x4 acc[MI][4];
#pragma unroll
  for (int i = 0; i < MI; ++i)
#pragma unroll
    for (int j = 0; j < 4; ++j) acc[i][j] = (f32x4){0.f, 0.f, 0.f, 0.f};
  const int arow = tid >> 3, akc = (tid & 7) * 8;
  u4 rs[4];
  const bfr* Ap = A + (size_t)(m0 + arow) * lda + akc;
  const bfr* Bp = Bt + (size_t)(n0 + arow) * ldb + akc;
#pragma unroll
  for (int i = 0; i < 4; ++i) rs[i] = *(const u4*)(Ap + (size_t)(64 * i) * lda);
  __syncthreads();
#pragma unroll
  for (int i = 0; i < 4; ++i) *(u4*)(As0 + (arow + 64 * i) * 72 + akc) = rs[i];
#pragma unroll
  for (int i = 0; i < NBL; ++i) rs[i] = *(const u4*)(Bp + (size_t)(64 * i) * ldb);
#pragma unroll
  for (int i = 0; i < NBL; ++i) *(u4*)(Bs0 + (arow + 64 * i) * 72 + akc) = rs[i];
  const int nk = K >> 6;
  if (nk > 1) {
#pragma unroll
    for (int i = 0; i < 4; ++i) rs[i] = *(const u4*)(Ap + (size_t)(64 * i) * lda + 64);
  }
  __syncthreads();
  for (int kt = 0; kt < nk; ++kt) {
    const bfr* As = As0 + (kt & 1) * (256 * 72);
    const bfr* Bs = Bs0 + (kt & 1) * (BN * 72);
    bfr* Asn = As0 + ((kt + 1) & 1) * (256 * 72);
    bfr* Bsn = Bs0 + ((kt + 1) & 1) * (BN * 72);
#pragma unroll
    for (int kk = 0; kk < 2; ++kk) {
      bf16x8 b[4];
#pragma unroll
      for (int j = 0; j < 4; ++j) b[j] = *(const bf16x8*)(Bs + (wn * 64 + j * 16 + fr) * 72 + kk * 32 + fq * 8);
      {
        bf16x8 a_cur = *(const bf16x8*)(As + (wm * (MI * 16) + fr) * 72 + kk * 32 + fq * 8);
#pragma unroll
        for (int i = 0; i < MI; ++i) {
          bf16x8 a_nxt = a_cur;
          if (i + 1 < MI) a_nxt = *(const bf16x8*)(As + (wm * (MI * 16) + (i + 1) * 16 + fr) * 72 + kk * 32 + fq * 8);
#pragma unroll
          for (int j = 0; j < 4; ++j) acc[i][j] = __builtin_amdgcn_mfma_f32_16x16x32_bf16(b[j], a_cur, acc[i][j], 0, 0, 0);
          if (BIG) __builtin_amdgcn_sched_barrier(0);
          a_cur = a_nxt;
        }
      }
      if (kt + 1 < nk) {
        if (kk == 0) {
#pragma unroll
          for (int i = 0; i < 4; ++i) *(u4*)(Asn + (arow + 64 * i) * 72 + akc) = rs[i];
#pragma unroll
          for (int i = 0; i < NBL; ++i) rs[i] = *(const u4*)(Bp + (size_t)(64 * i) * ldb + (kt + 1) * 64);
        } else {
#pragma unroll
          for (int i = 0; i < NBL; ++i) *(u4*)(Bsn + (arow + 64 * i) * 72 + akc) = rs[i];
          if (kt + 2 < nk) {
#pragma unroll
            for (int i = 0; i < 4; ++i) rs[i] = *(const u4*)(Ap + (size_t)(64 * i) * lda + (kt + 2) * 64);
          }
        }
      }
    }
    __syncthreads();
  }
  const int nb0 = n0 + wn * 64 + fq * 4;
#pragma unroll
  for (int i = 0; i < MI; ++i) {
    const int m = m0 + wm * (MI * 16) + i * 16 + fr;
    if (EPI == 0) {
      bfr* crow = (bfr*)Cout + (size_t)m * ldc + nb0;
#pragma unroll
      for (int j = 0; j < 4; ++j) {
        uint2 o;
        o.x = pack2(acc[i][j][0], acc[i][j][1]); o.y = pack2(acc[i][j][2], acc[i][j][3]);
        *(uint2*)(crow + j * 16) = o;
      }
    } else if (EPI == 2) {
      float* crow = (float*)Cout + (size_t)m * ldc + nb0;
#pragma unroll
      for (int j = 0; j < 4; ++j) *(float4*)(crow + j * 16) = make_float4(acc[i][j][0], acc[i][j][1], acc[i][j][2], acc[i][j][3]);
    } else {
      const float* src;
      if (layer == 0) src = (m < MX) ? p.x + (size_t)m * D : p.ctx + (size_t)(m - MX) * D;
      else src = p.xcur + (size_t)m * D;
      src += nb0;
      const int vec = m < S ? 0 : (m < MX ? 1 : 2);
      const float* grow = p.mod + (layer * 3 + vec) * 12288 + 2 * D + nb0;
      float* orow = p.xcur + (size_t)m * D + nb0;
#pragma unroll
      for (int j = 0; j < 4; ++j) {
        const float4 gate = *(const float4*)(grow + j * 16);
        const float4 xs = *(const float4*)(src + j * 16);
        *(float4*)(orow + j * 16) = make_float4(xs.x + gate.x * acc[i][j][0], xs.y + gate.y * acc[i][j][1], xs.z + gate.z * acc[i][j][2], xs.w + gate.w * acc[i][j][3]);
      }
      __builtin_amdgcn_sched_barrier(0);
    }
  }
}

#define MFMA16(a, b, c) __builtin_amdgcn_mfma_f32_16x16x32_bf16((a), (b), (c), 0, 0, 0)
typedef __attribute__((ext_vector_type(4))) short s16x4;

__device__ __forceinline__ void load_kv_tile(bfr* dst, const bfr* src, int nrows, int tok0, int toklimit) {
  for (int c = get_tid(); c < nrows * 8; c += NTHR) {
    int r = c >> 3, ch = c & 7;
    int tok = tok0 + r;
    u4 v = (u4){0u, 0u, 0u, 0u};
    if (tok >= 0 && tok < toklimit) v = *(const u4*)(src + (ptrdiff_t)r * DINP + ch * 8);
    *(u4*)(dst + r * 72 + ch * 8) = v;
  }
}
__device__ __forceinline__ void load_vt_tile(bfr* Vt, int VS, const bfr* src, int nrows, int tok0, int toklimit) {
  for (int c = get_tid(); c < nrows * 8; c += NTHR) {
    int key = c % nrows, dch = c / nrows;
    int tok = tok0 + key;
    u4 v = (u4){0u, 0u, 0u, 0u};
    if (tok >= 0 && tok < toklimit) v = *(const u4*)(src + (ptrdiff_t)key * DINP + dch * 8);
    bfr* d = Vt + (dch * 8) * VS + key;
    d[0 * VS] = (bfr)(v.x & 0xffffu); d[1 * VS] = (bfr)(v.x >> 16);
    d[2 * VS] = (bfr)(v.y & 0xffffu); d[3 * VS] = (bfr)(v.y >> 16);
    d[4 * VS] = (bfr)(v.z & 0xffffu); d[5 * VS] = (bfr)(v.z >> 16);
    d[6 * VS] = (bfr)(v.w & 0xffffu); d[7 * VS] = (bfr)(v.w >> 16);
  }
}
__device__ __forceinline__ void load_kfrags(bf16x8 (&kf)[2][2], const bfr* Ks, int kt, int fr, int q4) {
#pragma unroll
  for (int blk = 0; blk < 2; ++blk)
#pragma unroll
    for (int ds = 0; ds < 2; ++ds) kf[blk][ds] = *(const bf16x8*)(Ks + (kt + blk * 16 + fr) * 72 + ds * 32 + q4 * 8);
}
__device__ __forceinline__ void load_vfrags(bf16x8 (&vf)[4], const bfr* Vt, int VS, int kt, int fr, int q4) {
#pragma unroll
  for (int db = 0; db < 4; ++db) {
    const bfr* vp = Vt + (db * 16 + fr) * VS + kt + q4 * 4;
    s16x4 lo = *(const s16x4*)vp, hi = *(const s16x4*)(vp + 16);
    vf[db] = __builtin_shufflevector(lo, hi, 0, 1, 2, 3, 4, 5, 6, 7);
  }
}
__device__ __forceinline__ void attn_tile_group(const bf16x8 (&kf)[2][2], const bf16x8 (&qf)[2], const bf16x8 (&vf)[4],
                                                f32x4 (&o)[4], float& m, float& l, const float (&badd)[8]) {
  f32x4 s0 = (f32x4){0.f, 0.f, 0.f, 0.f}, s1 = s0;
  s0 = MFMA16(kf[0][0], qf[0], s0); s0 = MFMA16(kf[0][1], qf[1], s0);
  s1 = MFMA16(kf[1][0], qf[0], s1); s1 = MFMA16(kf[1][1], qf[1], s1);
  float sv[8];
#pragma unroll
  for (int i = 0; i < 4; ++i) { sv[i] = s0[i] + badd[i]; sv[4 + i] = s1[i] + badd[4 + i]; }
  float mx = fmaxf(fmaxf(fmaxf(sv[0], sv[1]), fmaxf(sv[2], sv[3])), fmaxf(fmaxf(sv[4], sv[5]), fmaxf(sv[6], sv[7])));
  mx = fmaxf(mx, __shfl_xor(mx, 16));
  mx = fmaxf(mx, __shfl_xor(mx, 32));
  const float mn = fmaxf(m, mx);
  const float mref = (mn == -INFINITY) ? 0.f : mn;
  const float alpha = __expf(m - mref);
  float pv[8];
  float ls = 0.f;
#pragma unroll
  for (int i = 0; i < 8; ++i) { pv[i] = __expf(sv[i] - mref); ls += pv[i]; }
  ls += __shfl_xor(ls, 16);
  ls += __shfl_xor(ls, 32);
  l = l * alpha + ls;
  m = mn;
  u4 pk;
  pk.x = pack2(pv[0], pv[1]); pk.y = pack2(pv[2], pv[3]); pk.z = pack2(pv[4], pv[5]); pk.w = pack2(pv[6], pv[7]);
  const bf16x8 pb = __builtin_bit_cast(bf16x8, pk);
#pragma unroll
  for (int db = 0; db < 4; ++db) {
    o[db] *= alpha;
    o[db] = MFMA16(vf[db], pb, o[db]);
  }
}
__device__ __forceinline__ void load_qfrags(bf16x8 (&qf)[2], const bfr* qrow, int q4, float scale) {
#pragma unroll
  for (int ds = 0; ds < 2; ++ds) {
    u4 w = *(const u4*)(qrow + ds * 32 + q4 * 8);
    float f[8];
    unpack8(w, f);
    u4 o;
    o.x = pack2(f[0] * scale, f[1] * scale); o.y = pack2(f[2] * scale, f[3] * scale);
    o.z = pack2(f[4] * scale, f[5] * scale); o.w = pack2(f[6] * scale, f[7] * scale);
    qf[ds] = __builtin_bit_cast(bf16x8, o);
  }
}
__device__ __forceinline__ void store_ot(bfr* dst, const f32x4 (&o)[4], float inv, int q4) {
#pragma unroll
  for (int db = 0; db < 4; ++db) {
    uint2 w;
    w.x = pack2(o[db][0] * inv, o[db][1] * inv);
    w.y = pack2(o[db][2] * inv, o[db][3] * inv);
    *(uint2*)(dst + db * 16 + q4 * 4) = w;
  }
}

__device__ void swa_item(const Params& p, int layer, int item, char* smem) {
  const int b = item >> 7, kvh = (item >> 6) & 1, nbk = item & 63;
  bfr* Ks = (bfr*)smem;
  bfr* Vt = Ks + 384 * 72;
  constexpr int VS = 392;
  const int tid = get_tid();
  const int lane = tid & 63, w = tid >> 6, fr = lane & 15, q4 = lane >> 4;
  const float* cos16 = p.rope;
  const float* sin16 = p.rope + 2048;
  __syncthreads();
  const int tok0 = (nbk - 1) * 128;
  const bfr* rowbase = p.proj + (ptrdiff_t)(b * S + tok0) * DINP;
  load_vt_tile(Vt, VS, rowbase + C_SWV + kvh * 64, 384, tok0, S);
  for (int u = tid; u < 384 * 4; u += NTHR) {
    int r = u >> 2, A = (u >> 1) & 1, fc = u & 1;
    int tok = tok0 + r;
    u4 o1 = (u4){0u, 0u, 0u, 0u}, o2 = o1;
    if (tok >= 0 && tok < S) {
      const bfr* kp = rowbase + (ptrdiff_t)r * DINP + C_SWK + kvh * 64 + A * 32 + fc * 8;
      u4 w1 = *(const u4*)kp, w2 = *(const u4*)(kp + 16);
      float x1[8], x2[8], y1[8], y2[8];
      unpack8(w1, x1); unpack8(w2, x2);
      int pos = A ? (tok & 63) : (tok >> 6);
#pragma unroll
      for (int j = 0; j < 8; ++j) {
        float cs = cos16[pos * 16 + fc * 8 + j], sn = sin16[pos * 16 + fc * 8 + j];
        y1[j] = x1[j] * cs - x2[j] * sn;
        y2[j] = x2[j] * cs + x1[j] * sn;
      }
      o1.x = pack2(y1[0], y1[1]); o1.y = pack2(y1[2], y1[3]); o1.z = pack2(y1[4], y1[5]); o1.w = pack2(y1[6], y1[7]);
      o2.x = pack2(y2[0], y2[1]); o2.y = pack2(y2[2], y2[3]); o2.z = pack2(y2[4], y2[5]); o2.w = pack2(y2[6], y2[7]);
    }
    int ch1 = A * 4 + fc, ch2 = A * 4 + 2 + fc;
    *(u4*)(Ks + r * 72 + ch1 * 8) = o1;
    *(u4*)(Ks + r * 72 + ch2 * 8) = o2;
  }
  const int g = w >> 1, qhalf = w & 1;
  const int hq = kvh * 4 + g;
  bf16x8 qf[4][2];
  f32x4 oacc[4][4];
  float mm[4], ll[4];
#pragma unroll
  for (int grp = 0; grp < 4; ++grp) {
    const int tq = nbk * 128 + qhalf * 64 + grp * 16 + fr;
    const bfr* qrow = p.proj + (size_t)(b * S + tq) * DINP + C_SWQ + hq * 64;
#pragma unroll
    for (int ds = 0; ds < 2; ++ds) {
      u4 wq = *(const u4*)(qrow + ds * 32 + q4 * 8);
      float f[8], y[8];
      unpack8(wq, f);
      const int pos = ds ? (tq & 63) : (tq >> 6);
#pragma unroll
      for (int j = 0; j < 8; ++j) {
        const float other = __shfl_xor(f[j], 32);
        const int fi = (q4 & 1) * 8 + j;
        const float cs = cos16[pos * 16 + fi], sn = sin16[pos * 16 + fi];
        y[j] = ((q4 < 2) ? (f[j] * cs - other * sn) : (f[j] * cs + other * sn)) * 0.125f;
      }
      u4 o;
      o.x = pack2(y[0], y[1]); o.y = pack2(y[2], y[3]); o.z = pack2(y[4], y[5]); o.w = pack2(y[6], y[7]);
      qf[grp][ds] = __builtin_bit_cast(bf16x8, o);
    }
    mm[grp] = -INFINITY; ll[grp] = 0.f;
#pragma unroll
    for (int db = 0; db < 4; ++db) oacc[grp][db] = (f32x4){0.f, 0.f, 0.f, 0.f};
  }
  __syncthreads();
#pragma unroll 1
  for (int t = 0; t < 10; ++t) {
    const int kt = qhalf * 64 + 32 * t;
    if (tok0 + kt + 31 < 0 || tok0 + kt >= S) continue;
    bf16x8 kf[2][2], vf[4];
    load_kfrags(kf, Ks, kt, fr, q4);
    load_vfrags(vf, Vt, VS, kt, fr, q4);
#pragma unroll
    for (int grp = 0; grp < 4; ++grp) {
      const int qg0 = 128 + qhalf * 64 + grp * 16;
      if (kt > qg0 + 15 + 128 || kt + 31 < qg0 - 128) continue;
      const int qrow = qg0 + fr;
      float badd[8];
#pragma unroll
      for (int i = 0; i < 8; ++i) {
        const int lr = kt + (i >> 2) * 16 + q4 * 4 + (i & 3);
        const int dd = qrow - lr;
        const int tok = tok0 + lr;
        const bool ok = (dd <= 128) && (dd >= -128) && (tok >= 0) && (tok < S);
        badd[i] = ok ? 0.f : -INFINITY;
      }
      attn_tile_group(kf, qf[grp], vf, oacc[grp], mm[grp], ll[grp], badd);
    }
  }
  __syncthreads();
  const bfr* zbase = p.proj + (size_t)(MX + b * 256) * DINP;
  load_kv_tile(Ks, zbase + C_SWK + kvh * 64, 256, 0, 256);
  load_vt_tile(Vt, VS, zbase + C_SWV + kvh * 64, 256, 0, 256);
  __syncthreads();
  float zb[8];
#pragma unroll
  for (int i = 0; i < 8; ++i) zb[i] = 0.f;
#pragma unroll 1
  for (int t = 0; t < 8; ++t) {
    const int kt = 32 * t;
    bf16x8 kf[2][2], vf[4];
    load_kfrags(kf, Ks, kt, fr, q4);
    load_vfrags(vf, Vt, VS, kt, fr, q4);
#pragma unroll
    for (int grp = 0; grp < 4; ++grp) attn_tile_group(kf, qf[grp], vf, oacc[grp], mm[grp], ll[grp], zb);
  }
  const float sk = p.sink[layer * 8 + hq];
#pragma unroll
  for (int grp = 0; grp < 4; ++grp) {
    const int tq = nbk * 128 + qhalf * 64 + grp * 16 + fr;
    const float mn = fmaxf(mm[grp], sk);
    const float alpha = __expf(mm[grp] - mn);
    const float lt = ll[grp] * alpha + __expf(sk - mn);
    store_ot(p.mix + (size_t)(b * S + tq) * D + 1536 + hq * 64, oacc[grp], alpha / lt, q4);
  }
}

__device__ void na_item(const Params& p, int layer, int item, char* smem) {
  const int b = item >> 10, h = (item >> 7) & 7, r = item & 127;
  bfr* Ks = (bfr*)smem;
  bfr* Vt = Ks + 512 * 72;
  constexpr int VS = 520;
  float* rp = (float*)(Vt + 64 * VS);
  float* mg = (float*)smem;
  const int tid = get_tid();
  const int lane = tid & 63, w = tid >> 6, fr = lane & 15, q4 = lane >> 4;
  __syncthreads();
  int r0 = r - 4; r0 = r0 < 0 ? 0 : (r0 > 120 ? 120 : r0);
  const bfr* rowbase = p.proj + (size_t)(b * S + r0 * 64) * DINP;
  load_kv_tile(Ks, rowbase + C_NAK + h * 64, 512, 0, 512);
  load_vt_tile(Vt, VS, rowbase + C_NAV + h * 64, 512, 0, 512);
  if (tid < 15 * 31) rp[tid] = p.rpb[(layer * 8 + h) * 465 + tid];
  const int grp = w >> 1, half = w & 1;
  const int cq = grp * 16 + fr;
  const int tq = r * 64 + cq;
  bf16x8 qf[2];
  load_qfrags(qf, p.proj + (size_t)(b * S + tq) * DINP + C_NAQ + h * 64, q4, 0.125f);
  f32x4 oacc[4];
#pragma unroll
  for (int db = 0; db < 4; ++db) oacc[db] = (f32x4){0.f, 0.f, 0.f, 0.f};
  float m = -INFINITY, l = 0.f;
  __syncthreads();
  int cs = cq - 8; cs = cs < 0 ? 0 : (cs > 48 ? 48 : cs);
  const int tstart = grp == 0 ? 0 : (grp == 1 ? 8 : (grp == 2 ? 24 : 32));
#pragma unroll 1
  for (int jj = 0; jj < 4; ++jj) {
    const int jrow = half * 4 + jj;
    const int drow = (r0 + jrow) - r + 7;
    const int kt = jrow * 64 + tstart;
    bf16x8 kf[2][2], vf[4];
    load_kfrags(kf, Ks, kt, fr, q4);
    load_vfrags(vf, Vt, VS, kt, fr, q4);
    float badd[8];
#pragma unroll
    for (int i = 0; i < 8; ++i) {
      const int ck = tstart + (i >> 2) * 16 + q4 * 4 + (i & 3);
      const bool ok = (ck >= cs) && (ck < cs + 16);
      int dc = ck - cq + 15; dc = dc < 0 ? 0 : (dc > 30 ? 30 : dc);
      badd[i] = ok ? rp[drow * 31 + dc] : -INFINITY;
    }
    attn_tile_group(kf, qf, vf, oacc, m, l, badd);
  }
  __syncthreads();
  const bfr* zbase = p.proj + (size_t)(MX + b * 256) * DINP;
  load_kv_tile(Ks, zbase + C_NAK + h * 64, 256, 0, 256);
  load_vt_tile(Vt, VS, zbase + C_NAV + h * 64, 256, 0, 256);
  __syncthreads();
  float zb[8];
#pragma unroll
  for (int i = 0; i < 8; ++i) zb[i] = 0.f;
#pragma unroll 1
  for (int t = 0; t < 4; ++t) {
    const int kt = half * 128 + 32 * t;
    bf16x8 kf[2][2], vf[4];
    load_kfrags(kf, Ks, kt, fr, q4);
    load_vfrags(vf, Vt, VS, kt, fr, q4);
    attn_tile_group(kf, qf, vf, oacc, m, l, zb);
  }
  __syncthreads();
  float* mo = mg + grp * (16 * 64 + 64) ;
  if (half == 1) {
#pragma unroll
    for (int db = 0; db < 4; ++db)
#pragma unroll
      for (int i = 0; i < 4; ++i) mo[(db * 4 + i) * 64 + lane] = oacc[db][i];
    if (q4 == 0) { mo[16 * 64 + fr] = m; mo[16 * 64 + 16 + fr] = l; }
  }
  __syncthreads();
  if (half == 0) {
    const float m2 = mo[16 * 64 + fr], l2 = mo[16 * 64 + 16 + fr];
    const float mn = fmaxf(m, m2);
    const float a1 = __expf(m - mn), a2 = __expf(m2 - mn);
    const float lt = l * a1 + l2 * a2;
    const float i1 = a1 / lt, i2 = a2 / lt;
#pragma unroll
    for (int db = 0; db < 4; ++db)
#pragma unroll
      for (int i = 0; i < 4; ++i) oacc[db][i] = oacc[db][i] * i1 + mo[(db * 4 + i) * 64 + lane] * i2;
    store_ot(p.mix + (size_t)(b * S + tq) * D + h * 64, oacc, 1.f, q4);
  }
}

__device__ void ctx_item(const Params& p, int layer, int item, char* smem) {
  const int b = item >> 4, type = (item >> 3) & 1, h = item & 7;
  bfr* Ks = (bfr*)smem;
  bfr* Vt = Ks + 256 * 72;
  constexpr int VS = 264;
  const int tid = get_tid();
  const int lane = tid & 63, w = tid >> 6, fr = lane & 15, q4 = lane >> 4;
  __syncthreads();
  const bfr* zbase = p.proj + (size_t)(MX + b * 256) * DINP;
  const int kcol = type ? (C_SWK + (h >> 2) * 64) : (C_NAK + h * 64);
  const int vcol = type ? (C_SWV + (h >> 2) * 64) : (C_NAV + h * 64);
  const int qcol = type ? (C_SWQ + h * 64) : (C_NAQ + h * 64);
  load_kv_tile(Ks, zbase + kcol, 256, 0, 256);
  load_vt_tile(Vt, VS, zbase + vcol, 256, 0, 256);
  bf16x8 qf[2][2];
  f32x4 oacc[2][4];
  float mm[2], ll[2];
#pragma unroll
  for (int grp = 0; grp < 2; ++grp) {
    const int qz = w * 32 + grp * 16 + fr;
    load_qfrags(qf[grp], zbase + (size_t)qz * DINP + qcol, q4, 0.125f);
    mm[grp] = -INFINITY; ll[grp] = 0.f;
#pragma unroll
    for (int db = 0; db < 4; ++db) oacc[grp][db] = (f32x4){0.f, 0.f, 0.f, 0.f};
  }
  __syncthreads();
  float zb[8];
#pragma unroll
  for (int i = 0; i < 8; ++i) zb[i] = 0.f;
#pragma unroll 1
  for (int t = 0; t < 8; ++t) {
    const int kt = 32 * t;
    bf16x8 kf[2][2], vf[4];
    load_kfrags(kf, Ks, kt, fr, q4);
    load_vfrags(vf, Vt, VS, kt, fr, q4);
#pragma unroll
    for (int grp = 0; grp < 2; ++grp) attn_tile_group(kf, qf[grp], vf, oacc[grp], mm[grp], ll[grp], zb);
  }
#pragma unroll
  for (int grp = 0; grp < 2; ++grp) {
    const int qz = w * 32 + grp * 16 + fr;
    float inv;
    if (type == 1) {
      const float sk = p.sink[layer * 8 + h];
      const float mn = fmaxf(mm[grp], sk);
      const float a = __expf(mm[grp] - mn);
      inv = a / (ll[grp] * a + __expf(sk - mn));
    } else {
      inv = 1.f / ll[grp];
    }
    store_ot(p.mix + (size_t)(MX + b * 256 + qz) * D + (type ? 1536 : 0) + h * 64, oacc[grp], inv, q4);
  }
}

template <int W>
__device__ __forceinline__ void load_rows_f32(float* dst, int stride, const bfr* src, float scale) {
  constexpr int CPR = W / 8;
  for (int c = get_tid(); c < 64 * CPR; c += NTHR) {
    int j = c / CPR, ch = c % CPR;
    u4 w = *(const u4*)(src + (size_t)j * DINP + ch * 8);
    float f[8];
    unpack8(w, f);
    float4 a = make_float4(f[0] * scale, f[1] * scale, f[2] * scale, f[3] * scale);
    float4 bq = make_float4(f[4] * scale, f[5] * scale, f[6] * scale, f[7] * scale);
    *(float4*)(dst + j * stride + ch * 8) = a;
    *(float4*)(dst + j * stride + ch * 8 + 4) = bq;
  }
}

__device__ __forceinline__ void rope128_tile(float* t, int stride, int prow, const float* rope, float scale) {
  const float* cos32 = rope + 4096;
  const float* sin32 = rope + 8192;
  for (int u = get_tid(); u < 64 * 64; u += NTHR) {
    int j = u >> 6, A = (u >> 5) & 1, f = u & 31;
    int pos = A ? j : prow;
    float cs = cos32[pos * 32 + f], sn = sin32[pos * 32 + f];
    float x1 = t[j * stride + A * 64 + f], x2 = t[j * stride + A * 64 + 32 + f];
    t[j * stride + A * 64 + f] = (x1 * cs - x2 * sn) * scale;
    t[j * stride + A * 64 + 32 + f] = (x2 * cs + x1 * sn) * scale;
  }
}

__device__ __forceinline__ void gla_logdecay(const Params& p, int layer, int h, int dir, const bfr* rowbase, float* G) {
  const int tid = get_tid();
  const int j = tid >> 3, dg = tid & 7;
  const bfr* dl = rowbase + (size_t)j * DINP + C_GLD + dir * 16;
  u4 w0 = *(const u4*)dl, w1 = *(const u4*)(dl + 8);
  float x[16];
  unpack8(w0, x); unpack8(w1, x + 8);
  const float* wu = p.gla_wu + (size_t)layer * 8192 + dir * 4096 + h * 64;
  const float* bb = p.gla_b + layer * 512 + dir * 256 + h * 64;
#pragma unroll
  for (int dd = 0; dd < 8; ++dd) {
    int d = dg + 8 * dd;
    float pre = bb[d];
#pragma unroll
    for (int r = 0; r < 16; ++r) pre += x[r] * wu[r * 256 + d];
    G[j * 68 + d] = logsig_f(pre) * (1.f / 16.f);
  }
}

__device__ __forceinline__ void gla_logdecay2(const Params& p, int layer, int h, const bfr* rowbase, float* G0, float* G1) {
  const int tid = get_tid();
  const int w = tid >> 6, lane = tid & 63, fr = lane & 15, q4 = lane >> 4;
  const int dir = w >> 2, dt = w & 3;
  const int d = dt * 16 + fr;
  float* G = dir ? G1 : G0;
  u4 bw = (u4){0u, 0u, 0u, 0u};
  if (q4 < 2) {
    const float* wu = p.gla_wu + (size_t)layer * 8192 + dir * 4096 + (q4 * 8) * 256 + h * 64 + d;
    bw.x = pack2(wu[0 * 256], wu[1 * 256]); bw.y = pack2(wu[2 * 256], wu[3 * 256]);
    bw.z = pack2(wu[4 * 256], wu[5 * 256]); bw.w = pack2(wu[6 * 256], wu[7 * 256]);
  }
  const bf16x8 bq = __builtin_bit_cast(bf16x8, bw);
  const float bias = p.gla_b[layer * 512 + dir * 256 + h * 64 + d];
#pragma unroll
  for (int rt = 0; rt < 4; ++rt) {
    u4 aw = (u4){0u, 0u, 0u, 0u};
    if (q4 < 2) aw = *(const u4*)(rowbase + (size_t)(rt * 16 + fr) * DINP + C_GLD + dir * 16 + q4 * 8);
    f32x4 acc = (f32x4){0.f, 0.f, 0.f, 0.f};
    acc = MFMA16(__builtin_bit_cast(bf16x8, aw), bq, acc);
#pragma unroll
    for (int r = 0; r < 4; ++r) G[(rt * 16 + q4 * 4 + r) * 68 + d] = logsig_f(acc[r] + bias) * (1.f / 16.f);
  }
}

__device__ __forceinline__ int scan_pos(int dir, int g) { return dir == 0 ? g : (g < 4 ? 3 - g : 135 - g); }
__device__ __forceinline__ int group_row0(int b, int g) { return g < 4 ? (MX + b * 256 + g * 64) : (b * S + (g - 4) * 64); }

template <int W>
__device__ __forceinline__ void load_rows_transposed(bfr* T, const bfr* src) {
  for (int c = get_tid(); c < 64 * (W / 8); c += NTHR) {
    const int j = c & 63, dch = c >> 6;
    const u4 v = *(const u4*)(src + (size_t)j * DINP + dch * 8);
    bfr* d = T + (dch * 8) * 72 + j;
    d[0 * 72] = (bfr)(v.x & 0xffffu); d[1 * 72] = (bfr)(v.x >> 16);
    d[2 * 72] = (bfr)(v.y & 0xffffu); d[3 * 72] = (bfr)(v.y >> 16);
    d[4 * 72] = (bfr)(v.z & 0xffffu); d[5 * 72] = (bfr)(v.z >> 16);
    d[6 * 72] = (bfr)(v.w & 0xffffu); d[7 * 72] = (bfr)(v.w >> 16);
  }
}

template <int DK, bool GLA>
__device__ void scan_a_item(const Params& p, int layer, int item, char* smem) {
  const int g = item % 132;
  const int t2 = item / 132;
  const int h = t2 & 3, b = t2 >> 2;
  constexpr int KS = DK + 4;
  float* ks = (float*)smem;
  float* E0 = ks + 64 * KS;
  float* E1 = E0 + 64 * 68;
  bfr* Kt = (bfr*)(E1 + 64 * 68);
  bfr* Vt = Kt + DK * 72;
  const int tid = get_tid();
  const int w = tid >> 6, lane = tid & 63, fr = lane & 15, q4 = lane >> 4;
  const int row0 = group_row0(b, g);
  const bfr* rowbase = p.proj + (size_t)row0 * DINP;
  __syncthreads();
  if (GLA) {
    load_rows_transposed<128>(Vt, rowbase + C_GLV + h * 128);
    load_rows_f32<64>(ks, KS, rowbase + C_GLK + h * 64, 1.f);
    gla_logdecay2(p, layer, h, rowbase, E0, E1);
  } else {
    const float kscale = 0.08838834764831845f;
    load_rows_transposed<128>(Vt, rowbase + C_RTV + h * 128);
    load_rows_f32<128>(ks, KS, rowbase + C_RTK + h * 128, g < 4 ? kscale : 1.f);
    __syncthreads();
    if (g >= 4) rope128_tile(ks, KS, g - 4, p.rope, kscale);
  }
#pragma unroll 1
  for (int dir = 0; dir < 2; ++dir) {
    const int scan = ((b * 4 + h) * 2 + dir);
    const int pos = scan_pos(dir, g);
    float lg = 0.f;
    __syncthreads();
    float* E = dir ? E1 : E0;
    if (GLA) {
      if (tid < 64) {
        float run = 0.f;
        if (dir == 0) {
          for (int j = 63; j >= 0; --j) { float v = E[j * 68 + tid]; E[j * 68 + tid] = run; run += v; }
        } else {
          for (int j = 0; j < 64; ++j) { float v = E[j * 68 + tid]; E[j * 68 + tid] = run; run += v; }
        }
        p.dec_gla[(size_t)(scan * 132 + pos) * 64 + tid] = __expf(run);
      }
      __syncthreads();
    } else {
      lg = p.ret_lg[layer * 8 + dir * 4 + h];
      if (tid < 128) p.dec_ret[(size_t)(scan * 132 + pos) * 128 + tid] = __expf(lg * 64.f);
    }
    for (int u = tid; u < 64 * DK; u += NTHR) {
      const int j = u & 63, d = u >> 6;
      const float sc = GLA ? __expf(E[j * 68 + d]) : __expf(lg * (dir == 0 ? (float)(63 - j) : (float)j));
      Kt[d * 72 + j] = f2bf(ks[j * KS + d] * sc);
    }
    __syncthreads();
    bf16x8 vfr[2];
#pragma unroll
    for (int k2 = 0; k2 < 2; ++k2) vfr[k2] = *(const bf16x8*)(Vt + (w * 16 + fr) * 72 + k2 * 32 + q4 * 8);
    bfr* st = (GLA ? p.st_gla : p.st_ret) + (size_t)(scan * 132 + pos) * DK * 128;
#pragma unroll 2
    for (int dt = 0; dt < DK / 16; ++dt) {
      f32x4 acc = (f32x4){0.f, 0.f, 0.f, 0.f};
#pragma unroll
      for (int k2 = 0; k2 < 2; ++k2) {
        const bf16x8 kq = *(const bf16x8*)(Kt + (dt * 16 + fr) * 72 + k2 * 32 + q4 * 8);
        acc = MFMA16(kq, vfr[k2], acc);
      }
      uint2 o;
      o.x = pack2(acc[0], acc[1]); o.y = pack2(acc[2], acc[3]);
      *(uint2*)(st + (size_t)(w * 16 + fr) * DK + dt * 16 + q4 * 4) = o;
    }
  }
}

__device__ void scan_b_phase(const Params& p) {
  const int gt = get_bid() * NTHR + get_tid(), ntot = gridDim.x * NTHR;
  for (int ch = gt; ch < 98304; ch += ntot) {
    bfr* st; const float* dec; int DK, e4;
    if (ch < 65536) { int scan = ch >> 12; e4 = ch & 4095; DK = 128; st = p.st_ret + (size_t)scan * 132 * 16384; dec = p.dec_ret + (size_t)scan * 132 * 128; }
    else { int c2 = ch - 65536; int scan = c2 >> 11; e4 = c2 & 2047; DK = 64; st = p.st_gla + (size_t)scan * 132 * 8192; dec = p.dec_gla + (size_t)scan * 132 * 64; }
    const int d0 = (e4 * 4) & (DK - 1);
    const size_t cstride = (size_t)DK * 128;
    float4 s = make_float4(0.f, 0.f, 0.f, 0.f);
    bfr* ptr = st + e4 * 4;
    const float* dp = dec + d0;
    for (int pos = 0; pos < 132; pos += 4) {
      uint2 u[4];
      float4 dv[4];
#pragma unroll
      for (int q = 0; q < 4; ++q) {
        u[q] = *(const uint2*)(ptr + (size_t)(pos + q) * cstride);
        dv[q] = *(const float4*)(dp + (pos + q) * DK);
      }
#pragma unroll
      for (int q = 0; q < 4; ++q) {
        uint2 o;
        o.x = pack2(s.x, s.y); o.y = pack2(s.z, s.w);
        *(uint2*)(ptr + (size_t)(pos + q) * cstride) = o;
        s = make_float4(dv[q].x * s.x + lo16(u[q].x), dv[q].y * s.y + hi16(u[q].x), dv[q].z * s.z + lo16(u[q].y), dv[q].w * s.w + hi16(u[q].y));
      }
    }
  }
}

template <int DK, bool GLA>
__device__ void scan_c_item(const Params& p, int layer, int item, char* smem) {
  const int g = item % 132;
  const int t2 = item / 132;
  const int h = t2 & 3, b = t2 >> 2;
  constexpr int FS = DK + 4;
  constexpr int QS = DK + 8;
  float* stg = (float*)smem;
  float* Gf = stg + 64 * FS;
  float* Gb = Gf + (GLA ? 64 * 68 : 0);
  float* red = Gb + (GLA ? 64 * 68 : 0);
  float* red2 = red + 8 * 64 * 2;
  bfr* T0 = (bfr*)(red2 + 64 * 2);
  bfr* T1 = T0 + 64 * QS;
  bfr* T2 = T1 + 64 * QS;
  bfr* T3 = T2 + 64 * QS;
  bfr* T4 = T3 + 64 * QS;
  bfr* T5 = T4 + (GLA ? 64 * QS : 0);
  bfr* Vt = T5 + (GLA ? 64 * QS : 0);
  bfr* Am = Vt + 128 * 72;
  const int tid = get_tid();
  const int w = tid >> 6, lane = tid & 63, fr = lane & 15, q4 = lane >> 4;
  const int row0 = group_row0(b, g);
  const bfr* rowbase = p.proj + (size_t)row0 * DINP;
  float lgf = 0.f, lgb = 0.f;
  __syncthreads();
  if (GLA) {
    load_rows_transposed<128>(Vt, rowbase + C_GLV + h * 128);
    load_rows_f32<64>(stg, FS, rowbase + C_GLQ + h * 64, 0.125f);
    gla_logdecay2(p, layer, h, rowbase, Gf, Gb);
    __syncthreads();
    {
      const int d = tid & 63, seg = tid >> 6;
      float runf = 0.f, runb = 0.f;
#pragma unroll
      for (int jj = 0; jj < 8; ++jj) {
        const int jf = seg * 8 + jj, jb = seg * 8 + 7 - jj;
        runf += Gf[jf * 68 + d]; Gf[jf * 68 + d] = runf;
        runb += Gb[jb * 68 + d]; Gb[jb * 68 + d] = runb;
      }
      red[seg * 64 + d] = runf;
      red[512 + seg * 64 + d] = runb;
      __syncthreads();
      float offf = 0.f, offb = 0.f;
#pragma unroll
      for (int s2 = 0; s2 < 8; ++s2) {
        if (s2 < seg) offf += red[s2 * 64 + d];
        if (s2 > seg) offb += red[512 + s2 * 64 + d];
      }
#pragma unroll
      for (int jj = 0; jj < 8; ++jj) {
        const int j = seg * 8 + jj;
        Gf[j * 68 + d] += offf;
        Gb[j * 68 + d] += offb;
      }
    }
    __syncthreads();
    for (int u = tid; u < 64 * 64; u += NTHR) {
      const int i = u >> 6, d = u & 63;
      const float qv = stg[i * FS + d];
      const float gf = Gf[i * 68 + d], gb = Gb[i * 68 + d];
      T0[i * QS + d] = f2bf(qv * __expf(gf - Gf[63 * 68 + d]));
      T2[i * QS + d] = f2bf(qv * __expf(gf));
      T4[i * QS + d] = f2bf(qv * __expf(gb - Gb[d]));
      T3[i * QS + d] = f2bf(qv * __expf(gb));
    }
    __syncthreads();
    load_rows_f32<64>(stg, FS, rowbase + C_GLK + h * 64, 1.f);
    __syncthreads();
    for (int u = tid; u < 64 * 64; u += NTHR) {
      const int j = u >> 6, d = u & 63;
      const float kv = stg[j * FS + d];
      T1[j * QS + d] = f2bf(kv * __expf(Gf[63 * 68 + d] - Gf[j * 68 + d]));
      T5[j * QS + d] = f2bf(kv * __expf(Gb[d] - Gb[j * 68 + d]));
    }
  } else {
    const float kscale = 0.08838834764831845f;
    lgf = p.ret_lg[layer * 8 + 0 + h];
    lgb = p.ret_lg[layer * 8 + 4 + h];
    load_rows_transposed<128>(Vt, rowbase + C_RTV + h * 128);
    {
      const int j = tid >> 3, A = (tid >> 2) & 1, fc = tid & 3;
      float cs[8], sn[8];
      if (g >= 4) {
        const int pos = A ? j : (g - 4);
        const float* cp = p.rope + 4096 + pos * 32 + fc * 8;
        const float4 c0 = *(const float4*)cp, c1 = *(const float4*)(cp + 4);
        const float4 s0 = *(const float4*)(cp + 4096), s1 = *(const float4*)(cp + 4100);
        cs[0] = c0.x; cs[1] = c0.y; cs[2] = c0.z; cs[3] = c0.w; cs[4] = c1.x; cs[5] = c1.y; cs[6] = c1.z; cs[7] = c1.w;
        sn[0] = s0.x; sn[1] = s0.y; sn[2] = s0.z; sn[3] = s0.w; sn[4] = s1.x; sn[5] = s1.y; sn[6] = s1.z; sn[7] = s1.w;
      } else {
#pragma unroll
        for (int e = 0; e < 8; ++e) { cs[e] = 1.f; sn[e] = 0.f; }
      }
      const int col = A * 64 + fc * 8;
      const bfr* qp = rowbase + (size_t)j * DINP + C_RTQ + h * 128 + col;
      const bfr* kp = rowbase + (size_t)j * DINP + C_RTK + h * 128 + col;
      const u4 q1 = *(const u4*)qp, q2 = *(const u4*)(qp + 32);
      const u4 k1 = *(const u4*)kp, k2w = *(const u4*)(kp + 32);
      float x1[8], x2[8], y1[8], y2[8];
      unpack8(q1, x1); unpack8(q2, x2);
#pragma unroll
      for (int e = 0; e < 8; ++e) { y1[e] = x1[e] * cs[e] - x2[e] * sn[e]; y2[e] = x2[e] * cs[e] + x1[e] * sn[e]; }
      const float ff = __expf(lgf * (float)(j + 1)), fb = __expf(lgb * (float)(64 - j));
      u4 o;
      o.x = pack2(y1[0], y1[1]); o.y = pack2(y1[2], y1[3]); o.z = pack2(y1[4], y1[5]); o.w = pack2(y1[6], y1[7]);
      *(u4*)(T0 + j * QS + col) = o;
      o.x = pack2(y2[0], y2[1]); o.y = pack2(y2[2], y2[3]); o.z = pack2(y2[4], y2[5]); o.w = pack2(y2[6], y2[7]);
      *(u4*)(T0 + j * QS + col + 32) = o;
      o.x = pack2(y1[0] * ff, y1[1] * ff); o.y = pack2(y1[2] * ff, y1[3] * ff); o.z = pack2(y1[4] * ff, y1[5] * ff); o.w = pack2(y1[6] * ff, y1[7] * ff);
      *(u4*)(T2 + j * QS + col) = o;
      o.x = pack2(y2[0] * ff, y2[1] * ff); o.y = pack2(y2[2] * ff, y2[3] * ff); o.z = pack2(y2[4] * ff, y2[5] * ff); o.w = pack2(y2[6] * ff, y2[7] * ff);
      *(u4*)(T2 + j * QS + col + 32) = o;
      o.x = pack2(y1[0] * fb, y1[1] * fb); o.y = pack2(y1[2] * fb, y1[3] * fb); o.z = pack2(y1[4] * fb, y1[5] * fb); o.w = pack2(y1[6] * fb, y1[7] * fb);
      *(u4*)(T3 + j * QS + col) = o;
      o.x = pack2(y2[0] * fb, y2[1] * fb); o.y = pack2(y2[2] * fb, y2[3] * fb); o.z = pack2(y2[4] * fb, y2[5] * fb); o.w = pack2(y2[6] * fb, y2[7] * fb);
      *(u4*)(T3 + j * QS + col + 32) = o;
      unpack8(k1, x1); unpack8(k2w, x2);
#pragma unroll
      for (int e = 0; e < 8; ++e) { y1[e] = (x1[e] * cs[e] - x2[e] * sn[e]) * kscale; y2[e] = (x2[e] * cs[e] + x1[e] * sn[e]) * kscale; }
      o.x = pack2(y1[0], y1[1]); o.y = pack2(y1[2], y1[3]); o.z = pack2(y1[4], y1[5]); o.w = pack2(y1[6], y1[7]);
      *(u4*)(T1 + j * QS + col) = o;
      o.x = pack2(y2[0], y2[1]); o.y = pack2(y2[2], y2[3]); o.z = pack2(y2[4], y2[5]); o.w = pack2(y2[6], y2[7]);
      *(u4*)(T1 + j * QS + col + 32) = o;
    }
  }
  __syncthreads();
  {
    const int ti = w >> 1;
#pragma unroll
    for (int tt = 0; tt < 2; ++tt) {
      const int tj = (w & 1) * 2 + tt;
      f32x4 af = (f32x4){0.f, 0.f, 0.f, 0.f}, ab = af;
#pragma unroll
      for (int k2 = 0; k2 < DK / 32; ++k2) {
        const bf16x8 a = *(const bf16x8*)(T0 + (ti * 16 + fr) * QS + k2 * 32 + q4 * 8);
        const bf16x8 bq = *(const bf16x8*)(T1 + (tj * 16 + fr) * QS + k2 * 32 + q4 * 8);
        af = MFMA16(a, bq, af);
        if (GLA) {
          const bf16x8 a2 = *(const bf16x8*)(T4 + (ti * 16 + fr) * QS + k2 * 32 + q4 * 8);
          const bf16x8 b2 = *(const bf16x8*)(T5 + (tj * 16 + fr) * QS + k2 * 32 + q4 * 8);
          ab = MFMA16(a2, b2, ab);
        }
      }
#pragma unroll
      for (int r = 0; r < 4; ++r) {
        const int i = ti * 16 + q4 * 4 + r, j = tj * 16 + fr;
        float v;
        if (GLA) v = (j <= i) ? af[r] : ab[r];
        else v = af[r] * ((j <= i) ? __expf(lgf * (float)(i - j)) : __expf(lgb * (float)(j - i)));
        Am[i * 72 + j] = f2bf(v);
      }
    }
  }
  __syncthreads();
  f32x4 acc[4];
#pragma unroll
  for (int rt = 0; rt < 4; ++rt) acc[rt] = (f32x4){0.f, 0.f, 0.f, 0.f};
#pragma unroll
  for (int k2 = 0; k2 < 2; ++k2) {
    const bf16x8 bq = *(const bf16x8*)(Vt + (w * 16 + fr) * 72 + k2 * 32 + q4 * 8);
#pragma unroll
    for (int rt = 0; rt < 4; ++rt) {
      const bf16x8 a = *(const bf16x8*)(Am + (rt * 16 + fr) * 72 + k2 * 32 + q4 * 8);
      acc[rt] = MFMA16(a, bq, acc[rt]);
    }
  }
#pragma unroll
  for (int dir = 0; dir < 2; ++dir) {
    const int scan = (b * 4 + h) * 2 + dir;
    const int pos = scan_pos(dir, g);
    const bfr* St = (GLA ? p.st_gla : p.st_ret) + (size_t)(scan * 132 + pos) * DK * 128 + (size_t)(w * 16 + fr) * DK + q4 * 8;
    const bfr* qt = dir == 0 ? T2 : T3;
#pragma unroll
    for (int k2 = 0; k2 < DK / 32; ++k2) {
      const bf16x8 bq = *(const bf16x8*)(St + k2 * 32);
#pragma unroll
      for (int rt = 0; rt < 4; ++rt) {
        const bf16x8 a = *(const bf16x8*)(qt + (rt * 16 + fr) * QS + k2 * 32 + q4 * 8);
        acc[rt] = MFMA16(a, bq, acc[rt]);
      }
    }
  }
#pragma unroll
  for (int rt = 0; rt < 4; ++rt)
#pragma unroll
    for (int r = 0; r < 4; ++r) {
      float s1 = acc[rt][r], s2 = s1 * s1;
#pragma unroll
      for (int of = 8; of; of >>= 1) { s1 += __shfl_xor(s1, of); s2 += __shfl_xor(s2, of); }
      if (fr == 0) {
        const int i = rt * 16 + q4 * 4 + r;
        red[(w * 64 + i) * 2 + 0] = s1;
        red[(w * 64 + i) * 2 + 1] = s2;
      }
    }
  __syncthreads();
  if (tid < 128) {
    const int i = tid >> 1, c = tid & 1;
    float t = 0.f;
#pragma unroll
    for (int ww = 0; ww < 8; ++ww) t += red[(ww * 64 + i) * 2 + c];
    red2[i * 2 + c] = t;
  }
  __syncthreads();
  const int gcol = GLA ? C_GLG : C_RTG;
  const int ocol = GLA ? 1024 : 512;
  const int vcol = h * 128 + w * 16 + fr;
  const float gg = GLA ? p.gla_g[layer * 128 + w * 16 + fr] : 1.f;
#pragma unroll
  for (int rt = 0; rt < 4; ++rt)
#pragma unroll
    for (int r = 0; r < 4; ++r) {
      const int i = rt * 16 + q4 * 4 + r;
      const float S1 = red2[i * 2 + 0], S2 = red2[i * 2 + 1];
      float y;
      if (GLA) {
        y = acc[rt][r] * rsqrtf(S2 * (1.f / 128.f) + EPS) * gg;
      } else {
        const float mu = S1 * (1.f / 128.f);
        const float var = fmaxf(S2 * (1.f / 128.f) - mu * mu, 0.f);
        y = (acc[rt][r] - mu) * rsqrtf(var + EPS);
      }
      const int row = row0 + i;
      const float gt = bf2f(p.proj[(size_t)row * DINP + gcol + vcol]);
      y *= silu_f(gt);
      p.mix[(size_t)row * D + ocol + vcol] = f2bf(y);
    }
}

__constant__ unsigned char c_cand_tab[64] = {0, 1, 2, 3, 4, 5, 6, 7, 8, 9, 10, 11, 12, 13, 14, 15, 16, 17, 18, 19, 20, 21, 22, 23, 32, 33, 34, 35, 36, 48, 49, 50, 51, 64, 65, 66, 80, 81, 96, 97, 112, 113, 128, 144, 160, 176, 192, 208, 224, 240, 255, 255, 255, 255, 255, 255, 255, 255, 255, 255, 255, 255, 255, 255};

template <int N>
__device__ __forceinline__ void bitonic_sort_desc(float (&v)[N]) {
#pragma unroll
  for (int k = 2; k <= N; k <<= 1)
#pragma unroll
    for (int j = k >> 1; j > 0; j >>= 1)
#pragma unroll
      for (int i = 0; i < N; ++i) {
        const int l = i ^ j;
        if (l > i) {
          const bool desc = ((i & k) == 0);
          const float x = v[i], y = v[l];
          const float hi = fmaxf(x, y), lo = fminf(x, y);
          v[i] = desc ? hi : lo;
          v[l] = desc ? lo : hi;
        }
      }
}
__device__ __forceinline__ void merge_top16(float (&v)[16], const int xl) {
  float o[16];
#pragma unroll
  for (int i = 0; i < 16; ++i) o[i] = __shfl_xor(v[15 - i], xl);
#pragma unroll
  for (int i = 0; i < 16; ++i) v[i] = fmaxf(v[i], o[i]);
#pragma unroll
  for (int j = 8; j > 0; j >>= 1)
#pragma unroll
    for (int i = 0; i < 16; ++i) {
      const int l = i ^ j;
      if (l > i) {
        const float x = v[i], y = v[l];
        v[i] = fmaxf(x, y);
        v[l] = fminf(x, y);
      }
    }
}
__device__ __forceinline__ float pack_key(float x, unsigned mask, unsigned key) {
  return __uint_as_float((__float_as_uint(x) & ~mask) | key);
}

__device__ void topk_phase(const Params& p, int layer, int ntok, char* smem) {
  float* sc = (float*)smem;
  const int tid = get_tid();
  const int lane = tid & 63, w = tid >> 6, fr = lane & 15, q4 = lane >> 4;
  const int nbatch = ntok >> 4;
  for (int bt = get_bid(); bt < nbatch; bt += gridDim.x) {
    __syncthreads();
#pragma unroll 1
    for (int pp = 0; pp < 2; ++pp) {
      const int pair = 2 * w + pp;
      const bfr* qrow = p.q + (size_t)(bt * 16 + fr) * D + pair * 128 + q4 * 8;
      const bfr* skb = p.sk_bf + (size_t)(((layer * 2 + (pair & 1)) * 8 + (pair >> 1))) * 128 * 128 + q4 * 8;
      bf16x8 af[4];
#pragma unroll
      for (int k2 = 0; k2 < 4; ++k2) af[k2] = *(const bf16x8*)(qrow + k2 * 32);
#pragma unroll 2
      for (int nt = 0; nt < 8; ++nt) {
        f32x4 acc = (f32x4){0.f, 0.f, 0.f, 0.f};
#pragma unroll
        for (int k2 = 0; k2 < 4; ++k2) {
          const bf16x8 bq = *(const bf16x8*)(skb + (size_t)(nt * 16 + fr) * 128 + k2 * 32);
          acc = MFMA16(af[k2], bq, acc);
        }
#pragma unroll
        for (int r = 0; r < 4; ++r) sc[((q4 * 4 + r) * 16 + pair) * 132 + nt * 16 + fr] = acc[r];
      }
    }
    __syncthreads();
#pragma unroll 1
    for (int ps = 0; ps < 2; ++ps) {
      const int list = ps * 128 + (tid >> 2), qd = tid & 3;
      float v[32];
#pragma unroll
      for (int j = 0; j < 8; ++j) {
        float4 t = *(const float4*)(sc + list * 132 + qd * 32 + j * 4);
        const unsigned kb = qd * 32 + j * 4;
        v[j * 4 + 0] = pack_key(t.x, 127u, kb + 0); v[j * 4 + 1] = pack_key(t.y, 127u, kb + 1);
        v[j * 4 + 2] = pack_key(t.z, 127u, kb + 2); v[j * 4 + 3] = pack_key(t.w, 127u, kb + 3);
      }
      bitonic_sort_desc<32>(v);
      float wv[16];
#pragma unroll
      for (int i = 0; i < 16; ++i) wv[i] = v[i];
      merge_top16(wv, 1);
      merge_top16(wv, 2);
      if (qd == 0) {
#pragma unroll
        for (int j = 0; j < 4; ++j)
          *(float4*)(sc + list * 132 + j * 4) = make_float4(wv[j * 4 + 0], wv[j * 4 + 1], wv[j * 4 + 2], wv[j * 4 + 3]);
      }
    }
    __syncthreads();
    {
      const int pair = tid >> 2, qd = tid & 3;
      const int tok = pair >> 3, hh = pair & 7;
      const float* o0 = sc + (tok * 16 + hh * 2) * 132;
      const float* o1 = o0 + 132;
      float c[16];
#pragma unroll
      for (int i = 0; i < 16; ++i) {
        const unsigned code = c_cand_tab[qd * 16 + i];
        const float sum = o0[code >> 4] + o1[code & 15];
        c[i] = (code == 255u) ? -INFINITY : pack_key(sum, 255u, code);
      }
      bitonic_sort_desc<16>(c);
      merge_top16(c, 1);
      merge_top16(c, 2);
      float e[16];
      float esum = 0.f;
#pragma unroll
      for (int i = 0; i < 16; ++i) { e[i] = __expf(c[i] - c[0]); esum += e[i]; }
      const float inv = 1.f / esum;
      const int m = bt * 16 + tok;
#pragma unroll
      for (int j = 0; j < 4; ++j) {
        const float ev = qd == 0 ? e[j] : (qd == 1 ? e[4 + j] : (qd == 2 ? e[8 + j] : e[12 + j]));
        const float cv = qd == 0 ? c[j] : (qd == 1 ? c[4 + j] : (qd == 2 ? c[8 + j] : c[12 + j]));
        const unsigned code = __float_as_uint(cv) & 255u;
        const unsigned k0 = __float_as_uint(o0[code >> 4]) & 127u;
        const unsigned k1 = __float_as_uint(o1[code & 15]) & 127u;
        p.pidx[(size_t)m * 128 + hh * 16 + qd * 4 + j] = (int)(k0 * 128u + k1);
        p.pgate[(size_t)m * 128 + hh * 16 + qd * 4 + j] = ev * inv;
      }
    }
  }
}

typedef __attribute__((ext_vector_type(2))) float f32x2;
__device__ __forceinline__ float dot16_fp8(const float* hf, const u4 w) {
  f32x2 a0 = __builtin_amdgcn_cvt_pk_f32_fp8((int)w.x, false), a1 = __builtin_amdgcn_cvt_pk_f32_fp8((int)w.x, true);
  f32x2 b0 = __builtin_amdgcn_cvt_pk_f32_fp8((int)w.y, false), b1 = __builtin_amdgcn_cvt_pk_f32_fp8((int)w.y, true);
  f32x2 c0 = __builtin_amdgcn_cvt_pk_f32_fp8((int)w.z, false), c1 = __builtin_amdgcn_cvt_pk_f32_fp8((int)w.z, true);
  f32x2 d0 = __builtin_amdgcn_cvt_pk_f32_fp8((int)w.w, false), d1 = __builtin_amdgcn_cvt_pk_f32_fp8((int)w.w, true);
  return hf[0] * a0.x + hf[1] * a0.y + hf[2] * a1.x + hf[3] * a1.y + hf[4] * b0.x + hf[5] * b0.y + hf[6] * b1.x + hf[7] * b1.y +
         hf[8] * c0.x + hf[9] * c0.y + hf[10] * c1.x + hf[11] * c1.y + hf[12] * d0.x + hf[13] * d0.y + hf[14] * d1.x + hf[15] * d1.y;
}
__device__ __forceinline__ void fma16_fp8(float* o, float c, const u4 w) {
  f32x2 a0 = __builtin_amdgcn_cvt_pk_f32_fp8((int)w.x, false), a1 = __builtin_amdgcn_cvt_pk_f32_fp8((int)w.x, true);
  f32x2 b0 = __builtin_amdgcn_cvt_pk_f32_fp8((int)w.y, false), b1 = __builtin_amdgcn_cvt_pk_f32_fp8((int)w.y, true);
  f32x2 c0 = __builtin_amdgcn_cvt_pk_f32_fp8((int)w.z, false), c1 = __builtin_amdgcn_cvt_pk_f32_fp8((int)w.z, true);
  f32x2 d0 = __builtin_amdgcn_cvt_pk_f32_fp8((int)w.w, false), d1 = __builtin_amdgcn_cvt_pk_f32_fp8((int)w.w, true);
  o[0] += c * a0.x; o[1] += c * a0.y; o[2] += c * a1.x; o[3] += c * a1.y;
  o[4] += c * b0.x; o[5] += c * b0.y; o[6] += c * b1.x; o[7] += c * b1.y;
  o[8] += c * c0.x; o[9] += c * c0.y; o[10] += c * c1.x; o[11] += c * c1.y;
  o[12] += c * d0.x; o[13] += c * d0.y; o[14] += c * d1.x; o[15] += c * d1.y;
}

__device__ void peer_phase(const Params& p, int layer, int ntok) {
  const int lane = get_tid() & 63;
  const int wave = get_bid() * 8 + (get_tid() >> 6), nw = gridDim.x * 8;
  const unsigned char* U = p.u8 + (size_t)layer * 16384 * D;
  const unsigned char* V = p.v8 + (size_t)layer * 16384 * D;
  const float* usc = p.uscl + layer * 16384;
  const float* vsc = p.vscl + layer * 16384;
  for (int m = wave; m < ntok; m += nw) {
    float hf[32];
    const bfr* hr = p.h + (size_t)m * D + lane * 16;
#pragma unroll
    for (int i = 0; i < 2; ++i) {
      u4 w0 = *(const u4*)(hr + i * 1024), w1 = *(const u4*)(hr + i * 1024 + 8);
      unpack8(w0, hf + i * 16);
      unpack8(w1, hf + i * 16 + 8);
    }
    const int idA = p.pidx[(size_t)m * 128 + lane], idB = p.pidx[(size_t)m * 128 + 64 + lane];
    const float gA = p.pgate[(size_t)m * 128 + lane] * vsc[idA], gB = p.pgate[(size_t)m * 128 + 64 + lane] * vsc[idB];
    const float usA = usc[idA], usB = usc[idB];
    float cA = 0.f, cB = 0.f;
#pragma unroll 1
    for (int e0 = 0; e0 < 128; e0 += 8) {
      u4 r[8][2];
#pragma unroll
      for (int u = 0; u < 8; ++u) {
        int e = e0 + u;
        int row = __shfl(e0 < 64 ? idA : idB, e & 63);
        const unsigned char* up = U + (size_t)row * D + lane * 16;
        r[u][0] = *(const u4*)(up);
        r[u][1] = *(const u4*)(up + 1024);
      }
      __builtin_amdgcn_sched_barrier(0);
#pragma unroll
      for (int u = 0; u < 8; ++u) {
        int e = e0 + u;
        float dsum = dot16_fp8(hf, r[u][0]) + dot16_fp8(hf + 16, r[u][1]);
        dsum = wave_sum(dsum);
        if (e0 < 64) { if (lane == e) cA = gA * gelu_f(dsum * usA); }
        else { if (lane == e - 64) cB = gB * gelu_f(dsum * usB); }
        __builtin_amdgcn_sched_barrier(0);
      }
    }
    float o[32];
#pragma unroll
    for (int i = 0; i < 32; ++i) o[i] = 0.f;
#pragma unroll 1
    for (int e0 = 0; e0 < 128; e0 += 4) {
      u4 r[4][2];
      float cf[4];
#pragma unroll
      for (int u = 0; u < 4; ++u) {
        int e = e0 + u;
        int row = __shfl(e0 < 64 ? idA : idB, e & 63);
        cf[u] = __shfl(e0 < 64 ? cA : cB, e & 63);
        const unsigned char* vp = V + (size_t)row * D + lane * 16;
        r[u][0] = *(const u4*)(vp);
        r[u][1] = *(const u4*)(vp + 1024);
      }
      __builtin_amdgcn_sched_barrier(0);
#pragma unroll
      for (int u = 0; u < 4; ++u) {
        fma16_fp8(o, cf[u], r[u][0]);
        fma16_fp8(o + 16, cf[u], r[u][1]);
        __builtin_amdgcn_sched_barrier(0);
      }
    }
    const int vec = m < S ? 0 : (m < MX ? 1 : 2);
    const float* modl = p.mod + (layer * 3 + vec) * 12288;
    float* xr = p.xcur + (size_t)m * D + lane * 16;
    float xn[32];
    float ss = 0.f;
#pragma unroll
    for (int i = 0; i < 2; ++i)
#pragma unroll
      for (int k = 0; k < 4; ++k) {
        int col = i * 1024 + lane * 16 + k * 4;
        float4 a = *(const float4*)(xr + i * 1024 + k * 4);
        float4 g0 = *(const float4*)(modl + 5 * D + col);
        float* xx = xn + i * 16 + k * 4;
        const float* oo = o + i * 16 + k * 4;
        xx[0] = a.x + g0.x * oo[0]; xx[1] = a.y + g0.y * oo[1]; xx[2] = a.z + g0.z * oo[2]; xx[3] = a.w + g0.w * oo[3];
        ss += xx[0] * xx[0] + xx[1] * xx[1] + xx[2] * xx[2] + xx[3] * xx[3];
      }
    ss = wave_sum(ss);
    const float rstd = rsqrtf(ss * (1.f / D) + EPS);
    if (layer == 1) {
      float* orow = p.out + (size_t)m * D;
#pragma unroll
      for (int i = 0; i < 2; ++i)
#pragma unroll
        for (int k = 0; k < 4; ++k) {
          int col = i * 1024 + lane * 16 + k * 4;
          float4 f0 = *(const float4*)(p.final_g + col);
          const float* xx = xn + i * 16 + k * 4;
          *(float4*)(orow + col) = make_float4(xx[0] * rstd * f0.x, xx[1] * rstd * f0.y, xx[2] * rstd * f0.z, xx[3] * rstd * f0.w);
        }
    } else {
      const float* modn = p.mod + ((layer + 1) * 3 + vec) * 12288;
      const float* gn = p.g_attn + (layer + 1) * D;
#pragma unroll
      for (int i = 0; i < 2; ++i) {
        float y[16];
#pragma unroll
        for (int k = 0; k < 4; ++k) {
          int col = i * 1024 + lane * 16 + k * 4;
          const float* xx = xn + i * 16 + k * 4;
          *(float4*)(xr + i * 1024 + k * 4) = make_float4(xx[0], xx[1], xx[2], xx[3]);
          float4 gv = *(const float4*)(gn + col), scv = *(const float4*)(modn + D + col), shv = *(const float4*)(modn + col);
          y[k * 4 + 0] = xx[0] * rstd * gv.x * (1.f + scv.x) + shv.x;
          y[k * 4 + 1] = xx[1] * rstd * gv.y * (1.f + scv.y) + shv.y;
          y[k * 4 + 2] = xx[2] * rstd * gv.z * (1.f + scv.z) + shv.z;
          y[k * 4 + 3] = xx[3] * rstd * gv.w * (1.f + scv.w) + shv.w;
        }
        u4 w0, w1;
        w0.x = pack2(y[0], y[1]); w0.y = pack2(y[2], y[3]); w0.z = pack2(y[4], y[5]); w0.w = pack2(y[6], y[7]);
        w1.x = pack2(y[8], y[9]); w1.y = pack2(y[10], y[11]); w1.z = pack2(y[12], y[13]); w1.w = pack2(y[14], y[15]);
        *(u4*)(p.h + (size_t)m * D + i * 1024 + lane * 16) = w0;
        *(u4*)(p.h + (size_t)m * D + i * 1024 + lane * 16 + 8) = w1;
      }
    }
  }
}

constexpr int PH_INIT = 0, PH_MOD_ATTN = 1, PH_INPROJ = 2, PH_MIX1 = 3, PH_SCANB = 4, PH_SCANC = 5, PH_OUTPROJ = 6,
              PH_MOD_FFN = 7, PH_QPROJ = 8, PH_SCORES = 9, PH_TOPK = 10, PH_PEER = 11;

template <int EPI, bool ALLOW_BIG>
__device__ __forceinline__ void gemm_phase(const Params& p, int layer, int vid, const bfr* A, const bfr* Bt, int MB, int MT,
                                           int NB, int N128, int small_nt, void* Cout, int ldc, char* smem) {
  const int nbig = MB * NB;
  const int nsm1 = small_nt >= 0 ? MB : 0;
  const int nsm2 = (MT - MB) * N128;
  const int total = nbig + nsm1 + nsm2;
  for (int t = vid; t < total; t += gridDim.x) {
    if (t < nbig) {
      if constexpr (ALLOW_BIG) {
        const int mt = t / NB, nt = t - mt * NB;
        gemm_tile<EPI, true>(A, D, Bt, D, D, mt * 256, nt * 256, Cout, ldc, p, layer, smem);
      }
    } else if (t < nbig + nsm1) {
      gemm_tile<EPI, false>(A, D, Bt, D, D, (t - nbig) * 256, small_nt * 128, Cout, ldc, p, layer, smem);
    } else {
      const int u = t - nbig - nsm1;
      const int mt = MB + u / N128, nt = u % N128;
      gemm_tile<EPI, false>(A, D, Bt, D, D, mt * 256, nt * 128, Cout, ldc, p, layer, smem);
    }
  }
}

__device__ void run_phase(const Params& p, int ph, int layer, char* smem, int vid) {
  const int bid = get_bid(), nb = gridDim.x;
  const bool last = (layer == 1);
  switch (ph) {
    case PH_INIT: phase0(p, smem); break;
    case PH_MOD_ATTN: modulate_phase(p, layer, 0, MT); break;
    case PH_INPROJ:
      gemm_phase<0, true>(p, layer, vid, p.h, p.wt_in + (size_t)layer * DINP * D, 66, 66, 23, 47, 46, p.proj, DINP, smem);
      break;
    case PH_MIX1: {
      const int n_swa = 256, n_na = 2048, n_sa = 1056, n_ctx = last ? 0 : 32;
      const int total = n_swa + n_na + 2 * n_sa + n_ctx;
      for (int it = bid; it < total; it += nb) {
        int t = it;
        if (t < n_swa) { swa_item(p, layer, t, smem); continue; }
        t -= n_swa;
        if (t < n_na) { na_item(p, layer, t, smem); continue; }
        t -= n_na;
        if (t < n_sa) { scan_a_item<128, false>(p, layer, t, smem); continue; }
        t -= n_sa;
        if (t < n_sa) { scan_a_item<64, true>(p, layer, t, smem); continue; }
        t -= n_sa;
        ctx_item(p, layer, t, smem);
      }
    } break;
    case PH_SCANB: scan_b_phase(p); break;
    case PH_SCANC:
      for (int it = bid; it < 2 * 1056; it += nb) {
        const bool gla = it < 1056;
        const int t = gla ? it : it - 1056;
        if (last && (t % 132) < 4) continue;
        if (gla) scan_c_item<64, true>(p, layer, t, smem);
        else scan_c_item<128, false>(p, layer, t, smem);
      }
      break;
    case PH_OUTPROJ: {
      gemm_phase<1, false>(p, layer, vid, p.mix, p.wt_out + (size_t)layer * D * D, 0, last ? 64 : 66, 8, 16, -1, nullptr, 0, smem);
    } break;
    case PH_MOD_FFN: modulate_phase(p, layer, 1, last ? MX : MT); break;
    case PH_QPROJ: {
      gemm_phase<0, true>(p, layer, vid, p.h, p.wt_q + (size_t)layer * D * D, 64, last ? 64 : 66, 8, 16, -1, p.q, D, smem);
    } break;
    case PH_SCORES: {
      const int mt = last ? 64 : 66;
      for (int t = bid; t < mt * 16; t += nb) {
        int j = t & 15;
        int hh = j >> 1, pp = j & 1;
        const bfr* bt = p.sk_bf + (size_t)(((layer * 2 + pp) * 8 + hh)) * 128 * 128;
        gemm_tile<2, false>(p.q + j * 128, D, bt, 128, 128, (t >> 4) * 256, 0, p.scores + j * 128, D, p, layer, smem);
      }
    } break;
    case PH_TOPK: topk_phase(p, layer, last ? MX : MT, smem); break;
    case PH_PEER: peer_phase(p, layer, last ? MX : MT); break;
  }
}

__device__ __forceinline__ void grid_barrier(unsigned* bar, unsigned& epoch) {
  asm volatile("s_waitcnt vmcnt(0)" ::: "memory");
  __syncthreads();
  epoch += gridDim.x;
  if (threadIdx.x == 0) {
    __builtin_amdgcn_fence(__ATOMIC_RELEASE, "agent");
    asm volatile("s_waitcnt vmcnt(0)" ::: "memory");
    (void)__hip_atomic_fetch_add(bar, 1u, __ATOMIC_RELAXED, __HIP_MEMORY_SCOPE_AGENT);
    unsigned spins = 0;
    while (__hip_atomic_load(bar, __ATOMIC_RELAXED, __HIP_MEMORY_SCOPE_AGENT) < epoch) {
      __builtin_amdgcn_s_sleep(1);
      if (++spins > (1u << 24)) break;
    }
    __builtin_amdgcn_fence(__ATOMIC_ACQUIRE, "agent");
    asm volatile("s_waitcnt vmcnt(0)" ::: "memory");
  }
  __syncthreads();
}

#if MULTI_LAUNCH
__global__ void __launch_bounds__(NTHR) phase_kernel(Params p, int ph, int layer) {
  extern __shared__ __attribute__((aligned(16))) char smem[];
  run_phase(p, ph, layer, smem, blockIdx.x);
}
#else
__global__ void __launch_bounds__(NTHR) mega_kernel(Params p) {
  extern __shared__ __attribute__((aligned(16))) char smem[];
  cg::grid_group grid = cg::this_grid();
  const unsigned xcd = (unsigned)__builtin_amdgcn_s_getreg((3 << 11) | 20) & 7u;
  run_phase(p, PH_INIT, 0, smem, 0);
  __syncthreads();
  if (threadIdx.x == 0) ((volatile unsigned*)smem)[0] = atomicAdd(&p.bar[16 + xcd], 1u);
  grid.sync();
  int vid = (int)((volatile unsigned*)smem)[0];
  for (unsigned x = 0; x < xcd; ++x) vid += (int)__hip_atomic_load(&p.bar[16 + x], __ATOMIC_RELAXED, __HIP_MEMORY_SCOPE_AGENT);
  vid = __builtin_amdgcn_readfirstlane(vid);
  __syncthreads();
  unsigned epoch = 0;
  for (int layer = 0; layer < 2; ++layer) {
    for (int ph = (layer == 0 ? PH_MOD_ATTN : PH_INPROJ); ph <= PH_PEER; ++ph) {
      if (ph == PH_SCORES) continue;
      run_phase(p, ph, layer, smem, vid);
      if (!(layer == 1 && ph == PH_PEER)) grid_barrier(p.bar, epoch);
    }
  }
}
#endif

static inline size_t align_up(size_t v) { return (v + 255) & ~(size_t)255; }

extern "C" void kernel_launch(void* const* d_in, const int* in_sizes, int n_in, void* d_out, int out_size, void* d_ws,
                              size_t ws_size, hipStream_t stream) {
  Params p{};
  p.x = (const float*)d_in[0]; p.c = (const float*)d_in[1]; p.ctx = (const float*)d_in[2]; p.c_ctx = (const float*)d_in[3];
  p.w_ada = (const float*)d_in[4]; p.b_ada = (const float*)d_in[5]; p.g_attn = (const float*)d_in[6]; p.g_ffn = (const float*)d_in[7];
  p.w_in = (const float*)d_in[8]; p.rpb = (const float*)d_in[9]; p.ret_lg = (const float*)d_in[10]; p.gla_wu = (const float*)d_in[11];
  p.gla_b = (const float*)d_in[12]; p.gla_g = (const float*)d_in[13]; p.sink = (const float*)d_in[14]; p.w_out = (const float*)d_in[15];
  p.w_q = (const float*)d_in[16]; p.sub_keys = (const float*)d_in[17]; p.pu = (const float*)d_in[18]; p.pv = (const float*)d_in[19];
  p.final_g = (const float*)d_in[20];
  p.out = (float*)d_out;
  char* ws = (char*)d_ws;
  size_t off = 0;
  auto take = [&](size_t bytes) { char* r = ws + off; off = align_up(off + bytes); return r; };
  p.mod = (float*)take((size_t)2 * 3 * 12288 * 4);
  p.bar = (unsigned*)take(256);
  p.rope = (float*)take((size_t)16384 * 4);
  p.wt_in = (bfr*)take((size_t)2 * DINP * D * 2);
  p.wt_out = (bfr*)take((size_t)2 * D * D * 2);
  p.wt_q = (bfr*)take((size_t)2 * D * D * 2);
  p.sk_bf = (bfr*)take((size_t)524288 * 2);
  p.u8 = (unsigned char*)take((size_t)2 * 16384 * D);
  p.v8 = (unsigned char*)take((size_t)2 * 16384 * D);
  p.uscl = (float*)take((size_t)2 * 16384 * 4);
  p.vscl = (float*)take((size_t)2 * 16384 * 4);
  p.xcur = (float*)take((size_t)MT * D * 4);
  p.h = (bfr*)take((size_t)MT * D * 2);
  p.proj = (bfr*)take((size_t)MT * DINP * 2);
  p.mix = (bfr*)take((size_t)MT * D * 2);
  p.st_ret = (bfr*)take((size_t)16 * 132 * 16384 * 4);
  p.dec_ret = (float*)take((size_t)16 * 132 * 128 * 4);
  p.dec_gla = (float*)take((size_t)16 * 132 * 64 * 4);
  p.pidx = (int*)take((size_t)MT * 128 * 4);
  p.pgate = (float*)take((size_t)MT * 128 * 4);
  p.st_gla = (bfr*)p.h;
  p.q = p.proj;
  p.scores = (float*)p.st_ret;
  if (off > ws_size) { fprintf(stderr, "workspace too small: need %zu have %zu\n", off, ws_size); return; }

  hipMemsetAsync(p.mod, 0, (size_t)2 * 3 * 12288 * 4 + 256, stream);
#if MULTI_LAUNCH
  hipFuncSetAttribute((const void*)phase_kernel, hipFuncAttributeMaxDynamicSharedMemorySize, SMEM_BYTES);
  const int grid = 256;
  hipLaunchKernelGGL(phase_kernel, dim3(grid), dim3(NTHR), SMEM_BYTES, stream, p, PH_INIT, 0);
  for (int layer = 0; layer < 2; ++layer)
    for (int ph = (layer == 0 ? PH_MOD_ATTN : PH_INPROJ); ph <= PH_PEER; ++ph)
      hipLaunchKernelGGL(phase_kernel, dim3(grid), dim3(NTHR), SMEM_BYTES, stream, p, ph, layer);
#else
  static int grid_blocks = 0;
  if (!grid_blocks) {
    hipFuncSetAttribute((const void*)mega_kernel, hipFuncAttributeMaxDynamicSharedMemorySize, SMEM_BYTES);
    int dev = 0, cus = 0, per_cu = 0;
    hipGetDevice(&dev);
    hipDeviceGetAttribute(&cus, hipDeviceAttributeMultiprocessorCount, dev);
    hipOccupancyMaxActiveBlocksPerMultiprocessor(&per_cu, mega_kernel, NTHR, SMEM_BYTES);
    if (per_cu < 1) per_cu = 1;
    grid_blocks = cus * per_cu;
    if (grid_blocks > 256) grid_blocks = 256;
  }
  void* args[] = {&p};
  hipError_t e = hipLaunchCooperativeKernel((void*)mega_kernel, dim3(grid_blocks), dim3(NTHR), args, SMEM_BYTES, stream);
  if (e != hipSuccess) fprintf(stderr, "cooperative launch failed: %s (grid %d)\n", hipGetErrorString(e), grid_blocks);
#endif
}
```

```cpp
#include <hip/hip_runtime.h>
#include <hip/hip_cooperative_groups.h>
#include <cstdio>
namespace cg = cooperative_groups;

#ifndef MULTI_LAUNCH
#define MULTI_LAUNCH 0
#endif

typedef unsigned short bfr;
typedef __attribute__((ext_vector_type(8))) short bf16x8;
typedef __attribute__((ext_vector_type(4))) float f32x4;
typedef __attribute__((ext_vector_type(4))) unsigned int u4;

constexpr int D = 2048;
constexpr int S = 8192;
constexpr int MX = 16384;
constexpr int MT = 16896;
constexpr int DIN = 5920;
constexpr int DINP = 6016;
constexpr int NTHR = 512;
constexpr float EPS = 1e-6f;
constexpr int SMEM_BYTES = 149504;

constexpr int C_NAQ = 0, C_NAK = 512, C_NAV = 1024;
constexpr int C_RTQ = 1536, C_RTK = 2048, C_RTV = 2560, C_RTG = 3072;
constexpr int C_GLQ = 3584, C_GLK = 3840, C_GLV = 4096, C_GLG = 4608, C_GLD = 5120;
constexpr int C_SWQ = 5152, C_SWK = 5664, C_SWV = 5792;

struct Params {
  const float *x, *c, *ctx, *c_ctx, *w_ada, *b_ada, *g_attn, *g_ffn, *w_in, *rpb, *ret_lg, *gla_wu, *gla_b,
      *gla_g, *sink, *w_out, *w_q, *sub_keys, *pu, *pv, *final_g;
  float* out;
  bfr *wt_in, *wt_out, *wt_q, *sk_bf;
  unsigned char *u8, *v8;
  float *uscl, *vscl;
  float *mod, *rope, *xcur;
  bfr *h, *proj, *mix;
  bfr *st_ret, *st_gla;
  float *dec_ret, *dec_gla;
  bfr* q;
  float* scores;
  int* pidx;
  float* pgate;
  unsigned* bar;
};

__device__ __forceinline__ int get_tid() { int t = threadIdx.x; asm volatile("" : "+v"(t)); return t; }
__device__ __forceinline__ int get_bid() { int t = blockIdx.x; asm volatile("" : "+s"(t)); return t; }
__device__ __forceinline__ float bf2f(bfr u) { return __uint_as_float(((unsigned)u) << 16); }
__device__ __forceinline__ bfr f2bf(float f) {
  unsigned u = __float_as_uint(f);
  u += 0x7fffu + ((u >> 16) & 1u);
  return (bfr)(u >> 16);
}
__device__ __forceinline__ unsigned pack2(float a, float b) { return (unsigned)f2bf(a) | ((unsigned)f2bf(b) << 16); }
__device__ __forceinline__ float lo16(unsigned w) { return __uint_as_float(w << 16); }
__device__ __forceinline__ float hi16(unsigned w) { return __uint_as_float(w & 0xffff0000u); }
__device__ __forceinline__ float wave_sum(float v) {
#pragma unroll
  for (int o = 32; o; o >>= 1) v += __shfl_xor(v, o);
  return v;
}
__device__ __forceinline__ float wave_max(float v) {
#pragma unroll
  for (int o = 32; o; o >>= 1) v = fmaxf(v, __shfl_xor(v, o));
  return v;
}
__device__ __forceinline__ float silu_f(float x) { return x / (1.f + __expf(-x)); }
__device__ __forceinline__ float gelu_f(float x) { return 0.5f * x * (1.f + erff(x * 0.70710678118654752f)); }
__device__ __forceinline__ float logsig_f(float x) { return fminf(x, 0.f) - log1pf(__expf(-fabsf(x))); }
__device__ __forceinline__ void unpack8(const u4 w, float* f) {
  f[0] = lo16(w.x); f[1] = hi16(w.x); f[2] = lo16(w.y); f[3] = hi16(w.y);
  f[4] = lo16(w.z); f[5] = hi16(w.z); f[6] = lo16(w.w); f[7] = hi16(w.w);
}

__device__ void transpose_cvt(const float* __restrict__ W, int K, int N, int Npad, bfr* __restrict__ Wt, int item,
                              float* tile) {
  const int nkt = K >> 6;
  const int kt = item % nkt, nt = item / nkt;
  const int tid = get_tid();
  __syncthreads();
#pragma unroll
  for (int i = 0; i < 2; ++i) {
    int kk = (tid >> 4) + 32 * i, nn = (tid & 15) * 4;
    int n = nt * 64 + nn;
    float4 v = make_float4(0.f, 0.f, 0.f, 0.f);
    if (n < N) v = *(const float4*)(W + (size_t)(kt * 64 + kk) * N + n);
    tile[kk * 65 + nn + 0] = v.x; tile[kk * 65 + nn + 1] = v.y; tile[kk * 65 + nn + 2] = v.z; tile[kk * 65 + nn + 3] = v.w;
  }
  __syncthreads();
  {
    int nl = tid >> 3, kc = (tid & 7) * 8;
    u4 o;
    o.x = pack2(tile[(kc + 0) * 65 + nl], tile[(kc + 1) * 65 + nl]);
    o.y = pack2(tile[(kc + 2) * 65 + nl], tile[(kc + 3) * 65 + nl]);
    o.z = pack2(tile[(kc + 4) * 65 + nl], tile[(kc + 5) * 65 + nl]);
    o.w = pack2(tile[(kc + 6) * 65 + nl], tile[(kc + 7) * 65 + nl]);
    *(u4*)(Wt + (size_t)(nt * 64 + nl) * K + kt * 64 + kc) = o;
  }
}

__device__ void cvt_linear(const float* __restrict__ src, bfr* __restrict__ dst, size_t n8) {
  for (size_t i = (size_t)get_bid() * NTHR + get_tid(); i < n8; i += (size_t)gridDim.x * NTHR) {
    float4 a = *(const float4*)(src + i * 8), b = *(const float4*)(src + i * 8 + 4);
    u4 o;
    o.x = pack2(a.x, a.y); o.y = pack2(a.z, a.w); o.z = pack2(b.x, b.y); o.w = pack2(b.z, b.w);
    *(u4*)(dst + i * 8) = o;
  }
}

__device__ void cvt_fp8_rows(const float* __restrict__ src, unsigned char* __restrict__ dst, float* __restrict__ scl, int nrows) {
  const int lane = get_tid() & 63;
  const int wave = get_bid() * 8 + (get_tid() >> 6), nw = gridDim.x * 8;
  for (int row = wave; row < nrows; row += nw) {
    const float* sp = src + (size_t)row * D + lane * 16;
    float4 v[8];
    float amax = 0.f;
#pragma unroll
    for (int i = 0; i < 2; ++i)
#pragma unroll
      for (int k = 0; k < 4; ++k) {
        float4 t = *(const float4*)(sp + i * 1024 + k * 4);
        v[i * 4 + k] = t;
        amax = fmaxf(amax, fmaxf(fmaxf(fabsf(t.x), fabsf(t.y)), fmaxf(fabsf(t.z), fabsf(t.w))));
      }
    amax = wave_max(amax);
    const float sc = amax > 0.f ? 256.f / amax : 1.f;
#pragma unroll
    for (int i = 0; i < 2; ++i) {
      u4 o;
      int w;
      w = __builtin_amdgcn_cvt_pk_fp8_f32(v[i * 4 + 0].x * sc, v[i * 4 + 0].y * sc, 0, false);
      w = __builtin_amdgcn_cvt_pk_fp8_f32(v[i * 4 + 0].z * sc, v[i * 4 + 0].w * sc, w, true); o.x = (unsigned)w;
      w = __builtin_amdgcn_cvt_pk_fp8_f32(v[i * 4 + 1].x * sc, v[i * 4 + 1].y * sc, 0, false);
      w = __builtin_amdgcn_cvt_pk_fp8_f32(v[i * 4 + 1].z * sc, v[i * 4 + 1].w * sc, w, true); o.y = (unsigned)w;
      w = __builtin_amdgcn_cvt_pk_fp8_f32(v[i * 4 + 2].x * sc, v[i * 4 + 2].y * sc, 0, false);
      w = __builtin_amdgcn_cvt_pk_fp8_f32(v[i * 4 + 2].z * sc, v[i * 4 + 2].w * sc, w, true); o.z = (unsigned)w;
      w = __builtin_amdgcn_cvt_pk_fp8_f32(v[i * 4 + 3].x * sc, v[i * 4 + 3].y * sc, 0, false);
      w = __builtin_amdgcn_cvt_pk_fp8_f32(v[i * 4 + 3].z * sc, v[i * 4 + 3].w * sc, w, true); o.w = (unsigned)w;
      *(u4*)(dst + (size_t)row * D + i * 1024 + lane * 16) = o;
    }
    if (lane == 0) scl[row] = amax > 0.f ? amax * (1.f / 256.f) : 1.f;
  }
}

__device__ void sincos_d(double a, float& s, float& c) {
  double k = rint(a * 0.63661977236758134308);
  double r = a - k * 1.57079632679489661923;
  double r2 = r * r;
  double sn = r * (1.0 + r2 * (-1.0 / 6 + r2 * (1.0 / 120 + r2 * (-1.0 / 5040 + r2 * (1.0 / 362880 + r2 * (-1.0 / 39916800 + r2 * (1.0 / 6227020800.0)))))));
  double cs = 1.0 + r2 * (-0.5 + r2 * (1.0 / 24 + r2 * (-1.0 / 720 + r2 * (1.0 / 40320 + r2 * (-1.0 / 3628800 + r2 * (1.0 / 479001600.0))))));
  int q = ((int)k) & 3;
  double so = (q == 0) ? sn : (q == 1) ? cs : (q == 2) ? -sn : -cs;
  double co = (q == 0) ? cs : (q == 1) ? -sn : (q == 2) ? -cs : sn;
  s = (float)so; c = (float)co;
}

__device__ void phase0(const Params& p, char* smem) {
  const int tid = get_tid(), bid = get_bid(), nb = gridDim.x;
  float* fs = (float*)smem;
  if (bid == 0) {
    for (int e = tid; e < 128 * 16 + 128 * 32; e += NTHR) {
      int F, pos, f, base;
      if (e < 2048) { F = 16; pos = e >> 4; f = e & 15; base = 0; }
      else { int e2 = e - 2048; F = 32; pos = e2 >> 5; f = e2 & 31; base = 4096; }
      double bb = (F == 16) ? 0.56234132519034908 : 0.74989420933245582;
      double inv = 1.0;
      for (int i = 0; i < f; ++i) inv *= bb;
      float invf = (float)inv;
      float ang = (float)pos * invf;
      float sn, cs;
      sincos_d((double)ang, sn, cs);
      p.rope[base + pos * F + f] = cs;
      p.rope[base + 128 * F + pos * F + f] = sn;
    }
  }
  for (int it = bid; it < 384; it += nb) {
    int layer = it / 192, r = it % 192, kc = r / 6, nc = r % 6;
    __syncthreads();
    if (tid < 192) {
      int v = tid >> 6, kk = tid & 63;
      float cv = (v < 2) ? p.c[v * D + kc * 64 + kk] : p.c_ctx[kc * 64 + kk];
      fs[tid] = silu_f(cv);
    }
    __syncthreads();
    int n = nc * 2048 + tid * 4;
    float4 a0 = make_float4(0, 0, 0, 0), a1 = a0, a2 = a0;
    if (kc == 0) { a0 = *(const float4*)(p.b_ada + layer * 12288 + n); a1 = a0; a2 = a0; }
    const float* w = p.w_ada + (size_t)layer * D * 12288 + (size_t)(kc * 64) * 12288 + n;
#pragma unroll 8
    for (int kk = 0; kk < 64; ++kk) {
      float4 wv = *(const float4*)(w + (size_t)kk * 12288);
      float s0 = fs[kk], s1 = fs[64 + kk], s2 = fs[128 + kk];
      a0.x += s0 * wv.x; a0.y += s0 * wv.y; a0.z += s0 * wv.z; a0.w += s0 * wv.w;
      a1.x += s1 * wv.x; a1.y += s1 * wv.y; a1.z += s1 * wv.z; a1.w += s1 * wv.w;
      a2.x += s2 * wv.x; a2.y += s2 * wv.y; a2.z += s2 * wv.z; a2.w += s2 * wv.w;
    }
    float* m0 = p.mod + (layer * 3 + 0) * 12288 + n;
    float* m1 = p.mod + (layer * 3 + 1) * 12288 + n;
    float* m2 = p.mod + (layer * 3 + 2) * 12288 + n;
    atomicAdd(m0 + 0, a0.x); atomicAdd(m0 + 1, a0.y); atomicAdd(m0 + 2, a0.z); atomicAdd(m0 + 3, a0.w);
    atomicAdd(m1 + 0, a1.x); atomicAdd(m1 + 1, a1.y); atomicAdd(m1 + 2, a1.z); atomicAdd(m1 + 3, a1.w);
    atomicAdd(m2 + 0, a2.x); atomicAdd(m2 + 1, a2.y); atomicAdd(m2 + 2, a2.z); atomicAdd(m2 + 3, a2.w);
  }
  for (int layer = 0; layer < 2; ++layer) {
    for (int it = bid; it < 32 * 94; it += nb)
      transpose_cvt(p.w_in + (size_t)layer * D * DIN, D, DIN, DINP, p.wt_in + (size_t)layer * DINP * D, it, fs);
    for (int it = bid; it < 32 * 32; it += nb)
      transpose_cvt(p.w_out + (size_t)layer * D * D, D, D, D, p.wt_out + (size_t)layer * D * D, it, fs);
    for (int it = bid; it < 32 * 32; it += nb)
      transpose_cvt(p.w_q + (size_t)layer * D * D, D, D, D, p.wt_q + (size_t)layer * D * D, it, fs);
  }
  cvt_linear(p.sub_keys, p.sk_bf, (size_t)524288 / 8);
  cvt_fp8_rows(p.pu, p.u8, p.uscl, 2 * 16384);
  cvt_fp8_rows(p.pv, p.v8, p.vscl, 2 * 16384);
}

__device__ void modulate_phase(const Params& p, int layer, int which, int nrows) {
  const int lane = get_tid() & 63;
  const int wave = get_bid() * 8 + (get_tid() >> 6), nw = gridDim.x * 8;
  const float* g = (which == 0 ? p.g_attn : p.g_ffn) + layer * D;
  for (int m = wave; m < nrows; m += nw) {
    const float* src;
    if (layer == 0 && which == 0) src = (m < MX) ? p.x + (size_t)m * D : p.ctx + (size_t)(m - MX) * D;
    else src = p.xcur + (size_t)m * D;
    int vec = m < S ? 0 : (m < MX ? 1 : 2);
    const float* modl = p.mod + (layer * 3 + vec) * 12288 + which * 3 * D;
    float4 v[8];
    float ss = 0.f;
#pragma unroll
    for (int i = 0; i < 8; ++i) {
      v[i] = *(const float4*)(src + i * 256 + lane * 4);
      ss += v[i].x * v[i].x + v[i].y * v[i].y + v[i].z * v[i].z + v[i].w * v[i].w;
    }
    ss = wave_sum(ss);
    float rstd = rsqrtf(ss * (1.f / D) + EPS);
#pragma unroll
    for (int i = 0; i < 8; ++i) {
      int col = i * 256 + lane * 4;
      float4 gg = *(const float4*)(g + col);
      float4 sh = *(const float4*)(modl + col);
      float4 sc = *(const float4*)(modl + D + col);
      float y0 = v[i].x * rstd * gg.x * (1.f + sc.x) + sh.x;
      float y1 = v[i].y * rstd * gg.y * (1.f + sc.y) + sh.y;
      float y2 = v[i].z * rstd * gg.z * (1.f + sc.z) + sh.z;
      float y3 = v[i].w * rstd * gg.w * (1.f + sc.w) + sh.w;
      uint2 o; o.x = pack2(y0, y1); o.y = pack2(y2, y3);
      *(uint2*)(p.h + (size_t)m * D + col) = o;
    }
  }
}

template <int EPI, bool BIG>
__device__ void gemm_tile(const bfr* __restrict__ A, int lda, const bfr* __restrict__ Bt, int ldb, int K, int m0,
                          int n0, void* Cout, int ldc, const Params& p, int layer, char* smem) {
  constexpr int BN = BIG ? 256 : 128;
  constexpr int MI = BIG ? 8 : 4;
  constexpr int NBL = BN / 64;
  bfr* As0 = (bfr*)smem;
  bfr* Bs0 = As0 + 2 * 256 * 72;
  const int tid = get_tid(), lane = tid & 63, w = tid >> 6;
  const int wm = BIG ? (w >> 2) : (w >> 1), wn = BIG ? (w & 3) : (w & 1);
  const int fr = lane & 15, fq = lane >> 4;
  f32x4 acc[MI][4];
#pragma unroll
  for (int i = 0; i < MI; ++i)
#pragma unroll
    for (int j = 0; j < 4; ++j) acc[i][j] = (f32x4){0.f, 0.f, 0.f, 0.f};
  const int arow = tid >> 3, akc = (tid & 7) * 8;
  u4 rs[4];
  const bfr* Ap = A + (size_t)(m0 + arow) * lda + akc;
  const bfr* Bp = Bt + (size_t)(n0 + arow) * ldb + akc;
#pragma unroll
  for (int i = 0; i < 4; ++i) rs[i] = *(const u4*)(Ap + (size_t)(64 * i) * lda);
  __syncthreads();
#pragma unroll
  for (int i = 0; i < 4; ++i) *(u4*)(As0 + (arow + 64 * i) * 72 + akc) = rs[i];
#pragma unroll
  for (int i = 0; i < NBL; ++i) rs[i] = *(const u4*)(Bp + (size_t)(64 * i) * ldb);
#pragma unroll
  for (int i = 0; i < NBL; ++i) *(u4*)(Bs0 + (arow + 64 * i) * 72 + akc) = rs[i];
  const int nk = K >> 6;
  if (nk > 1) {
#pragma unroll
    for (int i = 0; i < 4; ++i) rs[i] = *(const u4*)(Ap + (size_t)(64 * i) * lda + 64);
  }
  __syncthreads();
  for (int kt = 0; kt < nk; ++kt) {
    const bfr* As = As0 + (kt & 1) * (256 * 72);
    const bfr* Bs = Bs0 + (kt & 1) * (BN * 72);
    bfr* Asn = As0 + ((kt + 1) & 1) * (256 * 72);
    bfr* Bsn = Bs0 + ((kt + 1) & 1) * (BN * 72);
#pragma unroll
    for (int kk = 0; kk < 2; ++kk) {
      bf16x8 b[4];
#pragma unroll
      for (int j = 0; j < 4; ++j) b[j] = *(const bf16x8*)(Bs + (wn * 64 + j * 16 + fr) * 72 + kk * 32 + fq * 8);
      {
        bf16x8 a_cur = *(const bf16x8*)(As + (wm * (MI * 16) + fr) * 72 + kk * 32 + fq * 8);
#pragma unroll
        for (int i = 0; i < MI; ++i) {
          bf16x8 a_nxt = a_cur;
          if (i + 1 < MI) a_nxt = *(const bf16x8*)(As + (wm * (MI * 16) + (i + 1) * 16 + fr) * 72 + kk * 32 + fq * 8);
#pragma unroll
          for (int j = 0; j < 4; ++j) acc[i][j] = __builtin_amdgcn_mfma_f32_16x16x32_bf16(b[j], a_cur, acc[i][j], 0, 0, 0);
          if (BIG) __builtin_amdgcn_sched_barrier(0);
          a_cur = a_nxt;
        }
      }
      if (kt + 1 < nk) {
        if (kk == 0) {
#pragma unroll
          for (int i = 0; i < 4; ++i) *(u4*)(Asn + (arow + 64 * i) * 72 + akc) = rs[i];
#pragma unroll
          for (int i = 0; i < NBL; ++i) rs[i] = *(const u4*)(Bp + (size_t)(64 * i) * ldb + (kt + 1) * 64);
        } else {
#pragma unroll
          for (int i = 0; i < NBL; ++i) *(u4*)(Bsn + (arow + 64 * i) * 72 + akc) = rs[i];
          if (kt + 2 < nk) {
#pragma unroll
            for (int i = 0; i < 4; ++i) rs[i] = *(const u4*)(Ap + (size_t)(64 * i) * lda + (kt + 2) * 64);
          }
        }
      }
    }
    __syncthreads();
  }
  const int nb0 = n0 + wn * 64 + fq * 4;
#pragma unroll
  for (int i = 0; i < MI; ++i) {
    const int m = m0 + wm * (MI * 16) + i * 16 + fr;
    if (EPI == 0) {
      bfr* crow = (bfr*)Cout + (size_t)m * ldc + nb0;
#pragma unroll
      for (int j = 0; j < 4; ++j) {
        uint2 o;
        o.x = pack2(acc[i][j][0], acc[i][j][1]); o.y = pack2(acc[i][j][2], acc[i][j][3]);
        *(uint2*)(crow + j * 16) = o;
      }
    } else if (EPI == 2) {
      float* crow = (float*)Cout + (size_t)m * ldc + nb0;
#pragma unroll
      for (int j = 0; j < 4; ++j) *(float4*)(crow + j * 16) = make_float4(acc[i][j][0], acc[i][j][1], acc[i][j][2], acc[i][j][3]);
    } else {
      const float* src;
      if (layer == 0) src = (m < MX) ? p.x + (size_t)m * D : p.ctx + (size_t)(m - MX) * D;
      else src = p.xcur + (size_t)m * D;
      src += nb0;
      const int vec = m < S ? 0 : (m < MX ? 1 : 2);
      const float* grow = p.mod + (layer * 3 + vec) * 12288 + 2 * D + nb0;
      float* orow = p.xcur + (size_t)m * D + nb0;
#pragma unroll
      for (int j = 0; j < 4; ++j) {
        const float4 gate = *(const float4*)(grow + j * 16);
        const float4 xs = *(const float4*)(src + j * 16);
        *(float4*)(orow + j * 16) = make_float4(xs.x + gate.x * acc[i][j][0], xs.y + gate.y * acc[i][j][1], xs.z + gate.z * acc[i][j][2], xs.w + gate.w * acc[i][j][3]);
      }
      __builtin_amdgcn_sched_barrier(0);
    }
  }
}

#define MFMA16(a, b, c) __builtin_amdgcn_mfma_f32_16x16x32_bf16((a), (b), (c), 0, 0, 0)
typedef __attribute__((ext_vector_type(4))) short s16x4;

__device__ __forceinline__ void load_kv_tile(bfr* dst, const bfr* src, int nrows, int tok0, int toklimit) {
  for (int c = get_tid(); c < nrows * 8; c += NTHR) {
    int r = c >> 3, ch = c & 7;
    int tok = tok0 + r;
    u4 v = (u4){0u, 0u, 0u, 0u};
    if (tok >= 0 && tok < toklimit) v = *(const u4*)(src + (ptrdiff_t)r * DINP + ch * 8);
    *(u4*)(dst + r * 72 + ch * 8) = v;
  }
}
__device__ __forceinline__ void load_vt_tile(bfr* Vt, int VS, const bfr* src, int nrows, int tok0, int toklimit) {
  for (int c = get_tid(); c < nrows * 8; c += NTHR) {
    int key = c % nrows, dch = c / nrows;
    int tok = tok0 + key;
    u4 v = (u4){0u, 0u, 0u, 0u};
    if (tok >= 0 && tok < toklimit) v = *(const u4*)(src + (ptrdiff_t)key * DINP + dch * 8);
    bfr* d = Vt + (dch * 8) * VS + key;
    d[0 * VS] = (bfr)(v.x & 0xffffu); d[1 * VS] = (bfr)(v.x >> 16);
    d[2 * VS] = (bfr)(v.y & 0xffffu); d[3 * VS] = (bfr)(v.y >> 16);
    d[4 * VS] = (bfr)(v.z & 0xffffu); d[5 * VS] = (bfr)(v.z >> 16);
    d[6 * VS] = (bfr)(v.w & 0xffffu); d[7 * VS] = (bfr)(v.w >> 16);
  }
}
__device__ __forceinline__ void load_kfrags(bf16x8 (&kf)[2][2], const bfr* Ks, int kt, int fr, int q4) {
#pragma unroll
  for (int blk = 0; blk < 2; ++blk)
#pragma unroll
    for (int ds = 0; ds < 2; ++ds) kf[blk][ds] = *(const bf16x8*)(Ks + (kt + blk * 16 + fr) * 72 + ds * 32 + q4 * 8);
}
__device__ __forceinline__ void load_vfrags(bf16x8 (&vf)[4], const bfr* Vt, int VS, int kt, int fr, int q4) {
#pragma unroll
  for (int db = 0; db < 4; ++db) {
    const bfr* vp = Vt + (db * 16 + fr) * VS + kt + q4 * 4;
    s16x4 lo = *(const s16x4*)vp, hi = *(const s16x4*)(vp + 16);
    vf[db] = __builtin_shufflevector(lo, hi, 0, 1, 2, 3, 4, 5, 6, 7);
  }
}
__device__ __forceinline__ void attn_tile_group(const bf16x8 (&kf)[2][2], const bf16x8 (&qf)[2], const bf16x8 (&vf)[4],
                                                f32x4 (&o)[4], float& m, float& l, const float (&badd)[8]) {
  f32x4 s0 = (f32x4){0.f, 0.f, 0.f, 0.f}, s1 = s0;
  s0 = MFMA16(kf[0][0], qf[0], s0); s0 = MFMA16(kf[0][1], qf[1], s0);
  s1 = MFMA16(kf[1][0], qf[0], s1); s1 = MFMA16(kf[1][1], qf[1], s1);
  float sv[8];
#pragma unroll
  for (int i = 0; i < 4; ++i) { sv[i] = s0[i] + badd[i]; sv[4 + i] = s1[i] + badd[4 + i]; }
  float mx = fmaxf(fmaxf(fmaxf(sv[0], sv[1]), fmaxf(sv[2], sv[3])), fmaxf(fmaxf(sv[4], sv[5]), fmaxf(sv[6], sv[7])));
  mx = fmaxf(mx, __shfl_xor(mx, 16));
  mx = fmaxf(mx, __shfl_xor(mx, 32));
  const float mn = fmaxf(m, mx);
  const float mref = (mn == -INFINITY) ? 0.f : mn;
  const float alpha = __expf(m - mref);
  float pv[8];
  float ls = 0.f;
#pragma unroll
  for (int i = 0; i < 8; ++i) { pv[i] = __expf(sv[i] - mref); ls += pv[i]; }
  ls += __shfl_xor(ls, 16);
  ls += __shfl_xor(ls, 32);
  l = l * alpha + ls;
  m = mn;
  u4 pk;
  pk.x = pack2(pv[0], pv[1]); pk.y = pack2(pv[2], pv[3]); pk.z = pack2(pv[4], pv[5]); pk.w = pack2(pv[6], pv[7]);
  const bf16x8 pb = __builtin_bit_cast(bf16x8, pk);
#pragma unroll
  for (int db = 0; db < 4; ++db) {
    o[db] *= alpha;
    o[db] = MFMA16(vf[db], pb, o[db]);
  }
}
__device__ __forceinline__ void load_qfrags(bf16x8 (&qf)[2], const bfr* qrow, int q4, float scale) {
#pragma unroll
  for (int ds = 0; ds < 2; ++ds) {
    u4 w = *(const u4*)(qrow + ds * 32 + q4 * 8);
    float f[8];
    unpack8(w, f);
    u4 o;
    o.x = pack2(f[0] * scale, f[1] * scale); o.y = pack2(f[2] * scale, f[3] * scale);
    o.z = pack2(f[4] * scale, f[5] * scale); o.w = pack2(f[6] * scale, f[7] * scale);
    qf[ds] = __builtin_bit_cast(bf16x8, o);
  }
}
__device__ __forceinline__ void store_ot(bfr* dst, const f32x4 (&o)[4], float inv, int q4) {
#pragma unroll
  for (int db = 0; db < 4; ++db) {
    uint2 w;
    w.x = pack2(o[db][0] * inv, o[db][1] * inv);
    w.y = pack2(o[db][2] * inv, o[db][3] * inv);
    *(uint2*)(dst + db * 16 + q4 * 4) = w;
  }
}

__device__ void swa_item(const Params& p, int layer, int item, char* smem) {
  const int b = item >> 7, kvh = (item >> 6) & 1, nbk = item & 63;
  bfr* Ks = (bfr*)smem;
  bfr* Vt = Ks + 384 * 72;
  constexpr int VS = 392;
  const int tid = get_tid();
  const int lane = tid & 63, w = tid >> 6, fr = lane & 15, q4 = lane >> 4;
  const float* cos16 = p.rope;
  const float* sin16 = p.rope + 2048;
  __syncthreads();
  const int tok0 = (nbk - 1) * 128;
  const bfr* rowbase = p.proj + (ptrdiff_t)(b * S + tok0) * DINP;
  load_vt_tile(Vt, VS, rowbase + C_SWV + kvh * 64, 384, tok0, S);
  for (int u = tid; u < 384 * 4; u += NTHR) {
    int r = u >> 2, A = (u >> 1) & 1, fc = u & 1;
    int tok = tok0 + r;
    u4 o1 = (u4){0u, 0u, 0u, 0u}, o2 = o1;
    if (tok >= 0 && tok < S) {
      const bfr* kp = rowbase + (ptrdiff_t)r * DINP + C_SWK + kvh * 64 + A * 32 + fc * 8;
      u4 w1 = *(const u4*)kp, w2 = *(const u4*)(kp + 16);
      float x1[8], x2[8], y1[8], y2[8];
      unpack8(w1, x1); unpack8(w2, x2);
      int pos = A ? (tok & 63) : (tok >> 6);
#pragma unroll
      for (int j = 0; j < 8; ++j) {
        float cs = cos16[pos * 16 + fc * 8 + j], sn = sin16[pos * 16 + fc * 8 + j];
        y1[j] = x1[j] * cs - x2[j] * sn;
        y2[j] = x2[j] * cs + x1[j] * sn;
      }
      o1.x = pack2(y1[0], y1[1]); o1.y = pack2(y1[2], y1[3]); o1.z = pack2(y1[4], y1[5]); o1.w = pack2(y1[6], y1[7]);
      o2.x = pack2(y2[0], y2[1]); o2.y = pack2(y2[2], y2[3]); o2.z = pack2(y2[4], y2[5]); o2.w = pack2(y2[6], y2[7]);
    }
    int ch1 = A * 4 + fc, ch2 = A * 4 + 2 + fc;
    *(u4*)(Ks + r * 72 + ch1 * 8) = o1;
    *(u4*)(Ks + r * 72 + ch2 * 8) = o2;
  }
  const int g = w >> 1, qhalf = w & 1;
  const int hq = kvh * 4 + g;
  bf16x8 qf[4][2];
  f32x4 oacc[4][4];
  float mm[4], ll[4];
#pragma unroll
  for (int grp = 0; grp < 4; ++grp) {
    const int tq = nbk * 128 + qhalf * 64 + grp * 16 + fr;
    const bfr* qrow = p.proj + (size_t)(b * S + tq) * DINP + C_SWQ + hq * 64;
#pragma unroll
    for (int ds = 0; ds < 2; ++ds) {
      u4 wq = *(const u4*)(qrow + ds * 32 + q4 * 8);
      float f[8], y[8];
      unpack8(wq, f);
      const int pos = ds ? (tq & 63) : (tq >> 6);
#pragma unroll
      for (int j = 0; j < 8; ++j) {
        const float other = __shfl_xor(f[j], 32);
        const int fi = (q4 & 1) * 8 + j;
        const float cs = cos16[pos * 16 + fi], sn = sin16[pos * 16 + fi];
        y[j] = ((q4 < 2) ? (f[j] * cs - other * sn) : (f[j] * cs + other * sn)) * 0.125f;
      }
      u4 o;
      o.x = pack2(y[0], y[1]); o.y = pack2(y[2], y[3]); o.z = pack2(y[4], y[5]); o.w = pack2(y[6], y[7]);
      qf[grp][ds] = __builtin_bit_cast(bf16x8, o);
    }
    mm[grp] = -INFINITY; ll[grp] = 0.f;
#pragma unroll
    for (int db = 0; db < 4; ++db) oacc[grp][db] = (f32x4){0.f, 0.f, 0.f, 0.f};
  }
  __syncthreads();
#pragma unroll 1
  for (int t = 0; t < 10; ++t) {
    const int kt = qhalf * 64 + 32 * t;
    if (tok0 + kt + 31 < 0 || tok0 + kt >= S) continue;
    bf16x8 kf[2][2], vf[4];
    load_kfrags(kf, Ks, kt, fr, q4);
    load_vfrags(vf, Vt, VS, kt, fr, q4);
#pragma unroll
    for (int grp = 0; grp < 4; ++grp) {
      const int qg0 = 128 + qhalf * 64 + grp * 16;
      if (kt > qg0 + 15 + 128 || kt + 31 < qg0 - 128) continue;
      const int qrow = qg0 + fr;
      float badd[8];
#pragma unroll
      for (int i = 0; i < 8; ++i) {
        const int lr = kt + (i >> 2) * 16 + q4 * 4 + (i & 3);
        const int dd = qrow - lr;
        const int tok = tok0 + lr;
        const bool ok = (dd <= 128) && (dd >= -128) && (tok >= 0) && (tok < S);
        badd[i] = ok ? 0.f : -INFINITY;
      }
      attn_tile_group(kf, qf[grp], vf, oacc[grp], mm[grp], ll[grp], badd);
    }
  }
  __syncthreads();
  const bfr* zbase = p.proj + (size_t)(MX + b * 256) * DINP;
  load_kv_tile(Ks, zbase + C_SWK + kvh * 64, 256, 0, 256);
  load_vt_tile(Vt, VS, zbase + C_SWV + kvh * 64, 256, 0, 256);
  __syncthreads();
  float zb[8];
#pragma unroll
  for (int i = 0; i < 8; ++i) zb[i] = 0.f;
#pragma unroll 1
  for (int t = 0; t < 8; ++t) {
    const int kt = 32 * t;
    bf16x8 kf[2][2], vf[4];
    load_kfrags(kf, Ks, kt, fr, q4);
    load_vfrags(vf, Vt, VS, kt, fr, q4);
#pragma unroll
    for (int grp = 0; grp < 4; ++grp) attn_tile_group(kf, qf[grp], vf, oacc[grp], mm[grp], ll[grp], zb);
  }
  const float sk = p.sink[layer * 8 + hq];
#pragma unroll
  for (int grp = 0; grp < 4; ++grp) {
    const int tq = nbk * 128 + qhalf * 64 + grp * 16 + fr;
    const float mn = fmaxf(mm[grp], sk);
    const float alpha = __expf(mm[grp] - mn);
    const float lt = ll[grp] * alpha + __expf(sk - mn);
    store_ot(p.mix + (size_t)(b * S + tq) * D + 1536 + hq * 64, oacc[grp], alpha / lt, q4);
  }
}

__device__ void na_item(const Params& p, int layer, int item, char* smem) {
  const int b = item >> 10, h = (item >> 7) & 7, r = item & 127;
  bfr* Ks = (bfr*)smem;
  bfr* Vt = Ks + 512 * 72;
  constexpr int VS = 520;
  float* rp = (float*)(Vt + 64 * VS);
  float* mg = (float*)smem;
  const int tid = get_tid();
  const int lane = tid & 63, w = tid >> 6, fr = lane & 15, q4 = lane >> 4;
  __syncthreads();
  int r0 = r - 4; r0 = r0 < 0 ? 0 : (r0 > 120 ? 120 : r0);
  const bfr* rowbase = p.proj + (size_t)(b * S + r0 * 64) * DINP;
  load_kv_tile(Ks, rowbase + C_NAK + h * 64, 512, 0, 512);
  load_vt_tile(Vt, VS, rowbase + C_NAV + h * 64, 512, 0, 512);
  if (tid < 15 * 31) rp[tid] = p.rpb[(layer * 8 + h) * 465 + tid];
  const int grp = w >> 1, half = w & 1;
  const int cq = grp * 16 + fr;
  const int tq = r * 64 + cq;
  bf16x8 qf[2];
  load_qfrags(qf, p.proj + (size_t)(b * S + tq) * DINP + C_NAQ + h * 64, q4, 0.125f);
  f32x4 oacc[4];
#pragma unroll
  for (int db = 0; db < 4; ++db) oacc[db] = (f32x4){0.f, 0.f, 0.f, 0.f};
  float m = -INFINITY, l = 0.f;
  __syncthreads();
  int cs = cq - 8; cs = cs < 0 ? 0 : (cs > 48 ? 48 : cs);
  const int tstart = grp == 0 ? 0 : (grp == 1 ? 8 : (grp == 2 ? 24 : 32));
#pragma unroll 1
  for (int jj = 0; jj < 4; ++jj) {
    const int jrow = half * 4 + jj;
    const int drow = (r0 + jrow) - r + 7;
    const int kt = jrow * 64 + tstart;
    bf16x8 kf[2][2], vf[4];
    load_kfrags(kf, Ks, kt, fr, q4);
    load_vfrags(vf, Vt, VS, kt, fr, q4);
    float badd[8];
#pragma unroll
    for (int i = 0; i < 8; ++i) {
      const int ck = tstart + (i >> 2) * 16 + q4 * 4 + (i & 3);
      const bool ok = (ck >= cs) && (ck < cs + 16);
      int dc = ck - cq + 15; dc = dc < 0 ? 0 : (dc > 30 ? 30 : dc);
      badd[i] = ok ? rp[drow * 31 + dc] : -INFINITY;
    }
    attn_tile_group(kf, qf, vf, oacc, m, l, badd);
  }
  __syncthreads();
  const bfr* zbase = p.proj + (size_t)(MX + b * 256) * DINP;
  load_kv_tile(Ks, zbase + C_NAK + h * 64, 256, 0, 256);
  load_vt_tile(Vt, VS, zbase + C_NAV + h * 64, 256, 0, 256);
  __syncthreads();
  float zb[8];
#pragma unroll
  for (int i = 0; i < 8; ++i) zb[i] = 0.f;
#pragma unroll 1
  for (int t = 0; t < 4; ++t) {
    const int kt = half * 128 + 32 * t;
    bf16x8 kf[2][2], vf[4];
    load_kfrags(kf, Ks, kt, fr, q4);
    load_vfrags(vf, Vt, VS, kt, fr, q4);
    attn_tile_group(kf, qf, vf, oacc, m, l, zb);
  }
  __syncthreads();
  float* mo = mg + grp * (16 * 64 + 64) ;
  if (half == 1) {
#pragma unroll
    for (int db = 0; db < 4; ++db)
#pragma unroll
      for (int i = 0; i < 4; ++i) mo[(db * 4 + i) * 64 + lane] = oacc[db][i];
    if (q4 == 0) { mo[16 * 64 + fr] = m; mo[16 * 64 + 16 + fr] = l; }
  }
  __syncthreads();
  if (half == 0) {
    const float m2 = mo[16 * 64 + fr], l2 = mo[16 * 64 + 16 + fr];
    const float mn = fmaxf(m, m2);
    const float a1 = __expf(m - mn), a2 = __expf(m2 - mn);
    const float lt = l * a1 + l2 * a2;
    const float i1 = a1 / lt, i2 = a2 / lt;
#pragma unroll
    for (int db = 0; db < 4; ++db)
#pragma unroll
      for (int i = 0; i < 4; ++i) oacc[db][i] = oacc[db][i] * i1 + mo[(db * 4 + i) * 64 + lane] * i2;
    store_ot(p.mix + (size_t)(b * S + tq) * D + h * 64, oacc, 1.f, q4);
  }
}

__device__ void ctx_item(const Params& p, int layer, int item, char* smem) {
  const int b = item >> 4, type = (item >> 3) & 1, h = item & 7;
  bfr* Ks = (bfr*)smem;
  bfr* Vt = Ks + 256 * 72;
  constexpr int VS = 264;
  const int tid = get_tid();
  const int lane = tid & 63, w = tid >> 6, fr = lane & 15, q4 = lane >> 4;
  __syncthreads();
  const bfr* zbase = p.proj + (size_t)(MX + b * 256) * DINP;
  const int kcol = type ? (C_SWK + (h >> 2) * 64) : (C_NAK + h * 64);
  const int vcol = type ? (C_SWV + (h >> 2) * 64) : (C_NAV + h * 64);
  const int qcol = type ? (C_SWQ + h * 64) : (C_NAQ + h * 64);
  load_kv_tile(Ks, zbase + kcol, 256, 0, 256);
  load_vt_tile(Vt, VS, zbase + vcol, 256, 0, 256);
  bf16x8 qf[2][2];
  f32x4 oacc[2][4];
  float mm[2], ll[2];
#pragma unroll
  for (int grp = 0; grp < 2; ++grp) {
    const int qz = w * 32 + grp * 16 + fr;
    load_qfrags(qf[grp], zbase + (size_t)qz * DINP + qcol, q4, 0.125f);
    mm[grp] = -INFINITY; ll[grp] = 0.f;
#pragma unroll
    for (int db = 0; db < 4; ++db) oacc[grp][db] = (f32x4){0.f, 0.f, 0.f, 0.f};
  }
  __syncthreads();
  float zb[8];
#pragma unroll
  for (int i = 0; i < 8; ++i) zb[i] = 0.f;
#pragma unroll 1
  for (int t = 0; t < 8; ++t) {
    const int kt = 32 * t;
    bf16x8 kf[2][2], vf[4];
    load_kfrags(kf, Ks, kt, fr, q4);
    load_vfrags(vf, Vt, VS, kt, fr, q4);
#pragma unroll
    for (int grp = 0; grp < 2; ++grp) attn_tile_group(kf, qf[grp], vf, oacc[grp], mm[grp], ll[grp], zb);
  }
#pragma unroll
  for (int grp = 0; grp < 2; ++grp) {
    const int qz = w * 32 + grp * 16 + fr;
    float inv;
    if (type == 1) {
      const float sk = p.sink[layer * 8 + h];
      const float mn = fmaxf(mm[grp], sk);
      const float a = __expf(mm[grp] - mn);
      inv = a / (ll[grp] * a + __expf(sk - mn));
    } else {
      inv = 1.f / ll[grp];
    }
    store_ot(p.mix + (size_t)(MX + b * 256 + qz) * D + (type ? 1536 : 0) + h * 64, oacc[grp], inv, q4);
  }
}

template <int W>
__device__ __forceinline__ void load_rows_f32(float* dst, int stride, const bfr* src, float scale) {
  constexpr int CPR = W / 8;
  for (int c = get_tid(); c < 64 * CPR; c += NTHR) {
    int j = c / CPR, ch = c % CPR;
    u4 w = *(const u4*)(src + (size_t)j * DINP + ch * 8);
    float f[8];
    unpack8(w, f);
    float4 a = make_float4(f[0] * scale, f[1] * scale, f[2] * scale, f[3] * scale);
    float4 bq = make_float4(f[4] * scale, f[5] * scale, f[6] * scale, f[7] * scale);
    *(float4*)(dst + j * stride + ch * 8) = a;
    *(float4*)(dst + j * stride + ch * 8 + 4) = bq;
  }
}

__device__ __forceinline__ void rope128_tile(float* t, int stride, int prow, const float* rope, float scale) {
  const float* cos32 = rope + 4096;
  const float* sin32 = rope + 8192;
  for (int u = get_tid(); u < 64 * 64; u += NTHR) {
    int j = u >> 6, A = (u >> 5) & 1, f = u & 31;
    int pos = A ? j : prow;
    float cs = cos32[pos * 32 + f], sn = sin32[pos * 32 + f];
    float x1 = t[j * stride + A * 64 + f], x2 = t[j * stride + A * 64 + 32 + f];
    t[j * stride + A * 64 + f] = (x1 * cs - x2 * sn) * scale;
    t[j * stride + A * 64 + 32 + f] = (x2 * cs + x1 * sn) * scale;
  }
}

__device__ __forceinline__ void gla_logdecay(const Params& p, int layer, int h, int dir, const bfr* rowbase, float* G) {
  const int tid = get_tid();
  const int j = tid >> 3, dg = tid & 7;
  const bfr* dl = rowbase + (size_t)j * DINP + C_GLD + dir * 16;
  u4 w0 = *(const u4*)dl, w1 = *(const u4*)(dl + 8);
  float x[16];
  unpack8(w0, x); unpack8(w1, x + 8);
  const float* wu = p.gla_wu + (size_t)layer * 8192 + dir * 4096 + h * 64;
  const float* bb = p.gla_b + layer * 512 + dir * 256 + h * 64;
#pragma unroll
  for (int dd = 0; dd < 8; ++dd) {
    int d = dg + 8 * dd;
    float pre = bb[d];
#pragma unroll
    for (int r = 0; r < 16; ++r) pre += x[r] * wu[r * 256 + d];
    G[j * 68 + d] = logsig_f(pre) * (1.f / 16.f);
  }
}

__device__ __forceinline__ void gla_logdecay2(const Params& p, int layer, int h, const bfr* rowbase, float* G0, float* G1) {
  const int tid = get_tid();
  const int w = tid >> 6, lane = tid & 63, fr = lane & 15, q4 = lane >> 4;
  const int dir = w >> 2, dt = w & 3;
  const int d = dt * 16 + fr;
  float* G = dir ? G1 : G0;
  u4 bw = (u4){0u, 0u, 0u, 0u};
  if (q4 < 2) {
    const float* wu = p.gla_wu + (size_t)layer * 8192 + dir * 4096 + (q4 * 8) * 256 + h * 64 + d;
    bw.x = pack2(wu[0 * 256], wu[1 * 256]); bw.y = pack2(wu[2 * 256], wu[3 * 256]);
    bw.z = pack2(wu[4 * 256], wu[5 * 256]); bw.w = pack2(wu[6 * 256], wu[7 * 256]);
  }
  const bf16x8 bq = __builtin_bit_cast(bf16x8, bw);
  const float bias = p.gla_b[layer * 512 + dir * 256 + h * 64 + d];
#pragma unroll
  for (int rt = 0; rt < 4; ++rt) {
    u4 aw = (u4){0u, 0u, 0u, 0u};
    if (q4 < 2) aw = *(const u4*)(rowbase + (size_t)(rt * 16 + fr) * DINP + C_GLD + dir * 16 + q4 * 8);
    f32x4 acc = (f32x4){0.f, 0.f, 0.f, 0.f};
    acc = MFMA16(__builtin_bit_cast(bf16x8, aw), bq, acc);
#pragma unroll
    for (int r = 0; r < 4; ++r) G[(rt * 16 + q4 * 4 + r) * 68 + d] = logsig_f(acc[r] + bias) * (1.f / 16.f);
  }
}

__device__ __forceinline__ int scan_pos(int dir, int g) { return dir == 0 ? g : (g < 4 ? 3 - g : 135 - g); }
__device__ __forceinline__ int group_row0(int b, int g) { return g < 4 ? (MX + b * 256 + g * 64) : (b * S + (g - 4) * 64); }

template <int W>
__device__ __forceinline__ void load_rows_transposed(bfr* T, const bfr* src) {
  for (int c = get_tid(); c < 64 * (W / 8); c += NTHR) {
    const int j = c & 63, dch = c >> 6;
    const u4 v = *(const u4*)(src + (size_t)j * DINP + dch * 8);
    bfr* d = T + (dch * 8) * 72 + j;
    d[0 * 72] = (bfr)(v.x & 0xffffu); d[1 * 72] = (bfr)(v.x >> 16);
    d[2 * 72] = (bfr)(v.y & 0xffffu); d[3 * 72] = (bfr)(v.y >> 16);
    d[4 * 72] = (bfr)(v.z & 0xffffu); d[5 * 72] = (bfr)(v.z >> 16);
    d[6 * 72] = (bfr)(v.w & 0xffffu); d[7 * 72] = (bfr)(v.w >> 16);
  }
}

template <int DK, bool GLA>
__device__ void scan_a_item(const Params& p, int layer, int item, char* smem) {
  const int g = item % 132;
  const int t2 = item / 132;
  const int h = t2 & 3, b = t2 >> 2;
  constexpr int KS = DK + 4;
  float* ks = (float*)smem;
  float* E0 = ks + 64 * KS;
  float* E1 = E0 + 64 * 68;
  bfr* Kt = (bfr*)(E1 + 64 * 68);
  bfr* Vt = Kt + DK * 72;
  const int tid = get_tid();
  const int w = tid >> 6, lane = tid & 63, fr = lane & 15, q4 = lane >> 4;
  const int row0 = group_row0(b, g);
  const bfr* rowbase = p.proj + (size_t)row0 * DINP;
  __syncthreads();
  if (GLA) {
    load_rows_transposed<128>(Vt, rowbase + C_GLV + h * 128);
    load_rows_f32<64>(ks, KS, rowbase + C_GLK + h * 64, 1.f);
    gla_logdecay2(p, layer, h, rowbase, E0, E1);
  } else {
    const float kscale = 0.08838834764831845f;
    load_rows_transposed<128>(Vt, rowbase + C_RTV + h * 128);
    load_rows_f32<128>(ks, KS, rowbase + C_RTK + h * 128, g < 4 ? kscale : 1.f);
    __syncthreads();
    if (g >= 4) rope128_tile(ks, KS, g - 4, p.rope, kscale);
  }
#pragma unroll 1
  for (int dir = 0; dir < 2; ++dir) {
    const int scan = ((b * 4 + h) * 2 + dir);
    const int pos = scan_pos(dir, g);
    float lg = 0.f;
    __syncthreads();
    float* E = dir ? E1 : E0;
    if (GLA) {
      if (tid < 64) {
        float run = 0.f;
        if (dir == 0) {
          for (int j = 63; j >= 0; --j) { float v = E[j * 68 + tid]; E[j * 68 + tid] = run; run += v; }
        } else {
          for (int j = 0; j < 64; ++j) { float v = E[j * 68 + tid]; E[j * 68 + tid] = run; run += v; }
        }
        p.dec_gla[(size_t)(scan * 132 + pos) * 64 + tid] = __expf(run);
      }
      __syncthreads();
    } else {
      lg = p.ret_lg[layer * 8 + dir * 4 + h];
      if (tid < 128) p.dec_ret[(size_t)(scan * 132 + pos) * 128 + tid] = __expf(lg * 64.f);
    }
    for (int u = tid; u < 64 * DK; u += NTHR) {
      const int j = u & 63, d = u >> 6;
      const float sc = GLA ? __expf(E[j * 68 + d]) : __expf(lg * (dir == 0 ? (float)(63 - j) : (float)j));
      Kt[d * 72 + j] = f2bf(ks[j * KS + d] * sc);
    }
    __syncthreads();
    bf16x8 vfr[2];
#pragma unroll
    for (int k2 = 0; k2 < 2; ++k2) vfr[k2] = *(const bf16x8*)(Vt + (w * 16 + fr) * 72 + k2 * 32 + q4 * 8);
    bfr* st = (GLA ? p.st_gla : p.st_ret) + (size_t)(scan * 132 + pos) * DK * 128;
#pragma unroll 2
    for (int dt = 0; dt < DK / 16; ++dt) {
      f32x4 acc = (f32x4){0.f, 0.f, 0.f, 0.f};
#pragma unroll
      for (int k2 = 0; k2 < 2; ++k2) {
        const bf16x8 kq = *(const bf16x8*)(Kt + (dt * 16 + fr) * 72 + k2 * 32 + q4 * 8);
        acc = MFMA16(kq, vfr[k2], acc);
      }
      uint2 o;
      o.x = pack2(acc[0], acc[1]); o.y = pack2(acc[2], acc[3]);
      *(uint2*)(st + (size_t)(w * 16 + fr) * DK + dt * 16 + q4 * 4) = o;
    }
  }
}

__device__ void scan_b_phase(const Params& p) {
  const int gt = get_bid() * NTHR + get_tid(), ntot = gridDim.x * NTHR;
  for (int ch = gt; ch < 98304; ch += ntot) {
    bfr* st; const float* dec; int DK, e4;
    if (ch < 65536) { int scan = ch >> 12; e4 = ch & 4095; DK = 128; st = p.st_ret + (size_t)scan * 132 * 16384; dec = p.dec_ret + (size_t)scan * 132 * 128; }
    else { int c2 = ch - 65536; int scan = c2 >> 11; e4 = c2 & 2047; DK = 64; st = p.st_gla + (size_t)scan * 132 * 8192; dec = p.dec_gla + (size_t)scan * 132 * 64; }
    const int d0 = (e4 * 4) & (DK - 1);
    const size_t cstride = (size_t)DK * 128;
    float4 s = make_float4(0.f, 0.f, 0.f, 0.f);
    bfr* ptr = st + e4 * 4;
    const float* dp = dec + d0;
    for (int pos = 0; pos < 132; pos += 4) {
      uint2 u[4];
      float4 dv[4];
#pragma unroll
      for (int q = 0; q < 4; ++q) {
        u[q] = *(const uint2*)(ptr + (size_t)(pos + q) * cstride);
        dv[q] = *(const float4*)(dp + (pos + q) * DK);
      }
#pragma unroll
      for (int q = 0; q < 4; ++q) {
        uint2 o;
        o.x = pack2(s.x, s.y); o.y = pack2(s.z, s.w);
        *(uint2*)(ptr + (size_t)(pos + q) * cstride) = o;
        s = make_float4(dv[q].x * s.x + lo16(u[q].x), dv[q].y * s.y + hi16(u[q].x), dv[q].z * s.z + lo16(u[q].y), dv[q].w * s.w + hi16(u[q].y));
      }
    }
  }
}

template <int DK, bool GLA>
__device__ void scan_c_item(const Params& p, int layer, int item, char* smem) {
  const int g = item % 132;
  const int t2 = item / 132;
  const int h = t2 & 3, b = t2 >> 2;
  constexpr int FS = DK + 4;
  constexpr int QS = DK + 8;
  float* stg = (float*)smem;
  float* Gf = stg + 64 * FS;
  float* Gb = Gf + (GLA ? 64 * 68 : 0);
  float* red = Gb + (GLA ? 64 * 68 : 0);
  float* red2 = red + 8 * 64 * 2;
  bfr* T0 = (bfr*)(red2 + 64 * 2);
  bfr* T1 = T0 + 64 * QS;
  bfr* T2 = T1 + 64 * QS;
  bfr* T3 = T2 + 64 * QS;
  bfr* T4 = T3 + 64 * QS;
  bfr* T5 = T4 + (GLA ? 64 * QS : 0);
  bfr* Vt = T5 + (GLA ? 64 * QS : 0);
  bfr* Am = Vt + 128 * 72;
  const int tid = get_tid();
  const int w = tid >> 6, lane = tid & 63, fr = lane & 15, q4 = lane >> 4;
  const int row0 = group_row0(b, g);
  const bfr* rowbase = p.proj + (size_t)row0 * DINP;
  float lgf = 0.f, lgb = 0.f;
  __syncthreads();
  if (GLA) {
    load_rows_transposed<128>(Vt, rowbase + C_GLV + h * 128);
    load_rows_f32<64>(stg, FS, rowbase + C_GLQ + h * 64, 0.125f);
    gla_logdecay2(p, layer, h, rowbase, Gf, Gb);
    __syncthreads();
    {
      const int d = tid & 63, seg = tid >> 6;
      float runf = 0.f, runb = 0.f;
#pragma unroll
      for (int jj = 0; jj < 8; ++jj) {
        const int jf = seg * 8 + jj, jb = seg * 8 + 7 - jj;
        runf += Gf[jf * 68 + d]; Gf[jf * 68 + d] = runf;
        runb += Gb[jb * 68 + d]; Gb[jb * 68 + d] = runb;
      }
      red[seg * 64 + d] = runf;
      red[512 + seg * 64 + d] = runb;
      __syncthreads();
      float offf = 0.f, offb = 0.f;
#pragma unroll
      for (int s2 = 0; s2 < 8; ++s2) {
        if (s2 < seg) offf += red[s2 * 64 + d];
        if (s2 > seg) offb += red[512 + s2 * 64 + d];
      }
#pragma unroll
      for (int jj = 0; jj < 8; ++jj) {
        const int j = seg * 8 + jj;
        Gf[j * 68 + d] += offf;
        Gb[j * 68 + d] += offb;
      }
    }
    __syncthreads();
    for (int u = tid; u < 64 * 64; u += NTHR) {
      const int i = u >> 6, d = u & 63;
      const float qv = stg[i * FS + d];
      const float gf = Gf[i * 68 + d], gb = Gb[i * 68 + d];
      T0[i * QS + d] = f2bf(qv * __expf(gf - Gf[63 * 68 + d]));
      T2[i * QS + d] = f2bf(qv * __expf(gf));
      T4[i * QS + d] = f2bf(qv * __expf(gb - Gb[d]));
      T3[i * QS + d] = f2bf(qv * __expf(gb));
    }
    __syncthreads();
    load_rows_f32<64>(stg, FS, rowbase + C_GLK + h * 64, 1.f);
    __syncthreads();
    for (int u = tid; u < 64 * 64; u += NTHR) {
      const int j = u >> 6, d = u & 63;
      const float kv = stg[j * FS + d];
      T1[j * QS + d] = f2bf(kv * __expf(Gf[63 * 68 + d] - Gf[j * 68 + d]));
      T5[j * QS + d] = f2bf(kv * __expf(Gb[d] - Gb[j * 68 + d]));
    }
  } else {
    const float kscale = 0.08838834764831845f;
    lgf = p.ret_lg[layer * 8 + 0 + h];
    lgb = p.ret_lg[layer * 8 + 4 + h];
    load_rows_transposed<128>(Vt, rowbase + C_RTV + h * 128);
    {
      const int j = tid >> 3, A = (tid >> 2) & 1, fc = tid & 3;
      float cs[8], sn[8];
      if (g >= 4) {
        const int pos = A ? j : (g - 4);
        const float* cp = p.rope + 4096 + pos * 32 + fc * 8;
        const float4 c0 = *(const float4*)cp, c1 = *(const float4*)(cp + 4);
        const float4 s0 = *(const float4*)(cp + 4096), s1 = *(const float4*)(cp + 4100);
        cs[0] = c0.x; cs[1] = c0.y; cs[2] = c0.z; cs[3] = c0.w; cs[4] = c1.x; cs[5] = c1.y; cs[6] = c1.z; cs[7] = c1.w;
        sn[0] = s0.x; sn[1] = s0.y; sn[2] = s0.z; sn[3] = s0.w; sn[4] = s1.x; sn[5] = s1.y; sn[6] = s1.z; sn[7] = s1.w;
      } else {
#pragma unroll
        for (int e = 0; e < 8; ++e) { cs[e] = 1.f; sn[e] = 0.f; }
      }
      const int col = A * 64 + fc * 8;
      const bfr* qp = rowbase + (size_t)j * DINP + C_RTQ + h * 128 + col;
      const bfr* kp = rowbase + (size_t)j * DINP + C_RTK + h * 128 + col;
      const u4 q1 = *(const u4*)qp, q2 = *(const u4*)(qp + 32);
      const u4 k1 = *(const u4*)kp, k2w = *(const u4*)(kp + 32);
      float x1[8], x2[8], y1[8], y2[8];
      unpack8(q1, x1); unpack8(q2, x2);
#pragma unroll
      for (int e = 0; e < 8; ++e) { y1[e] = x1[e] * cs[e] - x2[e] * sn[e]; y2[e] = x2[e] * cs[e] + x1[e] * sn[e]; }
      const float ff = __expf(lgf * (float)(j + 1)), fb = __expf(lgb * (float)(64 - j));
      u4 o;
      o.x = pack2(y1[0], y1[1]); o.y = pack2(y1[2], y1[3]); o.z = pack2(y1[4], y1[5]); o.w = pack2(y1[6], y1[7]);
      *(u4*)(T0 + j * QS + col) = o;
      o.x = pack2(y2[0], y2[1]); o.y = pack2(y2[2], y2[3]); o.z = pack2(y2[4], y2[5]); o.w = pack2(y2[6], y2[7]);
      *(u4*)(T0 + j * QS + col + 32) = o;
      o.x = pack2(y1[0] * ff, y1[1] * ff); o.y = pack2(y1[2] * ff, y1[3] * ff); o.z = pack2(y1[4] * ff, y1[5] * ff); o.w = pack2(y1[6] * ff, y1[7] * ff);
      *(u4*)(T2 + j * QS + col) = o;
      o.x = pack2(y2[0] * ff, y2[1] * ff); o.y = pack2(y2[2] * ff, y2[3] * ff); o.z = pack2(y2[4] * ff, y2[5] * ff); o.w = pack2(y2[6] * ff, y2[7] * ff);
      *(u4*)(T2 + j * QS + col + 32) = o;
      o.x = pack2(y1[0] * fb, y1[1] * fb); o.y = pack2(y1[2] * fb, y1[3] * fb); o.z = pack2(y1[4] * fb, y1[5] * fb); o.w = pack2(y1[6] * fb, y1[7] * fb);
      *(u4*)(T3 + j * QS + col) = o;
      o.x = pack2(y2[0] * fb, y2[1] * fb); o.y = pack2(y2[2] * fb, y2[3] * fb); o.z = pack2(y2[4] * fb, y2[5] * fb); o.w = pack2(y2[6] * fb, y2[7] * fb);
      *(u4*)(T3 + j * QS + col + 32) = o;
      unpack8(k1, x1); unpack8(k2w, x2);
#pragma unroll
      for (int e = 0; e < 8; ++e) { y1[e] = (x1[e] * cs[e] - x2[e] * sn[e]) * kscale; y2[e] = (x2[e] * cs[e] + x1[e] * sn[e]) * kscale; }
      o.x = pack2(y1[0], y1[1]); o.y = pack2(y1[2], y1[3]); o.z = pack2(y1[4], y1[5]); o.w = pack2(y1[6], y1[7]);
      *(u4*)(T1 + j * QS + col) = o;
      o.x = pack2(y2[0], y2[1]); o.y = pack2(y2[2], y2[3]); o.z = pack2(y2[4], y2[5]); o.w = pack2(y2[6], y2[7]);
      *(u4*)(T1 + j * QS + col + 32) = o;
    }
  }
  __syncthreads();
  {
    const int ti = w >> 1;
#pragma unroll
    for (int tt = 0; tt < 2; ++tt) {
      const int tj = (w & 1) * 2 + tt;
      f32x4 af = (f32x4){0.f, 0.f, 0.f, 0.f}, ab = af;
#pragma unroll
      for (int k2 = 0; k2 < DK / 32; ++k2) {
        const bf16x8 a = *(const bf16x8*)(T0 + (ti * 16 + fr) * QS + k2 * 32 + q4 * 8);
        const bf16x8 bq = *(const bf16x8*)(T1 + (tj * 16 + fr) * QS + k2 * 32 + q4 * 8);
        af = MFMA16(a, bq, af);
        if (GLA) {
          const bf16x8 a2 = *(const bf16x8*)(T4 + (ti * 16 + fr) * QS + k2 * 32 + q4 * 8);
          const bf16x8 b2 = *(const bf16x8*)(T5 + (tj * 16 + fr) * QS + k2 * 32 + q4 * 8);
          ab = MFMA16(a2, b2, ab);
        }
      }
#pragma unroll
      for (int r = 0; r < 4; ++r) {
        const int i = ti * 16 + q4 * 4 + r, j = tj * 16 + fr;
        float v;
        if (GLA) v = (j <= i) ? af[r] : ab[r];
        else v = af[r] * ((j <= i) ? __expf(lgf * (float)(i - j)) : __expf(lgb * (float)(j - i)));
        Am[i * 72 + j] = f2bf(v);
      }
    }
  }
  __syncthreads();
  f32x4 acc[4];
#pragma unroll
  for (int rt = 0; rt < 4; ++rt) acc[rt] = (f32x4){0.f, 0.f, 0.f, 0.f};
#pragma unroll
  for (int k2 = 0; k2 < 2; ++k2) {
    const bf16x8 bq = *(const bf16x8*)(Vt + (w * 16 + fr) * 72 + k2 * 32 + q4 * 8);
#pragma unroll
    for (int rt = 0; rt < 4; ++rt) {
      const bf16x8 a = *(const bf16x8*)(Am + (rt * 16 + fr) * 72 + k2 * 32 + q4 * 8);
      acc[rt] = MFMA16(a, bq, acc[rt]);
    }
  }
#pragma unroll
  for (int dir = 0; dir < 2; ++dir) {
    const int scan = (b * 4 + h) * 2 + dir;
    const int pos = scan_pos(dir, g);
    const bfr* St = (GLA ? p.st_gla : p.st_ret) + (size_t)(scan * 132 + pos) * DK * 128 + (size_t)(w * 16 + fr) * DK + q4 * 8;
    const bfr* qt = dir == 0 ? T2 : T3;
#pragma unroll
    for (int k2 = 0; k2 < DK / 32; ++k2) {
      const bf16x8 bq = *(const bf16x8*)(St + k2 * 32);
#pragma unroll
      for (int rt = 0; rt < 4; ++rt) {
        const bf16x8 a = *(const bf16x8*)(qt + (rt * 16 + fr) * QS + k2 * 32 + q4 * 8);
        acc[rt] = MFMA16(a, bq, acc[rt]);
      }
    }
  }
#pragma unroll
  for (int rt = 0; rt < 4; ++rt)
#pragma unroll
    for (int r = 0; r < 4; ++r) {
      float s1 = acc[rt][r], s2 = s1 * s1;
#pragma unroll
      for (int of = 8; of; of >>= 1) { s1 += __shfl_xor(s1, of); s2 += __shfl_xor(s2, of); }
      if (fr == 0) {
        const int i = rt * 16 + q4 * 4 + r;
        red[(w * 64 + i) * 2 + 0] = s1;
        red[(w * 64 + i) * 2 + 1] = s2;
      }
    }
  __syncthreads();
  if (tid < 128) {
    const int i = tid >> 1, c = tid & 1;
    float t = 0.f;
#pragma unroll
    for (int ww = 0; ww < 8; ++ww) t += red[(ww * 64 + i) * 2 + c];
    red2[i * 2 + c] = t;
  }
  __syncthreads();
  const int gcol = GLA ? C_GLG : C_RTG;
  const int ocol = GLA ? 1024 : 512;
  const int vcol = h * 128 + w * 16 + fr;
  const float gg = GLA ? p.gla_g[layer * 128 + w * 16 + fr] : 1.f;
#pragma unroll
  for (int rt = 0; rt < 4; ++rt)
#pragma unroll
    for (int r = 0; r < 4; ++r) {
      const int i = rt * 16 + q4 * 4 + r;
      const float S1 = red2[i * 2 + 0], S2 = red2[i * 2 + 1];
      float y;
      if (GLA) {
        y = acc[rt][r] * rsqrtf(S2 * (1.f / 128.f) + EPS) * gg;
      } else {
        const float mu = S1 * (1.f / 128.f);
        const float var = fmaxf(S2 * (1.f / 128.f) - mu * mu, 0.f);
        y = (acc[rt][r] - mu) * rsqrtf(var + EPS);
      }
      const int row = row0 + i;
      const float gt = bf2f(p.proj[(size_t)row * DINP + gcol + vcol]);
      y *= silu_f(gt);
      p.mix[(size_t)row * D + ocol + vcol] = f2bf(y);
    }
}

__constant__ unsigned char c_cand_tab[64] = {0, 1, 2, 3, 4, 5, 6, 7, 8, 9, 10, 11, 12, 13, 14, 15, 16, 17, 18, 19, 20, 21, 22, 23, 32, 33, 34, 35, 36, 48, 49, 50, 51, 64, 65, 66, 80, 81, 96, 97, 112, 113, 128, 144, 160, 176, 192, 208, 224, 240, 255, 255, 255, 255, 255, 255, 255, 255, 255, 255, 255, 255, 255, 255};

template <int N>
__device__ __forceinline__ void bitonic_sort_desc(float (&v)[N]) {
#pragma unroll
  for (int k = 2; k <= N; k <<= 1)
#pragma unroll
    for (int j = k >> 1; j > 0; j >>= 1)
#pragma unroll
      for (int i = 0; i < N; ++i) {
        const int l = i ^ j;
        if (l > i) {
          const bool desc = ((i & k) == 0);
          const float x = v[i], y = v[l];
          const float hi = fmaxf(x, y), lo = fminf(x, y);
          v[i] = desc ? hi : lo;
          v[l] = desc ? lo : hi;
        }
      }
}
__device__ __forceinline__ void merge_top16(float (&v)[16], const int xl) {
  float o[16];
#pragma unroll
  for (int i = 0; i < 16; ++i) o[i] = __shfl_xor(v[15 - i], xl);
#pragma unroll
  for (int i = 0; i < 16; ++i) v[i] = fmaxf(v[i], o[i]);
#pragma unroll
  for (int j = 8; j > 0; j >>= 1)
#pragma unroll
    for (int i = 0; i < 16; ++i) {
      const int l = i ^ j;
      if (l > i) {
        const float x = v[i], y = v[l];
        v[i] = fmaxf(x, y);
        v[l] = fminf(x, y);
      }
    }
}
__device__ __forceinline__ float pack_key(float x, unsigned mask, unsigned key) {
  return __uint_as_float((__float_as_uint(x) & ~mask) | key);
}

__device__ void topk_phase(const Params& p, int layer, int ntok, char* smem) {
  float* sc = (float*)smem;
  const int tid = get_tid();
  const int lane = tid & 63, w = tid >> 6, fr = lane & 15, q4 = lane >> 4;
  const int nbatch = ntok >> 4;
  for (int bt = get_bid(); bt < nbatch; bt += gridDim.x) {
    __syncthreads();
#pragma unroll 1
    for (int pp = 0; pp < 2; ++pp) {
      const int pair = 2 * w + pp;
      const bfr* qrow = p.q + (size_t)(bt * 16 + fr) * D + pair * 128 + q4 * 8;
      const bfr* skb = p.sk_bf + (size_t)(((layer * 2 + (pair & 1)) * 8 + (pair >> 1))) * 128 * 128 + q4 * 8;
      bf16x8 af[4];
#pragma unroll
      for (int k2 = 0; k2 < 4; ++k2) af[k2] = *(const bf16x8*)(qrow + k2 * 32);
#pragma unroll 4
      for (int nt = 0; nt < 8; ++nt) {
        f32x4 acc = (f32x4){0.f, 0.f, 0.f, 0.f};
#pragma unroll
        for (int k2 = 0; k2 < 4; ++k2) {
          const bf16x8 bq = *(const bf16x8*)(skb + (size_t)(nt * 16 + fr) * 128 + k2 * 32);
          acc = MFMA16(af[k2], bq, acc);
        }
#pragma unroll
        for (int r = 0; r < 4; ++r) sc[((q4 * 4 + r) * 16 + pair) * 132 + nt * 16 + fr] = acc[r];
      }
    }
    __syncthreads();
#pragma unroll 1
    for (int ps = 0; ps < 2; ++ps) {
      const int list = ps * 128 + (tid >> 2), qd = tid & 3;
      float v[32];
#pragma unroll
      for (int j = 0; j < 8; ++j) {
        float4 t = *(const float4*)(sc + list * 132 + qd * 32 + j * 4);
        const unsigned kb = qd * 32 + j * 4;
        v[j * 4 + 0] = pack_key(t.x, 127u, kb + 0); v[j * 4 + 1] = pack_key(t.y, 127u, kb + 1);
        v[j * 4 + 2] = pack_key(t.z, 127u, kb + 2); v[j * 4 + 3] = pack_key(t.w, 127u, kb + 3);
      }
      bitonic_sort_desc<32>(v);
      float wv[16];
#pragma unroll
      for (int i = 0; i < 16; ++i) wv[i] = v[i];
      merge_top16(wv, 1);
      merge_top16(wv, 2);
      if (qd == 0) {
#pragma unroll
        for (int j = 0; j < 4; ++j)
          *(float4*)(sc + list * 132 + j * 4) = make_float4(wv[j * 4 + 0], wv[j * 4 + 1], wv[j * 4 + 2], wv[j * 4 + 3]);
      }
    }
    __syncthreads();
    {
      const int pair = tid >> 2, qd = tid & 3;
      const int tok = pair >> 3, hh = pair & 7;
      const float* o0 = sc + (tok * 16 + hh * 2) * 132;
      const float* o1 = o0 + 132;
      float c[16];
#pragma unroll
      for (int i = 0; i < 16; ++i) {
        const unsigned code = c_cand_tab[qd * 16 + i];
        const float sum = o0[code >> 4] + o1[code & 15];
        c[i] = (code == 255u) ? -INFINITY : pack_key(sum, 255u, code);
      }
      bitonic_sort_desc<16>(c);
      merge_top16(c, 1);
      merge_top16(c, 2);
      float e[16];
      float esum = 0.f;
#pragma unroll
      for (int i = 0; i < 16; ++i) { e[i] = __expf(c[i] - c[0]); esum += e[i]; }
      const float inv = 1.f / esum;
      const int m = bt * 16 + tok;
#pragma unroll
      for (int j = 0; j < 4; ++j) {
        const float ev = qd == 0 ? e[j] : (qd == 1 ? e[4 + j] : (qd == 2 ? e[8 + j] : e[12 + j]));
        const float cv = qd == 0 ? c[j] : (qd == 1 ? c[4 + j] : (qd == 2 ? c[8 + j] : c[12 + j]));
        const unsigned code = __float_as_uint(cv) & 255u;
        const unsigned k0 = __float_as_uint(o0[code >> 4]) & 127u;
        const unsigned k1 = __float_as_uint(o1[code & 15]) & 127u;
        p.pidx[(size_t)m * 128 + hh * 16 + qd * 4 + j] = (int)(k0 * 128u + k1);
        p.pgate[(size_t)m * 128 + hh * 16 + qd * 4 + j] = ev * inv;
      }
    }
  }
}

typedef __attribute__((ext_vector_type(2))) float f32x2;
__device__ __forceinline__ float dot16_fp8(const float* hf, const u4 w) {
  f32x2 a0 = __builtin_amdgcn_cvt_pk_f32_fp8((int)w.x, false), a1 = __builtin_amdgcn_cvt_pk_f32_fp8((int)w.x, true);
  f32x2 b0 = __builtin_amdgcn_cvt_pk_f32_fp8((int)w.y, false), b1 = __builtin_amdgcn_cvt_pk_f32_fp8((int)w.y, true);
  f32x2 c0 = __builtin_amdgcn_cvt_pk_f32_fp8((int)w.z, false), c1 = __builtin_amdgcn_cvt_pk_f32_fp8((int)w.z, true);
  f32x2 d0 = __builtin_amdgcn_cvt_pk_f32_fp8((int)w.w, false), d1 = __builtin_amdgcn_cvt_pk_f32_fp8((int)w.w, true);
  return hf[0] * a0.x + hf[1] * a0.y + hf[2] * a1.x + hf[3] * a1.y + hf[4] * b0.x + hf[5] * b0.y + hf[6] * b1.x + hf[7] * b1.y +
         hf[8] * c0.x + hf[9] * c0.y + hf[10] * c1.x + hf[11] * c1.y + hf[12] * d0.x + hf[13] * d0.y + hf[14] * d1.x + hf[15] * d1.y;
}
__device__ __forceinline__ void fma16_fp8(float* o, float c, const u4 w) {
  f32x2 a0 = __builtin_amdgcn_cvt_pk_f32_fp8((int)w.x, false), a1 = __builtin_amdgcn_cvt_pk_f32_fp8((int)w.x, true);
  f32x2 b0 = __builtin_amdgcn_cvt_pk_f32_fp8((int)w.y, false), b1 = __builtin_amdgcn_cvt_pk_f32_fp8((int)w.y, true);
  f32x2 c0 = __builtin_amdgcn_cvt_pk_f32_fp8((int)w.z, false), c1 = __builtin_amdgcn_cvt_pk_f32_fp8((int)w.z, true);
  f32x2 d0 = __builtin_amdgcn_cvt_pk_f32_fp8((int)w.w, false), d1 = __builtin_amdgcn_cvt_pk_f32_fp8((int)w.w, true);
  o[0] += c * a0.x; o[1] += c * a0.y; o[2] += c * a1.x; o[3] += c * a1.y;
  o[4] += c * b0.x; o[5] += c * b0.y; o[6] += c * b1.x; o[7] += c * b1.y;
  o[8] += c * c0.x; o[9] += c * c0.y; o[10] += c * c1.x; o[11] += c * c1.y;
  o[12] += c * d0.x; o[13] += c * d0.y; o[14] += c * d1.x; o[15] += c * d1.y;
}

__device__ void peer_phase(const Params& p, int layer, int ntok) {
  const int lane = get_tid() & 63;
  const int wave = get_bid() * 8 + (get_tid() >> 6), nw = gridDim.x * 8;
  const unsigned char* U = p.u8 + (size_t)layer * 16384 * D;
  const unsigned char* V = p.v8 + (size_t)layer * 16384 * D;
  const float* usc = p.uscl + layer * 16384;
  const float* vsc = p.vscl + layer * 16384;
  for (int m = wave; m < ntok; m += nw) {
    float hf[32];
    const bfr* hr = p.h + (size_t)m * D + lane * 16;
#pragma unroll
    for (int i = 0; i < 2; ++i) {
      u4 w0 = *(const u4*)(hr + i * 1024), w1 = *(const u4*)(hr + i * 1024 + 8);
      unpack8(w0, hf + i * 16);
      unpack8(w1, hf + i * 16 + 8);
    }
    const int idA = p.pidx[(size_t)m * 128 + lane], idB = p.pidx[(size_t)m * 128 + 64 + lane];
    const float gA = p.pgate[(size_t)m * 128 + lane] * vsc[idA], gB = p.pgate[(size_t)m * 128 + 64 + lane] * vsc[idB];
    const float usA = usc[idA], usB = usc[idB];
    float cA = 0.f, cB = 0.f;
#pragma unroll 1
    for (int e0 = 0; e0 < 128; e0 += 8) {
      u4 r[8][2];
#pragma unroll
      for (int u = 0; u < 8; ++u) {
        int e = e0 + u;
        int row = __shfl(e0 < 64 ? idA : idB, e & 63);
        const unsigned char* up = U + (size_t)row * D + lane * 16;
        r[u][0] = *(const u4*)(up);
        r[u][1] = *(const u4*)(up + 1024);
      }
      __builtin_amdgcn_sched_barrier(0);
#pragma unroll
      for (int u = 0; u < 8; ++u) {
        int e = e0 + u;
        float dsum = dot16_fp8(hf, r[u][0]) + dot16_fp8(hf + 16, r[u][1]);
        dsum = wave_sum(dsum);
        if (e0 < 64) { if (lane == e) cA = gA * gelu_f(dsum * usA); }
        else { if (lane == e - 64) cB = gB * gelu_f(dsum * usB); }
        __builtin_amdgcn_sched_barrier(0);
      }
    }
    float o[32];
#pragma unroll
    for (int i = 0; i < 32; ++i) o[i] = 0.f;
#pragma unroll 1
    for (int e0 = 0; e0 < 128; e0 += 4) {
      u4 r[4][2];
      float cf[4];
#pragma unroll
      for (int u = 0; u < 4; ++u) {
        int e = e0 + u;
        int row = __shfl(e0 < 64 ? idA : idB, e & 63);
        cf[u] = __shfl(e0 < 64 ? cA : cB, e & 63);
        const unsigned char* vp = V + (size_t)row * D + lane * 16;
        r[u][0] = *(const u4*)(vp);
        r[u][1] = *(const u4*)(vp + 1024);
      }
      __builtin_amdgcn_sched_barrier(0);
#pragma unroll
      for (int u = 0; u < 4; ++u) {
        fma16_fp8(o, cf[u], r[u][0]);
        fma16_fp8(o + 16, cf[u], r[u][1]);
        __builtin_amdgcn_sched_barrier(0);
      }
    }
    const int vec = m < S ? 0 : (m < MX ? 1 : 2);
    const float* modl = p.mod + (layer * 3 + vec) * 12288;
    float* xr = p.xcur + (size_t)m * D + lane * 16;
    float xn[32];
    float ss = 0.f;
#pragma unroll
    for (int i = 0; i < 2; ++i)
#pragma unroll
      for (int k = 0; k < 4; ++k) {
        int col = i * 1024 + lane * 16 + k * 4;
        float4 a = *(const float4*)(xr + i * 1024 + k * 4);
        float4 g0 = *(const float4*)(modl + 5 * D + col);
        float* xx = xn + i * 16 + k * 4;
        const float* oo = o + i * 16 + k * 4;
        xx[0] = a.x + g0.x * oo[0]; xx[1] = a.y + g0.y * oo[1]; xx[2] = a.z + g0.z * oo[2]; xx[3] = a.w + g0.w * oo[3];
        ss += xx[0] * xx[0] + xx[1] * xx[1] + xx[2] * xx[2] + xx[3] * xx[3];
      }
    ss = wave_sum(ss);
    const float rstd = rsqrtf(ss * (1.f / D) + EPS);
    if (layer == 1) {
      float* orow = p.out + (size_t)m * D;
#pragma unroll
      for (int i = 0; i < 2; ++i)
#pragma unroll
        for (int k = 0; k < 4; ++k) {
          int col = i * 1024 + lane * 16 + k * 4;
          float4 f0 = *(const float4*)(p.final_g + col);
          const float* xx = xn + i * 16 + k * 4;
          *(float4*)(orow + col) = make_float4(xx[0] * rstd * f0.x, xx[1] * rstd * f0.y, xx[2] * rstd * f0.z, xx[3] * rstd * f0.w);
        }
    } else {
      const float* modn = p.mod + ((layer + 1) * 3 + vec) * 12288;
      const float* gn = p.g_attn + (layer + 1) * D;
#pragma unroll
      for (int i = 0; i < 2; ++i) {
        float y[16];
#pragma unroll
        for (int k = 0; k < 4; ++k) {
          int col = i * 1024 + lane * 16 + k * 4;
          const float* xx = xn + i * 16 + k * 4;
          *(float4*)(xr + i * 1024 + k * 4) = make_float4(xx[0], xx[1], xx[2], xx[3]);
          float4 gv = *(const float4*)(gn + col), scv = *(const float4*)(modn + D + col), shv = *(const float4*)(modn + col);
          y[k * 4 + 0] = xx[0] * rstd * gv.x * (1.f + scv.x) + shv.x;
          y[k * 4 + 1] = xx[1] * rstd * gv.y * (1.f + scv.y) + shv.y;
          y[k * 4 + 2] = xx[2] * rstd * gv.z * (1.f + scv.z) + shv.z;
          y[k * 4 + 3] = xx[3] * rstd * gv.w * (1.f + scv.w) + shv.w;
        }
        u4 w0, w1;
        w0.x = pack2(y[0], y[1]); w0.y = pack2(y[2], y[3]); w0.z = pack2(y[4], y[5]); w0.w = pack2(y[6], y[7]);
        w1.x = pack2(y[8], y[9]); w1.y = pack2(y[10], y[11]); w1.z = pack2(y[12], y[13]); w1.w = pack2(y[14], y[15]);
        *(u4*)(p.h + (size_t)m * D + i * 1024 + lane * 16) = w0;
        *(u4*)(p.h + (size_t)m * D + i * 1024 + lane * 16 + 8) = w1;
      }
    }
  }
}

constexpr int PH_INIT = 0, PH_MOD_ATTN = 1, PH_INPROJ = 2, PH_MIX1 = 3, PH_SCANB = 4, PH_SCANC = 5, PH_OUTPROJ = 6,
              PH_MOD_FFN = 7, PH_QPROJ = 8, PH_SCORES = 9, PH_TOPK = 10, PH_PEER = 11;

template <int EPI, bool ALLOW_BIG>
__device__ __forceinline__ void gemm_phase(const Params& p, int layer, int vid, const bfr* A, const bfr* Bt, int MB, int MT,
                                           int NB, int N128, int small_nt, void* Cout, int ldc, char* smem) {
  const int nbig = MB * NB;
  const int nsm1 = small_nt >= 0 ? MB : 0;
  const int nsm2 = (MT - MB) * N128;
  const int total = nbig + nsm1 + nsm2;
  for (int t = vid; t < total; t += gridDim.x) {
    if (t < nbig) {
      if constexpr (ALLOW_BIG) {
        const int mt = t / NB, nt = t - mt * NB;
        gemm_tile<EPI, true>(A, D, Bt, D, D, mt * 256, nt * 256, Cout, ldc, p, layer, smem);
      }
    } else if (t < nbig + nsm1) {
      gemm_tile<EPI, false>(A, D, Bt, D, D, (t - nbig) * 256, small_nt * 128, Cout, ldc, p, layer, smem);
    } else {
      const int u = t - nbig - nsm1;
      const int mt = MB + u / N128, nt = u % N128;
      gemm_tile<EPI, false>(A, D, Bt, D, D, mt * 256, nt * 128, Cout, ldc, p, layer, smem);
    }
  }
}

__device__ void run_phase(const Params& p, int ph, int layer, char* smem, int vid) {
  const int bid = get_bid(), nb = gridDim.x;
  const bool last = (layer == 1);
  switch (ph) {
    case PH_INIT: phase0(p, smem); break;
    case PH_MOD_ATTN: modulate_phase(p, layer, 0, MT); break;
    case PH_INPROJ:
      gemm_phase<0, true>(p, layer, vid, p.h, p.wt_in + (size_t)layer * DINP * D, 66, 66, 23, 47, 46, p.proj, DINP, smem);
      break;
    case PH_MIX1: {
      const int n_swa = 256, n_na = 2048, n_sa = 1056, n_ctx = last ? 0 : 32;
      const int total = n_swa + n_na + 2 * n_sa + n_ctx;
      for (int it = bid; it < total; it += nb) {
        int t = it;
        if (t < n_swa) { swa_item(p, layer, t, smem); continue; }
        t -= n_swa;
        if (t < n_na) { na_item(p, layer, t, smem); continue; }
        t -= n_na;
        if (t < n_sa) { scan_a_item<128, false>(p, layer, t, smem); continue; }
        t -= n_sa;
        if (t < n_sa) { scan_a_item<64, true>(p, layer, t, smem); continue; }
        t -= n_sa;
        ctx_item(p, layer, t, smem);
      }
    } break;
    case PH_SCANB: scan_b_phase(p); break;
    case PH_SCANC:
      for (int it = bid; it < 2 * 1056; it += nb) {
        const bool gla = it < 1056;
        const int t = gla ? it : it - 1056;
        if (last && (t % 132) < 4) continue;
        if (gla) scan_c_item<64, true>(p, layer, t, smem);
        else scan_c_item<128, false>(p, layer, t, smem);
      }
      break;
    case PH_OUTPROJ: {
      gemm_phase<1, false>(p, layer, vid, p.mix, p.wt_out + (size_t)layer * D * D, 0, last ? 64 : 66, 8, 16, -1, nullptr, 0, smem);
    } break;
    case PH_MOD_FFN: modulate_phase(p, layer, 1, last ? MX : MT); break;
    case PH_QPROJ: {
      gemm_phase<0, true>(p, layer, vid, p.h, p.wt_q + (size_t)layer * D * D, 64, last ? 64 : 66, 8, 16, -1, p.q, D, smem);
    } break;
    case PH_SCORES: {
      const int mt = last ? 64 : 66;
      for (int t = bid; t < mt * 16; t += nb) {
        int j = t & 15;
        int hh = j >> 1, pp = j & 1;
        const bfr* bt = p.sk_bf + (size_t)(((layer * 2 + pp) * 8 + hh)) * 128 * 128;
        gemm_tile<2, false>(p.q + j * 128, D, bt, 128, 128, (t >> 4) * 256, 0, p.scores + j * 128, D, p, layer, smem);
      }
    } break;
    case PH_TOPK: topk_phase(p, layer, last ? MX : MT, smem); break;
    case PH_PEER: peer_phase(p, layer, last ? MX : MT); break;
  }
}

__device__ __forceinline__ void grid_barrier(unsigned* bar, unsigned& epoch) {
  asm volatile("s_waitcnt vmcnt(0)" ::: "memory");
  __syncthreads();
  epoch += gridDim.x;
  if (threadIdx.x == 0) {
    __builtin_amdgcn_fence(__ATOMIC_RELEASE, "agent");
    asm volatile("s_waitcnt vmcnt(0)" ::: "memory");
    (void)__hip_atomic_fetch_add(bar, 1u, __ATOMIC_RELAXED, __HIP_MEMORY_SCOPE_AGENT);
    unsigned spins = 0;
    while (__hip_atomic_load(bar, __ATOMIC_RELAXED, __HIP_MEMORY_SCOPE_AGENT) < epoch) {
      __builtin_amdgcn_s_sleep(1);
      if (++spins > (1u << 24)) break;
    }
    __builtin_amdgcn_fence(__ATOMIC_ACQUIRE, "agent");
    asm volatile("s_waitcnt vmcnt(0)" ::: "memory");
  }
  __syncthreads();
}

#if MULTI_LAUNCH
__global__ void __launch_bounds__(NTHR) phase_kernel(Params p, int ph, int layer) {
  extern __shared__ __attribute__((aligned(16))) char smem[];
  run_phase(p, ph, layer, smem, blockIdx.x);
}
#else
__global__ void __launch_bounds__(NTHR) mega_kernel(Params p) {
  extern __shared__ __attribute__((aligned(16))) char smem[];
  cg::grid_group grid = cg::this_grid();
  const unsigned xcd = (unsigned)__builtin_amdgcn_s_getreg((3 << 11) | 20) & 7u;
  run_phase(p, PH_INIT, 0, smem, 0);
  __syncthreads();
  if (threadIdx.x == 0) ((volatile unsigned*)smem)[0] = atomicAdd(&p.bar[16 + xcd], 1u);
  grid.sync();
  int vid = (int)((volatile unsigned*)smem)[0];
  for (unsigned x = 0; x < xcd; ++x) vid += (int)__hip_atomic_load(&p.bar[16 + x], __ATOMIC_RELAXED, __HIP_MEMORY_SCOPE_AGENT);
  vid = __builtin_amdgcn_readfirstlane(vid);
  __syncthreads();
  unsigned epoch = 0;
  for (int layer = 0; layer < 2; ++layer) {
    for (int ph = (layer == 0 ? PH_MOD_ATTN : PH_INPROJ); ph <= PH_PEER; ++ph) {
      if (ph == PH_SCORES) continue;
      run_phase(p, ph, layer, smem, vid);
      if (!(layer == 1 && ph == PH_PEER)) grid_barrier(p.bar, epoch);
    }
  }
}
#endif

static inline size_t align_up(size_t v) { return (v + 255) & ~(size_t)255; }

extern "C" void kernel_launch(void* const* d_in, const int* in_sizes, int n_in, void* d_out, int out_size, void* d_ws,
                              size_t ws_size, hipStream_t stream) {
  Params p{};
  p.x = (const float*)d_in[0]; p.c = (const float*)d_in[1]; p.ctx = (const float*)d_in[2]; p.c_ctx = (const float*)d_in[3];
  p.w_ada = (const float*)d_in[4]; p.b_ada = (const float*)d_in[5]; p.g_attn = (const float*)d_in[6]; p.g_ffn = (const float*)d_in[7];
  p.w_in = (const float*)d_in[8]; p.rpb = (const float*)d_in[9]; p.ret_lg = (const float*)d_in[10]; p.gla_wu = (const float*)d_in[11];
  p.gla_b = (const float*)d_in[12]; p.gla_g = (const float*)d_in[13]; p.sink = (const float*)d_in[14]; p.w_out = (const float*)d_in[15];
  p.w_q = (const float*)d_in[16]; p.sub_keys = (const float*)d_in[17]; p.pu = (const float*)d_in[18]; p.pv = (const float*)d_in[19];
  p.final_g = (const float*)d_in[20];
  p.out = (float*)d_out;
  char* ws = (char*)d_ws;
  size_t off = 0;
  auto take = [&](size_t bytes) { char* r = ws + off; off = align_up(off + bytes); return r; };
  p.mod = (float*)take((size_t)2 * 3 * 12288 * 4);
  p.bar = (unsigned*)take(256);
  p.rope = (float*)take((size_t)16384 * 4);
  p.wt_in = (bfr*)take((size_t)2 * DINP * D * 2);
  p.wt_out = (bfr*)take((size_t)2 * D * D * 2);
  p.wt_q = (bfr*)take((size_t)2 * D * D * 2);
  p.sk_bf = (bfr*)take((size_t)524288 * 2);
  p.u8 = (unsigned char*)take((size_t)2 * 16384 * D);
  p.v8 = (unsigned char*)take((size_t)2 * 16384 * D);
  p.uscl = (float*)take((size_t)2 * 16384 * 4);
  p.vscl = (float*)take((size_t)2 * 16384 * 4);
  p.xcur = (float*)take((size_t)MT * D * 4);
  p.h = (bfr*)take((size_t)MT * D * 2);
  p.proj = (bfr*)take((size_t)MT * DINP * 2);
  p.mix = (bfr*)take((size_t)MT * D * 2);
  p.st_ret = (bfr*)take((size_t)16 * 132 * 16384 * 4);
  p.dec_ret = (float*)take((size_t)16 * 132 * 128 * 4);
  p.dec_gla = (float*)take((size_t)16 * 132 * 64 * 4);
  p.pidx = (int*)take((size_t)MT * 128 * 4);
  p.pgate = (float*)take((size_t)MT * 128 * 4);
  p.st_gla = (bfr*)p.h;
  p.q = p.proj;
  p.scores = (float*)p.st_ret;
  if (off > ws_size) { fprintf(stderr, "workspace too small: need %zu have %zu\n", off, ws_size); return; }

  hipMemsetAsync(p.mod, 0, (size_t)2 * 3 * 12288 * 4 + 256, stream);
#if MULTI_LAUNCH
  hipFuncSetAttribute((const void*)phase_kernel, hipFuncAttributeMaxDynamicSharedMemorySize, SMEM_BYTES);
  const int grid = 256;
  hipLaunchKernelGGL(phase_kernel, dim3(grid), dim3(NTHR), SMEM_BYTES, stream, p, PH_INIT, 0);
  for (int layer = 0; layer < 2; ++layer)
    for (int ph = (layer == 0 ? PH_MOD_ATTN : PH_INPROJ); ph <= PH_PEER; ++ph)
      hipLaunchKernelGGL(phase_kernel, dim3(grid), dim3(NTHR), SMEM_BYTES, stream, p, ph, layer);
#else
  static int grid_blocks = 0;
  if (!grid_blocks) {
    hipFuncSetAttribute((const void*)mega_kernel, hipFuncAttributeMaxDynamicSharedMemorySize, SMEM_BYTES);
    int dev = 0, cus = 0, per_cu = 0;
    hipGetDevice(&dev);
    hipDeviceGetAttribute(&cus, hipDeviceAttributeMultiprocessorCount, dev);
    hipOccupancyMaxActiveBlocksPerMultiprocessor(&per_cu, mega_kernel, NTHR, SMEM_BYTES);
    if (per_cu < 1) per_cu = 1;
    grid_blocks = cus * per_cu;
    if (grid_blocks > 256) grid_blocks = 256;
  }
  void* args[] = {&p};
  hipError_t e = hipLaunchCooperativeKernel((void*)mega_kernel, dim3(grid_blocks), dim3(NTHR), args, SMEM_BYTES, stream);
  if (e != hipSuccess) fprintf(stderr, "cooperative launch failed: %s (grid %d)\n", hipGetErrorString(e), grid_blocks);
#endif
}
```

```cpp
#include <hip/hip_runtime.h>
#include <hip/hip_cooperative_groups.h>
#include <cstdio>
namespace cg = cooperative_groups;

#ifndef MULTI_LAUNCH
#define MULTI_LAUNCH 0
#endif

typedef unsigned short bfr;
typedef __attribute__((ext_vector_type(8))) short bf16x8;
typedef __attribute__((ext_vector_type(4))) float f32x4;
typedef __attribute__((ext_vector_type(4))) unsigned int u4;

constexpr int D = 2048;
constexpr int S = 8192;
constexpr int MX = 16384;
constexpr int MT = 16896;
constexpr int DIN = 5920;
constexpr int DINP = 6016;
constexpr int NTHR = 512;
constexpr float EPS = 1e-6f;
constexpr int SMEM_BYTES = 149504;

constexpr int C_NAQ = 0, C_NAK = 512, C_NAV = 1024;
constexpr int C_RTQ = 1536, C_RTK = 2048, C_RTV = 2560, C_RTG = 3072;
constexpr int C_GLQ = 3584, C_GLK = 3840, C_GLV = 4096, C_GLG = 4608, C_GLD = 5120;
constexpr int C_SWQ = 5152, C_SWK = 5664, C_SWV = 5792;

struct Params {
  const float *x, *c, *ctx, *c_ctx, *w_ada, *b_ada, *g_attn, *g_ffn, *w_in, *rpb, *ret_lg, *gla_wu, *gla_b,
      *gla_g, *sink, *w_out, *w_q, *sub_keys, *pu, *pv, *final_g;
  float* out;
  bfr *wt_in, *wt_out, *wt_q, *sk_bf;
  unsigned char *u8, *v8;
  float *uscl, *vscl;
  float *mod, *rope, *xcur;
  bfr *h, *proj, *mix;
  bfr *st_ret, *st_gla;
  float *dec_ret, *dec_gla;
  bfr* q;
  float* scores;
  int* pidx;
  float* pgate;
  unsigned* bar;
};

__device__ __forceinline__ int get_tid() { int t = threadIdx.x; asm volatile("" : "+v"(t)); return t; }
__device__ __forceinline__ int get_bid() { int t = blockIdx.x; asm volatile("" : "+s"(t)); return t; }
__device__ __forceinline__ float bf2f(bfr u) { return __uint_as_float(((unsigned)u) << 16); }
typedef __bf16 hwbf16x2 __attribute__((ext_vector_type(2)));
typedef float hwf32x2 __attribute__((ext_vector_type(2)));
__device__ __forceinline__ unsigned pack2(float a, float b) {
  hwf32x2 v = {a, b};
  hwbf16x2 r = __builtin_convertvector(v, hwbf16x2);
  return __builtin_bit_cast(unsigned, r);
}
__device__ __forceinline__ bfr f2bf(float f) { return (bfr)(pack2(f, 0.f) & 0xffffu); }
__device__ __forceinline__ float lo16(unsigned w) { return __uint_as_float(w << 16); }
__device__ __forceinline__ float hi16(unsigned w) { return __uint_as_float(w & 0xffff0000u); }
__device__ __forceinline__ float wave_sum(float v) {
#pragma unroll
  for (int o = 32; o; o >>= 1) v += __shfl_xor(v, o);
  return v;
}
__device__ __forceinline__ float wave_max(float v) {
#pragma unroll
  for (int o = 32; o; o >>= 1) v = fmaxf(v, __shfl_xor(v, o));
  return v;
}
__device__ __forceinline__ float silu_f(float x) { return x / (1.f + __expf(-x)); }
__device__ __forceinline__ float gelu_f(float x) { return 0.5f * x * (1.f + erff(x * 0.70710678118654752f)); }
__device__ __forceinline__ float logsig_f(float x) { return fminf(x, 0.f) - log1pf(__expf(-fabsf(x))); }
__device__ __forceinline__ void unpack8(const u4 w, float* f) {
  f[0] = lo16(w.x); f[1] = hi16(w.x); f[2] = lo16(w.y); f[3] = hi16(w.y);
  f[4] = lo16(w.z); f[5] = hi16(w.z); f[6] = lo16(w.w); f[7] = hi16(w.w);
}

__device__ void transpose_cvt(const float* __restrict__ W, int K, int N, int Npad, bfr* __restrict__ Wt, int item,
                              float* tile) {
  const int nkt = K >> 6;
  const int kt = item % nkt, nt = item / nkt;
  const int tid = get_tid();
  __syncthreads();
#pragma unroll
  for (int i = 0; i < 2; ++i) {
    int kk = (tid >> 4) + 32 * i, nn = (tid & 15) * 4;
    int n = nt * 64 + nn;
    float4 v = make_float4(0.f, 0.f, 0.f, 0.f);
    if (n < N) v = *(const float4*)(W + (size_t)(kt * 64 + kk) * N + n);
    tile[kk * 65 + nn + 0] = v.x; tile[kk * 65 + nn + 1] = v.y; tile[kk * 65 + nn + 2] = v.z; tile[kk * 65 + nn + 3] = v.w;
  }
  __syncthreads();
  {
    int nl = tid >> 3, kc = (tid & 7) * 8;
    u4 o;
    o.x = pack2(tile[(kc + 0) * 65 + nl], tile[(kc + 1) * 65 + nl]);
    o.y = pack2(tile[(kc + 2) * 65 + nl], tile[(kc + 3) * 65 + nl]);
    o.z = pack2(tile[(kc + 4) * 65 + nl], tile[(kc + 5) * 65 + nl]);
    o.w = pack2(tile[(kc + 6) * 65 + nl], tile[(kc + 7) * 65 + nl]);
    *(u4*)(Wt + (size_t)(nt * 64 + nl) * K + kt * 64 + kc) = o;
  }
}

__device__ void cvt_linear(const float* __restrict__ src, bfr* __restrict__ dst, size_t n8) {
  for (size_t i = (size_t)get_bid() * NTHR + get_tid(); i < n8; i += (size_t)gridDim.x * NTHR) {
    float4 a = *(const float4*)(src + i * 8), b = *(const float4*)(src + i * 8 + 4);
    u4 o;
    o.x = pack2(a.x, a.y); o.y = pack2(a.z, a.w); o.z = pack2(b.x, b.y); o.w = pack2(b.z, b.w);
    *(u4*)(dst + i * 8) = o;
  }
}

__device__ void cvt_fp8_rows(const float* __restrict__ src, unsigned char* __restrict__ dst, float* __restrict__ scl, int nrows) {
  const int lane = get_tid() & 63;
  const int wave = get_bid() * 8 + (get_tid() >> 6), nw = gridDim.x * 8;
  for (int row = wave; row < nrows; row += nw) {
    const float* sp = src + (size_t)row * D + lane * 16;
    float4 v[8];
    float amax = 0.f;
#pragma unroll
    for (int i = 0; i < 2; ++i)
#pragma unroll
      for (int k = 0; k < 4; ++k) {
        float4 t = *(const float4*)(sp + i * 1024 + k * 4);
        v[i * 4 + k] = t;
        amax = fmaxf(amax, fmaxf(fmaxf(fabsf(t.x), fabsf(t.y)), fmaxf(fabsf(t.z), fabsf(t.w))));
      }
    amax = wave_max(amax);
    const float sc = amax > 0.f ? 256.f / amax : 1.f;
#pragma unroll
    for (int i = 0; i < 2; ++i) {
      u4 o;
      int w;
      w = __builtin_amdgcn_cvt_pk_fp8_f32(v[i * 4 + 0].x * sc, v[i * 4 + 0].y * sc, 0, false);
      w = __builtin_amdgcn_cvt_pk_fp8_f32(v[i * 4 + 0].z * sc, v[i * 4 + 0].w * sc, w, true); o.x = (unsigned)w;
      w = __builtin_amdgcn_cvt_pk_fp8_f32(v[i * 4 + 1].x * sc, v[i * 4 + 1].y * sc, 0, false);
      w = __builtin_amdgcn_cvt_pk_fp8_f32(v[i * 4 + 1].z * sc, v[i * 4 + 1].w * sc, w, true); o.y = (unsigned)w;
      w = __builtin_amdgcn_cvt_pk_fp8_f32(v[i * 4 + 2].x * sc, v[i * 4 + 2].y * sc, 0, false);
      w = __builtin_amdgcn_cvt_pk_fp8_f32(v[i * 4 + 2].z * sc, v[i * 4 + 2].w * sc, w, true); o.z = (unsigned)w;
      w = __builtin_amdgcn_cvt_pk_fp8_f32(v[i * 4 + 3].x * sc, v[i * 4 + 3].y * sc, 0, false);
      w = __builtin_amdgcn_cvt_pk_fp8_f32(v[i * 4 + 3].z * sc, v[i * 4 + 3].w * sc, w, true); o.w = (unsigned)w;
      *(u4*)(dst + (size_t)row * D + i * 1024 + lane * 16) = o;
    }
    if (lane == 0) scl[row] = amax > 0.f ? amax * (1.f / 256.f) : 1.f;
  }
}

__device__ void sincos_d(double a, float& s, float& c) {
  double k = rint(a * 0.63661977236758134308);
  double r = a - k * 1.57079632679489661923;
  double r2 = r * r;
  double sn = r * (1.0 + r2 * (-1.0 / 6 + r2 * (1.0 / 120 + r2 * (-1.0 / 5040 + r2 * (1.0 / 362880 + r2 * (-1.0 / 39916800 + r2 * (1.0 / 6227020800.0)))))));
  double cs = 1.0 + r2 * (-0.5 + r2 * (1.0 / 24 + r2 * (-1.0 / 720 + r2 * (1.0 / 40320 + r2 * (-1.0 / 3628800 + r2 * (1.0 / 479001600.0))))));
  int q = ((int)k) & 3;
  double so = (q == 0) ? sn : (q == 1) ? cs : (q == 2) ? -sn : -cs;
  double co = (q == 0) ? cs : (q == 1) ? -sn : (q == 2) ? -cs : sn;
  s = (float)so; c = (float)co;
}

__device__ void phase0(const Params& p, char* smem) {
  const int tid = get_tid(), bid = get_bid(), nb = gridDim.x;
  float* fs = (float*)smem;
  if (bid == 0) {
    for (int e = tid; e < 128 * 16 + 128 * 32; e += NTHR) {
      int F, pos, f, base;
      if (e < 2048) { F = 16; pos = e >> 4; f = e & 15; base = 0; }
      else { int e2 = e - 2048; F = 32; pos = e2 >> 5; f = e2 & 31; base = 4096; }
      double bb = (F == 16) ? 0.56234132519034908 : 0.74989420933245582;
      double inv = 1.0;
      for (int i = 0; i < f; ++i) inv *= bb;
      float invf = (float)inv;
      float ang = (float)pos * invf;
      float sn, cs;
      sincos_d((double)ang, sn, cs);
      p.rope[base + pos * F + f] = cs;
      p.rope[base + 128 * F + pos * F + f] = sn;
    }
  }
  for (int it = bid; it < 384; it += nb) {
    int layer = it / 192, r = it % 192, kc = r / 6, nc = r % 6;
    __syncthreads();
    if (tid < 192) {
      int v = tid >> 6, kk = tid & 63;
      float cv = (v < 2) ? p.c[v * D + kc * 64 + kk] : p.c_ctx[kc * 64 + kk];
      fs[tid] = silu_f(cv);
    }
    __syncthreads();
    int n = nc * 2048 + tid * 4;
    float4 a0 = make_float4(0, 0, 0, 0), a1 = a0, a2 = a0;
    if (kc == 0) { a0 = *(const float4*)(p.b_ada + layer * 12288 + n); a1 = a0; a2 = a0; }
    const float* w = p.w_ada + (size_t)layer * D * 12288 + (size_t)(kc * 64) * 12288 + n;
#pragma unroll 8
    for (int kk = 0; kk < 64; ++kk) {
      float4 wv = *(const float4*)(w + (size_t)kk * 12288);
      float s0 = fs[kk], s1 = fs[64 + kk], s2 = fs[128 + kk];
      a0.x += s0 * wv.x; a0.y += s0 * wv.y; a0.z += s0 * wv.z; a0.w += s0 * wv.w;
      a1.x += s1 * wv.x; a1.y += s1 * wv.y; a1.z += s1 * wv.z; a1.w += s1 * wv.w;
      a2.x += s2 * wv.x; a2.y += s2 * wv.y; a2.z += s2 * wv.z; a2.w += s2 * wv.w;
    }
    float* m0 = p.mod + (layer * 3 + 0) * 12288 + n;
    float* m1 = p.mod + (layer * 3 + 1) * 12288 + n;
    float* m2 = p.mod + (layer * 3 + 2) * 12288 + n;
    atomicAdd(m0 + 0, a0.x); atomicAdd(m0 + 1, a0.y); atomicAdd(m0 + 2, a0.z); atomicAdd(m0 + 3, a0.w);
    atomicAdd(m1 + 0, a1.x); atomicAdd(m1 + 1, a1.y); atomicAdd(m1 + 2, a1.z); atomicAdd(m1 + 3, a1.w);
    atomicAdd(m2 + 0, a2.x); atomicAdd(m2 + 1, a2.y); atomicAdd(m2 + 2, a2.z); atomicAdd(m2 + 3, a2.w);
  }
  for (int layer = 0; layer < 2; ++layer) {
    for (int it = bid; it < 32 * 94; it += nb)
      transpose_cvt(p.w_in + (size_t)layer * D * DIN, D, DIN, DINP, p.wt_in + (size_t)layer * DINP * D, it, fs);
    for (int it = bid; it < 32 * 32; it += nb)
      transpose_cvt(p.w_out + (size_t)layer * D * D, D, D, D, p.wt_out + (size_t)layer * D * D, it, fs);
    for (int it = bid; it < 32 * 32; it += nb)
      transpose_cvt(p.w_q + (size_t)layer * D * D, D, D, D, p.wt_q + (size_t)layer * D * D, it, fs);
  }
  cvt_linear(p.sub_keys, p.sk_bf, (size_t)524288 / 8);
  cvt_fp8_rows(p.pu, p.u8, p.uscl, 2 * 16384);
  cvt_fp8_rows(p.pv, p.v8, p.vscl, 2 * 16384);
}

__device__ void modulate_phase(const Params& p, int layer, int which, int nrows) {
  const int lane = get_tid() & 63;
  const int wave = get_bid() * 8 + (get_tid() >> 6), nw = gridDim.x * 8;
  const float* g = (which == 0 ? p.g_attn : p.g_ffn) + layer * D;
  for (int m = wave; m < nrows; m += nw) {
    const float* src;
    if (layer == 0 && which == 0) src = (m < MX) ? p.x + (size_t)m * D : p.ctx + (size_t)(m - MX) * D;
    else src = p.xcur + (size_t)m * D;
    int vec = m < S ? 0 : (m < MX ? 1 : 2);
    const float* modl = p.mod + (layer * 3 + vec) * 12288 + which * 3 * D;
    float4 v[8];
    float ss = 0.f;
#pragma unroll
    for (int i = 0; i < 8; ++i) {
      v[i] = *(const float4*)(src + i * 256 + lane * 4);
      ss += v[i].x * v[i].x + v[i].y * v[i].y + v[i].z * v[i].z + v[i].w * v[i].w;
    }
    ss = wave_sum(ss);
    float rstd = rsqrtf(ss * (1.f / D) + EPS);
#pragma unroll
    for (int i = 0; i < 8; ++i) {
      int col = i * 256 + lane * 4;
      float4 gg = *(const float4*)(g + col);
      float4 sh = *(const float4*)(modl + col);
      float4 sc = *(const float4*)(modl + D + col);
      float y0 = v[i].x * rstd * gg.x * (1.f + sc.x) + sh.x;
      float y1 = v[i].y * rstd * gg.y * (1.f + sc.y) + sh.y;
      float y2 = v[i].z * rstd * gg.z * (1.f + sc.z) + sh.z;
      float y3 = v[i].w * rstd * gg.w * (1.f + sc.w) + sh.w;
      uint2 o; o.x = pack2(y0, y1); o.y = pack2(y2, y3);
      *(uint2*)(p.h + (size_t)m * D + col) = o;
    }
  }
}

template <int EPI, bool BIG>
__device__ void gemm_tile(const bfr* __restrict__ A, int lda, const bfr* __restrict__ Bt, int ldb, int K, int m0,
                          int n0, void* Cout, int ldc, const Params& p, int layer, char* smem) {
  constexpr int BN = BIG ? 256 : 128;
  constexpr int MI = BIG ? 8 : 4;
  constexpr int NBL = BN / 64;
  bfr* As0 = (bfr*)smem;
  bfr* Bs0 = As0 + 2 * 256 * 72;
  const int tid = get_tid(), lane = tid & 63, w = tid >> 6;
  const int wm = BIG ? (w >> 2) : (w >> 1), wn = BIG ? (w & 3) : (w & 1);
  const int fr = lane & 15, fq = lane >> 4;
  f32x4 acc[MI][4];
#pragma unroll
  for (int i = 0; i < MI; ++i)
#pragma unroll
    for (int j = 0; j < 4; ++j) acc[i][j] = (f32x4){0.f, 0.f, 0.f, 0.f};
  const int arow = tid >> 3, akc = (tid & 7) * 8;
  u4 rs[4];
  const bfr* Ap = A + (size_t)(m0 + arow) * lda + akc;
  const bfr* Bp = Bt + (size_t)(n0 + arow) * ldb + akc;
#pragma unroll
  for (int i = 0; i < 4; ++i) rs[i] = *(const u4*)(Ap + (size_t)(64 * i) * lda);
  __syncthreads();
#pragma unroll
  for (int i = 0; i < 4; ++i) *(u4*)(As0 + (arow + 64 * i) * 72 + akc) = rs[i];
#pragma unroll
  for (int i = 0; i < NBL; ++i) rs[i] = *(const u4*)(Bp + (size_t)(64 * i) * ldb);
#pragma unroll
  for (int i = 0; i < NBL; ++i) *(u4*)(Bs0 + (arow + 64 * i) * 72 + akc) = rs[i];
  const int nk = K >> 6;
  if (nk > 1) {
#pragma unroll
    for (int i = 0; i < 4; ++i) rs[i] = *(const u4*)(Ap + (size_t)(64 * i) * lda + 64);
  }
  __syncthreads();
  for (int kt = 0; kt < nk; ++kt) {
    const bfr* As = As0 + (kt & 1) * (256 * 72);
    const bfr* Bs = Bs0 + (kt & 1) * (BN * 72);
    bfr* Asn = As0 + ((kt + 1) & 1) * (256 * 72);
    bfr* Bsn = Bs0 + ((kt + 1) & 1) * (BN * 72);
#pragma unroll
    for (int kk = 0; kk < 2; ++kk) {
      bf16x8 b[4];
#pragma unroll
      for (int j = 0; j < 4; ++j) b[j] = *(const bf16x8*)(Bs + (wn * 64 + j * 16 + fr) * 72 + kk * 32 + fq * 8);
      {
        bf16x8 a_cur = *(const bf16x8*)(As + (wm * (MI * 16) + fr) * 72 + kk * 32 + fq * 8);
#pragma unroll
        for (int i = 0; i < MI; ++i) {
          bf16x8 a_nxt = a_cur;
          if (i + 1 < MI) a_nxt = *(const bf16x8*)(As + (wm * (MI * 16) + (i + 1) * 16 + fr) * 72 + kk * 32 + fq * 8);
#pragma unroll
          for (int j = 0; j < 4; ++j) acc[i][j] = __builtin_amdgcn_mfma_f32_16x16x32_bf16(b[j], a_cur, acc[i][j], 0, 0, 0);
          if (BIG) __builtin_amdgcn_sched_barrier(0);
          a_cur = a_nxt;
        }
      }
      if (kt + 1 < nk) {
        if (kk == 0) {
#pragma unroll
          for (int i = 0; i < 4; ++i) *(u4*)(Asn + (arow + 64 * i) * 72 + akc) = rs[i];
#pragma unroll
          for (int i = 0; i < NBL; ++i) rs[i] = *(const u4*)(Bp + (size_t)(64 * i) * ldb + (kt + 1) * 64);
        } else {
#pragma unroll
          for (int i = 0; i < NBL; ++i) *(u4*)(Bsn + (arow + 64 * i) * 72 + akc) = rs[i];
          if (kt + 2 < nk) {
#pragma unroll
            for (int i = 0; i < 4; ++i) rs[i] = *(const u4*)(Ap + (size_t)(64 * i) * lda + (kt + 2) * 64);
          }
        }
      }
    }
    __syncthreads();
  }
  const int nb0 = n0 + wn * 64 + fq * 4;
#pragma unroll
  for (int i = 0; i < MI; ++i) {
    const int m = m0 + wm * (MI * 16) + i * 16 + fr;
    if (EPI == 0) {
      bfr* crow = (bfr*)Cout + (size_t)m * ldc + nb0;
#pragma unroll
      for (int j = 0; j < 4; ++j) {
        uint2 o;
        o.x = pack2(acc[i][j][0], acc[i][j][1]); o.y = pack2(acc[i][j][2], acc[i][j][3]);
        *(uint2*)(crow + j * 16) = o;
      }
    } else if (EPI == 2) {
      float* crow = (float*)Cout + (size_t)m * ldc + nb0;
#pragma unroll
      for (int j = 0; j < 4; ++j) *(float4*)(crow + j * 16) = make_float4(acc[i][j][0], acc[i][j][1], acc[i][j][2], acc[i][j][3]);
    } else {
      const float* src;
      if (layer == 0) src = (m < MX) ? p.x + (size_t)m * D : p.ctx + (size_t)(m - MX) * D;
      else src = p.xcur + (size_t)m * D;
      src += nb0;
      const int vec = m < S ? 0 : (m < MX ? 1 : 2);
      const float* grow = p.mod + (layer * 3 + vec) * 12288 + 2 * D + nb0;
      float* orow = p.xcur + (size_t)m * D + nb0;
#pragma unroll
      for (int j = 0; j < 4; ++j) {
        const float4 gate = *(const float4*)(grow + j * 16);
        const float4 xs = *(const float4*)(src + j * 16);
        *(float4*)(orow + j * 16) = make_float4(xs.x + gate.x * acc[i][j][0], xs.y + gate.y * acc[i][j][1], xs.z + gate.z * acc[i][j][2], xs.w + gate.w * acc[i][j][3]);
      }
      __builtin_amdgcn_sched_barrier(0);
    }
  }
}

#define MFMA16(a, b, c) __builtin_amdgcn_mfma_f32_16x16x32_bf16((a), (b), (c), 0, 0, 0)
typedef __attribute__((ext_vector_type(4))) short s16x4;

__device__ __forceinline__ void load_kv_tile(bfr* dst, const bfr* src, int nrows, int tok0, int toklimit) {
  for (int c = get_tid(); c < nrows * 8; c += NTHR) {
    int r = c >> 3, ch = c & 7;
    int tok = tok0 + r;
    u4 v = (u4){0u, 0u, 0u, 0u};
    if (tok >= 0 && tok < toklimit) v = *(const u4*)(src + (ptrdiff_t)r * DINP + ch * 8);
    *(u4*)(dst + r * 72 + ch * 8) = v;
  }
}
__device__ __forceinline__ void load_vt_tile(bfr* Vt, int VS, const bfr* src, int nrows, int tok0, int toklimit) {
  for (int c = get_tid(); c < nrows * 8; c += NTHR) {
    int key = c % nrows, dch = c / nrows;
    int tok = tok0 + key;
    u4 v = (u4){0u, 0u, 0u, 0u};
    if (tok >= 0 && tok < toklimit) v = *(const u4*)(src + (ptrdiff_t)key * DINP + dch * 8);
    bfr* d = Vt + (dch * 8) * VS + key;
    d[0 * VS] = (bfr)(v.x & 0xffffu); d[1 * VS] = (bfr)(v.x >> 16);
    d[2 * VS] = (bfr)(v.y & 0xffffu); d[3 * VS] = (bfr)(v.y >> 16);
    d[4 * VS] = (bfr)(v.z & 0xffffu); d[5 * VS] = (bfr)(v.z >> 16);
    d[6 * VS] = (bfr)(v.w & 0xffffu); d[7 * VS] = (bfr)(v.w >> 16);
  }
}
__device__ __forceinline__ void load_kfrags(bf16x8 (&kf)[2][2], const bfr* Ks, int kt, int fr, int q4) {
#pragma unroll
  for (int blk = 0; blk < 2; ++blk)
#pragma unroll
    for (int ds = 0; ds < 2; ++ds) kf[blk][ds] = *(const bf16x8*)(Ks + (kt + blk * 16 + fr) * 72 + ds * 32 + q4 * 8);
}
__device__ __forceinline__ void load_vfrags(bf16x8 (&vf)[4], const bfr* Vt, int VS, int kt, int fr, int q4) {
#pragma unroll
  for (int db = 0; db < 4; ++db) {
    const bfr* vp = Vt + (db * 16 + fr) * VS + kt + q4 * 4;
    s16x4 lo = *(const s16x4*)vp, hi = *(const s16x4*)(vp + 16);
    vf[db] = __builtin_shufflevector(lo, hi, 0, 1, 2, 3, 4, 5, 6, 7);
  }
}
__device__ __forceinline__ void attn_tile_group(const bf16x8 (&kf)[2][2], const bf16x8 (&qf)[2], const bf16x8 (&vf)[4],
                                                f32x4 (&o)[4], float& m, float& l, const float (&badd)[8]) {
  f32x4 s0 = (f32x4){0.f, 0.f, 0.f, 0.f}, s1 = s0;
  s0 = MFMA16(kf[0][0], qf[0], s0); s0 = MFMA16(kf[0][1], qf[1], s0);
  s1 = MFMA16(kf[1][0], qf[0], s1); s1 = MFMA16(kf[1][1], qf[1], s1);
  float sv[8];
#pragma unroll
  for (int i = 0; i < 4; ++i) { sv[i] = s0[i] + badd[i]; sv[4 + i] = s1[i] + badd[4 + i]; }
  float mx = fmaxf(fmaxf(fmaxf(sv[0], sv[1]), fmaxf(sv[2], sv[3])), fmaxf(fmaxf(sv[4], sv[5]), fmaxf(sv[6], sv[7])));
  mx = fmaxf(mx, __shfl_xor(mx, 16));
  mx = fmaxf(mx, __shfl_xor(mx, 32));
  const float mn = fmaxf(m, mx);
  const float mref = (mn == -INFINITY) ? 0.f : mn;
  const float alpha = __expf(m - mref);
  float pv[8];
  float ls = 0.f;
#pragma unroll
  for (int i = 0; i < 8; ++i) { pv[i] = __expf(sv[i] - mref); ls += pv[i]; }
  ls += __shfl_xor(ls, 16);
  ls += __shfl_xor(ls, 32);
  l = l * alpha + ls;
  m = mn;
  u4 pk;
  pk.x = pack2(pv[0], pv[1]); pk.y = pack2(pv[2], pv[3]); pk.z = pack2(pv[4], pv[5]); pk.w = pack2(pv[6], pv[7]);
  const bf16x8 pb = __builtin_bit_cast(bf16x8, pk);
#pragma unroll
  for (int db = 0; db < 4; ++db) {
    o[db] *= alpha;
    o[db] = MFMA16(vf[db], pb, o[db]);
  }
}
__device__ __forceinline__ void load_qfrags(bf16x8 (&qf)[2], const bfr* qrow, int q4, float scale) {
#pragma unroll
  for (int ds = 0; ds < 2; ++ds) {
    u4 w = *(const u4*)(qrow + ds * 32 + q4 * 8);
    float f[8];
    unpack8(w, f);
    u4 o;
    o.x = pack2(f[0] * scale, f[1] * scale); o.y = pack2(f[2] * scale, f[3] * scale);
    o.z = pack2(f[4] * scale, f[5] * scale); o.w = pack2(f[6] * scale, f[7] * scale);
    qf[ds] = __builtin_bit_cast(bf16x8, o);
  }
}
__device__ __forceinline__ void store_ot(bfr* dst, const f32x4 (&o)[4], float inv, int q4) {
#pragma unroll
  for (int db = 0; db < 4; ++db) {
    uint2 w;
    w.x = pack2(o[db][0] * inv, o[db][1] * inv);
    w.y = pack2(o[db][2] * inv, o[db][3] * inv);
    *(uint2*)(dst + db * 16 + q4 * 4) = w;
  }
}

__device__ void swa_item(const Params& p, int layer, int item, char* smem) {
  const int b = item >> 7, kvh = (item >> 6) & 1, nbk = item & 63;
  bfr* Ks = (bfr*)smem;
  bfr* Vt = Ks + 384 * 72;
  constexpr int VS = 392;
  const int tid = get_tid();
  const int lane = tid & 63, w = tid >> 6, fr = lane & 15, q4 = lane >> 4;
  const float* cos16 = p.rope;
  const float* sin16 = p.rope + 2048;
  __syncthreads();
  const int tok0 = (nbk - 1) * 128;
  const bfr* rowbase = p.proj + (ptrdiff_t)(b * S + tok0) * DINP;
  load_vt_tile(Vt, VS, rowbase + C_SWV + kvh * 64, 384, tok0, S);
  for (int u = tid; u < 384 * 4; u += NTHR) {
    int r = u >> 2, A = (u >> 1) & 1, fc = u & 1;
    int tok = tok0 + r;
    u4 o1 = (u4){0u, 0u, 0u, 0u}, o2 = o1;
    if (tok >= 0 && tok < S) {
      const bfr* kp = rowbase + (ptrdiff_t)r * DINP + C_SWK + kvh * 64 + A * 32 + fc * 8;
      u4 w1 = *(const u4*)kp, w2 = *(const u4*)(kp + 16);
      float x1[8], x2[8], y1[8], y2[8];
      unpack8(w1, x1); unpack8(w2, x2);
      int pos = A ? (tok & 63) : (tok >> 6);
#pragma unroll
      for (int j = 0; j < 8; ++j) {
        float cs = cos16[pos * 16 + fc * 8 + j], sn = sin16[pos * 16 + fc * 8 + j];
        y1[j] = x1[j] * cs - x2[j] * sn;
        y2[j] = x2[j] * cs + x1[j] * sn;
      }
      o1.x = pack2(y1[0], y1[1]); o1.y = pack2(y1[2], y1[3]); o1.z = pack2(y1[4], y1[5]); o1.w = pack2(y1[6], y1[7]);
      o2.x = pack2(y2[0], y2[1]); o2.y = pack2(y2[2], y2[3]); o2.z = pack2(y2[4], y2[5]); o2.w = pack2(y2[6], y2[7]);
    }
    int ch1 = A * 4 + fc, ch2 = A * 4 + 2 + fc;
    *(u4*)(Ks + r * 72 + ch1 * 8) = o1;
    *(u4*)(Ks + r * 72 + ch2 * 8) = o2;
  }
  const int g = w >> 1, qhalf = w & 1;
  const int hq = kvh * 4 + g;
  bf16x8 qf[4][2];
  f32x4 oacc[4][4];
  float mm[4], ll[4];
#pragma unroll
  for (int grp = 0; grp < 4; ++grp) {
    const int tq = nbk * 128 + qhalf * 64 + grp * 16 + fr;
    const bfr* qrow = p.proj + (size_t)(b * S + tq) * DINP + C_SWQ + hq * 64;
#pragma unroll
    for (int ds = 0; ds < 2; ++ds) {
      u4 wq = *(const u4*)(qrow + ds * 32 + q4 * 8);
      float f[8], y[8];
      unpack8(wq, f);
      const int pos = ds ? (tq & 63) : (tq >> 6);
#pragma unroll
      for (int j = 0; j < 8; ++j) {
        const float other = __shfl_xor(f[j], 32);
        const int fi = (q4 & 1) * 8 + j;
        const float cs = cos16[pos * 16 + fi], sn = sin16[pos * 16 + fi];
        y[j] = ((q4 < 2) ? (f[j] * cs - other * sn) : (f[j] * cs + other * sn)) * 0.125f;
      }
      u4 o;
      o.x = pack2(y[0], y[1]); o.y = pack2(y[2], y[3]); o.z = pack2(y[4], y[5]); o.w = pack2(y[6], y[7]);
      qf[grp][ds] = __builtin_bit_cast(bf16x8, o);
    }
    mm[grp] = -INFINITY; ll[grp] = 0.f;
#pragma unroll
    for (int db = 0; db < 4; ++db) oacc[grp][db] = (f32x4){0.f, 0.f, 0.f, 0.f};
  }
  __syncthreads();
#pragma unroll 1
  for (int t = 0; t < 10; ++t) {
    const int kt = qhalf * 64 + 32 * t;
    if (tok0 + kt + 31 < 0 || tok0 + kt >= S) continue;
    bf16x8 kf[2][2], vf[4];
    load_kfrags(kf, Ks, kt, fr, q4);
    load_vfrags(vf, Vt, VS, kt, fr, q4);
#pragma unroll
    for (int grp = 0; grp < 4; ++grp) {
      const int qg0 = 128 + qhalf * 64 + grp * 16;
      if (kt > qg0 + 15 + 128 || kt + 31 < qg0 - 128) continue;
      const int qrow = qg0 + fr;
      float badd[8];
#pragma unroll
      for (int i = 0; i < 8; ++i) {
        const int lr = kt + (i >> 2) * 16 + q4 * 4 + (i & 3);
        const int dd = qrow - lr;
        const int tok = tok0 + lr;
        const bool ok = (dd <= 128) && (dd >= -128) && (tok >= 0) && (tok < S);
        badd[i] = ok ? 0.f : -INFINITY;
      }
      attn_tile_group(kf, qf[grp], vf, oacc[grp], mm[grp], ll[grp], badd);
    }
  }
  __syncthreads();
  const bfr* zbase = p.proj + (size_t)(MX + b * 256) * DINP;
  load_kv_tile(Ks, zbase + C_SWK + kvh * 64, 256, 0, 256);
  load_vt_tile(Vt, VS, zbase + C_SWV + kvh * 64, 256, 0, 256);
  __syncthreads();
  float zb[8];
#pragma unroll
  for (int i = 0; i < 8; ++i) zb[i] = 0.f;
#pragma unroll 1
  for (int t = 0; t < 8; ++t) {
    const int kt = 32 * t;
    bf16x8 kf[2][2], vf[4];
    load_kfrags(kf, Ks, kt, fr, q4);
    load_vfrags(vf, Vt, VS, kt, fr, q4);
#pragma unroll
    for (int grp = 0; grp < 4; ++grp) attn_tile_group(kf, qf[grp], vf, oacc[grp], mm[grp], ll[grp], zb);
  }
  const float sk = p.sink[layer * 8 + hq];
#pragma unroll
  for (int grp = 0; grp < 4; ++grp) {
    const int tq = nbk * 128 + qhalf * 64 + grp * 16 + fr;
    const float mn = fmaxf(mm[grp], sk);
    const float alpha = __expf(mm[grp] - mn);
    const float lt = ll[grp] * alpha + __expf(sk - mn);
    store_ot(p.mix + (size_t)(b * S + tq) * D + 1536 + hq * 64, oacc[grp], alpha / lt, q4);
  }
}

__device__ void na_item(const Params& p, int layer, int item, char* smem) {
  const int b = item >> 10, h = (item >> 7) & 7, r = item & 127;
  bfr* Ks = (bfr*)smem;
  bfr* Vt = Ks + 512 * 72;
  constexpr int VS = 520;
  float* rp = (float*)(Vt + 64 * VS);
  float* mg = (float*)smem;
  const int tid = get_tid();
  const int lane = tid & 63, w = tid >> 6, fr = lane & 15, q4 = lane >> 4;
  __syncthreads();
  int r0 = r - 4; r0 = r0 < 0 ? 0 : (r0 > 120 ? 120 : r0);
  const bfr* rowbase = p.proj + (size_t)(b * S + r0 * 64) * DINP;
  load_kv_tile(Ks, rowbase + C_NAK + h * 64, 512, 0, 512);
  load_vt_tile(Vt, VS, rowbase + C_NAV + h * 64, 512, 0, 512);
  if (tid < 15 * 31) rp[tid] = p.rpb[(layer * 8 + h) * 465 + tid];
  const int grp = w >> 1, half = w & 1;
  const int cq = grp * 16 + fr;
  const int tq = r * 64 + cq;
  bf16x8 qf[2];
  load_qfrags(qf, p.proj + (size_t)(b * S + tq) * DINP + C_NAQ + h * 64, q4, 0.125f);
  f32x4 oacc[4];
#pragma unroll
  for (int db = 0; db < 4; ++db) oacc[db] = (f32x4){0.f, 0.f, 0.f, 0.f};
  float m = -INFINITY, l = 0.f;
  __syncthreads();
  int cs = cq - 8; cs = cs < 0 ? 0 : (cs > 48 ? 48 : cs);
  const int tstart = grp == 0 ? 0 : (grp == 1 ? 8 : (grp == 2 ? 24 : 32));
#pragma unroll 1
  for (int jj = 0; jj < 4; ++jj) {
    const int jrow = half * 4 + jj;
    const int drow = (r0 + jrow) - r + 7;
    const int kt = jrow * 64 + tstart;
    bf16x8 kf[2][2], vf[4];
    load_kfrags(kf, Ks, kt, fr, q4);
    load_vfrags(vf, Vt, VS, kt, fr, q4);
    float badd[8];
#pragma unroll
    for (int i = 0; i < 8; ++i) {
      const int ck = tstart + (i >> 2) * 16 + q4 * 4 + (i & 3);
      const bool ok = (ck >= cs) && (ck < cs + 16);
      int dc = ck - cq + 15; dc = dc < 0 ? 0 : (dc > 30 ? 30 : dc);
      badd[i] = ok ? rp[drow * 31 + dc] : -INFINITY;
    }
    attn_tile_group(kf, qf, vf, oacc, m, l, badd);
  }
  __syncthreads();
  const bfr* zbase = p.proj + (size_t)(MX + b * 256) * DINP;
  load_kv_tile(Ks, zbase + C_NAK + h * 64, 256, 0, 256);
  load_vt_tile(Vt, VS, zbase + C_NAV + h * 64, 256, 0, 256);
  __syncthreads();
  float zb[8];
#pragma unroll
  for (int i = 0; i < 8; ++i) zb[i] = 0.f;
#pragma unroll 1
  for (int t = 0; t < 4; ++t) {
    const int kt = half * 128 + 32 * t;
    bf16x8 kf[2][2], vf[4];
    load_kfrags(kf, Ks, kt, fr, q4);
    load_vfrags(vf, Vt, VS, kt, fr, q4);
    attn_tile_group(kf, qf, vf, oacc, m, l, zb);
  }
  __syncthreads();
  float* mo = mg + grp * (16 * 64 + 64) ;
  if (half == 1) {
#pragma unroll
    for (int db = 0; db < 4; ++db)
#pragma unroll
      for (int i = 0; i < 4; ++i) mo[(db * 4 + i) * 64 + lane] = oacc[db][i];
    if (q4 == 0) { mo[16 * 64 + fr] = m; mo[16 * 64 + 16 + fr] = l; }
  }
  __syncthreads();
  if (half == 0) {
    const float m2 = mo[16 * 64 + fr], l2 = mo[16 * 64 + 16 + fr];
    const float mn = fmaxf(m, m2);
    const float a1 = __expf(m - mn), a2 = __expf(m2 - mn);
    const float lt = l * a1 + l2 * a2;
    const float i1 = a1 / lt, i2 = a2 / lt;
#pragma unroll
    for (int db = 0; db < 4; ++db)
#pragma unroll
      for (int i = 0; i < 4; ++i) oacc[db][i] = oacc[db][i] * i1 + mo[(db * 4 + i) * 64 + lane] * i2;
    store_ot(p.mix + (size_t)(b * S + tq) * D + h * 64, oacc, 1.f, q4);
  }
}

__device__ void ctx_item(const Params& p, int layer, int item, char* smem) {
  const int b = item >> 4, type = (item >> 3) & 1, h = item & 7;
  bfr* Ks = (bfr*)smem;
  bfr* Vt = Ks + 256 * 72;
  constexpr int VS = 264;
  const int tid = get_tid();
  const int lane = tid & 63, w = tid >> 6, fr = lane & 15, q4 = lane >> 4;
  __syncthreads();
  const bfr* zbase = p.proj + (size_t)(MX + b * 256) * DINP;
  const int kcol = type ? (C_SWK + (h >> 2) * 64) : (C_NAK + h * 64);
  const int vcol = type ? (C_SWV + (h >> 2) * 64) : (C_NAV + h * 64);
  const int qcol = type ? (C_SWQ + h * 64) : (C_NAQ + h * 64);
  load_kv_tile(Ks, zbase + kcol, 256, 0, 256);
  load_vt_tile(Vt, VS, zbase + vcol, 256, 0, 256);
  bf16x8 qf[2][2];
  f32x4 oacc[2][4];
  float mm[2], ll[2];
#pragma unroll
  for (int grp = 0; grp < 2; ++grp) {
    const int qz = w * 32 + grp * 16 + fr;
    load_qfrags(qf[grp], zbase + (size_t)qz * DINP + qcol, q4, 0.125f);
    mm[grp] = -INFINITY; ll[grp] = 0.f;
#pragma unroll
    for (int db = 0; db < 4; ++db) oacc[grp][db] = (f32x4){0.f, 0.f, 0.f, 0.f};
  }
  __syncthreads();
  float zb[8];
#pragma unroll
  for (int i = 0; i < 8; ++i) zb[i] = 0.f;
#pragma unroll 1
  for (int t = 0; t < 8; ++t) {
    const int kt = 32 * t;
    bf16x8 kf[2][2], vf[4];
    load_kfrags(kf, Ks, kt, fr, q4);
    load_vfrags(vf, Vt, VS, kt, fr, q4);
#pragma unroll
    for (int grp = 0; grp < 2; ++grp) attn_tile_group(kf, qf[grp], vf, oacc[grp], mm[grp], ll[grp], zb);
  }
#pragma unroll
  for (int grp = 0; grp < 2; ++grp) {
    const int qz = w * 32 + grp * 16 + fr;
    float inv;
    if (type == 1) {
      const float sk = p.sink[layer * 8 + h];
      const float mn = fmaxf(mm[grp], sk);
      const float a = __expf(mm[grp] - mn);
      inv = a / (ll[grp] * a + __expf(sk - mn));
    } else {
      inv = 1.f / ll[grp];
    }
    store_ot(p.mix + (size_t)(MX + b * 256 + qz) * D + (type ? 1536 : 0) + h * 64, oacc[grp], inv, q4);
  }
}

template <int W>
__device__ __forceinline__ void load_rows_f32(float* dst, int stride, const bfr* src, float scale) {
  constexpr int CPR = W / 8;
  for (int c = get_tid(); c < 64 * CPR; c += NTHR) {
    int j = c / CPR, ch = c % CPR;
    u4 w = *(const u4*)(src + (size_t)j * DINP + ch * 8);
    float f[8];
    unpack8(w, f);
    float4 a = make_float4(f[0] * scale, f[1] * scale, f[2] * scale, f[3] * scale);
    float4 bq = make_float4(f[4] * scale, f[5] * scale, f[6] * scale, f[7] * scale);
    *(float4*)(dst + j * stride + ch * 8) = a;
    *(float4*)(dst + j * stride + ch * 8 + 4) = bq;
  }
}

__device__ __forceinline__ void rope128_tile(float* t, int stride, int prow, const float* rope, float scale) {
  const float* cos32 = rope + 4096;
  const float* sin32 = rope + 8192;
  for (int u = get_tid(); u < 64 * 64; u += NTHR) {
    int j = u >> 6, A = (u >> 5) & 1, f = u & 31;
    int pos = A ? j : prow;
    float cs = cos32[pos * 32 + f], sn = sin32[pos * 32 + f];
    float x1 = t[j * stride + A * 64 + f], x2 = t[j * stride + A * 64 + 32 + f];
    t[j * stride + A * 64 + f] = (x1 * cs - x2 * sn) * scale;
    t[j * stride + A * 64 + 32 + f] = (x2 * cs + x1 * sn) * scale;
  }
}

__device__ __forceinline__ void gla_logdecay(const Params& p, int layer, int h, int dir, const bfr* rowbase, float* G) {
  const int tid = get_tid();
  const int j = tid >> 3, dg = tid & 7;
  const bfr* dl = rowbase + (size_t)j * DINP + C_GLD + dir * 16;
  u4 w0 = *(const u4*)dl, w1 = *(const u4*)(dl + 8);
  float x[16];
  unpack8(w0, x); unpack8(w1, x + 8);
  const float* wu = p.gla_wu + (size_t)layer * 8192 + dir * 4096 + h * 64;
  const float* bb = p.gla_b + layer * 512 + dir * 256 + h * 64;
#pragma unroll
  for (int dd = 0; dd < 8; ++dd) {
    int d = dg + 8 * dd;
    float pre = bb[d];
#pragma unroll
    for (int r = 0; r < 16; ++r) pre += x[r] * wu[r * 256 + d];
    G[j * 68 + d] = logsig_f(pre) * (1.f / 16.f);
  }
}

__device__ __forceinline__ void gla_logdecay2(const Params& p, int layer, int h, const bfr* rowbase, float* G0, float* G1) {
  const int tid = get_tid();
  const int w = tid >> 6, lane = tid & 63, fr = lane & 15, q4 = lane >> 4;
  const int dir = w >> 2, dt = w & 3;
  const int d = dt * 16 + fr;
  float* G = dir ? G1 : G0;
  u4 bw = (u4){0u, 0u, 0u, 0u};
  if (q4 < 2) {
    const float* wu = p.gla_wu + (size_t)layer * 8192 + dir * 4096 + (q4 * 8) * 256 + h * 64 + d;
    bw.x = pack2(wu[0 * 256], wu[1 * 256]); bw.y = pack2(wu[2 * 256], wu[3 * 256]);
    bw.z = pack2(wu[4 * 256], wu[5 * 256]); bw.w = pack2(wu[6 * 256], wu[7 * 256]);
  }
  const bf16x8 bq = __builtin_bit_cast(bf16x8, bw);
  const float bias = p.gla_b[layer * 512 + dir * 256 + h * 64 + d];
#pragma unroll
  for (int rt = 0; rt < 4; ++rt) {
    u4 aw = (u4){0u, 0u, 0u, 0u};
    if (q4 < 2) aw = *(const u4*)(rowbase + (size_t)(rt * 16 + fr) * DINP + C_GLD + dir * 16 + q4 * 8);
    f32x4 acc = (f32x4){0.f, 0.f, 0.f, 0.f};
    acc = MFMA16(__builtin_bit_cast(bf16x8, aw), bq, acc);
#pragma unroll
    for (int r = 0; r < 4; ++r) G[(rt * 16 + q4 * 4 + r) * 68 + d] = logsig_f(acc[r] + bias) * (1.f / 16.f);
  }
}

__device__ __forceinline__ int scan_pos(int dir, int g) { return dir == 0 ? g : (g < 4 ? 3 - g : 135 - g); }
__device__ __forceinline__ int group_row0(int b, int g) { return g < 4 ? (MX + b * 256 + g * 64) : (b * S + (g - 4) * 64); }

template <int W>
__device__ __forceinline__ void load_rows_transposed(bfr* T, const bfr* src) {
  for (int c = get_tid(); c < 64 * (W / 8); c += NTHR) {
    const int j = c & 63, dch = c >> 6;
    const u4 v = *(const u4*)(src + (size_t)j * DINP + dch * 8);
    bfr* d = T + (dch * 8) * 72 + j;
    d[0 * 72] = (bfr)(v.x & 0xffffu); d[1 * 72] = (bfr)(v.x >> 16);
    d[2 * 72] = (bfr)(v.y & 0xffffu); d[3 * 72] = (bfr)(v.y >> 16);
    d[4 * 72] = (bfr)(v.z & 0xffffu); d[5 * 72] = (bfr)(v.z >> 16);
    d[6 * 72] = (bfr)(v.w & 0xffffu); d[7 * 72] = (bfr)(v.w >> 16);
  }
}

template <int DK, bool GLA>
__device__ void scan_a_item(const Params& p, int layer, int item, char* smem) {
  const int g = item % 132;
  const int t2 = item / 132;
  const int h = t2 & 3, b = t2 >> 2;
  constexpr int KS = DK + 4;
  float* ks = (float*)smem;
  float* E0 = ks + 64 * KS;
  float* E1 = E0 + 64 * 68;
  bfr* Kt = (bfr*)(E1 + 64 * 68);
  bfr* Vt = Kt + DK * 72;
  const int tid = get_tid();
  const int w = tid >> 6, lane = tid & 63, fr = lane & 15, q4 = lane >> 4;
  const int row0 = group_row0(b, g);
  const bfr* rowbase = p.proj + (size_t)row0 * DINP;
  __syncthreads();
  if (GLA) {
    load_rows_transposed<128>(Vt, rowbase + C_GLV + h * 128);
    load_rows_f32<64>(ks, KS, rowbase + C_GLK + h * 64, 1.f);
    gla_logdecay2(p, layer, h, rowbase, E0, E1);
  } else {
    const float kscale = 0.08838834764831845f;
    load_rows_transposed<128>(Vt, rowbase + C_RTV + h * 128);
    load_rows_f32<128>(ks, KS, rowbase + C_RTK + h * 128, g < 4 ? kscale : 1.f);
    __syncthreads();
    if (g >= 4) rope128_tile(ks, KS, g - 4, p.rope, kscale);
  }
#pragma unroll 1
  for (int dir = 0; dir < 2; ++dir) {
    const int scan = ((b * 4 + h) * 2 + dir);
    const int pos = scan_pos(dir, g);
    float lg = 0.f;
    __syncthreads();
    float* E = dir ? E1 : E0;
    if (GLA) {
      if (tid < 64) {
        float run = 0.f;
        if (dir == 0) {
          for (int j = 63; j >= 0; --j) { float v = E[j * 68 + tid]; E[j * 68 + tid] = run; run += v; }
        } else {
          for (int j = 0; j < 64; ++j) { float v = E[j * 68 + tid]; E[j * 68 + tid] = run; run += v; }
        }
        p.dec_gla[(size_t)(scan * 132 + pos) * 64 + tid] = __expf(run);
      }
      __syncthreads();
    } else {
      lg = p.ret_lg[layer * 8 + dir * 4 + h];
      if (tid < 128) p.dec_ret[(size_t)(scan * 132 + pos) * 128 + tid] = __expf(lg * 64.f);
    }
    for (int u = tid; u < 64 * DK; u += NTHR) {
      const int j = u & 63, d = u >> 6;
      const float sc = GLA ? __expf(E[j * 68 + d]) : __expf(lg * (dir == 0 ? (float)(63 - j) : (float)j));
      Kt[d * 72 + j] = f2bf(ks[j * KS + d] * sc);
    }
    __syncthreads();
    bf16x8 vfr[2];
#pragma unroll
    for (int k2 = 0; k2 < 2; ++k2) vfr[k2] = *(const bf16x8*)(Vt + (w * 16 + fr) * 72 + k2 * 32 + q4 * 8);
    bfr* st = (GLA ? p.st_gla : p.st_ret) + (size_t)(scan * 132 + pos) * DK * 128;
#pragma unroll 2
    for (int dt = 0; dt < DK / 16; ++dt) {
      f32x4 acc = (f32x4){0.f, 0.f, 0.f, 0.f};
#pragma unroll
      for (int k2 = 0; k2 < 2; ++k2) {
        const bf16x8 kq = *(const bf16x8*)(Kt + (dt * 16 + fr) * 72 + k2 * 32 + q4 * 8);
        acc = MFMA16(kq, vfr[k2], acc);
      }
      uint2 o;
      o.x = pack2(acc[0], acc[1]); o.y = pack2(acc[2], acc[3]);
      *(uint2*)(st + (size_t)(w * 16 + fr) * DK + dt * 16 + q4 * 4) = o;
    }
  }
}

__device__ void scan_b_phase(const Params& p) {
  const int gt = get_bid() * NTHR + get_tid(), ntot = gridDim.x * NTHR;
  for (int ch = gt; ch < 98304; ch += ntot) {
    bfr* st; const float* dec; int DK, e4;
    if (ch < 65536) { int scan = ch >> 12; e4 = ch & 4095; DK = 128; st = p.st_ret + (size_t)scan * 132 * 16384; dec = p.dec_ret + (size_t)scan * 132 * 128; }
    else { int c2 = ch - 65536; int scan = c2 >> 11; e4 = c2 & 2047; DK = 64; st = p.st_gla + (size_t)scan * 132 * 8192; dec = p.dec_gla + (size_t)scan * 132 * 64; }
    const int d0 = (e4 * 4) & (DK - 1);
    const size_t cstride = (size_t)DK * 128;
    float4 s = make_float4(0.f, 0.f, 0.f, 0.f);
    bfr* ptr = st + e4 * 4;
    const float* dp = dec + d0;
    for (int pos = 0; pos < 132; pos += 4) {
      uint2 u[4];
      float4 dv[4];
#pragma unroll
      for (int q = 0; q < 4; ++q) {
        u[q] = *(const uint2*)(ptr + (size_t)(pos + q) * cstride);
        dv[q] = *(const float4*)(dp + (pos + q) * DK);
      }
#pragma unroll
      for (int q = 0; q < 4; ++q) {
        uint2 o;
        o.x = pack2(s.x, s.y); o.y = pack2(s.z, s.w);
        *(uint2*)(ptr + (size_t)(pos + q) * cstride) = o;
        s = make_float4(dv[q].x * s.x + lo16(u[q].x), dv[q].y * s.y + hi16(u[q].x), dv[q].z * s.z + lo16(u[q].y), dv[q].w * s.w + hi16(u[q].y));
      }
    }
  }
}

template <int DK, bool GLA>
__device__ void scan_c_item(const Params& p, int layer, int item, char* smem) {
  const int g = item % 132;
  const int t2 = item / 132;
  const int h = t2 & 3, b = t2 >> 2;
  constexpr int FS = DK + 4;
  constexpr int QS = DK + 8;
  float* stg = (float*)smem;
  float* Gf = stg + 64 * FS;
  float* Gb = Gf + (GLA ? 64 * 68 : 0);
  float* red = Gb + (GLA ? 64 * 68 : 0);
  float* red2 = red + 8 * 64 * 2;
  bfr* T0 = (bfr*)(red2 + 64 * 2);
  bfr* T1 = T0 + 64 * QS;
  bfr* T2 = T1 + 64 * QS;
  bfr* T3 = T2 + 64 * QS;
  bfr* T4 = T3 + 64 * QS;
  bfr* T5 = T4 + (GLA ? 64 * QS : 0);
  bfr* Vt = T5 + (GLA ? 64 * QS : 0);
  bfr* Am = Vt + 128 * 72;
  const int tid = get_tid();
  const int w = tid >> 6, lane = tid & 63, fr = lane & 15, q4 = lane >> 4;
  const int row0 = group_row0(b, g);
  const bfr* rowbase = p.proj + (size_t)row0 * DINP;
  float lgf = 0.f, lgb = 0.f;
  __syncthreads();
  if (GLA) {
    load_rows_transposed<128>(Vt, rowbase + C_GLV + h * 128);
    load_rows_f32<64>(stg, FS, rowbase + C_GLQ + h * 64, 0.125f);
    gla_logdecay2(p, layer, h, rowbase, Gf, Gb);
    __syncthreads();
    {
      const int d = tid & 63, seg = tid >> 6;
      float runf = 0.f, runb = 0.f;
#pragma unroll
      for (int jj = 0; jj < 8; ++jj) {
        const int jf = seg * 8 + jj, jb = seg * 8 + 7 - jj;
        runf += Gf[jf * 68 + d]; Gf[jf * 68 + d] = runf;
        runb += Gb[jb * 68 + d]; Gb[jb * 68 + d] = runb;
      }
      red[seg * 64 + d] = runf;
      red[512 + seg * 64 + d] = runb;
      __syncthreads();
      float offf = 0.f, offb = 0.f;
#pragma unroll
      for (int s2 = 0; s2 < 8; ++s2) {
        if (s2 < seg) offf += red[s2 * 64 + d];
        if (s2 > seg) offb += red[512 + s2 * 64 + d];
      }
#pragma unroll
      for (int jj = 0; jj < 8; ++jj) {
        const int j = seg * 8 + jj;
        Gf[j * 68 + d] += offf;
        Gb[j * 68 + d] += offb;
      }
    }
    __syncthreads();
    for (int u = tid; u < 64 * 64; u += NTHR) {
      const int i = u >> 6, d = u & 63;
      const float qv = stg[i * FS + d];
      const float gf = Gf[i * 68 + d], gb = Gb[i * 68 + d];
      T0[i * QS + d] = f2bf(qv * __expf(gf - Gf[63 * 68 + d]));
      T2[i * QS + d] = f2bf(qv * __expf(gf));
      T4[i * QS + d] = f2bf(qv * __expf(gb - Gb[d]));
      T3[i * QS + d] = f2bf(qv * __expf(gb));
    }
    __syncthreads();
    load_rows_f32<64>(stg, FS, rowbase + C_GLK + h * 64, 1.f);
    __syncthreads();
    for (int u = tid; u < 64 * 64; u += NTHR) {
      const int j = u >> 6, d = u & 63;
      const float kv = stg[j * FS + d];
      T1[j * QS + d] = f2bf(kv * __expf(Gf[63 * 68 + d] - Gf[j * 68 + d]));
      T5[j * QS + d] = f2bf(kv * __expf(Gb[d] - Gb[j * 68 + d]));
    }
  } else {
    const float kscale = 0.08838834764831845f;
    lgf = p.ret_lg[layer * 8 + 0 + h];
    lgb = p.ret_lg[layer * 8 + 4 + h];
    load_rows_transposed<128>(Vt, rowbase + C_RTV + h * 128);
    {
      const int j = tid >> 3, A = (tid >> 2) & 1, fc = tid & 3;
      float cs[8], sn[8];
      if (g >= 4) {
        const int pos = A ? j : (g - 4);
        const float* cp = p.rope + 4096 + pos * 32 + fc * 8;
        const float4 c0 = *(const float4*)cp, c1 = *(const float4*)(cp + 4);
        const float4 s0 = *(const float4*)(cp + 4096), s1 = *(const float4*)(cp + 4100);
        cs[0] = c0.x; cs[1] = c0.y; cs[2] = c0.z; cs[3] = c0.w; cs[4] = c1.x; cs[5] = c1.y; cs[6] = c1.z; cs[7] = c1.w;
        sn[0] = s0.x; sn[1] = s0.y; sn[2] = s0.z; sn[3] = s0.w; sn[4] = s1.x; sn[5] = s1.y; sn[6] = s1.z; sn[7] = s1.w;
      } else {
#pragma unroll
        for (int e = 0; e < 8; ++e) { cs[e] = 1.f; sn[e] = 0.f; }
      }
      const int col = A * 64 + fc * 8;
      const bfr* qp = rowbase + (size_t)j * DINP + C_RTQ + h * 128 + col;
      const bfr* kp = rowbase + (size_t)j * DINP + C_RTK + h * 128 + col;
      const u4 q1 = *(const u4*)qp, q2 = *(const u4*)(qp + 32);
      const u4 k1 = *(const u4*)kp, k2w = *(const u4*)(kp + 32);
      float x1[8], x2[8], y1[8], y2[8];
      unpack8(q1, x1); unpack8(q2, x2);
#pragma unroll
      for (int e = 0; e < 8; ++e) { y1[e] = x1[e] * cs[e] - x2[e] * sn[e]; y2[e] = x2[e] * cs[e] + x1[e] * sn[e]; }
      const float ff = __expf(lgf * (float)(j + 1)), fb = __expf(lgb * (float)(64 - j));
      u4 o;
      o.x = pack2(y1[0], y1[1]); o.y = pack2(y1[2], y1[3]); o.z = pack2(y1[4], y1[5]); o.w = pack2(y1[6], y1[7]);
      *(u4*)(T0 + j * QS + col) = o;
      o.x = pack2(y2[0], y2[1]); o.y = pack2(y2[2], y2[3]); o.z = pack2(y2[4], y2[5]); o.w = pack2(y2[6], y2[7]);
      *(u4*)(T0 + j * QS + col + 32) = o;
      o.x = pack2(y1[0] * ff, y1[1] * ff); o.y = pack2(y1[2] * ff, y1[3] * ff); o.z = pack2(y1[4] * ff, y1[5] * ff); o.w = pack2(y1[6] * ff, y1[7] * ff);
      *(u4*)(T2 + j * QS + col) = o;
      o.x = pack2(y2[0] * ff, y2[1] * ff); o.y = pack2(y2[2] * ff, y2[3] * ff); o.z = pack2(y2[4] * ff, y2[5] * ff); o.w = pack2(y2[6] * ff, y2[7] * ff);
      *(u4*)(T2 + j * QS + col + 32) = o;
      o.x = pack2(y1[0] * fb, y1[1] * fb); o.y = pack2(y1[2] * fb, y1[3] * fb); o.z = pack2(y1[4] * fb, y1[5] * fb); o.w = pack2(y1[6] * fb, y1[7] * fb);
      *(u4*)(T3 + j * QS + col) = o;
      o.x = pack2(y2[0] * fb, y2[1] * fb); o.y = pack2(y2[2] * fb, y2[3] * fb); o.z = pack2(y2[4] * fb, y2[5] * fb); o.w = pack2(y2[6] * fb, y2[7] * fb);
      *(u4*)(T3 + j * QS + col + 32) = o;
      unpack8(k1, x1); unpack8(k2w, x2);
#pragma unroll
      for (int e = 0; e < 8; ++e) { y1[e] = (x1[e] * cs[e] - x2[e] * sn[e]) * kscale; y2[e] = (x2[e] * cs[e] + x1[e] * sn[e]) * kscale; }
      o.x = pack2(y1[0], y1[1]); o.y = pack2(y1[2], y1[3]); o.z = pack2(y1[4], y1[5]); o.w = pack2(y1[6], y1[7]);
      *(u4*)(T1 + j * QS + col) = o;
      o.x = pack2(y2[0], y2[1]); o.y = pack2(y2[2], y2[3]); o.z = pack2(y2[4], y2[5]); o.w = pack2(y2[6], y2[7]);
      *(u4*)(T1 + j * QS + col + 32) = o;
    }
  }
  __syncthreads();
  {
    const int ti = w >> 1;
#pragma unroll
    for (int tt = 0; tt < 2; ++tt) {
      const int tj = (w & 1) * 2 + tt;
      f32x4 af = (f32x4){0.f, 0.f, 0.f, 0.f}, ab = af;
#pragma unroll
      for (int k2 = 0; k2 < DK / 32; ++k2) {
        const bf16x8 a = *(const bf16x8*)(T0 + (ti * 16 + fr) * QS + k2 * 32 + q4 * 8);
        const bf16x8 bq = *(const bf16x8*)(T1 + (tj * 16 + fr) * QS + k2 * 32 + q4 * 8);
        af = MFMA16(a, bq, af);
        if (GLA) {
          const bf16x8 a2 = *(const bf16x8*)(T4 + (ti * 16 + fr) * QS + k2 * 32 + q4 * 8);
          const bf16x8 b2 = *(const bf16x8*)(T5 + (tj * 16 + fr) * QS + k2 * 32 + q4 * 8);
          ab = MFMA16(a2, b2, ab);
        }
      }
#pragma unroll
      for (int r = 0; r < 4; ++r) {
        const int i = ti * 16 + q4 * 4 + r, j = tj * 16 + fr;
        float v;
        if (GLA) v = (j <= i) ? af[r] : ab[r];
        else v = af[r] * ((j <= i) ? __expf(lgf * (float)(i - j)) : __expf(lgb * (float)(j - i)));
        Am[i * 72 + j] = f2bf(v);
      }
    }
  }
  __syncthreads();
  f32x4 acc[4];
#pragma unroll
  for (int rt = 0; rt < 4; ++rt) acc[rt] = (f32x4){0.f, 0.f, 0.f, 0.f};
#pragma unroll
  for (int k2 = 0; k2 < 2; ++k2) {
    const bf16x8 bq = *(const bf16x8*)(Vt + (w * 16 + fr) * 72 + k2 * 32 + q4 * 8);
#pragma unroll
    for (int rt = 0; rt < 4; ++rt) {
      const bf16x8 a = *(const bf16x8*)(Am + (rt * 16 + fr) * 72 + k2 * 32 + q4 * 8);
      acc[rt] = MFMA16(a, bq, acc[rt]);
    }
  }
#pragma unroll
  for (int dir = 0; dir < 2; ++dir) {
    const int scan = (b * 4 + h) * 2 + dir;
    const int pos = scan_pos(dir, g);
    const bfr* St = (GLA ? p.st_gla : p.st_ret) + (size_t)(scan * 132 + pos) * DK * 128 + (size_t)(w * 16 + fr) * DK + q4 * 8;
    const bfr* qt = dir == 0 ? T2 : T3;
#pragma unroll
    for (int k2 = 0; k2 < DK / 32; ++k2) {
      const bf16x8 bq = *(const bf16x8*)(St + k2 * 32);
#pragma unroll
      for (int rt = 0; rt < 4; ++rt) {
        const bf16x8 a = *(const bf16x8*)(qt + (rt * 16 + fr) * QS + k2 * 32 + q4 * 8);
        acc[rt] = MFMA16(a, bq, acc[rt]);
      }
    }
  }
#pragma unroll
  for (int rt = 0; rt < 4; ++rt)
#pragma unroll
    for (int r = 0; r < 4; ++r) {
      float s1 = acc[rt][r], s2 = s1 * s1;
#pragma unroll
      for (int of = 8; of; of >>= 1) { s1 += __shfl_xor(s1, of); s2 += __shfl_xor(s2, of); }
      if (fr == 0) {
        const int i = rt * 16 + q4 * 4 + r;
        red[(w * 64 + i) * 2 + 0] = s1;
        red[(w * 64 + i) * 2 + 1] = s2;
      }
    }
  __syncthreads();
  if (tid < 128) {
    const int i = tid >> 1, c = tid & 1;
    float t = 0.f;
#pragma unroll
    for (int ww = 0; ww < 8; ++ww) t += red[(ww * 64 + i) * 2 + c];
    red2[i * 2 + c] = t;
  }
  __syncthreads();
  const int gcol = GLA ? C_GLG : C_RTG;
  const int ocol = GLA ? 1024 : 512;
  const int vcol = h * 128 + w * 16 + fr;
  const float gg = GLA ? p.gla_g[layer * 128 + w * 16 + fr] : 1.f;
#pragma unroll
  for (int rt = 0; rt < 4; ++rt)
#pragma unroll
    for (int r = 0; r < 4; ++r) {
      const int i = rt * 16 + q4 * 4 + r;
      const float S1 = red2[i * 2 + 0], S2 = red2[i * 2 + 1];
      float y;
      if (GLA) {
        y = acc[rt][r] * rsqrtf(S2 * (1.f / 128.f) + EPS) * gg;
      } else {
        const float mu = S1 * (1.f / 128.f);
        const float var = fmaxf(S2 * (1.f / 128.f) - mu * mu, 0.f);
        y = (acc[rt][r] - mu) * rsqrtf(var + EPS);
      }
      const int row = row0 + i;
      const float gt = bf2f(p.proj[(size_t)row * DINP + gcol + vcol]);
      y *= silu_f(gt);
      p.mix[(size_t)row * D + ocol + vcol] = f2bf(y);
    }
}

__constant__ unsigned char c_cand_tab[64] = {0, 1, 2, 3, 4, 5, 6, 7, 8, 9, 10, 11, 12, 13, 14, 15, 16, 17, 18, 19, 20, 21, 22, 23, 32, 33, 34, 35, 36, 48, 49, 50, 51, 64, 65, 66, 80, 81, 96, 97, 112, 113, 128, 144, 160, 176, 192, 208, 224, 240, 255, 255, 255, 255, 255, 255, 255, 255, 255, 255, 255, 255, 255, 255};

template <int N>
__device__ __forceinline__ void bitonic_sort_desc(float (&v)[N]) {
#pragma unroll
  for (int k = 2; k <= N; k <<= 1)
#pragma unroll
    for (int j = k >> 1; j > 0; j >>= 1)
#pragma unroll
      for (int i = 0; i < N; ++i) {
        const int l = i ^ j;
        if (l > i) {
          const bool desc = ((i & k) == 0);
          const float x = v[i], y = v[l];
          const float hi = fmaxf(x, y), lo = fminf(x, y);
          v[i] = desc ? hi : lo;
          v[l] = desc ? lo : hi;
        }
      }
}
__device__ __forceinline__ void merge_top16(float (&v)[16], const int xl) {
  float o[16];
#pragma unroll
  for (int i = 0; i < 16; ++i) o[i] = __shfl_xor(v[15 - i], xl);
#pragma unroll
  for (int i = 0; i < 16; ++i) v[i] = fmaxf(v[i], o[i]);
#pragma unroll
  for (int j = 8; j > 0; j >>= 1)
#pragma unroll
    for (int i = 0; i < 16; ++i) {
      const int l = i ^ j;
      if (l > i) {
        const float x = v[i], y = v[l];
        v[i] = fmaxf(x, y);
        v[l] = fminf(x, y);
      }
    }
}
__device__ __forceinline__ float pack_key(float x, unsigned mask, unsigned key) {
  return __uint_as_float((__float_as_uint(x) & ~mask) | key);
}

__device__ void topk_phase(const Params& p, int layer, int ntok, char* smem) {
  float* sc = (float*)smem;
  const int tid = get_tid();
  const int lane = tid & 63, w = tid >> 6, fr = lane & 15, q4 = lane >> 4;
  const int nbatch = ntok >> 4;
  for (int bt = get_bid(); bt < nbatch; bt += gridDim.x) {
    __syncthreads();
#pragma unroll 1
    for (int pp = 0; pp < 2; ++pp) {
      const int pair = 2 * w + pp;
      const bfr* qrow = p.q + (size_t)(bt * 16 + fr) * D + pair * 128 + q4 * 8;
      const bfr* skb = p.sk_bf + (size_t)(((layer * 2 + (pair & 1)) * 8 + (pair >> 1))) * 128 * 128 + q4 * 8;
      bf16x8 af[4];
#pragma unroll
      for (int k2 = 0; k2 < 4; ++k2) af[k2] = *(const bf16x8*)(qrow + k2 * 32);
#pragma unroll 4
      for (int nt = 0; nt < 8; ++nt) {
        f32x4 acc = (f32x4){0.f, 0.f, 0.f, 0.f};
#pragma unroll
        for (int k2 = 0; k2 < 4; ++k2) {
          const bf16x8 bq = *(const bf16x8*)(skb + (size_t)(nt * 16 + fr) * 128 + k2 * 32);
          acc = MFMA16(af[k2], bq, acc);
        }
#pragma unroll
        for (int r = 0; r < 4; ++r) sc[((q4 * 4 + r) * 16 + pair) * 132 + nt * 16 + fr] = acc[r];
      }
    }
    __syncthreads();
#pragma unroll 1
    for (int ps = 0; ps < 2; ++ps) {
      const int list = ps * 128 + (tid >> 2), qd = tid & 3;
      float v[32];
#pragma unroll
      for (int j = 0; j < 8; ++j) {
        float4 t = *(const float4*)(sc + list * 132 + qd * 32 + j * 4);
        const unsigned kb = qd * 32 + j * 4;
        v[j * 4 + 0] = pack_key(t.x, 127u, kb + 0); v[j * 4 + 1] = pack_key(t.y, 127u, kb + 1);
        v[j * 4 + 2] = pack_key(t.z, 127u, kb + 2); v[j * 4 + 3] = pack_key(t.w, 127u, kb + 3);
      }
      bitonic_sort_desc<32>(v);
      float wv[16];
#pragma unroll
      for (int i = 0; i < 16; ++i) wv[i] = v[i];
      merge_top16(wv, 1);
      merge_top16(wv, 2);
      if (qd == 0) {
#pragma unroll
        for (int j = 0; j < 4; ++j)
          *(float4*)(sc + list * 132 + j * 4) = make_float4(wv[j * 4 + 0], wv[j * 4 + 1], wv[j * 4 + 2], wv[j * 4 + 3]);
      }
    }
    __syncthreads();
    {
      const int pair = tid >> 2, qd = tid & 3;
      const int tok = pair >> 3, hh = pair & 7;
      const float* o0 = sc + (tok * 16 + hh * 2) * 132;
      const float* o1 = o0 + 132;
      float c[16];
#pragma unroll
      for (int i = 0; i < 16; ++i) {
        const unsigned code = c_cand_tab[qd * 16 + i];
        const float sum = o0[code >> 4] + o1[code & 15];
        c[i] = (code == 255u) ? -INFINITY : pack_key(sum, 255u, code);
      }
      bitonic_sort_desc<16>(c);
      merge_top16(c, 1);
      merge_top16(c, 2);
      float e[16];
      float esum = 0.f;
#pragma unroll
      for (int i = 0; i < 16; ++i) { e[i] = __expf(c[i] - c[0]); esum += e[i]; }
      const float inv = 1.f / esum;
      const int m = bt * 16 + tok;
#pragma unroll
      for (int j = 0; j < 4; ++j) {
        const float ev = qd == 0 ? e[j] : (qd == 1 ? e[4 + j] : (qd == 2 ? e[8 + j] : e[12 + j]));
        const float cv = qd == 0 ? c[j] : (qd == 1 ? c[4 + j] : (qd == 2 ? c[8 + j] : c[12 + j]));
        const unsigned code = __float_as_uint(cv) & 255u;
        const unsigned k0 = __float_as_uint(o0[code >> 4]) & 127u;
        const unsigned k1 = __float_as_uint(o1[code & 15]) & 127u;
        p.pidx[(size_t)m * 128 + hh * 16 + qd * 4 + j] = (int)(k0 * 128u + k1);
        p.pgate[(size_t)m * 128 + hh * 16 + qd * 4 + j] = ev * inv;
      }
    }
  }
}

typedef __attribute__((ext_vector_type(2))) float f32x2;
__device__ __forceinline__ float dot16_fp8(const float* hf, const u4 w) {
  f32x2 a0 = __builtin_amdgcn_cvt_pk_f32_fp8((int)w.x, false), a1 = __builtin_amdgcn_cvt_pk_f32_fp8((int)w.x, true);
  f32x2 b0 = __builtin_amdgcn_cvt_pk_f32_fp8((int)w.y, false), b1 = __builtin_amdgcn_cvt_pk_f32_fp8((int)w.y, true);
  f32x2 c0 = __builtin_amdgcn_cvt_pk_f32_fp8((int)w.z, false), c1 = __builtin_amdgcn_cvt_pk_f32_fp8((int)w.z, true);
  f32x2 d0 = __builtin_amdgcn_cvt_pk_f32_fp8((int)w.w, false), d1 = __builtin_amdgcn_cvt_pk_f32_fp8((int)w.w, true);
  return hf[0] * a0.x + hf[1] * a0.y + hf[2] * a1.x + hf[3] * a1.y + hf[4] * b0.x + hf[5] * b0.y + hf[6] * b1.x + hf[7] * b1.y +
         hf[8] * c0.x + hf[9] * c0.y + hf[10] * c1.x + hf[11] * c1.y + hf[12] * d0.x + hf[13] * d0.y + hf[14] * d1.x + hf[15] * d1.y;
}
__device__ __forceinline__ void fma16_fp8(float* o, float c, const u4 w) {
  f32x2 a0 = __builtin_amdgcn_cvt_pk_f32_fp8((int)w.x, false), a1 = __builtin_amdgcn_cvt_pk_f32_fp8((int)w.x, true);
  f32x2 b0 = __builtin_amdgcn_cvt_pk_f32_fp8((int)w.y, false), b1 = __builtin_amdgcn_cvt_pk_f32_fp8((int)w.y, true);
  f32x2 c0 = __builtin_amdgcn_cvt_pk_f32_fp8((int)w.z, false), c1 = __builtin_amdgcn_cvt_pk_f32_fp8((int)w.z, true);
  f32x2 d0 = __builtin_amdgcn_cvt_pk_f32_fp8((int)w.w, false), d1 = __builtin_amdgcn_cvt_pk_f32_fp8((int)w.w, true);
  o[0] += c * a0.x; o[1] += c * a0.y; o[2] += c * a1.x; o[3] += c * a1.y;
  o[4] += c * b0.x; o[5] += c * b0.y; o[6] += c * b1.x; o[7] += c * b1.y;
  o[8] += c * c0.x; o[9] += c * c0.y; o[10] += c * c1.x; o[11] += c * c1.y;
  o[12] += c * d0.x; o[13] += c * d0.y; o[14] += c * d1.x; o[15] += c * d1.y;
}

__device__ void peer_phase(const Params& p, int layer, int ntok) {
  const int lane = get_tid() & 63;
  const int wave = get_bid() * 8 + (get_tid() >> 6), nw = gridDim.x * 8;
  const unsigned char* U = p.u8 + (size_t)layer * 16384 * D;
  const unsigned char* V = p.v8 + (size_t)layer * 16384 * D;
  const float* usc = p.uscl + layer * 16384;
  const float* vsc = p.vscl + layer * 16384;
  for (int m = wave; m < ntok; m += nw) {
    float hf[32];
    const bfr* hr = p.h + (size_t)m * D + lane * 16;
#pragma unroll
    for (int i = 0; i < 2; ++i) {
      u4 w0 = *(const u4*)(hr + i * 1024), w1 = *(const u4*)(hr + i * 1024 + 8);
      unpack8(w0, hf + i * 16);
      unpack8(w1, hf + i * 16 + 8);
    }
    const int idA = p.pidx[(size_t)m * 128 + lane], idB = p.pidx[(size_t)m * 128 + 64 + lane];
    const float gA = p.pgate[(size_t)m * 128 + lane] * vsc[idA], gB = p.pgate[(size_t)m * 128 + 64 + lane] * vsc[idB];
    const float usA = usc[idA], usB = usc[idB];
    float cA = 0.f, cB = 0.f;
#pragma unroll 1
    for (int e0 = 0; e0 < 128; e0 += 8) {
      u4 r[8][2];
#pragma unroll
      for (int u = 0; u < 8; ++u) {
        int e = e0 + u;
        int row = __shfl(e0 < 64 ? idA : idB, e & 63);
        const unsigned char* up = U + (size_t)row * D + lane * 16;
        r[u][0] = *(const u4*)(up);
        r[u][1] = *(const u4*)(up + 1024);
      }
      __builtin_amdgcn_sched_barrier(0);
#pragma unroll
      for (int u = 0; u < 8; ++u) {
        int e = e0 + u;
        float dsum = dot16_fp8(hf, r[u][0]) + dot16_fp8(hf + 16, r[u][1]);
        dsum = wave_sum(dsum);
        if (e0 < 64) { if (lane == e) cA = gA * gelu_f(dsum * usA); }
        else { if (lane == e - 64) cB = gB * gelu_f(dsum * usB); }
        __builtin_amdgcn_sched_barrier(0);
      }
    }
    float o[32];
#pragma unroll
    for (int i = 0; i < 32; ++i) o[i] = 0.f;
#pragma unroll 1
    for (int e0 = 0; e0 < 128; e0 += 4) {
      u4 r[4][2];
      float cf[4];
#pragma unroll
      for (int u = 0; u < 4; ++u) {
        int e = e0 + u;
        int row = __shfl(e0 < 64 ? idA : idB, e & 63);
        cf[u] = __shfl(e0 < 64 ? cA : cB, e & 63);
        const unsigned char* vp = V + (size_t)row * D + lane * 16;
        r[u][0] = *(const u4*)(vp);
        r[u][1] = *(const u4*)(vp + 1024);
      }
      __builtin_amdgcn_sched_barrier(0);
#pragma unroll
      for (int u = 0; u < 4; ++u) {
        fma16_fp8(o, cf[u], r[u][0]);
        fma16_fp8(o + 16, cf[u], r[u][1]);
        __builtin_amdgcn_sched_barrier(0);
      }
    }
    const int vec = m < S ? 0 : (m < MX ? 1 : 2);
    const float* modl = p.mod + (layer * 3 + vec) * 12288;
    float* xr = p.xcur + (size_t)m * D + lane * 16;
    float xn[32];
    float ss = 0.f;
#pragma unroll
    for (int i = 0; i < 2; ++i)
#pragma unroll
      for (int k = 0; k < 4; ++k) {
        int col = i * 1024 + lane * 16 + k * 4;
        float4 a = *(const float4*)(xr + i * 1024 + k * 4);
        float4 g0 = *(const float4*)(modl + 5 * D + col);
        float* xx = xn + i * 16 + k * 4;
        const float* oo = o + i * 16 + k * 4;
        xx[0] = a.x + g0.x * oo[0]; xx[1] = a.y + g0.y * oo[1]; xx[2] = a.z + g0.z * oo[2]; xx[3] = a.w + g0.w * oo[3];
        ss += xx[0] * xx[0] + xx[1] * xx[1] + xx[2] * xx[2] + xx[3] * xx[3];
      }
    ss = wave_sum(ss);
    const float rstd = rsqrtf(ss * (1.f / D) + EPS);
    if (layer == 1) {
      float* orow = p.out + (size_t)m * D;
#pragma unroll
      for (int i = 0; i < 2; ++i)
#pragma unroll
        for (int k = 0; k < 4; ++k) {
          int col = i * 1024 + lane * 16 + k * 4;
          float4 f0 = *(const float4*)(p.final_g + col);
          const float* xx = xn + i * 16 + k * 4;
          *(float4*)(orow + col) = make_float4(xx[0] * rstd * f0.x, xx[1] * rstd * f0.y, xx[2] * rstd * f0.z, xx[3] * rstd * f0.w);
        }
    } else {
      const float* modn = p.mod + ((layer + 1) * 3 + vec) * 12288;
      const float* gn = p.g_attn + (layer + 1) * D;
#pragma unroll
      for (int i = 0; i < 2; ++i) {
        float y[16];
#pragma unroll
        for (int k = 0; k < 4; ++k) {
          int col = i * 1024 + lane * 16 + k * 4;
          const float* xx = xn + i * 16 + k * 4;
          *(float4*)(xr + i * 1024 + k * 4) = make_float4(xx[0], xx[1], xx[2], xx[3]);
          float4 gv = *(const float4*)(gn + col), scv = *(const float4*)(modn + D + col), shv = *(const float4*)(modn + col);
          y[k * 4 + 0] = xx[0] * rstd * gv.x * (1.f + scv.x) + shv.x;
          y[k * 4 + 1] = xx[1] * rstd * gv.y * (1.f + scv.y) + shv.y;
          y[k * 4 + 2] = xx[2] * rstd * gv.z * (1.f + scv.z) + shv.z;
          y[k * 4 + 3] = xx[3] * rstd * gv.w * (1.f + scv.w) + shv.w;
        }
        u4 w0, w1;
        w0.x = pack2(y[0], y[1]); w0.y = pack2(y[2], y[3]); w0.z = pack2(y[4], y[5]); w0.w = pack2(y[6], y[7]);
        w1.x = pack2(y[8], y[9]); w1.y = pack2(y[10], y[11]); w1.z = pack2(y[12], y[13]); w1.w = pack2(y[14], y[15]);
        *(u4*)(p.h + (size_t)m * D + i * 1024 + lane * 16) = w0;
        *(u4*)(p.h + (size_t)m * D + i * 1024 + lane * 16 + 8) = w1;
      }
    }
  }
}

constexpr int PH_INIT = 0, PH_MOD_ATTN = 1, PH_INPROJ = 2, PH_MIX1 = 3, PH_SCANB = 4, PH_SCANC = 5, PH_OUTPROJ = 6,
              PH_MOD_FFN = 7, PH_QPROJ = 8, PH_SCORES = 9, PH_TOPK = 10, PH_PEER = 11;

template <int EPI, bool ALLOW_BIG>
__device__ __forceinline__ void gemm_phase(const Params& p, int layer, int vid, const bfr* A, const bfr* Bt, int MB, int MT,
                                           int NB, int N128, int small_nt, void* Cout, int ldc, char* smem) {
  const int nbig = MB * NB;
  const int nsm1 = small_nt >= 0 ? MB : 0;
  const int nsm2 = (MT - MB) * N128;
  const int total = nbig + nsm1 + nsm2;
  for (int t = vid; t < total; t += gridDim.x) {
    if (t < nbig) {
      if constexpr (ALLOW_BIG) {
        const int mt = t / NB, nt = t - mt * NB;
        gemm_tile<EPI, true>(A, D, Bt, D, D, mt * 256, nt * 256, Cout, ldc, p, layer, smem);
      }
    } else if (t < nbig + nsm1) {
      gemm_tile<EPI, false>(A, D, Bt, D, D, (t - nbig) * 256, small_nt * 128, Cout, ldc, p, layer, smem);
    } else {
      const int u = t - nbig - nsm1;
      const int mt = MB + u / N128, nt = u % N128;
      gemm_tile<EPI, false>(A, D, Bt, D, D, mt * 256, nt * 128, Cout, ldc, p, layer, smem);
    }
  }
}

__device__ void run_phase(const Params& p, int ph, int layer, char* smem, int vid) {
  const int bid = get_bid(), nb = gridDim.x;
  const bool last = (layer == 1);
  switch (ph) {
    case PH_INIT: phase0(p, smem); break;
    case PH_MOD_ATTN: modulate_phase(p, layer, 0, MT); break;
    case PH_INPROJ:
      gemm_phase<0, true>(p, layer, vid, p.h, p.wt_in + (size_t)layer * DINP * D, 66, 66, 23, 47, 46, p.proj, DINP, smem);
      break;
    case PH_MIX1: {
      const int n_swa = 256, n_na = 2048, n_sa = 1056, n_ctx = last ? 0 : 32;
      const int total = n_swa + n_na + 2 * n_sa + n_ctx;
      for (int it = bid; it < total; it += nb) {
        int t = it;
        if (t < n_swa) { swa_item(p, layer, t, smem); continue; }
        t -= n_swa;
        if (t < n_na) { na_item(p, layer, t, smem); continue; }
        t -= n_na;
        if (t < n_sa) { scan_a_item<128, false>(p, layer, t, smem); continue; }
        t -= n_sa;
        if (t < n_sa) { scan_a_item<64, true>(p, layer, t, smem); continue; }
        t -= n_sa;
        ctx_item(p, layer, t, smem);
      }
    } break;
    case PH_SCANB: scan_b_phase(p); break;
    case PH_SCANC:
      for (int it = bid; it < 2 * 1056; it += nb) {
        const bool gla = it < 1056;
        const int t = gla ? it : it - 1056;
        if (last && (t % 132) < 4) continue;
        if (gla) scan_c_item<64, true>(p, layer, t, smem);
        else scan_c_item<128, false>(p, layer, t, smem);
      }
      break;
    case PH_OUTPROJ: {
      gemm_phase<1, false>(p, layer, vid, p.mix, p.wt_out + (size_t)layer * D * D, 0, last ? 64 : 66, 8, 16, -1, nullptr, 0, smem);
    } break;
    case PH_MOD_FFN: modulate_phase(p, layer, 1, last ? MX : MT); break;
    case PH_QPROJ: {
      gemm_phase<0, true>(p, layer, vid, p.h, p.wt_q + (size_t)layer * D * D, 64, last ? 64 : 66, 8, 16, -1, p.q, D, smem);
    } break;
    case PH_SCORES: {
      const int mt = last ? 64 : 66;
      for (int t = bid; t < mt * 16; t += nb) {
        int j = t & 15;
        int hh = j >> 1, pp = j & 1;
        const bfr* bt = p.sk_bf + (size_t)(((layer * 2 + pp) * 8 + hh)) * 128 * 128;
        gemm_tile<2, false>(p.q + j * 128, D, bt, 128, 128, (t >> 4) * 256, 0, p.scores + j * 128, D, p, layer, smem);
      }
    } break;
    case PH_TOPK: topk_phase(p, layer, last ? MX : MT, smem); break;
    case PH_PEER: peer_phase(p, layer, last ? MX : MT); break;
  }
}

__device__ __forceinline__ void grid_barrier(unsigned* bar, unsigned& epoch) {
  asm volatile("s_waitcnt vmcnt(0)" ::: "memory");
  __syncthreads();
  epoch += gridDim.x;
  if (threadIdx.x == 0) {
    __builtin_amdgcn_fence(__ATOMIC_RELEASE, "agent");
    asm volatile("s_waitcnt vmcnt(0)" ::: "memory");
    (void)__hip_atomic_fetch_add(bar, 1u, __ATOMIC_RELAXED, __HIP_MEMORY_SCOPE_AGENT);
    unsigned spins = 0;
    while (__hip_atomic_load(bar, __ATOMIC_RELAXED, __HIP_MEMORY_SCOPE_AGENT) < epoch) {
      __builtin_amdgcn_s_sleep(1);
      if (++spins > (1u << 24)) break;
    }
    __builtin_amdgcn_fence(__ATOMIC_ACQUIRE, "agent");
    asm volatile("s_waitcnt vmcnt(0)" ::: "memory");
  }
  __syncthreads();
}

#if MULTI_LAUNCH
__global__ void __launch_bounds__(NTHR) phase_kernel(Params p, int ph, int layer) {
  extern __shared__ __attribute__((aligned(16))) char smem[];
  run_phase(p, ph, layer, smem, blockIdx.x);
}
#else
__global__ void __launch_bounds__(NTHR) mega_kernel(Params p) {
  extern __shared__ __attribute__((aligned(16))) char smem[];
  cg::grid_group grid = cg::this_grid();
  const unsigned xcd = (unsigned)__builtin_amdgcn_s_getreg((3 << 11) | 20) & 7u;
  run_phase(p, PH_INIT, 0, smem, 0);
  __syncthreads();
  if (threadIdx.x == 0) ((volatile unsigned*)smem)[0] = atomicAdd(&p.bar[16 + xcd], 1u);
  grid.sync();
  int vid = (int)((volatile unsigned*)smem)[0];
  for (unsigned x = 0; x < xcd; ++x) vid += (int)__hip_atomic_load(&p.bar[16 + x], __ATOMIC_RELAXED, __HIP_MEMORY_SCOPE_AGENT);
  vid = __builtin_amdgcn_readfirstlane(vid);
  __syncthreads();
  unsigned epoch = 0;
  for (int layer = 0; layer < 2; ++layer) {
    for (int ph = (layer == 0 ? PH_MOD_ATTN : PH_INPROJ); ph <= PH_PEER; ++ph) {
      if (ph == PH_SCORES) continue;
      run_phase(p, ph, layer, smem, vid);
      if (!(layer == 1 && ph == PH_PEER)) grid_barrier(p.bar, epoch);
    }
  }
}
#endif

static inline size_t align_up(size_t v) { return (v + 255) & ~(size_t)255; }

extern "C" void kernel_launch(void* const* d_in, const int* in_sizes, int n_in, void* d_out, int out_size, void* d_ws,
                              size_t ws_size, hipStream_t stream) {
  Params p{};
  p.x = (const float*)d_in[0]; p.c = (const float*)d_in[1]; p.ctx = (const float*)d_in[2]; p.c_ctx = (const float*)d_in[3];
  p.w_ada = (const float*)d_in[4]; p.b_ada = (const float*)d_in[5]; p.g_attn = (const float*)d_in[6]; p.g_ffn = (const float*)d_in[7];
  p.w_in = (const float*)d_in[8]; p.rpb = (const float*)d_in[9]; p.ret_lg = (const float*)d_in[10]; p.gla_wu = (const float*)d_in[11];
  p.gla_b = (const float*)d_in[12]; p.gla_g = (const float*)d_in[13]; p.sink = (const float*)d_in[14]; p.w_out = (const float*)d_in[15];
  p.w_q = (const float*)d_in[16]; p.sub_keys = (const float*)d_in[17]; p.pu = (const float*)d_in[18]; p.pv = (const float*)d_in[19];
  p.final_g = (const float*)d_in[20];
  p.out = (float*)d_out;
  char* ws = (char*)d_ws;
  size_t off = 0;
  auto take = [&](size_t bytes) { char* r = ws + off; off = align_up(off + bytes); return r; };
  p.mod = (float*)take((size_t)2 * 3 * 12288 * 4);
  p.bar = (unsigned*)take(256);
  p.rope = (float*)take((size_t)16384 * 4);
  p.wt_in = (bfr*)take((size_t)2 * DINP * D * 2);
  p.wt_out = (bfr*)take((size_t)2 * D * D * 2);
  p.wt_q = (bfr*)take((size_t)2 * D * D * 2);
  p.sk_bf = (bfr*)take((size_t)524288 * 2);
  p.u8 = (unsigned char*)take((size_t)2 * 16384 * D);
  p.v8 = (unsigned char*)take((size_t)2 * 16384 * D);
  p.uscl = (float*)take((size_t)2 * 16384 * 4);
  p.vscl = (float*)take((size_t)2 * 16384 * 4);
  p.xcur = (float*)take((size_t)MT * D * 4);
  p.h = (bfr*)take((size_t)MT * D * 2);
  p.proj = (bfr*)take((size_t)MT * DINP * 2);
  p.mix = (bfr*)take((size_t)MT * D * 2);
  p.st_ret = (bfr*)take((size_t)16 * 132 * 16384 * 4);
  p.dec_ret = (float*)take((size_t)16 * 132 * 128 * 4);
  p.dec_gla = (float*)take((size_t)16 * 132 * 64 * 4);
  p.pidx = (int*)take((size_t)MT * 128 * 4);
  p.pgate = (float*)take((size_t)MT * 128 * 4);
  p.st_gla = (bfr*)p.h;
  p.q = p.proj;
  p.scores = (float*)p.st_ret;
  if (off > ws_size) { fprintf(stderr, "workspace too small: need %zu have %zu\n", off, ws_size); return; }

  hipMemsetAsync(p.mod, 0, (size_t)2 * 3 * 12288 * 4 + 256, stream);
#if MULTI_LAUNCH
  hipFuncSetAttribute((const void*)phase_kernel, hipFuncAttributeMaxDynamicSharedMemorySize, SMEM_BYTES);
  const int grid = 256;
  hipLaunchKernelGGL(phase_kernel, dim3(grid), dim3(NTHR), SMEM_BYTES, stream, p, PH_INIT, 0);
  for (int layer = 0; layer < 2; ++layer)
    for (int ph = (layer == 0 ? PH_MOD_ATTN : PH_INPROJ); ph <= PH_PEER; ++ph)
      hipLaunchKernelGGL(phase_kernel, dim3(grid), dim3(NTHR), SMEM_BYTES, stream, p, ph, layer);
#else
  static int grid_blocks = 0;
  if (!grid_blocks) {
    hipFuncSetAttribute((const void*)mega_kernel, hipFuncAttributeMaxDynamicSharedMemorySize, SMEM_BYTES);
    int dev = 0, cus = 0, per_cu = 0;
    hipGetDevice(&dev);
    hipDeviceGetAttribute(&cus, hipDeviceAttributeMultiprocessorCount, dev);
    hipOccupancyMaxActiveBlocksPerMultiprocessor(&per_cu, mega_kernel, NTHR, SMEM_BYTES);
    if (per_cu < 1) per_cu = 1;
    grid_blocks = cus * per_cu;
    if (grid_blocks > 256) grid_blocks = 256;
  }
  void* args[] = {&p};
  hipError_t e = hipLaunchCooperativeKernel((void*)mega_kernel, dim3(grid_blocks), dim3(NTHR), args, SMEM_BYTES, stream);
  if (e != hipSuccess) fprintf(stderr, "cooperative launch failed: %s (grid %d)\n", hipGetErrorString(e), grid_blocks);
#endif
}
```

```cpp
#include <hip/hip_runtime.h>
#include <hip/hip_cooperative_groups.h>
#include <cstdio>
namespace cg = cooperative_groups;

#ifndef MULTI_LAUNCH
#define MULTI_LAUNCH 0
#endif

typedef unsigned short bfr;
typedef __attribute__((ext_vector_type(8))) short bf16x8;
typedef __attribute__((ext_vector_type(4))) float f32x4;
typedef __attribute__((ext_vector_type(4))) unsigned int u4;

constexpr int D = 2048;
constexpr int S = 8192;
constexpr int MX = 16384;
constexpr int MT = 16896;
constexpr int DIN = 5920;
constexpr int DINP = 6016;
constexpr int NTHR = 512;
constexpr float EPS = 1e-6f;
constexpr int SMEM_BYTES = 149504;

constexpr int C_NAQ = 0, C_NAK = 512, C_NAV = 1024;
constexpr int C_RTQ = 1536, C_RTK = 2048, C_RTV = 2560, C_RTG = 3072;
constexpr int C_GLQ = 3584, C_GLK = 3840, C_GLV = 4096, C_GLG = 4608, C_GLD = 5120;
constexpr int C_SWQ = 5152, C_SWK = 5664, C_SWV = 5792;

struct Params {
  const float *x, *c, *ctx, *c_ctx, *w_ada, *b_ada, *g_attn, *g_ffn, *w_in, *rpb, *ret_lg, *gla_wu, *gla_b,
      *gla_g, *sink, *w_out, *w_q, *sub_keys, *pu, *pv, *final_g;
  float* out;
  bfr *wt_in, *wt_out, *wt_q, *sk_bf;
  unsigned char *u8, *v8;
  float *uscl, *vscl;
  float *mod, *rope, *xcur;
  bfr *h, *proj, *mix;
  bfr *st_ret, *st_gla;
  float *dec_ret, *dec_gla;
  bfr* q;
  float* scores;
  int* pidx;
  float* pgate;
  unsigned* bar;
};

__device__ __forceinline__ int get_tid() { int t = threadIdx.x; asm volatile("" : "+v"(t)); return t; }
__device__ __forceinline__ int get_bid() { int t = blockIdx.x; asm volatile("" : "+s"(t)); return t; }
__device__ __forceinline__ float bf2f(bfr u) { return __uint_as_float(((unsigned)u) << 16); }
typedef __bf16 hwbf16x2 __attribute__((ext_vector_type(2)));
typedef float hwf32x2 __attribute__((ext_vector_type(2)));
__device__ __forceinline__ unsigned pack2(float a, float b) {
  hwf32x2 v = {a, b};
  hwbf16x2 r = __builtin_convertvector(v, hwbf16x2);
  return __builtin_bit_cast(unsigned, r);
}
__device__ __forceinline__ bfr f2bf(float f) { return (bfr)(pack2(f, 0.f) & 0xffffu); }
__device__ __forceinline__ float lo16(unsigned w) { return __uint_as_float(w << 16); }
__device__ __forceinline__ float hi16(unsigned w) { return __uint_as_float(w & 0xffff0000u); }
__device__ __forceinline__ float wave_sum(float v) {
#pragma unroll
  for (int o = 32; o; o >>= 1) v += __shfl_xor(v, o);
  return v;
}
__device__ __forceinline__ float wave_max(float v) {
#pragma unroll
  for (int o = 32; o; o >>= 1) v = fmaxf(v, __shfl_xor(v, o));
  return v;
}
__device__ __forceinline__ float silu_f(float x) { return x / (1.f + __expf(-x)); }
__device__ __forceinline__ float gelu_f(float x) { return 0.5f * x * (1.f + erff(x * 0.70710678118654752f)); }
__device__ __forceinline__ float logsig_f(float x) { return fminf(x, 0.f) - log1pf(__expf(-fabsf(x))); }
__device__ __forceinline__ void unpack8(const u4 w, float* f) {
  f[0] = lo16(w.x); f[1] = hi16(w.x); f[2] = lo16(w.y); f[3] = hi16(w.y);
  f[4] = lo16(w.z); f[5] = hi16(w.z); f[6] = lo16(w.w); f[7] = hi16(w.w);
}

__device__ void transpose_cvt(const float* __restrict__ W, int K, int N, int Npad, bfr* __restrict__ Wt, int item,
                              float* tile) {
  const int nkt = K >> 6;
  const int kt = item % nkt, nt = item / nkt;
  const int tid = get_tid();
  __syncthreads();
#pragma unroll
  for (int i = 0; i < 2; ++i) {
    int kk = (tid >> 4) + 32 * i, nn = (tid & 15) * 4;
    int n = nt * 64 + nn;
    float4 v = make_float4(0.f, 0.f, 0.f, 0.f);
    if (n < N) v = *(const float4*)(W + (size_t)(kt * 64 + kk) * N + n);
    tile[kk * 65 + nn + 0] = v.x; tile[kk * 65 + nn + 1] = v.y; tile[kk * 65 + nn + 2] = v.z; tile[kk * 65 + nn + 3] = v.w;
  }
  __syncthreads();
  {
    int nl = tid >> 3, kc = (tid & 7) * 8;
    u4 o;
    o.x = pack2(tile[(kc + 0) * 65 + nl], tile[(kc + 1) * 65 + nl]);
    o.y = pack2(tile[(kc + 2) * 65 + nl], tile[(kc + 3) * 65 + nl]);
    o.z = pack2(tile[(kc + 4) * 65 + nl], tile[(kc + 5) * 65 + nl]);
    o.w = pack2(tile[(kc + 6) * 65 + nl], tile[(kc + 7) * 65 + nl]);
    *(u4*)(Wt + (size_t)(nt * 64 + nl) * K + kt * 64 + kc) = o;
  }
}

__device__ void cvt_linear(const float* __restrict__ src, bfr* __restrict__ dst, size_t n8) {
  for (size_t i = (size_t)get_bid() * NTHR + get_tid(); i < n8; i += (size_t)gridDim.x * NTHR) {
    float4 a = *(const float4*)(src + i * 8), b = *(const float4*)(src + i * 8 + 4);
    u4 o;
    o.x = pack2(a.x, a.y); o.y = pack2(a.z, a.w); o.z = pack2(b.x, b.y); o.w = pack2(b.z, b.w);
    *(u4*)(dst + i * 8) = o;
  }
}

__device__ void cvt_fp8_rows(const float* __restrict__ src, unsigned char* __restrict__ dst, float* __restrict__ scl, int nrows) {
  const int lane = get_tid() & 63;
  const int wave = get_bid() * 8 + (get_tid() >> 6), nw = gridDim.x * 8;
  for (int row = wave; row < nrows; row += nw) {
    const float* sp = src + (size_t)row * D + lane * 16;
    float4 v[8];
    float amax = 0.f;
#pragma unroll
    for (int i = 0; i < 2; ++i)
#pragma unroll
      for (int k = 0; k < 4; ++k) {
        float4 t = *(const float4*)(sp + i * 1024 + k * 4);
        v[i * 4 + k] = t;
        amax = fmaxf(amax, fmaxf(fmaxf(fabsf(t.x), fabsf(t.y)), fmaxf(fabsf(t.z), fabsf(t.w))));
      }
    amax = wave_max(amax);
    const float sc = amax > 0.f ? 256.f / amax : 1.f;
#pragma unroll
    for (int i = 0; i < 2; ++i) {
      u4 o;
      int w;
      w = __builtin_amdgcn_cvt_pk_fp8_f32(v[i * 4 + 0].x * sc, v[i * 4 + 0].y * sc, 0, false);
      w = __builtin_amdgcn_cvt_pk_fp8_f32(v[i * 4 + 0].z * sc, v[i * 4 + 0].w * sc, w, true); o.x = (unsigned)w;
      w = __builtin_amdgcn_cvt_pk_fp8_f32(v[i * 4 + 1].x * sc, v[i * 4 + 1].y * sc, 0, false);
      w = __builtin_amdgcn_cvt_pk_fp8_f32(v[i * 4 + 1].z * sc, v[i * 4 + 1].w * sc, w, true); o.y = (unsigned)w;
      w = __builtin_amdgcn_cvt_pk_fp8_f32(v[i * 4 + 2].x * sc, v[i * 4 + 2].y * sc, 0, false);
      w = __builtin_amdgcn_cvt_pk_fp8_f32(v[i * 4 + 2].z * sc, v[i * 4 + 2].w * sc, w, true); o.z = (unsigned)w;
      w = __builtin_amdgcn_cvt_pk_fp8_f32(v[i * 4 + 3].x * sc, v[i * 4 + 3].y * sc, 0, false);
      w = __builtin_amdgcn_cvt_pk_fp8_f32(v[i * 4 + 3].z * sc, v[i * 4 + 3].w * sc, w, true); o.w = (unsigned)w;
      *(u4*)(dst + (size_t)row * D + i * 1024 + lane * 16) = o;
    }
    if (lane == 0) scl[row] = amax > 0.f ? amax * (1.f / 256.f) : 1.f;
  }
}

__device__ void sincos_d(double a, float& s, float& c) {
  double k = rint(a * 0.63661977236758134308);
  double r = a - k * 1.57079632679489661923;
  double r2 = r * r;
  double sn = r * (1.0 + r2 * (-1.0 / 6 + r2 * (1.0 / 120 + r2 * (-1.0 / 5040 + r2 * (1.0 / 362880 + r2 * (-1.0 / 39916800 + r2 * (1.0 / 6227020800.0)))))));
  double cs = 1.0 + r2 * (-0.5 + r2 * (1.0 / 24 + r2 * (-1.0 / 720 + r2 * (1.0 / 40320 + r2 * (-1.0 / 3628800 + r2 * (1.0 / 479001600.0))))));
  int q = ((int)k) & 3;
  double so = (q == 0) ? sn : (q == 1) ? cs : (q == 2) ? -sn : -cs;
  double co = (q == 0) ? cs : (q == 1) ? -sn : (q == 2) ? -cs : sn;
  s = (float)so; c = (float)co;
}

__device__ void phase0(const Params& p, char* smem) {
  const int tid = get_tid(), bid = get_bid(), nb = gridDim.x;
  float* fs = (float*)smem;
  if (bid == 0) {
    for (int e = tid; e < 128 * 16 + 128 * 32; e += NTHR) {
      int F, pos, f, base;
      if (e < 2048) { F = 16; pos = e >> 4; f = e & 15; base = 0; }
      else { int e2 = e - 2048; F = 32; pos = e2 >> 5; f = e2 & 31; base = 4096; }
      double bb = (F == 16) ? 0.56234132519034908 : 0.74989420933245582;
      double inv = 1.0;
      for (int i = 0; i < f; ++i) inv *= bb;
      float invf = (float)inv;
      float ang = (float)pos * invf;
      float sn, cs;
      sincos_d((double)ang, sn, cs);
      p.rope[base + pos * F + f] = cs;
      p.rope[base + 128 * F + pos * F + f] = sn;
    }
  }
  for (int it = bid; it < 384; it += nb) {
    int layer = it / 192, r = it % 192, kc = r / 6, nc = r % 6;
    __syncthreads();
    if (tid < 192) {
      int v = tid >> 6, kk = tid & 63;
      float cv = (v < 2) ? p.c[v * D + kc * 64 + kk] : p.c_ctx[kc * 64 + kk];
      fs[tid] = silu_f(cv);
    }
    __syncthreads();
    int n = nc * 2048 + tid * 4;
    float4 a0 = make_float4(0, 0, 0, 0), a1 = a0, a2 = a0;
    if (kc == 0) { a0 = *(const float4*)(p.b_ada + layer * 12288 + n); a1 = a0; a2 = a0; }
    const float* w = p.w_ada + (size_t)layer * D * 12288 + (size_t)(kc * 64) * 12288 + n;
#pragma unroll 8
    for (int kk = 0; kk < 64; ++kk) {
      float4 wv = *(const float4*)(w + (size_t)kk * 12288);
      float s0 = fs[kk], s1 = fs[64 + kk], s2 = fs[128 + kk];
      a0.x += s0 * wv.x; a0.y += s0 * wv.y; a0.z += s0 * wv.z; a0.w += s0 * wv.w;
      a1.x += s1 * wv.x; a1.y += s1 * wv.y; a1.z += s1 * wv.z; a1.w += s1 * wv.w;
      a2.x += s2 * wv.x; a2.y += s2 * wv.y; a2.z += s2 * wv.z; a2.w += s2 * wv.w;
    }
    float* m0 = p.mod + (layer * 3 + 0) * 12288 + n;
    float* m1 = p.mod + (layer * 3 + 1) * 12288 + n;
    float* m2 = p.mod + (layer * 3 + 2) * 12288 + n;
    atomicAdd(m0 + 0, a0.x); atomicAdd(m0 + 1, a0.y); atomicAdd(m0 + 2, a0.z); atomicAdd(m0 + 3, a0.w);
    atomicAdd(m1 + 0, a1.x); atomicAdd(m1 + 1, a1.y); atomicAdd(m1 + 2, a1.z); atomicAdd(m1 + 3, a1.w);
    atomicAdd(m2 + 0, a2.x); atomicAdd(m2 + 1, a2.y); atomicAdd(m2 + 2, a2.z); atomicAdd(m2 + 3, a2.w);
  }
  for (int layer = 0; layer < 2; ++layer) {
    for (int it = bid; it < 32 * 94; it += nb)
      transpose_cvt(p.w_in + (size_t)layer * D * DIN, D, DIN, DINP, p.wt_in + (size_t)layer * DINP * D, it, fs);
    for (int it = bid; it < 32 * 32; it += nb)
      transpose_cvt(p.w_out + (size_t)layer * D * D, D, D, D, p.wt_out + (size_t)layer * D * D, it, fs);
    for (int it = bid; it < 32 * 32; it += nb)
      transpose_cvt(p.w_q + (size_t)layer * D * D, D, D, D, p.wt_q + (size_t)layer * D * D, it, fs);
  }
  cvt_linear(p.sub_keys, p.sk_bf, (size_t)524288 / 8);
  cvt_fp8_rows(p.pu, p.u8, p.uscl, 2 * 16384);
  cvt_fp8_rows(p.pv, p.v8, p.vscl, 2 * 16384);
}

__device__ void modulate_phase(const Params& p, int layer, int which, int nrows) {
  const int lane = get_tid() & 63;
  const int wave = get_bid() * 8 + (get_tid() >> 6), nw = gridDim.x * 8;
  const float* g = (which == 0 ? p.g_attn : p.g_ffn) + layer * D;
  for (int m = wave; m < nrows; m += nw) {
    const float* src;
    if (layer == 0 && which == 0) src = (m < MX) ? p.x + (size_t)m * D : p.ctx + (size_t)(m - MX) * D;
    else src = p.xcur + (size_t)m * D;
    int vec = m < S ? 0 : (m < MX ? 1 : 2);
    const float* modl = p.mod + (layer * 3 + vec) * 12288 + which * 3 * D;
    float4 v[8];
    float ss = 0.f;
#pragma unroll
    for (int i = 0; i < 8; ++i) {
      v[i] = *(const float4*)(src + i * 256 + lane * 4);
      ss += v[i].x * v[i].x + v[i].y * v[i].y + v[i].z * v[i].z + v[i].w * v[i].w;
    }
    ss = wave_sum(ss);
    float rstd = rsqrtf(ss * (1.f / D) + EPS);
#pragma unroll
    for (int i = 0; i < 8; ++i) {
      int col = i * 256 + lane * 4;
      float4 gg = *(const float4*)(g + col);
      float4 sh = *(const float4*)(modl + col);
      float4 sc = *(const float4*)(modl + D + col);
      float y0 = v[i].x * rstd * gg.x * (1.f + sc.x) + sh.x;
      float y1 = v[i].y * rstd * gg.y * (1.f + sc.y) + sh.y;
      float y2 = v[i].z * rstd * gg.z * (1.f + sc.z) + sh.z;
      float y3 = v[i].w * rstd * gg.w * (1.f + sc.w) + sh.w;
      uint2 o; o.x = pack2(y0, y1); o.y = pack2(y2, y3);
      *(uint2*)(p.h + (size_t)m * D + col) = o;
    }
  }
}

template <int EPI, bool BIG>
__device__ void gemm_tile(const bfr* __restrict__ A, int lda, const bfr* __restrict__ Bt, int ldb, int K, int m0,
                          int n0, void* Cout, int ldc, const Params& p, int layer, char* smem) {
  constexpr int BN = BIG ? 256 : 128;
  constexpr int MI = BIG ? 8 : 4;
  constexpr int NBL = BN / 64;
  bfr* As0 = (bfr*)smem;
  bfr* Bs0 = As0 + 2 * 256 * 72;
  const int tid = get_tid(), lane = tid & 63, w = tid >> 6;
  const int wm = BIG ? (w >> 2) : (w >> 1), wn = BIG ? (w & 3) : (w & 1);
  const int fr = lane & 15, fq = lane >> 4;
  f32x4 acc[MI][4];
#pragma unroll
  for (int i = 0; i < MI; ++i)
#pragma unroll
    for (int j = 0; j < 4; ++j) acc[i][j] = (f32x4){0.f, 0.f, 0.f, 0.f};
  const int arow = tid >> 3, akc = (tid & 7) * 8;
  u4 rs[4];
  const bfr* Ap = A + (size_t)(m0 + arow) * lda + akc;
  const bfr* Bp = Bt + (size_t)(n0 + arow) * ldb + akc;
#pragma unroll
  for (int i = 0; i < 4; ++i) rs[i] = *(const u4*)(Ap + (size_t)(64 * i) * lda);
  __syncthreads();
#pragma unroll
  for (int i = 0; i < 4; ++i) *(u4*)(As0 + (arow + 64 * i) * 72 + akc) = rs[i];
#pragma unroll
  for (int i = 0; i < NBL; ++i) rs[i] = *(const u4*)(Bp + (size_t)(64 * i) * ldb);
#pragma unroll
  for (int i = 0; i < NBL; ++i) *(u4*)(Bs0 + (arow + 64 * i) * 72 + akc) = rs[i];
  const int nk = K >> 6;
  if (nk > 1) {
#pragma unroll
    for (int i = 0; i < 4; ++i) rs[i] = *(const u4*)(Ap + (size_t)(64 * i) * lda + 64);
  }
  __syncthreads();
  for (int kt = 0; kt < nk; ++kt) {
    const bfr* As = As0 + (kt & 1) * (256 * 72);
    const bfr* Bs = Bs0 + (kt & 1) * (BN * 72);
    bfr* Asn = As0 + ((kt + 1) & 1) * (256 * 72);
    bfr* Bsn = Bs0 + ((kt + 1) & 1) * (BN * 72);
#pragma unroll
    for (int kk = 0; kk < 2; ++kk) {
      bf16x8 b[4];
#pragma unroll
      for (int j = 0; j < 4; ++j) b[j] = *(const bf16x8*)(Bs + (wn * 64 + j * 16 + fr) * 72 + kk * 32 + fq * 8);
      {
        bf16x8 a_cur = *(const bf16x8*)(As + (wm * (MI * 16) + fr) * 72 + kk * 32 + fq * 8);
#pragma unroll
        for (int i = 0; i < MI; ++i) {
          bf16x8 a_nxt = a_cur;
          if (i + 1 < MI) a_nxt = *(const bf16x8*)(As + (wm * (MI * 16) + (i + 1) * 16 + fr) * 72 + kk * 32 + fq * 8);
#pragma unroll
          for (int j = 0; j < 4; ++j) acc[i][j] = __builtin_amdgcn_mfma_f32_16x16x32_bf16(b[j], a_cur, acc[i][j], 0, 0, 0);
          if (BIG) __builtin_amdgcn_sched_barrier(0);
          a_cur = a_nxt;
        }
      }
      if (kt + 1 < nk) {
        if (kk == 0) {
#pragma unroll
          for (int i = 0; i < 4; ++i) *(u4*)(Asn + (arow + 64 * i) * 72 + akc) = rs[i];
#pragma unroll
          for (int i = 0; i < NBL; ++i) rs[i] = *(const u4*)(Bp + (size_t)(64 * i) * ldb + (kt + 1) * 64);
        } else {
#pragma unroll
          for (int i = 0; i < NBL; ++i) *(u4*)(Bsn + (arow + 64 * i) * 72 + akc) = rs[i];
          if (kt + 2 < nk) {
#pragma unroll
            for (int i = 0; i < 4; ++i) rs[i] = *(const u4*)(Ap + (size_t)(64 * i) * lda + (kt + 2) * 64);
          }
        }
      }
    }
    __syncthreads();
  }
  const int nb0 = n0 + wn * 64 + fq * 4;
#pragma unroll
  for (int i = 0; i < MI; ++i) {
    const int m = m0 + wm * (MI * 16) + i * 16 + fr;
    if (EPI == 0) {
      bfr* crow = (bfr*)Cout + (size_t)m * ldc + nb0;
#pragma unroll
      for (int j = 0; j < 4; ++j) {
        uint2 o;
        o.x = pack2(acc[i][j][0], acc[i][j][1]); o.y = pack2(acc[i][j][2], acc[i][j][3]);
        *(uint2*)(crow + j * 16) = o;
      }
    } else if (EPI == 2) {
      float* crow = (float*)Cout + (size_t)m * ldc + nb0;
#pragma unroll
      for (int j = 0; j < 4; ++j) *(float4*)(crow + j * 16) = make_float4(acc[i][j][0], acc[i][j][1], acc[i][j][2], acc[i][j][3]);
    } else {
      const float* src;
      if (layer == 0) src = (m < MX) ? p.x + (size_t)m * D : p.ctx + (size_t)(m - MX) * D;
      else src = p.xcur + (size_t)m * D;
      src += nb0;
      const int vec = m < S ? 0 : (m < MX ? 1 : 2);
      const float* grow = p.mod + (layer * 3 + vec) * 12288 + 2 * D + nb0;
      float* orow = p.xcur + (size_t)m * D + nb0;
#pragma unroll
      for (int j = 0; j < 4; ++j) {
        const float4 gate = *(const float4*)(grow + j * 16);
        const float4 xs = *(const float4*)(src + j * 16);
        *(float4*)(orow + j * 16) = make_float4(xs.x + gate.x * acc[i][j][0], xs.y + gate.y * acc[i][j][1], xs.z + gate.z * acc[i][j][2], xs.w + gate.w * acc[i][j][3]);
      }
      __builtin_amdgcn_sched_barrier(0);
    }
  }
}

#define MFMA16(a, b, c) __builtin_amdgcn_mfma_f32_16x16x32_bf16((a), (b), (c), 0, 0, 0)
typedef __attribute__((ext_vector_type(4))) short s16x4;

__device__ __forceinline__ void load_kv_tile(bfr* dst, const bfr* src, int nrows, int tok0, int toklimit) {
  for (int c = get_tid(); c < nrows * 8; c += NTHR) {
    int r = c >> 3, ch = c & 7;
    int tok = tok0 + r;
    u4 v = (u4){0u, 0u, 0u, 0u};
    if (tok >= 0 && tok < toklimit) v = *(const u4*)(src + (ptrdiff_t)r * DINP + ch * 8);
    *(u4*)(dst + r * 72 + ch * 8) = v;
  }
}
__device__ __forceinline__ void load_vt_tile(bfr* Vt, int VS, const bfr* src, int nrows, int tok0, int toklimit) {
  for (int c = get_tid(); c < nrows * 8; c += NTHR) {
    int key = c % nrows, dch = c / nrows;
    int tok = tok0 + key;
    u4 v = (u4){0u, 0u, 0u, 0u};
    if (tok >= 0 && tok < toklimit) v = *(const u4*)(src + (ptrdiff_t)key * DINP + dch * 8);
    bfr* d = Vt + (dch * 8) * VS + key;
    d[0 * VS] = (bfr)(v.x & 0xffffu); d[1 * VS] = (bfr)(v.x >> 16);
    d[2 * VS] = (bfr)(v.y & 0xffffu); d[3 * VS] = (bfr)(v.y >> 16);
    d[4 * VS] = (bfr)(v.z & 0xffffu); d[5 * VS] = (bfr)(v.z >> 16);
    d[6 * VS] = (bfr)(v.w & 0xffffu); d[7 * VS] = (bfr)(v.w >> 16);
  }
}
__device__ __forceinline__ void load_kfrags(bf16x8 (&kf)[2][2], const bfr* Ks, int kt, int fr, int q4) {
#pragma unroll
  for (int blk = 0; blk < 2; ++blk)
#pragma unroll
    for (int ds = 0; ds < 2; ++ds) kf[blk][ds] = *(const bf16x8*)(Ks + (kt + blk * 16 + fr) * 72 + ds * 32 + q4 * 8);
}
__device__ __forceinline__ void load_vfrags(bf16x8 (&vf)[4], const bfr* Vt, int VS, int kt, int fr, int q4) {
#pragma unroll
  for (int db = 0; db < 4; ++db) {
    const bfr* vp = Vt + (db * 16 + fr) * VS + kt + q4 * 4;
    s16x4 lo = *(const s16x4*)vp, hi = *(const s16x4*)(vp + 16);
    vf[db] = __builtin_shufflevector(lo, hi, 0, 1, 2, 3, 4, 5, 6, 7);
  }
}
__device__ __forceinline__ void attn_tile_group(const bf16x8 (&kf)[2][2], const bf16x8 (&qf)[2], const bf16x8 (&vf)[4],
                                                f32x4 (&o)[4], float& m, float& l, const float (&badd)[8]) {
  f32x4 s0 = (f32x4){0.f, 0.f, 0.f, 0.f}, s1 = s0;
  s0 = MFMA16(kf[0][0], qf[0], s0); s0 = MFMA16(kf[0][1], qf[1], s0);
  s1 = MFMA16(kf[1][0], qf[0], s1); s1 = MFMA16(kf[1][1], qf[1], s1);
  float sv[8];
#pragma unroll
  for (int i = 0; i < 4; ++i) { sv[i] = s0[i] + badd[i]; sv[4 + i] = s1[i] + badd[4 + i]; }
  float mx = fmaxf(fmaxf(fmaxf(sv[0], sv[1]), fmaxf(sv[2], sv[3])), fmaxf(fmaxf(sv[4], sv[5]), fmaxf(sv[6], sv[7])));
  mx = fmaxf(mx, __shfl_xor(mx, 16));
  mx = fmaxf(mx, __shfl_xor(mx, 32));
  const float mn = fmaxf(m, mx);
  const float mref = (mn == -INFINITY) ? 0.f : mn;
  const float alpha = __expf(m - mref);
  float pv[8];
  float ls = 0.f;
#pragma unroll
  for (int i = 0; i < 8; ++i) { pv[i] = __expf(sv[i] - mref); ls += pv[i]; }
  l = l * alpha + ls;
  m = mn;
  u4 pk;
  pk.x = pack2(pv[0], pv[1]); pk.y = pack2(pv[2], pv[3]); pk.z = pack2(pv[4], pv[5]); pk.w = pack2(pv[6], pv[7]);
  const bf16x8 pb = __builtin_bit_cast(bf16x8, pk);
#pragma unroll
  for (int db = 0; db < 4; ++db) {
    o[db] *= alpha;
    o[db] = MFMA16(vf[db], pb, o[db]);
  }
}
__device__ __forceinline__ float attn_rowsum(float l) {
  l += __shfl_xor(l, 16);
  l += __shfl_xor(l, 32);
  return l;
}
__device__ __forceinline__ void load_qfrags(bf16x8 (&qf)[2], const bfr* qrow, int q4, float scale) {
#pragma unroll
  for (int ds = 0; ds < 2; ++ds) {
    u4 w = *(const u4*)(qrow + ds * 32 + q4 * 8);
    float f[8];
    unpack8(w, f);
    u4 o;
    o.x = pack2(f[0] * scale, f[1] * scale); o.y = pack2(f[2] * scale, f[3] * scale);
    o.z = pack2(f[4] * scale, f[5] * scale); o.w = pack2(f[6] * scale, f[7] * scale);
    qf[ds] = __builtin_bit_cast(bf16x8, o);
  }
}
__device__ __forceinline__ void store_ot(bfr* dst, const f32x4 (&o)[4], float inv, int q4) {
#pragma unroll
  for (int db = 0; db < 4; ++db) {
    uint2 w;
    w.x = pack2(o[db][0] * inv, o[db][1] * inv);
    w.y = pack2(o[db][2] * inv, o[db][3] * inv);
    *(uint2*)(dst + db * 16 + q4 * 4) = w;
  }
}

__device__ void swa_item(const Params& p, int layer, int item, char* smem) {
  const int b = item >> 7, kvh = (item >> 6) & 1, nbk = item & 63;
  bfr* Ks = (bfr*)smem;
  bfr* Vt = Ks + 384 * 72;
  constexpr int VS = 392;
  const int tid = get_tid();
  const int lane = tid & 63, w = tid >> 6, fr = lane & 15, q4 = lane >> 4;
  const float* cos16 = p.rope;
  const float* sin16 = p.rope + 2048;
  __syncthreads();
  const int tok0 = (nbk - 1) * 128;
  const bfr* rowbase = p.proj + (ptrdiff_t)(b * S + tok0) * DINP;
  load_vt_tile(Vt, VS, rowbase + C_SWV + kvh * 64, 384, tok0, S);
  for (int u = tid; u < 384 * 4; u += NTHR) {
    int r = u >> 2, A = (u >> 1) & 1, fc = u & 1;
    int tok = tok0 + r;
    u4 o1 = (u4){0u, 0u, 0u, 0u}, o2 = o1;
    if (tok >= 0 && tok < S) {
      const bfr* kp = rowbase + (ptrdiff_t)r * DINP + C_SWK + kvh * 64 + A * 32 + fc * 8;
      u4 w1 = *(const u4*)kp, w2 = *(const u4*)(kp + 16);
      float x1[8], x2[8], y1[8], y2[8];
      unpack8(w1, x1); unpack8(w2, x2);
      int pos = A ? (tok & 63) : (tok >> 6);
#pragma unroll
      for (int j = 0; j < 8; ++j) {
        float cs = cos16[pos * 16 + fc * 8 + j], sn = sin16[pos * 16 + fc * 8 + j];
        y1[j] = x1[j] * cs - x2[j] * sn;
        y2[j] = x2[j] * cs + x1[j] * sn;
      }
      o1.x = pack2(y1[0], y1[1]); o1.y = pack2(y1[2], y1[3]); o1.z = pack2(y1[4], y1[5]); o1.w = pack2(y1[6], y1[7]);
      o2.x = pack2(y2[0], y2[1]); o2.y = pack2(y2[2], y2[3]); o2.z = pack2(y2[4], y2[5]); o2.w = pack2(y2[6], y2[7]);
    }
    int ch1 = A * 4 + fc, ch2 = A * 4 + 2 + fc;
    *(u4*)(Ks + r * 72 + ch1 * 8) = o1;
    *(u4*)(Ks + r * 72 + ch2 * 8) = o2;
  }
  const int g = w >> 1, qhalf = w & 1;
  const int hq = kvh * 4 + g;
  bf16x8 qf[4][2];
  f32x4 oacc[4][4];
  float mm[4], ll[4];
#pragma unroll
  for (int grp = 0; grp < 4; ++grp) {
    const int tq = nbk * 128 + qhalf * 64 + grp * 16 + fr;
    const bfr* qrow = p.proj + (size_t)(b * S + tq) * DINP + C_SWQ + hq * 64;
#pragma unroll
    for (int ds = 0; ds < 2; ++ds) {
      u4 wq = *(const u4*)(qrow + ds * 32 + q4 * 8);
      float f[8], y[8];
      unpack8(wq, f);
      const int pos = ds ? (tq & 63) : (tq >> 6);
#pragma unroll
      for (int j = 0; j < 8; ++j) {
        const float other = __shfl_xor(f[j], 32);
        const int fi = (q4 & 1) * 8 + j;
        const float cs = cos16[pos * 16 + fi], sn = sin16[pos * 16 + fi];
        y[j] = ((q4 < 2) ? (f[j] * cs - other * sn) : (f[j] * cs + other * sn)) * 0.125f;
      }
      u4 o;
      o.x = pack2(y[0], y[1]); o.y = pack2(y[2], y[3]); o.z = pack2(y[4], y[5]); o.w = pack2(y[6], y[7]);
      qf[grp][ds] = __builtin_bit_cast(bf16x8, o);
    }
    mm[grp] = -INFINITY; ll[grp] = 0.f;
#pragma unroll
    for (int db = 0; db < 4; ++db) oacc[grp][db] = (f32x4){0.f, 0.f, 0.f, 0.f};
  }
  __syncthreads();
  float zb[8];
#pragma unroll
  for (int i = 0; i < 8; ++i) zb[i] = 0.f;
#pragma unroll 1
  for (int t = 0; t < 10; ++t) {
    const int kt = qhalf * 64 + 32 * t;
    if (tok0 + kt + 31 < 0 || tok0 + kt >= S) continue;
    bf16x8 kf[2][2], vf[4];
    load_kfrags(kf, Ks, kt, fr, q4);
    load_vfrags(vf, Vt, VS, kt, fr, q4);
#pragma unroll
    for (int grp = 0; grp < 4; ++grp) {
      const int qg0 = 128 + qhalf * 64 + grp * 16;
      if (kt > qg0 + 15 + 128 || kt + 31 < qg0 - 128) continue;
      const bool interior = (kt >= qg0 + 15 - 128) && (kt + 31 <= qg0 + 128) && (tok0 + kt >= 0) && (tok0 + kt + 31 < S);
      if (interior) {
        attn_tile_group(kf, qf[grp], vf, oacc[grp], mm[grp], ll[grp], zb);
      } else {
        const int qrow = qg0 + fr;
        float badd[8];
#pragma unroll
        for (int i = 0; i < 8; ++i) {
          const int lr = kt + (i >> 2) * 16 + q4 * 4 + (i & 3);
          const int dd = qrow - lr;
          const int tok = tok0 + lr;
          const bool ok = (dd <= 128) && (dd >= -128) && (tok >= 0) && (tok < S);
          badd[i] = ok ? 0.f : -INFINITY;
        }
        attn_tile_group(kf, qf[grp], vf, oacc[grp], mm[grp], ll[grp], badd);
      }
    }
  }
  __syncthreads();
  const bfr* zbase = p.proj + (size_t)(MX + b * 256) * DINP;
  load_kv_tile(Ks, zbase + C_SWK + kvh * 64, 256, 0, 256);
  load_vt_tile(Vt, VS, zbase + C_SWV + kvh * 64, 256, 0, 256);
  __syncthreads();
#pragma unroll 1
  for (int t = 0; t < 8; ++t) {
    const int kt = 32 * t;
    bf16x8 kf[2][2], vf[4];
    load_kfrags(kf, Ks, kt, fr, q4);
    load_vfrags(vf, Vt, VS, kt, fr, q4);
#pragma unroll
    for (int grp = 0; grp < 4; ++grp) attn_tile_group(kf, qf[grp], vf, oacc[grp], mm[grp], ll[grp], zb);
  }
  const float sk = p.sink[layer * 8 + hq];
#pragma unroll
  for (int grp = 0; grp < 4; ++grp) {
    const int tq = nbk * 128 + qhalf * 64 + grp * 16 + fr;
    const float mn = fmaxf(mm[grp], sk);
    const float alpha = __expf(mm[grp] - mn);
    const float lt = attn_rowsum(ll[grp]) * alpha + __expf(sk - mn);
    store_ot(p.mix + (size_t)(b * S + tq) * D + 1536 + hq * 64, oacc[grp], alpha / lt, q4);
  }
}

__device__ void na_item(const Params& p, int layer, int item, char* smem) {
  const int b = item >> 10, h = (item >> 7) & 7, r = item & 127;
  bfr* Ks = (bfr*)smem;
  bfr* Vt = Ks + 512 * 72;
  constexpr int VS = 520;
  float* rp = (float*)(Vt + 64 * VS);
  float* mg = (float*)smem;
  const int tid = get_tid();
  const int lane = tid & 63, w = tid >> 6, fr = lane & 15, q4 = lane >> 4;
  __syncthreads();
  int r0 = r - 4; r0 = r0 < 0 ? 0 : (r0 > 120 ? 120 : r0);
  const bfr* rowbase = p.proj + (size_t)(b * S + r0 * 64) * DINP;
  load_kv_tile(Ks, rowbase + C_NAK + h * 64, 512, 0, 512);
  load_vt_tile(Vt, VS, rowbase + C_NAV + h * 64, 512, 0, 512);
  if (tid < 15 * 31) rp[tid] = p.rpb[(layer * 8 + h) * 465 + tid];
  const int grp = w >> 1, half = w & 1;
  const int cq = grp * 16 + fr;
  const int tq = r * 64 + cq;
  bf16x8 qf[2];
  load_qfrags(qf, p.proj + (size_t)(b * S + tq) * DINP + C_NAQ + h * 64, q4, 0.125f);
  f32x4 oacc[4];
#pragma unroll
  for (int db = 0; db < 4; ++db) oacc[db] = (f32x4){0.f, 0.f, 0.f, 0.f};
  float m = -INFINITY, l = 0.f;
  __syncthreads();
  int cs = cq - 8; cs = cs < 0 ? 0 : (cs > 48 ? 48 : cs);
  const int tstart = grp == 0 ? 0 : (grp == 1 ? 8 : (grp == 2 ? 24 : 32));
#pragma unroll 1
  for (int jj = 0; jj < 4; ++jj) {
    const int jrow = half * 4 + jj;
    const int drow = (r0 + jrow) - r + 7;
    const int kt = jrow * 64 + tstart;
    bf16x8 kf[2][2], vf[4];
    load_kfrags(kf, Ks, kt, fr, q4);
    load_vfrags(vf, Vt, VS, kt, fr, q4);
    float badd[8];
#pragma unroll
    for (int i = 0; i < 8; ++i) {
      const int ck = tstart + (i >> 2) * 16 + q4 * 4 + (i & 3);
      const bool ok = (ck >= cs) && (ck < cs + 16);
      int dc = ck - cq + 15; dc = dc < 0 ? 0 : (dc > 30 ? 30 : dc);
      badd[i] = ok ? rp[drow * 31 + dc] : -INFINITY;
    }
    attn_tile_group(kf, qf, vf, oacc, m, l, badd);
  }
  __syncthreads();
  const bfr* zbase = p.proj + (size_t)(MX + b * 256) * DINP;
  load_kv_tile(Ks, zbase + C_NAK + h * 64, 256, 0, 256);
  load_vt_tile(Vt, VS, zbase + C_NAV + h * 64, 256, 0, 256);
  __syncthreads();
  float zb[8];
#pragma unroll
  for (int i = 0; i < 8; ++i) zb[i] = 0.f;
#pragma unroll 1
  for (int t = 0; t < 4; ++t) {
    const int kt = half * 128 + 32 * t;
    bf16x8 kf[2][2], vf[4];
    load_kfrags(kf, Ks, kt, fr, q4);
    load_vfrags(vf, Vt, VS, kt, fr, q4);
    attn_tile_group(kf, qf, vf, oacc, m, l, zb);
  }
  __syncthreads();
  l = attn_rowsum(l);
  float* mo = mg + grp * (16 * 64 + 64) ;
  if (half == 1) {
#pragma unroll
    for (int db = 0; db < 4; ++db)
#pragma unroll
      for (int i = 0; i < 4; ++i) mo[(db * 4 + i) * 64 + lane] = oacc[db][i];
    if (q4 == 0) { mo[16 * 64 + fr] = m; mo[16 * 64 + 16 + fr] = l; }
  }
  __syncthreads();
  if (half == 0) {
    const float m2 = mo[16 * 64 + fr], l2 = mo[16 * 64 + 16 + fr];
    const float mn = fmaxf(m, m2);
    const float a1 = __expf(m - mn), a2 = __expf(m2 - mn);
    const float lt = l * a1 + l2 * a2;
    const float i1 = a1 / lt, i2 = a2 / lt;
#pragma unroll
    for (int db = 0; db < 4; ++db)
#pragma unroll
      for (int i = 0; i < 4; ++i) oacc[db][i] = oacc[db][i] * i1 + mo[(db * 4 + i) * 64 + lane] * i2;
    store_ot(p.mix + (size_t)(b * S + tq) * D + h * 64, oacc, 1.f, q4);
  }
}

__device__ void ctx_item(const Params& p, int layer, int item, char* smem) {
  const int b = item >> 4, type = (item >> 3) & 1, h = item & 7;
  bfr* Ks = (bfr*)smem;
  bfr* Vt = Ks + 256 * 72;
  constexpr int VS = 264;
  const int tid = get_tid();
  const int lane = tid & 63, w = tid >> 6, fr = lane & 15, q4 = lane >> 4;
  __syncthreads();
  const bfr* zbase = p.proj + (size_t)(MX + b * 256) * DINP;
  const int kcol = type ? (C_SWK + (h >> 2) * 64) : (C_NAK + h * 64);
  const int vcol = type ? (C_SWV + (h >> 2) * 64) : (C_NAV + h * 64);
  const int qcol = type ? (C_SWQ + h * 64) : (C_NAQ + h * 64);
  load_kv_tile(Ks, zbase + kcol, 256, 0, 256);
  load_vt_tile(Vt, VS, zbase + vcol, 256, 0, 256);
  bf16x8 qf[2][2];
  f32x4 oacc[2][4];
  float mm[2], ll[2];
#pragma unroll
  for (int grp = 0; grp < 2; ++grp) {
    const int qz = w * 32 + grp * 16 + fr;
    load_qfrags(qf[grp], zbase + (size_t)qz * DINP + qcol, q4, 0.125f);
    mm[grp] = -INFINITY; ll[grp] = 0.f;
#pragma unroll
    for (int db = 0; db < 4; ++db) oacc[grp][db] = (f32x4){0.f, 0.f, 0.f, 0.f};
  }
  __syncthreads();
  float zb[8];
#pragma unroll
  for (int i = 0; i < 8; ++i) zb[i] = 0.f;
#pragma unroll 1
  for (int t = 0; t < 8; ++t) {
    const int kt = 32 * t;
    bf16x8 kf[2][2], vf[4];
    load_kfrags(kf, Ks, kt, fr, q4);
    load_vfrags(vf, Vt, VS, kt, fr, q4);
#pragma unroll
    for (int grp = 0; grp < 2; ++grp) attn_tile_group(kf, qf[grp], vf, oacc[grp], mm[grp], ll[grp], zb);
  }
#pragma unroll
  for (int grp = 0; grp < 2; ++grp) {
    const int qz = w * 32 + grp * 16 + fr;
    float inv;
    if (type == 1) {
      const float sk = p.sink[layer * 8 + h];
      const float mn = fmaxf(mm[grp], sk);
      const float a = __expf(mm[grp] - mn);
      inv = a / (attn_rowsum(ll[grp]) * a + __expf(sk - mn));
    } else {
      inv = 1.f / attn_rowsum(ll[grp]);
    }
    store_ot(p.mix + (size_t)(MX + b * 256 + qz) * D + (type ? 1536 : 0) + h * 64, oacc[grp], inv, q4);
  }
}

template <int W>
__device__ __forceinline__ void load_rows_f32(float* dst, int stride, const bfr* src, float scale) {
  constexpr int CPR = W / 8;
  for (int c = get_tid(); c < 64 * CPR; c += NTHR) {
    int j = c / CPR, ch = c % CPR;
    u4 w = *(const u4*)(src + (size_t)j * DINP + ch * 8);
    float f[8];
    unpack8(w, f);
    float4 a = make_float4(f[0] * scale, f[1] * scale, f[2] * scale, f[3] * scale);
    float4 bq = make_float4(f[4] * scale, f[5] * scale, f[6] * scale, f[7] * scale);
    *(float4*)(dst + j * stride + ch * 8) = a;
    *(float4*)(dst + j * stride + ch * 8 + 4) = bq;
  }
}

__device__ __forceinline__ void rope128_tile(float* t, int stride, int prow, const float* rope, float scale) {
  const float* cos32 = rope + 4096;
  const float* sin32 = rope + 8192;
  for (int u = get_tid(); u < 64 * 64; u += NTHR) {
    int j = u >> 6, A = (u >> 5) & 1, f = u & 31;
    int pos = A ? j : prow;
    float cs = cos32[pos * 32 + f], sn = sin32[pos * 32 + f];
    float x1 = t[j * stride + A * 64 + f], x2 = t[j * stride + A * 64 + 32 + f];
    t[j * stride + A * 64 + f] = (x1 * cs - x2 * sn) * scale;
    t[j * stride + A * 64 + 32 + f] = (x2 * cs + x1 * sn) * scale;
  }
}

__device__ __forceinline__ void gla_logdecay(const Params& p, int layer, int h, int dir, const bfr* rowbase, float* G) {
  const int tid = get_tid();
  const int j = tid >> 3, dg = tid & 7;
  const bfr* dl = rowbase + (size_t)j * DINP + C_GLD + dir * 16;
  u4 w0 = *(const u4*)dl, w1 = *(const u4*)(dl + 8);
  float x[16];
  unpack8(w0, x); unpack8(w1, x + 8);
  const float* wu = p.gla_wu + (size_t)layer * 8192 + dir * 4096 + h * 64;
  const float* bb = p.gla_b + layer * 512 + dir * 256 + h * 64;
#pragma unroll
  for (int dd = 0; dd < 8; ++dd) {
    int d = dg + 8 * dd;
    float pre = bb[d];
#pragma unroll
    for (int r = 0; r < 16; ++r) pre += x[r] * wu[r * 256 + d];
    G[j * 68 + d] = logsig_f(pre) * (1.f / 16.f);
  }
}

__device__ __forceinline__ void gla_logdecay2(const Params& p, int layer, int h, const bfr* rowbase, float* G0, float* G1) {
  const int tid = get_tid();
  const int w = tid >> 6, lane = tid & 63, fr = lane & 15, q4 = lane >> 4;
  const int dir = w >> 2, dt = w & 3;
  const int d = dt * 16 + fr;
  float* G = dir ? G1 : G0;
  u4 bw = (u4){0u, 0u, 0u, 0u};
  if (q4 < 2) {
    const float* wu = p.gla_wu + (size_t)layer * 8192 + dir * 4096 + (q4 * 8) * 256 + h * 64 + d;
    bw.x = pack2(wu[0 * 256], wu[1 * 256]); bw.y = pack2(wu[2 * 256], wu[3 * 256]);
    bw.z = pack2(wu[4 * 256], wu[5 * 256]); bw.w = pack2(wu[6 * 256], wu[7 * 256]);
  }
  const bf16x8 bq = __builtin_bit_cast(bf16x8, bw);
  const float bias = p.gla_b[layer * 512 + dir * 256 + h * 64 + d];
#pragma unroll
  for (int rt = 0; rt < 4; ++rt) {
    u4 aw = (u4){0u, 0u, 0u, 0u};
    if (q4 < 2) aw = *(const u4*)(rowbase + (size_t)(rt * 16 + fr) * DINP + C_GLD + dir * 16 + q4 * 8);
    f32x4 acc = (f32x4){0.f, 0.f, 0.f, 0.f};
    acc = MFMA16(__builtin_bit_cast(bf16x8, aw), bq, acc);
#pragma unroll
    for (int r = 0; r < 4; ++r) G[(rt * 16 + q4 * 4 + r) * 68 + d] = logsig_f(acc[r] + bias) * (1.f / 16.f);
  }
}

__device__ __forceinline__ int scan_pos(int dir, int g) { return dir == 0 ? g : (g < 4 ? 3 - g : 135 - g); }
__device__ __forceinline__ int group_row0(int b, int g) { return g < 4 ? (MX + b * 256 + g * 64) : (b * S + (g - 4) * 64); }

template <int W>
__device__ __forceinline__ void load_rows_transposed(bfr* T, const bfr* src) {
  for (int c = get_tid(); c < 64 * (W / 8); c += NTHR) {
    const int j = c & 63, dch = c >> 6;
    const u4 v = *(const u4*)(src + (size_t)j * DINP + dch * 8);
    bfr* d = T + (dch * 8) * 72 + j;
    d[0 * 72] = (bfr)(v.x & 0xffffu); d[1 * 72] = (bfr)(v.x >> 16);
    d[2 * 72] = (bfr)(v.y & 0xffffu); d[3 * 72] = (bfr)(v.y >> 16);
    d[4 * 72] = (bfr)(v.z & 0xffffu); d[5 * 72] = (bfr)(v.z >> 16);
    d[6 * 72] = (bfr)(v.w & 0xffffu); d[7 * 72] = (bfr)(v.w >> 16);
  }
}

template <int DK, bool GLA>
__device__ void scan_a_item(const Params& p, int layer, int item, char* smem) {
  const int g = item % 132;
  const int t2 = item / 132;
  const int h = t2 & 3, b = t2 >> 2;
  constexpr int KS = DK + 4;
  float* ks = (float*)smem;
  float* E0 = ks + 64 * KS;
  float* E1 = E0 + 64 * 68;
  bfr* Kt = (bfr*)(E1 + 64 * 68);
  bfr* Vt = Kt + DK * 72;
  const int tid = get_tid();
  const int w = tid >> 6, lane = tid & 63, fr = lane & 15, q4 = lane >> 4;
  const int row0 = group_row0(b, g);
  const bfr* rowbase = p.proj + (size_t)row0 * DINP;
  __syncthreads();
  if (GLA) {
    load_rows_transposed<128>(Vt, rowbase + C_GLV + h * 128);
    load_rows_f32<64>(ks, KS, rowbase + C_GLK + h * 64, 1.f);
    gla_logdecay2(p, layer, h, rowbase, E0, E1);
  } else {
    const float kscale = 0.08838834764831845f;
    load_rows_transposed<128>(Vt, rowbase + C_RTV + h * 128);
    load_rows_f32<128>(ks, KS, rowbase + C_RTK + h * 128, g < 4 ? kscale : 1.f);
    __syncthreads();
    if (g >= 4) rope128_tile(ks, KS, g - 4, p.rope, kscale);
  }
#pragma unroll 1
  for (int dir = 0; dir < 2; ++dir) {
    const int scan = ((b * 4 + h) * 2 + dir);
    const int pos = scan_pos(dir, g);
    float lg = 0.f;
    __syncthreads();
    float* E = dir ? E1 : E0;
    if (GLA) {
      if (tid < 64) {
        float run = 0.f;
        if (dir == 0) {
          for (int j = 63; j >= 0; --j) { float v = E[j * 68 + tid]; E[j * 68 + tid] = run; run += v; }
        } else {
          for (int j = 0; j < 64; ++j) { float v = E[j * 68 + tid]; E[j * 68 + tid] = run; run += v; }
        }
        p.dec_gla[(size_t)(scan * 132 + pos) * 64 + tid] = __expf(run);
      }
      __syncthreads();
    } else {
      lg = p.ret_lg[layer * 8 + dir * 4 + h];
      if (tid < 128) p.dec_ret[(size_t)(scan * 132 + pos) * 128 + tid] = __expf(lg * 64.f);
    }
    for (int u = tid; u < 64 * DK; u += NTHR) {
      const int j = u & 63, d = u >> 6;
      const float sc = GLA ? __expf(E[j * 68 + d]) : __expf(lg * (dir == 0 ? (float)(63 - j) : (float)j));
      Kt[d * 72 + j] = f2bf(ks[j * KS + d] * sc);
    }
    __syncthreads();
    bf16x8 vfr[2];
#pragma unroll
    for (int k2 = 0; k2 < 2; ++k2) vfr[k2] = *(const bf16x8*)(Vt + (w * 16 + fr) * 72 + k2 * 32 + q4 * 8);
    bfr* st = (GLA ? p.st_gla : p.st_ret) + (size_t)(scan * 132 + pos) * DK * 128;
#pragma unroll 2
    for (int dt = 0; dt < DK / 16; ++dt) {
      f32x4 acc = (f32x4){0.f, 0.f, 0.f, 0.f};
#pragma unroll
      for (int k2 = 0; k2 < 2; ++k2) {
        const bf16x8 kq = *(const bf16x8*)(Kt + (dt * 16 + fr) * 72 + k2 * 32 + q4 * 8);
        acc = MFMA16(kq, vfr[k2], acc);
      }
      uint2 o;
      o.x = pack2(acc[0], acc[1]); o.y = pack2(acc[2], acc[3]);
      *(uint2*)(st + (size_t)(w * 16 + fr) * DK + dt * 16 + q4 * 4) = o;
    }
  }
}

__device__ void scan_b_phase(const Params& p) {
  const int gt = get_bid() * NTHR + get_tid(), ntot = gridDim.x * NTHR;
  for (int ch = gt; ch < 98304; ch += ntot) {
    bfr* st; const float* dec; int DK, e4;
    if (ch < 65536) { int scan = ch >> 12; e4 = ch & 4095; DK = 128; st = p.st_ret + (size_t)scan * 132 * 16384; dec = p.dec_ret + (size_t)scan * 132 * 128; }
    else { int c2 = ch - 65536; int scan = c2 >> 11; e4 = c2 & 2047; DK = 64; st = p.st_gla + (size_t)scan * 132 * 8192; dec = p.dec_gla + (size_t)scan * 132 * 64; }
    const int d0 = (e4 * 4) & (DK - 1);
    const size_t cstride = (size_t)DK * 128;
    float4 s = make_float4(0.f, 0.f, 0.f, 0.f);
    bfr* ptr = st + e4 * 4;
    const float* dp = dec + d0;
    for (int pos = 0; pos < 132; pos += 4) {
      uint2 u[4];
      float4 dv[4];
#pragma unroll
      for (int q = 0; q < 4; ++q) {
        u[q] = *(const uint2*)(ptr + (size_t)(pos + q) * cstride);
        dv[q] = *(const float4*)(dp + (pos + q) * DK);
      }
#pragma unroll
      for (int q = 0; q < 4; ++q) {
        uint2 o;
        o.x = pack2(s.x, s.y); o.y = pack2(s.z, s.w);
        *(uint2*)(ptr + (size_t)(pos + q) * cstride) = o;
        s = make_float4(dv[q].x * s.x + lo16(u[q].x), dv[q].y * s.y + hi16(u[q].x), dv[q].z * s.z + lo16(u[q].y), dv[q].w * s.w + hi16(u[q].y));
      }
    }
  }
}

template <int DK, bool GLA>
__device__ void scan_c_item(const Params& p, int layer, int item, char* smem) {
  const int g = item % 132;
  const int t2 = item / 132;
  const int h = t2 & 3, b = t2 >> 2;
  constexpr int FS = DK + 4;
  constexpr int QS = DK + 8;
  float* stg = (float*)smem;
  float* Gf = stg + 64 * FS;
  float* Gb = Gf + (GLA ? 64 * 68 : 0);
  float* red = Gb + (GLA ? 64 * 68 : 0);
  float* red2 = red + 8 * 64 * 2;
  bfr* T0 = (bfr*)(red2 + 64 * 2);
  bfr* T1 = T0 + 64 * QS;
  bfr* T2 = T1 + 64 * QS;
  bfr* T3 = T2 + 64 * QS;
  bfr* T4 = T3 + 64 * QS;
  bfr* T5 = T4 + (GLA ? 64 * QS : 0);
  bfr* Vt = T5 + (GLA ? 64 * QS : 0);
  bfr* Am = Vt + 128 * 72;
  const int tid = get_tid();
  const int w = tid >> 6, lane = tid & 63, fr = lane & 15, q4 = lane >> 4;
  const int row0 = group_row0(b, g);
  const bfr* rowbase = p.proj + (size_t)row0 * DINP;
  float lgf = 0.f, lgb = 0.f;
  __syncthreads();
  if (GLA) {
    load_rows_transposed<128>(Vt, rowbase + C_GLV + h * 128);
    load_rows_f32<64>(stg, FS, rowbase + C_GLQ + h * 64, 0.125f);
    gla_logdecay2(p, layer, h, rowbase, Gf, Gb);
    __syncthreads();
    {
      const int d = tid & 63, seg = tid >> 6;
      float runf = 0.f, runb = 0.f;
#pragma unroll
      for (int jj = 0; jj < 8; ++jj) {
        const int jf = seg * 8 + jj, jb = seg * 8 + 7 - jj;
        runf += Gf[jf * 68 + d]; Gf[jf * 68 + d] = runf;
        runb += Gb[jb * 68 + d]; Gb[jb * 68 + d] = runb;
      }
      red[seg * 64 + d] = runf;
      red[512 + seg * 64 + d] = runb;
      __syncthreads();
      float offf = 0.f, offb = 0.f;
#pragma unroll
      for (int s2 = 0; s2 < 8; ++s2) {
        if (s2 < seg) offf += red[s2 * 64 + d];
        if (s2 > seg) offb += red[512 + s2 * 64 + d];
      }
#pragma unroll
      for (int jj = 0; jj < 8; ++jj) {
        const int j = seg * 8 + jj;
        Gf[j * 68 + d] += offf;
        Gb[j * 68 + d] += offb;
      }
    }
    __syncthreads();
    for (int u = tid; u < 64 * 64; u += NTHR) {
      const int i = u >> 6, d = u & 63;
      const float qv = stg[i * FS + d];
      const float gf = Gf[i * 68 + d], gb = Gb[i * 68 + d];
      T0[i * QS + d] = f2bf(qv * __expf(gf - Gf[63 * 68 + d]));
      T2[i * QS + d] = f2bf(qv * __expf(gf));
      T4[i * QS + d] = f2bf(qv * __expf(gb - Gb[d]));
      T3[i * QS + d] = f2bf(qv * __expf(gb));
    }
    __syncthreads();
    load_rows_f32<64>(stg, FS, rowbase + C_GLK + h * 64, 1.f);
    __syncthreads();
    for (int u = tid; u < 64 * 64; u += NTHR) {
      const int j = u >> 6, d = u & 63;
      const float kv = stg[j * FS + d];
      T1[j * QS + d] = f2bf(kv * __expf(Gf[63 * 68 + d] - Gf[j * 68 + d]));
      T5[j * QS + d] = f2bf(kv * __expf(Gb[d] - Gb[j * 68 + d]));
    }
  } else {
    const float kscale = 0.08838834764831845f;
    lgf = p.ret_lg[layer * 8 + 0 + h];
    lgb = p.ret_lg[layer * 8 + 4 + h];
    load_rows_transposed<128>(Vt, rowbase + C_RTV + h * 128);
    {
      const int j = tid >> 3, A = (tid >> 2) & 1, fc = tid & 3;
      float cs[8], sn[8];
      if (g >= 4) {
        const int pos = A ? j : (g - 4);
        const float* cp = p.rope + 4096 + pos * 32 + fc * 8;
        const float4 c0 = *(const float4*)cp, c1 = *(const float4*)(cp + 4);
        const float4 s0 = *(const float4*)(cp + 4096), s1 = *(const float4*)(cp + 4100);
        cs[0] = c0.x; cs[1] = c0.y; cs[2] = c0.z; cs[3] = c0.w; cs[4] = c1.x; cs[5] = c1.y; cs[6] = c1.z; cs[7] = c1.w;
        sn[0] = s0.x; sn[1] = s0.y; sn[2] = s0.z; sn[3] = s0.w; sn[4] = s1.x; sn[5] = s1.y; sn[6] = s1.z; sn[7] = s1.w;
      } else {
#pragma unroll
        for (int e = 0; e < 8; ++e) { cs[e] = 1.f; sn[e] = 0.f; }
      }
      const int col = A * 64 + fc * 8;
      const bfr* qp = rowbase + (size_t)j * DINP + C_RTQ + h * 128 + col;
      const bfr* kp = rowbase + (size_t)j * DINP + C_RTK + h * 128 + col;
      const u4 q1 = *(const u4*)qp, q2 = *(const u4*)(qp + 32);
      const u4 k1 = *(const u4*)kp, k2w = *(const u4*)(kp + 32);
      float x1[8], x2[8], y1[8], y2[8];
      unpack8(q1, x1); unpack8(q2, x2);
#pragma unroll
      for (int e = 0; e < 8; ++e) { y1[e] = x1[e] * cs[e] - x2[e] * sn[e]; y2[e] = x2[e] * cs[e] + x1[e] * sn[e]; }
      const float ff = __expf(lgf * (float)(j + 1)), fb = __expf(lgb * (float)(64 - j));
      u4 o;
      o.x = pack2(y1[0], y1[1]); o.y = pack2(y1[2], y1[3]); o.z = pack2(y1[4], y1[5]); o.w = pack2(y1[6], y1[7]);
      *(u4*)(T0 + j * QS + col) = o;
      o.x = pack2(y2[0], y2[1]); o.y = pack2(y2[2], y2[3]); o.z = pack2(y2[4], y2[5]); o.w = pack2(y2[6], y2[7]);
      *(u4*)(T0 + j * QS + col + 32) = o;
      o.x = pack2(y1[0] * ff, y1[1] * ff); o.y = pack2(y1[2] * ff, y1[3] * ff); o.z = pack2(y1[4] * ff, y1[5] * ff); o.w = pack2(y1[6] * ff, y1[7] * ff);
      *(u4*)(T2 + j * QS + col) = o;
      o.x = pack2(y2[0] * ff, y2[1] * ff); o.y = pack2(y2[2] * ff, y2[3] * ff); o.z = pack2(y2[4] * ff, y2[5] * ff); o.w = pack2(y2[6] * ff, y2[7] * ff);
      *(u4*)(T2 + j * QS + col + 32) = o;
      o.x = pack2(y1[0] * fb, y1[1] * fb); o.y = pack2(y1[2] * fb, y1[3] * fb); o.z = pack2(y1[4] * fb, y1[5] * fb); o.w = pack2(y1[6] * fb, y1[7] * fb);
      *(u4*)(T3 + j * QS + col) = o;
      o.x = pack2(y2[0] * fb, y2[1] * fb); o.y = pack2(y2[2] * fb, y2[3] * fb); o.z = pack2(y2[4] * fb, y2[5] * fb); o.w = pack2(y2[6] * fb, y2[7] * fb);
      *(u4*)(T3 + j * QS + col + 32) = o;
      unpack8(k1, x1); unpack8(k2w, x2);
#pragma unroll
      for (int e = 0; e < 8; ++e) { y1[e] = (x1[e] * cs[e] - x2[e] * sn[e]) * kscale; y2[e] = (x2[e] * cs[e] + x1[e] * sn[e]) * kscale; }
      o.x = pack2(y1[0], y1[1]); o.y = pack2(y1[2], y1[3]); o.z = pack2(y1[4], y1[5]); o.w = pack2(y1[6], y1[7]);
      *(u4*)(T1 + j * QS + col) = o;
      o.x = pack2(y2[0], y2[1]); o.y = pack2(y2[2], y2[3]); o.z = pack2(y2[4], y2[5]); o.w = pack2(y2[6], y2[7]);
      *(u4*)(T1 + j * QS + col + 32) = o;
    }
  }
  __syncthreads();
  {
    const int ti = w >> 1;
#pragma unroll
    for (int tt = 0; tt < 2; ++tt) {
      const int tj = (w & 1) * 2 + tt;
      f32x4 af = (f32x4){0.f, 0.f, 0.f, 0.f}, ab = af;
#pragma unroll
      for (int k2 = 0; k2 < DK / 32; ++k2) {
        const bf16x8 a = *(const bf16x8*)(T0 + (ti * 16 + fr) * QS + k2 * 32 + q4 * 8);
        const bf16x8 bq = *(const bf16x8*)(T1 + (tj * 16 + fr) * QS + k2 * 32 + q4 * 8);
        af = MFMA16(a, bq, af);
        if (GLA) {
          const bf16x8 a2 = *(const bf16x8*)(T4 + (ti * 16 + fr) * QS + k2 * 32 + q4 * 8);
          const bf16x8 b2 = *(const bf16x8*)(T5 + (tj * 16 + fr) * QS + k2 * 32 + q4 * 8);
          ab = MFMA16(a2, b2, ab);
        }
      }
#pragma unroll
      for (int r = 0; r < 4; ++r) {
        const int i = ti * 16 + q4 * 4 + r, j = tj * 16 + fr;
        float v;
        if (GLA) v = (j <= i) ? af[r] : ab[r];
        else v = af[r] * ((j <= i) ? __expf(lgf * (float)(i - j)) : __expf(lgb * (float)(j - i)));
        Am[i * 72 + j] = f2bf(v);
      }
    }
  }
  __syncthreads();
  f32x4 acc[4];
#pragma unroll
  for (int rt = 0; rt < 4; ++rt) acc[rt] = (f32x4){0.f, 0.f, 0.f, 0.f};
#pragma unroll
  for (int k2 = 0; k2 < 2; ++k2) {
    const bf16x8 bq = *(const bf16x8*)(Vt + (w * 16 + fr) * 72 + k2 * 32 + q4 * 8);
#pragma unroll
    for (int rt = 0; rt < 4; ++rt) {
      const bf16x8 a = *(const bf16x8*)(Am + (rt * 16 + fr) * 72 + k2 * 32 + q4 * 8);
      acc[rt] = MFMA16(a, bq, acc[rt]);
    }
  }
#pragma unroll
  for (int dir = 0; dir < 2; ++dir) {
    const int scan = (b * 4 + h) * 2 + dir;
    const int pos = scan_pos(dir, g);
    const bfr* St = (GLA ? p.st_gla : p.st_ret) + (size_t)(scan * 132 + pos) * DK * 128 + (size_t)(w * 16 + fr) * DK + q4 * 8;
    const bfr* qt = dir == 0 ? T2 : T3;
#pragma unroll
    for (int k2 = 0; k2 < DK / 32; ++k2) {
      const bf16x8 bq = *(const bf16x8*)(St + k2 * 32);
#pragma unroll
      for (int rt = 0; rt < 4; ++rt) {
        const bf16x8 a = *(const bf16x8*)(qt + (rt * 16 + fr) * QS + k2 * 32 + q4 * 8);
        acc[rt] = MFMA16(a, bq, acc[rt]);
      }
    }
  }
#pragma unroll
  for (int rt = 0; rt < 4; ++rt)
#pragma unroll
    for (int r = 0; r < 4; ++r) {
      float s1 = acc[rt][r], s2 = s1 * s1;
#pragma unroll
      for (int of = 8; of; of >>= 1) { s1 += __shfl_xor(s1, of); s2 += __shfl_xor(s2, of); }
      if (fr == 0) {
        const int i = rt * 16 + q4 * 4 + r;
        red[(w * 64 + i) * 2 + 0] = s1;
        red[(w * 64 + i) * 2 + 1] = s2;
      }
    }
  __syncthreads();
  if (tid < 128) {
    const int i = tid >> 1, c = tid & 1;
    float t = 0.f;
#pragma unroll
    for (int ww = 0; ww < 8; ++ww) t += red[(ww * 64 + i) * 2 + c];
    red2[i * 2 + c] = t;
  }
  __syncthreads();
  const int gcol = GLA ? C_GLG : C_RTG;
  const int ocol = GLA ? 1024 : 512;
  const int vcol = h * 128 + w * 16 + fr;
  const float gg = GLA ? p.gla_g[layer * 128 + w * 16 + fr] : 1.f;
#pragma unroll
  for (int rt = 0; rt < 4; ++rt)
#pragma unroll
    for (int r = 0; r < 4; ++r) {
      const int i = rt * 16 + q4 * 4 + r;
      const float S1 = red2[i * 2 + 0], S2 = red2[i * 2 + 1];
      float y;
      if (GLA) {
        y = acc[rt][r] * rsqrtf(S2 * (1.f / 128.f) + EPS) * gg;
      } else {
        const float mu = S1 * (1.f / 128.f);
        const float var = fmaxf(S2 * (1.f / 128.f) - mu * mu, 0.f);
        y = (acc[rt][r] - mu) * rsqrtf(var + EPS);
      }
      const int row = row0 + i;
      const float gt = bf2f(p.proj[(size_t)row * DINP + gcol + vcol]);
      y *= silu_f(gt);
      p.mix[(size_t)row * D + ocol + vcol] = f2bf(y);
    }
}

__constant__ unsigned char c_cand_tab[64] = {0, 1, 2, 3, 4, 5, 6, 7, 8, 9, 10, 11, 12, 13, 14, 15, 16, 17, 18, 19, 20, 21, 22, 23, 32, 33, 34, 35, 36, 48, 49, 50, 51, 64, 65, 66, 80, 81, 96, 97, 112, 113, 128, 144, 160, 176, 192, 208, 224, 240, 255, 255, 255, 255, 255, 255, 255, 255, 255, 255, 255, 255, 255, 255};

template <int N>
__device__ __forceinline__ void bitonic_sort_desc(float (&v)[N]) {
#pragma unroll
  for (int k = 2; k <= N; k <<= 1)
#pragma unroll
    for (int j = k >> 1; j > 0; j >>= 1)
#pragma unroll
      for (int i = 0; i < N; ++i) {
        const int l = i ^ j;
        if (l > i) {
          const bool desc = ((i & k) == 0);
          const float x = v[i], y = v[l];
          const float hi = fmaxf(x, y), lo = fminf(x, y);
          v[i] = desc ? hi : lo;
          v[l] = desc ? lo : hi;
        }
      }
}
__device__ __forceinline__ void merge_top16(float (&v)[16], const int xl) {
  float o[16];
#pragma unroll
  for (int i = 0; i < 16; ++i) o[i] = __shfl_xor(v[15 - i], xl);
#pragma unroll
  for (int i = 0; i < 16; ++i) v[i] = fmaxf(v[i], o[i]);
#pragma unroll
  for (int j = 8; j > 0; j >>= 1)
#pragma unroll
    for (int i = 0; i < 16; ++i) {
      const int l = i ^ j;
      if (l > i) {
        const float x = v[i], y = v[l];
        v[i] = fmaxf(x, y);
        v[l] = fminf(x, y);
      }
    }
}
__device__ __forceinline__ float pack_key(float x, unsigned mask, unsigned key) {
  return __uint_as_float((__float_as_uint(x) & ~mask) | key);
}

__device__ void topk_phase(const Params& p, int layer, int ntok, char* smem) {
  float* sc = (float*)smem;
  const int tid = get_tid();
  const int lane = tid & 63, w = tid >> 6, fr = lane & 15, q4 = lane >> 4;
  const int nbatch = ntok >> 4;
  for (int bt = get_bid(); bt < nbatch; bt += gridDim.x) {
    __syncthreads();
#pragma unroll 1
    for (int pp = 0; pp < 2; ++pp) {
      const int pair = 2 * w + pp;
      const bfr* qrow = p.q + (size_t)(bt * 16 + fr) * D + pair * 128 + q4 * 8;
      const bfr* skb = p.sk_bf + (size_t)(((layer * 2 + (pair & 1)) * 8 + (pair >> 1))) * 128 * 128 + q4 * 8;
      bf16x8 af[4];
#pragma unroll
      for (int k2 = 0; k2 < 4; ++k2) af[k2] = *(const bf16x8*)(qrow + k2 * 32);
#pragma unroll 4
      for (int nt = 0; nt < 8; ++nt) {
        f32x4 acc = (f32x4){0.f, 0.f, 0.f, 0.f};
#pragma unroll
        for (int k2 = 0; k2 < 4; ++k2) {
          const bf16x8 bq = *(const bf16x8*)(skb + (size_t)(nt * 16 + fr) * 128 + k2 * 32);
          acc = MFMA16(af[k2], bq, acc);
        }
#pragma unroll
        for (int r = 0; r < 4; ++r) sc[((q4 * 4 + r) * 16 + pair) * 132 + nt * 16 + fr] = acc[r];
      }
    }
    __syncthreads();
#pragma unroll 1
    for (int ps = 0; ps < 2; ++ps) {
      const int list = ps * 128 + (tid >> 2), qd = tid & 3;
      float v[32];
#pragma unroll
      for (int j = 0; j < 8; ++j) {
        float4 t = *(const float4*)(sc + list * 132 + qd * 32 + j * 4);
        const unsigned kb = qd * 32 + j * 4;
        v[j * 4 + 0] = pack_key(t.x, 127u, kb + 0); v[j * 4 + 1] = pack_key(t.y, 127u, kb + 1);
        v[j * 4 + 2] = pack_key(t.z, 127u, kb + 2); v[j * 4 + 3] = pack_key(t.w, 127u, kb + 3);
      }
      bitonic_sort_desc<32>(v);
      float wv[16];
#pragma unroll
      for (int i = 0; i < 16; ++i) wv[i] = v[i];
      merge_top16(wv, 1);
      merge_top16(wv, 2);
      if (qd == 0) {
#pragma unroll
        for (int j = 0; j < 4; ++j)
          *(float4*)(sc + list * 132 + j * 4) = make_float4(wv[j * 4 + 0], wv[j * 4 + 1], wv[j * 4 + 2], wv[j * 4 + 3]);
      }
    }
    __syncthreads();
    {
      const int pair = tid >> 2, qd = tid & 3;
      const int tok = pair >> 3, hh = pair & 7;
      const float* o0 = sc + (tok * 16 + hh * 2) * 132;
      const float* o1 = o0 + 132;
      float c[16];
#pragma unroll
      for (int i = 0; i < 16; ++i) {
        const unsigned code = c_cand_tab[qd * 16 + i];
        const float sum = o0[code >> 4] + o1[code & 15];
        c[i] = (code == 255u) ? -INFINITY : pack_key(sum, 255u, code);
      }
      bitonic_sort_desc<16>(c);
      merge_top16(c, 1);
      merge_top16(c, 2);
      float e[16];
      float esum = 0.f;
#pragma unroll
      for (int i = 0; i < 16; ++i) { e[i] = __expf(c[i] - c[0]); esum += e[i]; }
      const float inv = 1.f / esum;
      const int m = bt * 16 + tok;
#pragma unroll
      for (int j = 0; j < 4; ++j) {
        const float ev = qd == 0 ? e[j] : (qd == 1 ? e[4 + j] : (qd == 2 ? e[8 + j] : e[12 + j]));
        const float cv = qd == 0 ? c[j] : (qd == 1 ? c[4 + j] : (qd == 2 ? c[8 + j] : c[12 + j]));
        const unsigned code = __float_as_uint(cv) & 255u;
        const unsigned k0 = __float_as_uint(o0[code >> 4]) & 127u;
        const unsigned k1 = __float_as_uint(o1[code & 15]) & 127u;
        p.pidx[(size_t)m * 128 + hh * 16 + qd * 4 + j] = (int)(k0 * 128u + k1);
        p.pgate[(size_t)m * 128 + hh * 16 + qd * 4 + j] = ev * inv;
      }
    }
  }
}

typedef __attribute__((ext_vector_type(2))) float f32x2;
__device__ __forceinline__ float dot16_fp8(const float* hf, const u4 w) {
  f32x2 a0 = __builtin_amdgcn_cvt_pk_f32_fp8((int)w.x, false), a1 = __builtin_amdgcn_cvt_pk_f32_fp8((int)w.x, true);
  f32x2 b0 = __builtin_amdgcn_cvt_pk_f32_fp8((int)w.y, false), b1 = __builtin_amdgcn_cvt_pk_f32_fp8((int)w.y, true);
  f32x2 c0 = __builtin_amdgcn_cvt_pk_f32_fp8((int)w.z, false), c1 = __builtin_amdgcn_cvt_pk_f32_fp8((int)w.z, true);
  f32x2 d0 = __builtin_amdgcn_cvt_pk_f32_fp8((int)w.w, false), d1 = __builtin_amdgcn_cvt_pk_f32_fp8((int)w.w, true);
  return hf[0] * a0.x + hf[1] * a0.y + hf[2] * a1.x + hf[3] * a1.y + hf[4] * b0.x + hf[5] * b0.y + hf[6] * b1.x + hf[7] * b1.y +
         hf[8] * c0.x + hf[9] * c0.y + hf[10] * c1.x + hf[11] * c1.y + hf[12] * d0.x + hf[13] * d0.y + hf[14] * d1.x + hf[15] * d1.y;
}
__device__ __forceinline__ void fma16_fp8(float* o, float c, const u4 w) {
  f32x2 a0 = __builtin_amdgcn_cvt_pk_f32_fp8((int)w.x, false), a1 = __builtin_amdgcn_cvt_pk_f32_fp8((int)w.x, true);
  f32x2 b0 = __builtin_amdgcn_cvt_pk_f32_fp8((int)w.y, false), b1 = __builtin_amdgcn_cvt_pk_f32_fp8((int)w.y, true);
  f32x2 c0 = __builtin_amdgcn_cvt_pk_f32_fp8((int)w.z, false), c1 = __builtin_amdgcn_cvt_pk_f32_fp8((int)w.z, true);
  f32x2 d0 = __builtin_amdgcn_cvt_pk_f32_fp8((int)w.w, false), d1 = __builtin_amdgcn_cvt_pk_f32_fp8((int)w.w, true);
  o[0] += c * a0.x; o[1] += c * a0.y; o[2] += c * a1.x; o[3] += c * a1.y;
  o[4] += c * b0.x; o[5] += c * b0.y; o[6] += c * b1.x; o[7] += c * b1.y;
  o[8] += c * c0.x; o[9] += c * c0.y; o[10] += c * c1.x; o[11] += c * c1.y;
  o[12] += c * d0.x; o[13] += c * d0.y; o[14] += c * d1.x; o[15] += c * d1.y;
}

__device__ void peer_phase(const Params& p, int layer, int ntok) {
  const int lane = get_tid() & 63;
  const int wave = get_bid() * 8 + (get_tid() >> 6), nw = gridDim.x * 8;
  const unsigned char* U = p.u8 + (size_t)layer * 16384 * D;
  const unsigned char* V = p.v8 + (size_t)layer * 16384 * D;
  const float* usc = p.uscl + layer * 16384;
  const float* vsc = p.vscl + layer * 16384;
  for (int m = wave; m < ntok; m += nw) {
    float hf[32];
    const bfr* hr = p.h + (size_t)m * D + lane * 16;
#pragma unroll
    for (int i = 0; i < 2; ++i) {
      u4 w0 = *(const u4*)(hr + i * 1024), w1 = *(const u4*)(hr + i * 1024 + 8);
      unpack8(w0, hf + i * 16);
      unpack8(w1, hf + i * 16 + 8);
    }
    const int idA = p.pidx[(size_t)m * 128 + lane], idB = p.pidx[(size_t)m * 128 + 64 + lane];
    const float gA = p.pgate[(size_t)m * 128 + lane] * vsc[idA], gB = p.pgate[(size_t)m * 128 + 64 + lane] * vsc[idB];
    const float usA = usc[idA], usB = usc[idB];
    float cA = 0.f, cB = 0.f;
#pragma unroll 1
    for (int e0 = 0; e0 < 128; e0 += 8) {
      u4 r[8][2];
#pragma unroll
      for (int u = 0; u < 8; ++u) {
        int e = e0 + u;
        int row = __shfl(e0 < 64 ? idA : idB, e & 63);
        const unsigned char* up = U + (size_t)row * D + lane * 16;
        r[u][0] = *(const u4*)(up);
        r[u][1] = *(const u4*)(up + 1024);
      }
      __builtin_amdgcn_sched_barrier(0);
#pragma unroll
      for (int u = 0; u < 8; ++u) {
        int e = e0 + u;
        float dsum = dot16_fp8(hf, r[u][0]) + dot16_fp8(hf + 16, r[u][1]);
        dsum = wave_sum(dsum);
        if (e0 < 64) { if (lane == e) cA = gA * gelu_f(dsum * usA); }
        else { if (lane == e - 64) cB = gB * gelu_f(dsum * usB); }
        __builtin_amdgcn_sched_barrier(0);
      }
    }
    float o[32];
#pragma unroll
    for (int i = 0; i < 32; ++i) o[i] = 0.f;
#pragma unroll 1
    for (int e0 = 0; e0 < 128; e0 += 4) {
      u4 r[4][2];
      float cf[4];
#pragma unroll
      for (int u = 0; u < 4; ++u) {
        int e = e0 + u;
        int row = __shfl(e0 < 64 ? idA : idB, e & 63);
        cf[u] = __shfl(e0 < 64 ? cA : cB, e & 63);
        const unsigned char* vp = V + (size_t)row * D + lane * 16;
        r[u][0] = *(const u4*)(vp);
        r[u][1] = *(const u4*)(vp + 1024);
      }
      __builtin_amdgcn_sched_barrier(0);
#pragma unroll
      for (int u = 0; u < 4; ++u) {
        fma16_fp8(o, cf[u], r[u][0]);
        fma16_fp8(o + 16, cf[u], r[u][1]);
        __builtin_amdgcn_sched_barrier(0);
      }
    }
    const int vec = m < S ? 0 : (m < MX ? 1 : 2);
    const float* modl = p.mod + (layer * 3 + vec) * 12288;
    float* xr = p.xcur + (size_t)m * D + lane * 16;
    float xn[32];
    float ss = 0.f;
#pragma unroll
    for (int i = 0; i < 2; ++i)
#pragma unroll
      for (int k = 0; k < 4; ++k) {
        int col = i * 1024 + lane * 16 + k * 4;
        float4 a = *(const float4*)(xr + i * 1024 + k * 4);
        float4 g0 = *(const float4*)(modl + 5 * D + col);
        float* xx = xn + i * 16 + k * 4;
        const float* oo = o + i * 16 + k * 4;
        xx[0] = a.x + g0.x * oo[0]; xx[1] = a.y + g0.y * oo[1]; xx[2] = a.z + g0.z * oo[2]; xx[3] = a.w + g0.w * oo[3];
        ss += xx[0] * xx[0] + xx[1] * xx[1] + xx[2] * xx[2] + xx[3] * xx[3];
      }
    ss = wave_sum(ss);
    const float rstd = rsqrtf(ss * (1.f / D) + EPS);
    if (layer == 1) {
      float* orow = p.out + (size_t)m * D;
#pragma unroll
      for (int i = 0; i < 2; ++i)
#pragma unroll
        for (int k = 0; k < 4; ++k) {
          int col = i * 1024 + lane * 16 + k * 4;
          float4 f0 = *(const float4*)(p.final_g + col);
          const float* xx = xn + i * 16 + k * 4;
          *(float4*)(orow + col) = make_float4(xx[0] * rstd * f0.x, xx[1] * rstd * f0.y, xx[2] * rstd * f0.z, xx[3] * rstd * f0.w);
        }
    } else {
      const float* modn = p.mod + ((layer + 1) * 3 + vec) * 12288;
      const float* gn = p.g_attn + (layer + 1) * D;
#pragma unroll
      for (int i = 0; i < 2; ++i) {
        float y[16];
#pragma unroll
        for (int k = 0; k < 4; ++k) {
          int col = i * 1024 + lane * 16 + k * 4;
          const float* xx = xn + i * 16 + k * 4;
          *(float4*)(xr + i * 1024 + k * 4) = make_float4(xx[0], xx[1], xx[2], xx[3]);
          float4 gv = *(const float4*)(gn + col), scv = *(const float4*)(modn + D + col), shv = *(const float4*)(modn + col);
          y[k * 4 + 0] = xx[0] * rstd * gv.x * (1.f + scv.x) + shv.x;
          y[k * 4 + 1] = xx[1] * rstd * gv.y * (1.f + scv.y) + shv.y;
          y[k * 4 + 2] = xx[2] * rstd * gv.z * (1.f + scv.z) + shv.z;
          y[k * 4 + 3] = xx[3] * rstd * gv.w * (1.f + scv.w) + shv.w;
        }
        u4 w0, w1;
        w0.x = pack2(y[0], y[1]); w0.y = pack2(y[2], y[3]); w0.z = pack2(y[4], y[5]); w0.w = pack2(y[6], y[7]);
        w1.x = pack2(y[8], y[9]); w1.y = pack2(y[10], y[11]); w1.z = pack2(y[12], y[13]); w1.w = pack2(y[14], y[15]);
        *(u4*)(p.h + (size_t)m * D + i * 1024 + lane * 16) = w0;
        *(u4*)(p.h + (size_t)m * D + i * 1024 + lane * 16 + 8) = w1;
      }
    }
  }
}

constexpr int PH_INIT = 0, PH_MOD_ATTN = 1, PH_INPROJ = 2, PH_MIX1 = 3, PH_SCANB = 4, PH_SCANC = 5, PH_OUTPROJ = 6,
              PH_MOD_FFN = 7, PH_QPROJ = 8, PH_SCORES = 9, PH_TOPK = 10, PH_PEER = 11;

template <int EPI, bool ALLOW_BIG>
__device__ __forceinline__ void gemm_phase(const Params& p, int layer, int vid, const bfr* A, const bfr* Bt, int MB, int MT,
                                           int NB, int N128, int small_nt, void* Cout, int ldc, char* smem) {
  const int nbig = MB * NB;
  const int nsm1 = small_nt >= 0 ? MB : 0;
  const int nsm2 = (MT - MB) * N128;
  const int total = nbig + nsm1 + nsm2;
  for (int t = vid; t < total; t += gridDim.x) {
    if (t < nbig) {
      if constexpr (ALLOW_BIG) {
        const int mt = t / NB, nt = t - mt * NB;
        gemm_tile<EPI, true>(A, D, Bt, D, D, mt * 256, nt * 256, Cout, ldc, p, layer, smem);
      }
    } else if (t < nbig + nsm1) {
      gemm_tile<EPI, false>(A, D, Bt, D, D, (t - nbig) * 256, small_nt * 128, Cout, ldc, p, layer, smem);
    } else {
      const int u = t - nbig - nsm1;
      const int mt = MB + u / N128, nt = u % N128;
      gemm_tile<EPI, false>(A, D, Bt, D, D, mt * 256, nt * 128, Cout, ldc, p, layer, smem);
    }
  }
}

__device__ void run_phase(const Params& p, int ph, int layer, char* smem, int vid) {
  const int bid = get_bid(), nb = gridDim.x;
  const bool last = (layer == 1);
  switch (ph) {
    case PH_INIT: phase0(p, smem); break;
    case PH_MOD_ATTN: modulate_phase(p, layer, 0, MT); break;
    case PH_INPROJ:
      gemm_phase<0, true>(p, layer, vid, p.h, p.wt_in + (size_t)layer * DINP * D, 66, 66, 23, 47, 46, p.proj, DINP, smem);
      break;
    case PH_MIX1: {
      const int n_swa = 256, n_na = 2048, n_sa = 1056, n_ctx = last ? 0 : 32;
      const int total = n_swa + n_na + 2 * n_sa + n_ctx;
      for (int it = bid; it < total; it += nb) {
        int t = it;
        if (t < n_swa) { swa_item(p, layer, t, smem); continue; }
        t -= n_swa;
        if (t < n_na) { na_item(p, layer, t, smem); continue; }
        t -= n_na;
        if (t < n_sa) { scan_a_item<128, false>(p, layer, t, smem); continue; }
        t -= n_sa;
        if (t < n_sa) { scan_a_item<64, true>(p, layer, t, smem); continue; }
        t -= n_sa;
        ctx_item(p, layer, t, smem);
      }
    } break;
    case PH_SCANB: scan_b_phase(p); break;
    case PH_SCANC:
      for (int it = bid; it < 2 * 1056; it += nb) {
        const bool gla = it < 1056;
        const int t = gla ? it : it - 1056;
        if (last && (t % 132) < 4) continue;
        if (gla) scan_c_item<64, true>(p, layer, t, smem);
        else scan_c_item<128, false>(p, layer, t, smem);
      }
      break;
    case PH_OUTPROJ: {
      gemm_phase<1, false>(p, layer, vid, p.mix, p.wt_out + (size_t)layer * D * D, 0, last ? 64 : 66, 8, 16, -1, nullptr, 0, smem);
    } break;
    case PH_MOD_FFN: modulate_phase(p, layer, 1, last ? MX : MT); break;
    case PH_QPROJ: {
      gemm_phase<0, true>(p, layer, vid, p.h, p.wt_q + (size_t)layer * D * D, 64, last ? 64 : 66, 8, 16, -1, p.q, D, smem);
    } break;
    case PH_SCORES: {
      const int mt = last ? 64 : 66;
      for (int t = bid; t < mt * 16; t += nb) {
        int j = t & 15;
        int hh = j >> 1, pp = j & 1;
        const bfr* bt = p.sk_bf + (size_t)(((layer * 2 + pp) * 8 + hh)) * 128 * 128;
        gemm_tile<2, false>(p.q + j * 128, D, bt, 128, 128, (t >> 4) * 256, 0, p.scores + j * 128, D, p, layer, smem);
      }
    } break;
    case PH_TOPK: topk_phase(p, layer, last ? MX : MT, smem); break;
    case PH_PEER: peer_phase(p, layer, last ? MX : MT); break;
  }
}

__device__ __forceinline__ void grid_barrier(unsigned* bar, unsigned& epoch) {
  asm volatile("s_waitcnt vmcnt(0)" ::: "memory");
  __syncthreads();
  epoch += gridDim.x;
  if (threadIdx.x == 0) {
    __builtin_amdgcn_fence(__ATOMIC_RELEASE, "agent");
    asm volatile("s_waitcnt vmcnt(0)" ::: "memory");
    (void)__hip_atomic_fetch_add(bar, 1u, __ATOMIC_RELAXED, __HIP_MEMORY_SCOPE_AGENT);
    unsigned spins = 0;
    while (__hip_atomic_load(bar, __ATOMIC_RELAXED, __HIP_MEMORY_SCOPE_AGENT) < epoch) {
      __builtin_amdgcn_s_sleep(1);
      if (++spins > (1u << 24)) break;
    }
    __builtin_amdgcn_fence(__ATOMIC_ACQUIRE, "agent");
    asm volatile("s_waitcnt vmcnt(0)" ::: "memory");
  }
  __syncthreads();
}

#if MULTI_LAUNCH
__global__ void __launch_bounds__(NTHR) phase_kernel(Params p, int ph, int layer) {
  extern __shared__ __attribute__((aligned(16))) char smem[];
  run_phase(p, ph, layer, smem, blockIdx.x);
}
#else
__global__ void __launch_bounds__(NTHR) mega_kernel(Params p) {
  extern __shared__ __attribute__((aligned(16))) char smem[];
  cg::grid_group grid = cg::this_grid();
  const unsigned xcd = (unsigned)__builtin_amdgcn_s_getreg((3 << 11) | 20) & 7u;
  run_phase(p, PH_INIT, 0, smem, 0);
  __syncthreads();
  if (threadIdx.x == 0) ((volatile unsigned*)smem)[0] = atomicAdd(&p.bar[16 + xcd], 1u);
  grid.sync();
  int vid = (int)((volatile unsigned*)smem)[0];
  for (unsigned x = 0; x < xcd; ++x) vid += (int)__hip_atomic_load(&p.bar[16 + x], __ATOMIC_RELAXED, __HIP_MEMORY_SCOPE_AGENT);
  vid = __builtin_amdgcn_readfirstlane(vid);
  __syncthreads();
  unsigned epoch = 0;
  for (int layer = 0; layer < 2; ++layer) {
    for (int ph = (layer == 0 ? PH_MOD_ATTN : PH_INPROJ); ph <= PH_PEER; ++ph) {
      if (ph == PH_SCORES) continue;
      run_phase(p, ph, layer, smem, vid);
      if (!(layer == 1 && ph == PH_PEER)) grid_barrier(p.bar, epoch);
    }
  }
}
#endif

static inline size_t align_up(size_t v) { return (v + 255) & ~(size_t)255; }

extern "C" void kernel_launch(void* const* d_in, const int* in_sizes, int n_in, void* d_out, int out_size, void* d_ws,
                              size_t ws_size, hipStream_t stream) {
  Params p{};
  p.x = (const float*)d_in[0]; p.c = (const float*)d_in[1]; p.ctx = (const float*)d_in[2]; p.c_ctx = (const float*)d_in[3];
  p.w_ada = (const float*)d_in[4]; p.b_ada = (const float*)d_in[5]; p.g_attn = (const float*)d_in[6]; p.g_ffn = (const float*)d_in[7];
  p.w_in = (const float*)d_in[8]; p.rpb = (const float*)d_in[9]; p.ret_lg = (const float*)d_in[10]; p.gla_wu = (const float*)d_in[11];
  p.gla_b = (const float*)d_in[12]; p.gla_g = (const float*)d_in[13]; p.sink = (const float*)d_in[14]; p.w_out = (const float*)d_in[15];
  p.w_q = (const float*)d_in[16]; p.sub_keys = (const float*)d_in[17]; p.pu = (const float*)d_in[18]; p.pv = (const float*)d_in[19];
  p.final_g = (const float*)d_in[20];
  p.out = (float*)d_out;
  char* ws = (char*)d_ws;
  size_t off = 0;
  auto take = [&](size_t bytes) { char* r = ws + off; off = align_up(off + bytes); return r; };
  p.mod = (float*)take((size_t)2 * 3 * 12288 * 4);
  p.bar = (unsigned*)take(256);
  p.rope = (float*)take((size_t)16384 * 4);
  p.wt_in = (bfr*)take((size_t)2 * DINP * D * 2);
  p.wt_out = (bfr*)take((size_t)2 * D * D * 2);
  p.wt_q = (bfr*)take((size_t)2 * D * D * 2);
  p.sk_bf = (bfr*)take((size_t)524288 * 2);
  p.u8 = (unsigned char*)take((size_t)2 * 16384 * D);
  p.v8 = (unsigned char*)take((size_t)2 * 16384 * D);
  p.uscl = (float*)take((size_t)2 * 16384 * 4);
  p.vscl = (float*)take((size_t)2 * 16384 * 4);
  p.xcur = (float*)take((size_t)MT * D * 4);
  p.h = (bfr*)take((size_t)MT * D * 2);
  p.proj = (bfr*)take((size_t)MT * DINP * 2);
  p.mix = (bfr*)take((size_t)MT * D * 2);
  p.st_ret = (bfr*)take((size_t)16 * 132 * 16384 * 4);
  p.dec_ret = (float*)take((size_t)16 * 132 * 128 * 4);
  p.dec_gla = (float*)take((size_t)16 * 132 * 64 * 4);
  p.pidx = (int*)take((size_t)MT * 128 * 4);
  p.pgate = (float*)take((size_t)MT * 128 * 4);
  p.st_gla = (bfr*)p.h;
  p.q = p.proj;
  p.scores = (float*)p.st_ret;
  if (off > ws_size) { fprintf(stderr, "workspace too small: need %zu have %zu\n", off, ws_size); return; }

  hipMemsetAsync(p.mod, 0, (size_t)2 * 3 * 12288 * 4 + 256, stream);
#if MULTI_LAUNCH
  hipFuncSetAttribute((const void*)phase_kernel, hipFuncAttributeMaxDynamicSharedMemorySize, SMEM_BYTES);
  const int grid = 256;
  hipLaunchKernelGGL(phase_kernel, dim3(grid), dim3(NTHR), SMEM_BYTES, stream, p, PH_INIT, 0);
  for (int layer = 0; layer < 2; ++layer)
    for (int ph = (layer == 0 ? PH_MOD_ATTN : PH_INPROJ); ph <= PH_PEER; ++ph)
      hipLaunchKernelGGL(phase_kernel, dim3(grid), dim3(NTHR), SMEM_BYTES, stream, p, ph, layer);
#else
  static int grid_blocks = 0;
  if (!grid_blocks) {
    hipFuncSetAttribute((const void*)mega_kernel, hipFuncAttributeMaxDynamicSharedMemorySize, SMEM_BYTES);
    int dev = 0, cus = 0, per_cu = 0;
    hipGetDevice(&dev);
    hipDeviceGetAttribute(&cus, hipDeviceAttributeMultiprocessorCount, dev);
    hipOccupancyMaxActiveBlocksPerMultiprocessor(&per_cu, mega_kernel, NTHR, SMEM_BYTES);
    if (per_cu < 1) per_cu = 1;
    grid_blocks = cus * per_cu;
    if (grid_blocks > 256) grid_blocks = 256;
  }
  void* args[] = {&p};
  hipError_t e = hipLaunchCooperativeKernel((void*)mega_kernel, dim3(grid_blocks), dim3(NTHR), args, SMEM_BYTES, stream);
  if (e != hipSuccess) fprintf(stderr, "cooperative launch failed: %s (grid %d)\n", hipGetErrorString(e), grid_blocks);
#endif
}
```

```cpp
#include <hip/hip_runtime.h>
#include <hip/hip_cooperative_groups.h>
#include <cstdio>
namespace cg = cooperative_groups;

#ifndef MULTI_LAUNCH
#define MULTI_LAUNCH 0
#endif

typedef unsigned short bfr;
typedef __attribute__((ext_vector_type(8))) short bf16x8;
typedef __attribute__((ext_vector_type(4))) float f32x4;
typedef __attribute__((ext_vector_type(4))) unsigned int u4;

constexpr int D = 2048;
constexpr int S = 8192;
constexpr int MX = 16384;
constexpr int MT = 16896;
constexpr int DIN = 5920;
constexpr int DINP = 6016;
constexpr int NTHR = 512;
constexpr float EPS = 1e-6f;
constexpr int SMEM_BYTES = 149504;

constexpr int C_NAQ = 0, C_NAK = 512, C_NAV = 1024;
constexpr int C_RTQ = 1536, C_RTK = 2048, C_RTV = 2560, C_RTG = 3072;
constexpr int C_GLQ = 3584, C_GLK = 3840, C_GLV = 4096, C_GLG = 4608, C_GLD = 5120;
constexpr int C_SWQ = 5152, C_SWK = 5664, C_SWV = 5792;

struct Params {
  const float *x, *c, *ctx, *c_ctx, *w_ada, *b_ada, *g_attn, *g_ffn, *w_in, *rpb, *ret_lg, *gla_wu, *gla_b,
      *gla_g, *sink, *w_out, *w_q, *sub_keys, *pu, *pv, *final_g;
  float* out;
  bfr *wt_in, *wt_out, *wt_q, *sk_bf;
  unsigned char *u8, *v8;
  float *uscl, *vscl;
  float *mod, *rope, *xcur;
  bfr *h, *proj, *mix;
  bfr *st_ret, *st_gla;
  float *dec_ret, *dec_gla;
  bfr* q;
  float* scores;
  int* pidx;
  float* pgate;
  unsigned* bar;
};

__device__ __forceinline__ int get_tid() { int t = threadIdx.x; asm volatile("" : "+v"(t)); return t; }
__device__ __forceinline__ int get_bid() { int t = blockIdx.x; asm volatile("" : "+s"(t)); return t; }
__device__ __forceinline__ float bf2f(bfr u) { return __uint_as_float(((unsigned)u) << 16); }
typedef __bf16 hwbf16x2 __attribute__((ext_vector_type(2)));
typedef float hwf32x2 __attribute__((ext_vector_type(2)));
__device__ __forceinline__ unsigned pack2(float a, float b) {
  hwf32x2 v = {a, b};
  hwbf16x2 r = __builtin_convertvector(v, hwbf16x2);
  return __builtin_bit_cast(unsigned, r);
}
__device__ __forceinline__ bfr f2bf(float f) { return (bfr)(pack2(f, 0.f) & 0xffffu); }
__device__ __forceinline__ float lo16(unsigned w) { return __uint_as_float(w << 16); }
__device__ __forceinline__ float hi16(unsigned w) { return __uint_as_float(w & 0xffff0000u); }
__device__ __forceinline__ float wave_sum(float v) {
#pragma unroll
  for (int o = 32; o; o >>= 1) v += __shfl_xor(v, o);
  return v;
}
__device__ __forceinline__ float wave_max(float v) {
#pragma unroll
  for (int o = 32; o; o >>= 1) v = fmaxf(v, __shfl_xor(v, o));
  return v;
}
__device__ __forceinline__ float silu_f(float x) { return x / (1.f + __expf(-x)); }
__device__ __forceinline__ float gelu_f(float x) { return 0.5f * x * (1.f + erff(x * 0.70710678118654752f)); }
__device__ __forceinline__ float logsig_f(float x) { return fminf(x, 0.f) - log1pf(__expf(-fabsf(x))); }
__device__ __forceinline__ void unpack8(const u4 w, float* f) {
  f[0] = lo16(w.x); f[1] = hi16(w.x); f[2] = lo16(w.y); f[3] = hi16(w.y);
  f[4] = lo16(w.z); f[5] = hi16(w.z); f[6] = lo16(w.w); f[7] = hi16(w.w);
}

__device__ void transpose_cvt(const float* __restrict__ W, int K, int N, int Npad, bfr* __restrict__ Wt, int item,
                              float* tile) {
  const int nkt = K >> 6;
  const int kt = item % nkt, nt = item / nkt;
  const int tid = get_tid();
  __syncthreads();
#pragma unroll
  for (int i = 0; i < 2; ++i) {
    int kk = (tid >> 4) + 32 * i, nn = (tid & 15) * 4;
    int n = nt * 64 + nn;
    float4 v = make_float4(0.f, 0.f, 0.f, 0.f);
    if (n < N) v = *(const float4*)(W + (size_t)(kt * 64 + kk) * N + n);
    tile[kk * 65 + nn + 0] = v.x; tile[kk * 65 + nn + 1] = v.y; tile[kk * 65 + nn + 2] = v.z; tile[kk * 65 + nn + 3] = v.w;
  }
  __syncthreads();
  {
    int nl = tid >> 3, kc = (tid & 7) * 8;
    u4 o;
    o.x = pack2(tile[(kc + 0) * 65 + nl], tile[(kc + 1) * 65 + nl]);
    o.y = pack2(tile[(kc + 2) * 65 + nl], tile[(kc + 3) * 65 + nl]);
    o.z = pack2(tile[(kc + 4) * 65 + nl], tile[(kc + 5) * 65 + nl]);
    o.w = pack2(tile[(kc + 6) * 65 + nl], tile[(kc + 7) * 65 + nl]);
    *(u4*)(Wt + (size_t)(nt * 64 + nl) * K + kt * 64 + kc) = o;
  }
}

__device__ void cvt_linear(const float* __restrict__ src, bfr* __restrict__ dst, size_t n8) {
  for (size_t i = (size_t)get_bid() * NTHR + get_tid(); i < n8; i += (size_t)gridDim.x * NTHR) {
    float4 a = *(const float4*)(src + i * 8), b = *(const float4*)(src + i * 8 + 4);
    u4 o;
    o.x = pack2(a.x, a.y); o.y = pack2(a.z, a.w); o.z = pack2(b.x, b.y); o.w = pack2(b.z, b.w);
    *(u4*)(dst + i * 8) = o;
  }
}

__device__ void cvt_fp8_rows(const float* __restrict__ src, unsigned char* __restrict__ dst, float* __restrict__ scl, int nrows) {
  const int lane = get_tid() & 63;
  const int wave = get_bid() * 8 + (get_tid() >> 6), nw = gridDim.x * 8;
  for (int row = wave; row < nrows; row += nw) {
    const float* sp = src + (size_t)row * D + lane * 16;
    float4 v[8];
    float amax = 0.f;
#pragma unroll
    for (int i = 0; i < 2; ++i)
#pragma unroll
      for (int k = 0; k < 4; ++k) {
        float4 t = *(const float4*)(sp + i * 1024 + k * 4);
        v[i * 4 + k] = t;
        amax = fmaxf(amax, fmaxf(fmaxf(fabsf(t.x), fabsf(t.y)), fmaxf(fabsf(t.z), fabsf(t.w))));
      }
    amax = wave_max(amax);
    const float sc = amax > 0.f ? 256.f / amax : 1.f;
#pragma unroll
    for (int i = 0; i < 2; ++i) {
      u4 o;
      int w;
      w = __builtin_amdgcn_cvt_pk_fp8_f32(v[i * 4 + 0].x * sc, v[i * 4 + 0].y * sc, 0, false);
      w = __builtin_amdgcn_cvt_pk_fp8_f32(v[i * 4 + 0].z * sc, v[i * 4 + 0].w * sc, w, true); o.x = (unsigned)w;
      w = __builtin_amdgcn_cvt_pk_fp8_f32(v[i * 4 + 1].x * sc, v[i * 4 + 1].y * sc, 0, false);
      w = __builtin_amdgcn_cvt_pk_fp8_f32(v[i * 4 + 1].z * sc, v[i * 4 + 1].w * sc, w, true); o.y = (unsigned)w;
      w = __builtin_amdgcn_cvt_pk_fp8_f32(v[i * 4 + 2].x * sc, v[i * 4 + 2].y * sc, 0, false);
      w = __builtin_amdgcn_cvt_pk_fp8_f32(v[i * 4 + 2].z * sc, v[i * 4 + 2].w * sc, w, true); o.z = (unsigned)w;
      w = __builtin_amdgcn_cvt_pk_fp8_f32(v[i * 4 + 3].x * sc, v[i * 4 + 3].y * sc, 0, false);
      w = __builtin_amdgcn_cvt_pk_fp8_f32(v[i * 4 + 3].z * sc, v[i * 4 + 3].w * sc, w, true); o.w = (unsigned)w;
      *(u4*)(dst + (size_t)row * D + i * 1024 + lane * 16) = o;
    }
    if (lane == 0) scl[row] = amax > 0.f ? amax * (1.f / 256.f) : 1.f;
  }
}

__device__ void sincos_d(double a, float& s, float& c) {
  double k = rint(a * 0.63661977236758134308);
  double r = a - k * 1.57079632679489661923;
  double r2 = r * r;
  double sn = r * (1.0 + r2 * (-1.0 / 6 + r2 * (1.0 / 120 + r2 * (-1.0 / 5040 + r2 * (1.0 / 362880 + r2 * (-1.0 / 39916800 + r2 * (1.0 / 6227020800.0)))))));
  double cs = 1.0 + r2 * (-0.5 + r2 * (1.0 / 24 + r2 * (-1.0 / 720 + r2 * (1.0 / 40320 + r2 * (-1.0 / 3628800 + r2 * (1.0 / 479001600.0))))));
  int q = ((int)k) & 3;
  double so = (q == 0) ? sn : (q == 1) ? cs : (q == 2) ? -sn : -cs;
  double co = (q == 0) ? cs : (q == 1) ? -sn : (q == 2) ? -cs : sn;
  s = (float)so; c = (float)co;
}

__device__ void phase0(const Params& p, char* smem) {
  const int tid = get_tid(), bid = get_bid(), nb = gridDim.x;
  float* fs = (float*)smem;
  if (bid == 0) {
    for (int e = tid; e < 128 * 16 + 128 * 32; e += NTHR) {
      int F, pos, f, base;
      if (e < 2048) { F = 16; pos = e >> 4; f = e & 15; base = 0; }
      else { int e2 = e - 2048; F = 32; pos = e2 >> 5; f = e2 & 31; base = 4096; }
      double bb = (F == 16) ? 0.56234132519034908 : 0.74989420933245582;
      double inv = 1.0;
      for (int i = 0; i < f; ++i) inv *= bb;
      float invf = (float)inv;
      float ang = (float)pos * invf;
      float sn, cs;
      sincos_d((double)ang, sn, cs);
      p.rope[base + pos * F + f] = cs;
      p.rope[base + 128 * F + pos * F + f] = sn;
    }
  }
  for (int it = bid; it < 384; it += nb) {
    int layer = it / 192, r = it % 192, kc = r / 6, nc = r % 6;
    __syncthreads();
    if (tid < 192) {
      int v = tid >> 6, kk = tid & 63;
      float cv = (v < 2) ? p.c[v * D + kc * 64 + kk] : p.c_ctx[kc * 64 + kk];
      fs[tid] = silu_f(cv);
    }
    __syncthreads();
    int n = nc * 2048 + tid * 4;
    float4 a0 = make_float4(0, 0, 0, 0), a1 = a0, a2 = a0;
    if (kc == 0) { a0 = *(const float4*)(p.b_ada + layer * 12288 + n); a1 = a0; a2 = a0; }
    const float* w = p.w_ada + (size_t)layer * D * 12288 + (size_t)(kc * 64) * 12288 + n;
#pragma unroll 8
    for (int kk = 0; kk < 64; ++kk) {
      float4 wv = *(const float4*)(w + (size_t)kk * 12288);
      float s0 = fs[kk], s1 = fs[64 + kk], s2 = fs[128 + kk];
      a0.x += s0 * wv.x; a0.y += s0 * wv.y; a0.z += s0 * wv.z; a0.w += s0 * wv.w;
      a1.x += s1 * wv.x; a1.y += s1 * wv.y; a1.z += s1 * wv.z; a1.w += s1 * wv.w;
      a2.x += s2 * wv.x; a2.y += s2 * wv.y; a2.z += s2 * wv.z; a2.w += s2 * wv.w;
    }
    float* m0 = p.mod + (layer * 3 + 0) * 12288 + n;
    float* m1 = p.mod + (layer * 3 + 1) * 12288 + n;
    float* m2 = p.mod + (layer * 3 + 2) * 12288 + n;
    atomicAdd(m0 + 0, a0.x); atomicAdd(m0 + 1, a0.y); atomicAdd(m0 + 2, a0.z); atomicAdd(m0 + 3, a0.w);
    atomicAdd(m1 + 0, a1.x); atomicAdd(m1 + 1, a1.y); atomicAdd(m1 + 2, a1.z); atomicAdd(m1 + 3, a1.w);
    atomicAdd(m2 + 0, a2.x); atomicAdd(m2 + 1, a2.y); atomicAdd(m2 + 2, a2.z); atomicAdd(m2 + 3, a2.w);
  }
  for (int layer = 0; layer < 2; ++layer) {
    for (int it = bid; it < 32 * 94; it += nb)
      transpose_cvt(p.w_in + (size_t)layer * D * DIN, D, DIN, DINP, p.wt_in + (size_t)layer * DINP * D, it, fs);
    for (int it = bid; it < 32 * 32; it += nb)
      transpose_cvt(p.w_out + (size_t)layer * D * D, D, D, D, p.wt_out + (size_t)layer * D * D, it, fs);
    for (int it = bid; it < 32 * 32; it += nb)
      transpose_cvt(p.w_q + (size_t)layer * D * D, D, D, D, p.wt_q + (size_t)layer * D * D, it, fs);
  }
  cvt_linear(p.sub_keys, p.sk_bf, (size_t)524288 / 8);
  cvt_fp8_rows(p.pu, p.u8, p.uscl, 2 * 16384);
  cvt_fp8_rows(p.pv, p.v8, p.vscl, 2 * 16384);
}

__device__ __forceinline__ const float* modulate_src(const Params& p, int layer, int which, int m) {
  if (layer == 0 && which == 0) return (m < MX) ? p.x + (size_t)m * D : p.ctx + (size_t)(m - MX) * D;
  return p.xcur + (size_t)m * D;
}
__device__ void modulate_phase(const Params& p, int layer, int which, int nrows) {
  const int lane = get_tid() & 63;
  const int wave = get_bid() * 8 + (get_tid() >> 6), nw = gridDim.x * 8;
  const float* g = (which == 0 ? p.g_attn : p.g_ffn) + layer * D;
  float4 vn[8];
  if (wave < nrows) {
    const float* src = modulate_src(p, layer, which, wave);
#pragma unroll
    for (int i = 0; i < 8; ++i) vn[i] = *(const float4*)(src + i * 256 + lane * 4);
  }
  for (int m = wave; m < nrows; m += nw) {
    float4 v[8];
#pragma unroll
    for (int i = 0; i < 8; ++i) v[i] = vn[i];
    if (m + nw < nrows) {
      const float* src = modulate_src(p, layer, which, m + nw);
#pragma unroll
      for (int i = 0; i < 8; ++i) vn[i] = *(const float4*)(src + i * 256 + lane * 4);
    }
    int vec = m < S ? 0 : (m < MX ? 1 : 2);
    const float* modl = p.mod + (layer * 3 + vec) * 12288 + which * 3 * D;
    float ss = 0.f;
#pragma unroll
    for (int i = 0; i < 8; ++i) ss += v[i].x * v[i].x + v[i].y * v[i].y + v[i].z * v[i].z + v[i].w * v[i].w;
    ss = wave_sum(ss);
    float rstd = rsqrtf(ss * (1.f / D) + EPS);
#pragma unroll
    for (int i = 0; i < 8; ++i) {
      int col = i * 256 + lane * 4;
      float4 gg = *(const float4*)(g + col);
      float4 sh = *(const float4*)(modl + col);
      float4 sc = *(const float4*)(modl + D + col);
      float y0 = v[i].x * rstd * gg.x * (1.f + sc.x) + sh.x;
      float y1 = v[i].y * rstd * gg.y * (1.f + sc.y) + sh.y;
      float y2 = v[i].z * rstd * gg.z * (1.f + sc.z) + sh.z;
      float y3 = v[i].w * rstd * gg.w * (1.f + sc.w) + sh.w;
      uint2 o; o.x = pack2(y0, y1); o.y = pack2(y2, y3);
      *(uint2*)(p.h + (size_t)m * D + col) = o;
    }
  }
}

template <int EPI, bool BIG>
__device__ void gemm_tile(const bfr* __restrict__ A, int lda, const bfr* __restrict__ Bt, int ldb, int K, int m0,
                          int n0, void* Cout, int ldc, const Params& p, int layer, char* smem) {
  constexpr int BN = BIG ? 256 : 128;
  constexpr int MI = BIG ? 8 : 4;
  constexpr int NBL = BN / 64;
  bfr* As0 = (bfr*)smem;
  bfr* Bs0 = As0 + 2 * 256 * 72;
  const int tid = get_tid(), lane = tid & 63, w = tid >> 6;
  const int wm = BIG ? (w >> 2) : (w >> 1), wn = BIG ? (w & 3) : (w & 1);
  const int fr = lane & 15, fq = lane >> 4;
  f32x4 acc[MI][4];
#pragma unroll
  for (int i = 0; i < MI; ++i)
#pragma unroll
    for (int j = 0; j < 4; ++j) acc[i][j] = (f32x4){0.f, 0.f, 0.f, 0.f};
  const int arow = tid >> 3, akc = (tid & 7) * 8;
  u4 rs[4];
  const bfr* Ap = A + (size_t)(m0 + arow) * lda + akc;
  const bfr* Bp = Bt + (size_t)(n0 + arow) * ldb + akc;
#pragma unroll
  for (int i = 0; i < 4; ++i) rs[i] = *(const u4*)(Ap + (size_t)(64 * i) * lda);
  __syncthreads();
#pragma unroll
  for (int i = 0; i < 4; ++i) *(u4*)(As0 + (arow + 64 * i) * 72 + akc) = rs[i];
#pragma unroll
  for (int i = 0; i < NBL; ++i) rs[i] = *(const u4*)(Bp + (size_t)(64 * i) * ldb);
#pragma unroll
  for (int i = 0; i < NBL; ++i) *(u4*)(Bs0 + (arow + 64 * i) * 72 + akc) = rs[i];
  const int nk = K >> 6;
  if (nk > 1) {
#pragma unroll
    for (int i = 0; i < 4; ++i) rs[i] = *(const u4*)(Ap + (size_t)(64 * i) * lda + 64);
  }
  __syncthreads();
  for (int kt = 0; kt < nk; ++kt) {
    const bfr* As = As0 + (kt & 1) * (256 * 72);
    const bfr* Bs = Bs0 + (kt & 1) * (BN * 72);
    bfr* Asn = As0 + ((kt + 1) & 1) * (256 * 72);
    bfr* Bsn = Bs0 + ((kt + 1) & 1) * (BN * 72);
#pragma unroll
    for (int kk = 0; kk < 2; ++kk) {
      bf16x8 b[4];
#pragma unroll
      for (int j = 0; j < 4; ++j) b[j] = *(const bf16x8*)(Bs + (wn * 64 + j * 16 + fr) * 72 + kk * 32 + fq * 8);
      {
        bf16x8 a_cur = *(const bf16x8*)(As + (wm * (MI * 16) + fr) * 72 + kk * 32 + fq * 8);
#pragma unroll
        for (int i = 0; i < MI; ++i) {
          bf16x8 a_nxt = a_cur;
          if (i + 1 < MI) a_nxt = *(const bf16x8*)(As + (wm * (MI * 16) + (i + 1) * 16 + fr) * 72 + kk * 32 + fq * 8);
#pragma unroll
          for (int j = 0; j < 4; ++j) acc[i][j] = __builtin_amdgcn_mfma_f32_16x16x32_bf16(b[j], a_cur, acc[i][j], 0, 0, 0);
          if (BIG) __builtin_amdgcn_sched_barrier(0);
          a_cur = a_nxt;
        }
      }
      if (kt + 1 < nk) {
        if (kk == 0) {
#pragma unroll
          for (int i = 0; i < 4; ++i) *(u4*)(Asn + (arow + 64 * i) * 72 + akc) = rs[i];
#pragma unroll
          for (int i = 0; i < NBL; ++i) rs[i] = *(const u4*)(Bp + (size_t)(64 * i) * ldb + (kt + 1) * 64);
        } else {
#pragma unroll
          for (int i = 0; i < NBL; ++i) *(u4*)(Bsn + (arow + 64 * i) * 72 + akc) = rs[i];
          if (kt + 2 < nk) {
#pragma unroll
            for (int i = 0; i < 4; ++i) rs[i] = *(const u4*)(Ap + (size_t)(64 * i) * lda + (kt + 2) * 64);
          }
        }
      }
    }
    __syncthreads();
  }
  const int nb0 = n0 + wn * 64 + fq * 4;
#pragma unroll
  for (int i = 0; i < MI; ++i) {
    const int m = m0 + wm * (MI * 16) + i * 16 + fr;
    if (EPI == 0) {
      bfr* crow = (bfr*)Cout + (size_t)m * ldc + nb0;
#pragma unroll
      for (int j = 0; j < 4; ++j) {
        uint2 o;
        o.x = pack2(acc[i][j][0], acc[i][j][1]); o.y = pack2(acc[i][j][2], acc[i][j][3]);
        *(uint2*)(crow + j * 16) = o;
      }
    } else if (EPI == 2) {
      float* crow = (float*)Cout + (size_t)m * ldc + nb0;
#pragma unroll
      for (int j = 0; j < 4; ++j) *(float4*)(crow + j * 16) = make_float4(acc[i][j][0], acc[i][j][1], acc[i][j][2], acc[i][j][3]);
    } else {
      const float* src;
      if (layer == 0) src = (m < MX) ? p.x + (size_t)m * D : p.ctx + (size_t)(m - MX) * D;
      else src = p.xcur + (size_t)m * D;
      src += nb0;
      const int vec = m < S ? 0 : (m < MX ? 1 : 2);
      const float* grow = p.mod + (layer * 3 + vec) * 12288 + 2 * D + nb0;
      float* orow = p.xcur + (size_t)m * D + nb0;
#pragma unroll
      for (int j = 0; j < 4; ++j) {
        const float4 gate = *(const float4*)(grow + j * 16);
        const float4 xs = *(const float4*)(src + j * 16);
        *(float4*)(orow + j * 16) = make_float4(xs.x + gate.x * acc[i][j][0], xs.y + gate.y * acc[i][j][1], xs.z + gate.z * acc[i][j][2], xs.w + gate.w * acc[i][j][3]);
      }
      __builtin_amdgcn_sched_barrier(0);
    }
  }
}

#define MFMA16(a, b, c) __builtin_amdgcn_mfma_f32_16x16x32_bf16((a), (b), (c), 0, 0, 0)
typedef __attribute__((ext_vector_type(4))) short s16x4;

__device__ __forceinline__ void load_kv_tile(bfr* dst, const bfr* src, int nrows, int tok0, int toklimit) {
  for (int c = get_tid(); c < nrows * 8; c += NTHR) {
    int r = c >> 3, ch = c & 7;
    int tok = tok0 + r;
    u4 v = (u4){0u, 0u, 0u, 0u};
    if (tok >= 0 && tok < toklimit) v = *(const u4*)(src + (ptrdiff_t)r * DINP + ch * 8);
    *(u4*)(dst + r * 72 + ch * 8) = v;
  }
}
__device__ __forceinline__ void load_vt_tile(bfr* Vt, int VS, const bfr* src, int nrows, int tok0, int toklimit) {
  for (int c = get_tid(); c < nrows * 8; c += NTHR) {
    int key = c % nrows, dch = c / nrows;
    int tok = tok0 + key;
    u4 v = (u4){0u, 0u, 0u, 0u};
    if (tok >= 0 && tok < toklimit) v = *(const u4*)(src + (ptrdiff_t)key * DINP + dch * 8);
    bfr* d = Vt + (dch * 8) * VS + key;
    d[0 * VS] = (bfr)(v.x & 0xffffu); d[1 * VS] = (bfr)(v.x >> 16);
    d[2 * VS] = (bfr)(v.y & 0xffffu); d[3 * VS] = (bfr)(v.y >> 16);
    d[4 * VS] = (bfr)(v.z & 0xffffu); d[5 * VS] = (bfr)(v.z >> 16);
    d[6 * VS] = (bfr)(v.w & 0xffffu); d[7 * VS] = (bfr)(v.w >> 16);
  }
}
__device__ __forceinline__ void load_kfrags(bf16x8 (&kf)[2][2], const bfr* Ks, int kt, int fr, int q4) {
#pragma unroll
  for (int blk = 0; blk < 2; ++blk)
#pragma unroll
    for (int ds = 0; ds < 2; ++ds) kf[blk][ds] = *(const bf16x8*)(Ks + (kt + blk * 16 + fr) * 72 + ds * 32 + q4 * 8);
}
__device__ __forceinline__ void load_vfrags(bf16x8 (&vf)[4], const bfr* Vt, int VS, int kt, int fr, int q4) {
#pragma unroll
  for (int db = 0; db < 4; ++db) {
    const bfr* vp = Vt + (db * 16 + fr) * VS + kt + q4 * 4;
    s16x4 lo = *(const s16x4*)vp, hi = *(const s16x4*)(vp + 16);
    vf[db] = __builtin_shufflevector(lo, hi, 0, 1, 2, 3, 4, 5, 6, 7);
  }
}
__device__ __forceinline__ void attn_tile_group(const bf16x8 (&kf)[2][2], const bf16x8 (&qf)[2], const bf16x8 (&vf)[4],
                                                f32x4 (&o)[4], float& m, float& l, const float (&badd)[8]) {
  f32x4 s0 = (f32x4){0.f, 0.f, 0.f, 0.f}, s1 = s0;
  s0 = MFMA16(kf[0][0], qf[0], s0); s0 = MFMA16(kf[0][1], qf[1], s0);
  s1 = MFMA16(kf[1][0], qf[0], s1); s1 = MFMA16(kf[1][1], qf[1], s1);
  float sv[8];
#pragma unroll
  for (int i = 0; i < 4; ++i) { sv[i] = s0[i] + badd[i]; sv[4 + i] = s1[i] + badd[4 + i]; }
  float mx = fmaxf(fmaxf(fmaxf(sv[0], sv[1]), fmaxf(sv[2], sv[3])), fmaxf(fmaxf(sv[4], sv[5]), fmaxf(sv[6], sv[7])));
  mx = fmaxf(mx, __shfl_xor(mx, 16));
  mx = fmaxf(mx, __shfl_xor(mx, 32));
  const float mn = fmaxf(m, mx);
  const float mref = (mn == -INFINITY) ? 0.f : mn;
  const float alpha = __expf(m - mref);
  float pv[8];
  float ls = 0.f;
#pragma unroll
  for (int i = 0; i < 8; ++i) { pv[i] = __expf(sv[i] - mref); ls += pv[i]; }
  l = l * alpha + ls;
  m = mn;
  u4 pk;
  pk.x = pack2(pv[0], pv[1]); pk.y = pack2(pv[2], pv[3]); pk.z = pack2(pv[4], pv[5]); pk.w = pack2(pv[6], pv[7]);
  const bf16x8 pb = __builtin_bit_cast(bf16x8, pk);
#pragma unroll
  for (int db = 0; db < 4; ++db) {
    o[db] *= alpha;
    o[db] = MFMA16(vf[db], pb, o[db]);
  }
}
__device__ __forceinline__ float attn_rowsum(float l) {
  l += __shfl_xor(l, 16);
  l += __shfl_xor(l, 32);
  return l;
}
__device__ __forceinline__ void load_qfrags(bf16x8 (&qf)[2], const bfr* qrow, int q4, float scale) {
#pragma unroll
  for (int ds = 0; ds < 2; ++ds) {
    u4 w = *(const u4*)(qrow + ds * 32 + q4 * 8);
    float f[8];
    unpack8(w, f);
    u4 o;
    o.x = pack2(f[0] * scale, f[1] * scale); o.y = pack2(f[2] * scale, f[3] * scale);
    o.z = pack2(f[4] * scale, f[5] * scale); o.w = pack2(f[6] * scale, f[7] * scale);
    qf[ds] = __builtin_bit_cast(bf16x8, o);
  }
}
__device__ __forceinline__ void store_ot(bfr* dst, const f32x4 (&o)[4], float inv, int q4) {
#pragma unroll
  for (int db = 0; db < 4; ++db) {
    uint2 w;
    w.x = pack2(o[db][0] * inv, o[db][1] * inv);
    w.y = pack2(o[db][2] * inv, o[db][3] * inv);
    *(uint2*)(dst + db * 16 + q4 * 4) = w;
  }
}

__device__ void swa_item(const Params& p, int layer, int item, char* smem) {
  const int b = item >> 7, kvh = (item >> 6) & 1, nbk = item & 63;
  bfr* Ks = (bfr*)smem;
  bfr* Vt = Ks + 384 * 72;
  constexpr int VS = 392;
  const int tid = get_tid();
  const int lane = tid & 63, w = tid >> 6, fr = lane & 15, q4 = lane >> 4;
  const float* cos16 = p.rope;
  const float* sin16 = p.rope + 2048;
  __syncthreads();
  const int tok0 = (nbk - 1) * 128;
  const bfr* rowbase = p.proj + (ptrdiff_t)(b * S + tok0) * DINP;
  load_vt_tile(Vt, VS, rowbase + C_SWV + kvh * 64, 384, tok0, S);
  for (int u = tid; u < 384 * 4; u += NTHR) {
    int r = u >> 2, A = (u >> 1) & 1, fc = u & 1;
    int tok = tok0 + r;
    u4 o1 = (u4){0u, 0u, 0u, 0u}, o2 = o1;
    if (tok >= 0 && tok < S) {
      const bfr* kp = rowbase + (ptrdiff_t)r * DINP + C_SWK + kvh * 64 + A * 32 + fc * 8;
      u4 w1 = *(const u4*)kp, w2 = *(const u4*)(kp + 16);
      float x1[8], x2[8], y1[8], y2[8];
      unpack8(w1, x1); unpack8(w2, x2);
      int pos = A ? (tok & 63) : (tok >> 6);
#pragma unroll
      for (int j = 0; j < 8; ++j) {
        float cs = cos16[pos * 16 + fc * 8 + j], sn = sin16[pos * 16 + fc * 8 + j];
        y1[j] = x1[j] * cs - x2[j] * sn;
        y2[j] = x2[j] * cs + x1[j] * sn;
      }
      o1.x = pack2(y1[0], y1[1]); o1.y = pack2(y1[2], y1[3]); o1.z = pack2(y1[4], y1[5]); o1.w = pack2(y1[6], y1[7]);
      o2.x = pack2(y2[0], y2[1]); o2.y = pack2(y2[2], y2[3]); o2.z = pack2(y2[4], y2[5]); o2.w = pack2(y2[6], y2[7]);
    }
    int ch1 = A * 4 + fc, ch2 = A * 4 + 2 + fc;
    *(u4*)(Ks + r * 72 + ch1 * 8) = o1;
    *(u4*)(Ks + r * 72 + ch2 * 8) = o2;
  }
  const int g = w >> 1, qhalf = w & 1;
  const int hq = kvh * 4 + g;
  bf16x8 qf[4][2];
  f32x4 oacc[4][4];
  float mm[4], ll[4];
#pragma unroll
  for (int grp = 0; grp < 4; ++grp) {
    const int tq = nbk * 128 + qhalf * 64 + grp * 16 + fr;
    const bfr* qrow = p.proj + (size_t)(b * S + tq) * DINP + C_SWQ + hq * 64;
#pragma unroll
    for (int ds = 0; ds < 2; ++ds) {
      u4 wq = *(const u4*)(qrow + ds * 32 + q4 * 8);
      float f[8], y[8];
      unpack8(wq, f);
      const int pos = ds ? (tq & 63) : (tq >> 6);
#pragma unroll
      for (int j = 0; j < 8; ++j) {
        const float other = __shfl_xor(f[j], 32);
        const int fi = (q4 & 1) * 8 + j;
        const float cs = cos16[pos * 16 + fi], sn = sin16[pos * 16 + fi];
        y[j] = ((q4 < 2) ? (f[j] * cs - other * sn) : (f[j] * cs + other * sn)) * 0.125f;
      }
      u4 o;
      o.x = pack2(y[0], y[1]); o.y = pack2(y[2], y[3]); o.z = pack2(y[4], y[5]); o.w = pack2(y[6], y[7]);
      qf[grp][ds] = __builtin_bit_cast(bf16x8, o);
    }
    mm[grp] = -INFINITY; ll[grp] = 0.f;
#pragma unroll
    for (int db = 0; db < 4; ++db) oacc[grp][db] = (f32x4){0.f, 0.f, 0.f, 0.f};
  }
  __syncthreads();
  float zb[8];
#pragma unroll
  for (int i = 0; i < 8; ++i) zb[i] = 0.f;
#pragma unroll 1
  for (int t = 0; t < 10; ++t) {
    const int kt = qhalf * 64 + 32 * t;
    if (tok0 + kt + 31 < 0 || tok0 + kt >= S) continue;
    bf16x8 kf[2][2], vf[4];
    load_kfrags(kf, Ks, kt, fr, q4);
    load_vfrags(vf, Vt, VS, kt, fr, q4);
#pragma unroll
    for (int grp = 0; grp < 4; ++grp) {
      const int qg0 = 128 + qhalf * 64 + grp * 16;
      if (kt > qg0 + 15 + 128 || kt + 31 < qg0 - 128) continue;
      const bool interior = (kt >= qg0 + 15 - 128) && (kt + 31 <= qg0 + 128) && (tok0 + kt >= 0) && (tok0 + kt + 31 < S);
      if (interior) {
        attn_tile_group(kf, qf[grp], vf, oacc[grp], mm[grp], ll[grp], zb);
      } else {
        const int qrow = qg0 + fr;
        float badd[8];
#pragma unroll
        for (int i = 0; i < 8; ++i) {
          const int lr = kt + (i >> 2) * 16 + q4 * 4 + (i & 3);
          const int dd = qrow - lr;
          const int tok = tok0 + lr;
          const bool ok = (dd <= 128) && (dd >= -128) && (tok >= 0) && (tok < S);
          badd[i] = ok ? 0.f : -INFINITY;
        }
        attn_tile_group(kf, qf[grp], vf, oacc[grp], mm[grp], ll[grp], badd);
      }
    }
  }
  __syncthreads();
  const bfr* zbase = p.proj + (size_t)(MX + b * 256) * DINP;
  load_kv_tile(Ks, zbase + C_SWK + kvh * 64, 256, 0, 256);
  load_vt_tile(Vt, VS, zbase + C_SWV + kvh * 64, 256, 0, 256);
  __syncthreads();
#pragma unroll 1
  for (int t = 0; t < 8; ++t) {
    const int kt = 32 * t;
    bf16x8 kf[2][2], vf[4];
    load_kfrags(kf, Ks, kt, fr, q4);
    load_vfrags(vf, Vt, VS, kt, fr, q4);
#pragma unroll
    for (int grp = 0; grp < 4; ++grp) attn_tile_group(kf, qf[grp], vf, oacc[grp], mm[grp], ll[grp], zb);
  }
  const float sk = p.sink[layer * 8 + hq];
#pragma unroll
  for (int grp = 0; grp < 4; ++grp) {
    const int tq = nbk * 128 + qhalf * 64 + grp * 16 + fr;
    const float mn = fmaxf(mm[grp], sk);
    const float alpha = __expf(mm[grp] - mn);
    const float lt = attn_rowsum(ll[grp]) * alpha + __expf(sk - mn);
    store_ot(p.mix + (size_t)(b * S + tq) * D + 1536 + hq * 64, oacc[grp], alpha / lt, q4);
  }
}

__device__ void na_item(const Params& p, int layer, int item, char* smem) {
  const int b = item >> 10, h = (item >> 7) & 7, r = item & 127;
  bfr* Ks = (bfr*)smem;
  bfr* Vt = Ks + 512 * 72;
  constexpr int VS = 520;
  float* rp = (float*)(Vt + 64 * VS);
  float* mg = (float*)smem;
  const int tid = get_tid();
  const int lane = tid & 63, w = tid >> 6, fr = lane & 15, q4 = lane >> 4;
  __syncthreads();
  int r0 = r - 4; r0 = r0 < 0 ? 0 : (r0 > 120 ? 120 : r0);
  const bfr* rowbase = p.proj + (size_t)(b * S + r0 * 64) * DINP;
  load_kv_tile(Ks, rowbase + C_NAK + h * 64, 512, 0, 512);
  load_vt_tile(Vt, VS, rowbase + C_NAV + h * 64, 512, 0, 512);
  if (tid < 15 * 31) rp[tid] = p.rpb[(layer * 8 + h) * 465 + tid];
  const int grp = w >> 1, half = w & 1;
  const int cq = grp * 16 + fr;
  const int tq = r * 64 + cq;
  bf16x8 qf[2];
  load_qfrags(qf, p.proj + (size_t)(b * S + tq) * DINP + C_NAQ + h * 64, q4, 0.125f);
  f32x4 oacc[4];
#pragma unroll
  for (int db = 0; db < 4; ++db) oacc[db] = (f32x4){0.f, 0.f, 0.f, 0.f};
  float m = -INFINITY, l = 0.f;
  __syncthreads();
  int cs = cq - 8; cs = cs < 0 ? 0 : (cs > 48 ? 48 : cs);
  const int tstart = grp == 0 ? 0 : (grp == 1 ? 8 : (grp == 2 ? 24 : 32));
#pragma unroll 1
  for (int jj = 0; jj < 4; ++jj) {
    const int jrow = half * 4 + jj;
    const int drow = (r0 + jrow) - r + 7;
    const int kt = jrow * 64 + tstart;
    bf16x8 kf[2][2], vf[4];
    load_kfrags(kf, Ks, kt, fr, q4);
    load_vfrags(vf, Vt, VS, kt, fr, q4);
    float badd[8];
#pragma unroll
    for (int i = 0; i < 8; ++i) {
      const int ck = tstart + (i >> 2) * 16 + q4 * 4 + (i & 3);
      const bool ok = (ck >= cs) && (ck < cs + 16);
      int dc = ck - cq + 15; dc = dc < 0 ? 0 : (dc > 30 ? 30 : dc);
      badd[i] = ok ? rp[drow * 31 + dc] : -INFINITY;
    }
    attn_tile_group(kf, qf, vf, oacc, m, l, badd);
  }
  __syncthreads();
  const bfr* zbase = p.proj + (size_t)(MX + b * 256) * DINP;
  load_kv_tile(Ks, zbase + C_NAK + h * 64, 256, 0, 256);
  load_vt_tile(Vt, VS, zbase + C_NAV + h * 64, 256, 0, 256);
  __syncthreads();
  float zb[8];
#pragma unroll
  for (int i = 0; i < 8; ++i) zb[i] = 0.f;
#pragma unroll 1
  for (int t = 0; t < 4; ++t) {
    const int kt = half * 128 + 32 * t;
    bf16x8 kf[2][2], vf[4];
    load_kfrags(kf, Ks, kt, fr, q4);
    load_vfrags(vf, Vt, VS, kt, fr, q4);
    attn_tile_group(kf, qf, vf, oacc, m, l, zb);
  }
  __syncthreads();
  l = attn_rowsum(l);
  float* mo = mg + grp * (16 * 64 + 64) ;
  if (half == 1) {
#pragma unroll
    for (int db = 0; db < 4; ++db)
#pragma unroll
      for (int i = 0; i < 4; ++i) mo[(db * 4 + i) * 64 + lane] = oacc[db][i];
    if (q4 == 0) { mo[16 * 64 + fr] = m; mo[16 * 64 + 16 + fr] = l; }
  }
  __syncthreads();
  if (half == 0) {
    const float m2 = mo[16 * 64 + fr], l2 = mo[16 * 64 + 16 + fr];
    const float mn = fmaxf(m, m2);
    const float a1 = __expf(m - mn), a2 = __expf(m2 - mn);
    const float lt = l * a1 + l2 * a2;
    const float i1 = a1 / lt, i2 = a2 / lt;
#pragma unroll
    for (int db = 0; db < 4; ++db)
#pragma unroll
      for (int i = 0; i < 4; ++i) oacc[db][i] = oacc[db][i] * i1 + mo[(db * 4 + i) * 64 + lane] * i2;
    store_ot(p.mix + (size_t)(b * S + tq) * D + h * 64, oacc, 1.f, q4);
  }
}

__device__ void ctx_item(const Params& p, int layer, int item, char* smem) {
  const int b = item >> 4, type = (item >> 3) & 1, h = item & 7;
  bfr* Ks = (bfr*)smem;
  bfr* Vt = Ks + 256 * 72;
  constexpr int VS = 264;
  const int tid = get_tid();
  const int lane = tid & 63, w = tid >> 6, fr = lane & 15, q4 = lane >> 4;
  __syncthreads();
  const bfr* zbase = p.proj + (size_t)(MX + b * 256) * DINP;
  const int kcol = type ? (C_SWK + (h >> 2) * 64) : (C_NAK + h * 64);
  const int vcol = type ? (C_SWV + (h >> 2) * 64) : (C_NAV + h * 64);
  const int qcol = type ? (C_SWQ + h * 64) : (C_NAQ + h * 64);
  load_kv_tile(Ks, zbase + kcol, 256, 0, 256);
  load_vt_tile(Vt, VS, zbase + vcol, 256, 0, 256);
  bf16x8 qf[2][2];
  f32x4 oacc[2][4];
  float mm[2], ll[2];
#pragma unroll
  for (int grp = 0; grp < 2; ++grp) {
    const int qz = w * 32 + grp * 16 + fr;
    load_qfrags(qf[grp], zbase + (size_t)qz * DINP + qcol, q4, 0.125f);
    mm[grp] = -INFINITY; ll[grp] = 0.f;
#pragma unroll
    for (int db = 0; db < 4; ++db) oacc[grp][db] = (f32x4){0.f, 0.f, 0.f, 0.f};
  }
  __syncthreads();
  float zb[8];
#pragma unroll
  for (int i = 0; i < 8; ++i) zb[i] = 0.f;
#pragma unroll 1
  for (int t = 0; t < 8; ++t) {
    const int kt = 32 * t;
    bf16x8 kf[2][2], vf[4];
    load_kfrags(kf, Ks, kt, fr, q4);
    load_vfrags(vf, Vt, VS, kt, fr, q4);
#pragma unroll
    for (int grp = 0; grp < 2; ++grp) attn_tile_group(kf, qf[grp], vf, oacc[grp], mm[grp], ll[grp], zb);
  }
#pragma unroll
  for (int grp = 0; grp < 2; ++grp) {
    const int qz = w * 32 + grp * 16 + fr;
    float inv;
    if (type == 1) {
      const float sk = p.sink[layer * 8 + h];
      const float mn = fmaxf(mm[grp], sk);
      const float a = __expf(mm[grp] - mn);
      inv = a / (attn_rowsum(ll[grp]) * a + __expf(sk - mn));
    } else {
      inv = 1.f / attn_rowsum(ll[grp]);
    }
    store_ot(p.mix + (size_t)(MX + b * 256 + qz) * D + (type ? 1536 : 0) + h * 64, oacc[grp], inv, q4);
  }
}

template <int W>
__device__ __forceinline__ void load_rows_f32(float* dst, int stride, const bfr* src, float scale) {
  constexpr int CPR = W / 8;
  for (int c = get_tid(); c < 64 * CPR; c += NTHR) {
    int j = c / CPR, ch = c % CPR;
    u4 w = *(const u4*)(src + (size_t)j * DINP + ch * 8);
    float f[8];
    unpack8(w, f);
    float4 a = make_float4(f[0] * scale, f[1] * scale, f[2] * scale, f[3] * scale);
    float4 bq = make_float4(f[4] * scale, f[5] * scale, f[6] * scale, f[7] * scale);
    *(float4*)(dst + j * stride + ch * 8) = a;
    *(float4*)(dst + j * stride + ch * 8 + 4) = bq;
  }
}

__device__ __forceinline__ void rope128_tile(float* t, int stride, int prow, const float* rope, float scale) {
  const float* cos32 = rope + 4096;
  const float* sin32 = rope + 8192;
  for (int u = get_tid(); u < 64 * 64; u += NTHR) {
    int j = u >> 6, A = (u >> 5) & 1, f = u & 31;
    int pos = A ? j : prow;
    float cs = cos32[pos * 32 + f], sn = sin32[pos * 32 + f];
    float x1 = t[j * stride + A * 64 + f], x2 = t[j * stride + A * 64 + 32 + f];
    t[j * stride + A * 64 + f] = (x1 * cs - x2 * sn) * scale;
    t[j * stride + A * 64 + 32 + f] = (x2 * cs + x1 * sn) * scale;
  }
}

__device__ __forceinline__ void gla_logdecay(const Params& p, int layer, int h, int dir, const bfr* rowbase, float* G) {
  const int tid = get_tid();
  const int j = tid >> 3, dg = tid & 7;
  const bfr* dl = rowbase + (size_t)j * DINP + C_GLD + dir * 16;
  u4 w0 = *(const u4*)dl, w1 = *(const u4*)(dl + 8);
  float x[16];
  unpack8(w0, x); unpack8(w1, x + 8);
  const float* wu = p.gla_wu + (size_t)layer * 8192 + dir * 4096 + h * 64;
  const float* bb = p.gla_b + layer * 512 + dir * 256 + h * 64;
#pragma unroll
  for (int dd = 0; dd < 8; ++dd) {
    int d = dg + 8 * dd;
    float pre = bb[d];
#pragma unroll
    for (int r = 0; r < 16; ++r) pre += x[r] * wu[r * 256 + d];
    G[j * 68 + d] = logsig_f(pre) * (1.f / 16.f);
  }
}

__device__ __forceinline__ void gla_logdecay2(const Params& p, int layer, int h, const bfr* rowbase, float* G0, float* G1) {
  const int tid = get_tid();
  const int w = tid >> 6, lane = tid & 63, fr = lane & 15, q4 = lane >> 4;
  const int dir = w >> 2, dt = w & 3;
  const int d = dt * 16 + fr;
  float* G = dir ? G1 : G0;
  u4 bw = (u4){0u, 0u, 0u, 0u};
  if (q4 < 2) {
    const float* wu = p.gla_wu + (size_t)layer * 8192 + dir * 4096 + (q4 * 8) * 256 + h * 64 + d;
    bw.x = pack2(wu[0 * 256], wu[1 * 256]); bw.y = pack2(wu[2 * 256], wu[3 * 256]);
    bw.z = pack2(wu[4 * 256], wu[5 * 256]); bw.w = pack2(wu[6 * 256], wu[7 * 256]);
  }
  const bf16x8 bq = __builtin_bit_cast(bf16x8, bw);
  const float bias = p.gla_b[layer * 512 + dir * 256 + h * 64 + d];
#pragma unroll
  for (int rt = 0; rt < 4; ++rt) {
    u4 aw = (u4){0u, 0u, 0u, 0u};
    if (q4 < 2) aw = *(const u4*)(rowbase + (size_t)(rt * 16 + fr) * DINP + C_GLD + dir * 16 + q4 * 8);
    f32x4 acc = (f32x4){0.f, 0.f, 0.f, 0.f};
    acc = MFMA16(__builtin_bit_cast(bf16x8, aw), bq, acc);
#pragma unroll
    for (int r = 0; r < 4; ++r) G[(rt * 16 + q4 * 4 + r) * 68 + d] = logsig_f(acc[r] + bias) * (1.f / 16.f);
  }
}

__device__ __forceinline__ int scan_pos(int dir, int g) { return dir == 0 ? g : (g < 4 ? 3 - g : 135 - g); }
__device__ __forceinline__ int group_row0(int b, int g) { return g < 4 ? (MX + b * 256 + g * 64) : (b * S + (g - 4) * 64); }

template <int W>
__device__ __forceinline__ void load_rows_transposed(bfr* T, const bfr* src) {
  for (int c = get_tid(); c < 64 * (W / 8); c += NTHR) {
    const int j = c & 63, dch = c >> 6;
    const u4 v = *(const u4*)(src + (size_t)j * DINP + dch * 8);
    bfr* d = T + (dch * 8) * 72 + j;
    d[0 * 72] = (bfr)(v.x & 0xffffu); d[1 * 72] = (bfr)(v.x >> 16);
    d[2 * 72] = (bfr)(v.y & 0xffffu); d[3 * 72] = (bfr)(v.y >> 16);
    d[4 * 72] = (bfr)(v.z & 0xffffu); d[5 * 72] = (bfr)(v.z >> 16);
    d[6 * 72] = (bfr)(v.w & 0xffffu); d[7 * 72] = (bfr)(v.w >> 16);
  }
}

template <int DK, bool GLA>
__device__ void scan_a_item(const Params& p, int layer, int item, char* smem) {
  const int g = item % 132;
  const int t2 = item / 132;
  const int h = t2 & 3, b = t2 >> 2;
  constexpr int KS = DK + 4;
  float* ks = (float*)smem;
  float* E0 = ks + 64 * KS;
  float* E1 = E0 + 64 * 68;
  bfr* Kt = (bfr*)(E1 + 64 * 68);
  bfr* Vt = Kt + DK * 72;
  const int tid = get_tid();
  const int w = tid >> 6, lane = tid & 63, fr = lane & 15, q4 = lane >> 4;
  const int row0 = group_row0(b, g);
  const bfr* rowbase = p.proj + (size_t)row0 * DINP;
  __syncthreads();
  if (GLA) {
    load_rows_transposed<128>(Vt, rowbase + C_GLV + h * 128);
    load_rows_f32<64>(ks, KS, rowbase + C_GLK + h * 64, 1.f);
    gla_logdecay2(p, layer, h, rowbase, E0, E1);
  } else {
    const float kscale = 0.08838834764831845f;
    load_rows_transposed<128>(Vt, rowbase + C_RTV + h * 128);
    load_rows_f32<128>(ks, KS, rowbase + C_RTK + h * 128, g < 4 ? kscale : 1.f);
    __syncthreads();
    if (g >= 4) rope128_tile(ks, KS, g - 4, p.rope, kscale);
  }
#pragma unroll 1
  for (int dir = 0; dir < 2; ++dir) {
    const int scan = ((b * 4 + h) * 2 + dir);
    const int pos = scan_pos(dir, g);
    float lg = 0.f;
    __syncthreads();
    float* E = dir ? E1 : E0;
    if (GLA) {
      if (tid < 64) {
        float run = 0.f;
        if (dir == 0) {
          for (int j = 63; j >= 0; --j) { float v = E[j * 68 + tid]; E[j * 68 + tid] = run; run += v; }
        } else {
          for (int j = 0; j < 64; ++j) { float v = E[j * 68 + tid]; E[j * 68 + tid] = run; run += v; }
        }
        p.dec_gla[(size_t)(scan * 132 + pos) * 64 + tid] = __expf(run);
      }
      __syncthreads();
    } else {
      lg = p.ret_lg[layer * 8 + dir * 4 + h];
      if (tid < 128) p.dec_ret[(size_t)(scan * 132 + pos) * 128 + tid] = __expf(lg * 64.f);
    }
    for (int u = tid; u < 64 * DK; u += NTHR) {
      const int j = u & 63, d = u >> 6;
      const float sc = GLA ? __expf(E[j * 68 + d]) : __expf(lg * (dir == 0 ? (float)(63 - j) : (float)j));
      Kt[d * 72 + j] = f2bf(ks[j * KS + d] * sc);
    }
    __syncthreads();
    bf16x8 vfr[2];
#pragma unroll
    for (int k2 = 0; k2 < 2; ++k2) vfr[k2] = *(const bf16x8*)(Vt + (w * 16 + fr) * 72 + k2 * 32 + q4 * 8);
    bfr* st = (GLA ? p.st_gla : p.st_ret) + (size_t)(scan * 132 + pos) * DK * 128;
#pragma unroll 2
    for (int dt = 0; dt < DK / 16; ++dt) {
      f32x4 acc = (f32x4){0.f, 0.f, 0.f, 0.f};
#pragma unroll
      for (int k2 = 0; k2 < 2; ++k2) {
        const bf16x8 kq = *(const bf16x8*)(Kt + (dt * 16 + fr) * 72 + k2 * 32 + q4 * 8);
        acc = MFMA16(kq, vfr[k2], acc);
      }
      uint2 o;
      o.x = pack2(acc[0], acc[1]); o.y = pack2(acc[2], acc[3]);
      *(uint2*)(st + (size_t)(w * 16 + fr) * DK + dt * 16 + q4 * 4) = o;
    }
  }
}

__device__ void scan_b_phase(const Params& p) {
  const int gt = get_bid() * NTHR + get_tid(), ntot = gridDim.x * NTHR;
  for (int ch = gt; ch < 98304; ch += ntot) {
    bfr* st; const float* dec; int DK, e4;
    if (ch < 65536) { int scan = ch >> 12; e4 = ch & 4095; DK = 128; st = p.st_ret + (size_t)scan * 132 * 16384; dec = p.dec_ret + (size_t)scan * 132 * 128; }
    else { int c2 = ch - 65536; int scan = c2 >> 11; e4 = c2 & 2047; DK = 64; st = p.st_gla + (size_t)scan * 132 * 8192; dec = p.dec_gla + (size_t)scan * 132 * 64; }
    const int d0 = (e4 * 4) & (DK - 1);
    const size_t cstride = (size_t)DK * 128;
    float4 s = make_float4(0.f, 0.f, 0.f, 0.f);
    bfr* ptr = st + e4 * 4;
    const float* dp = dec + d0;
    for (int pos = 0; pos < 132; pos += 4) {
      uint2 u[4];
      float4 dv[4];
#pragma unroll
      for (int q = 0; q < 4; ++q) {
        u[q] = *(const uint2*)(ptr + (size_t)(pos + q) * cstride);
        dv[q] = *(const float4*)(dp + (pos + q) * DK);
      }
#pragma unroll
      for (int q = 0; q < 4; ++q) {
        uint2 o;
        o.x = pack2(s.x, s.y); o.y = pack2(s.z, s.w);
        *(uint2*)(ptr + (size_t)(pos + q) * cstride) = o;
        s = make_float4(dv[q].x * s.x + lo16(u[q].x), dv[q].y * s.y + hi16(u[q].x), dv[q].z * s.z + lo16(u[q].y), dv[q].w * s.w + hi16(u[q].y));
      }
    }
  }
}

template <int DK, bool GLA>
__device__ void scan_c_item(const Params& p, int layer, int item, char* smem) {
  const int g = item % 132;
  const int t2 = item / 132;
  const int h = t2 & 3, b = t2 >> 2;
  constexpr int FS = DK + 4;
  constexpr int QS = DK + 8;
  float* stg = (float*)smem;
  float* Gf = stg + 64 * FS;
  float* Gb = Gf + (GLA ? 64 * 68 : 0);
  float* red = Gb + (GLA ? 64 * 68 : 0);
  float* red2 = red + 8 * 64 * 2;
  bfr* T0 = (bfr*)(red2 + 64 * 2);
  bfr* T1 = T0 + 64 * QS;
  bfr* T2 = T1 + 64 * QS;
  bfr* T3 = T2 + 64 * QS;
  bfr* T4 = T3 + 64 * QS;
  bfr* T5 = T4 + (GLA ? 64 * QS : 0);
  bfr* Vt = T5 + (GLA ? 64 * QS : 0);
  bfr* Am = Vt + 128 * 72;
  const int tid = get_tid();
  const int w = tid >> 6, lane = tid & 63, fr = lane & 15, q4 = lane >> 4;
  const int row0 = group_row0(b, g);
  const bfr* rowbase = p.proj + (size_t)row0 * DINP;
  float lgf = 0.f, lgb = 0.f;
  __syncthreads();
  if (GLA) {
    load_rows_transposed<128>(Vt, rowbase + C_GLV + h * 128);
    load_rows_f32<64>(stg, FS, rowbase + C_GLQ + h * 64, 0.125f);
    gla_logdecay2(p, layer, h, rowbase, Gf, Gb);
    __syncthreads();
    {
      const int d = tid & 63, seg = tid >> 6;
      float runf = 0.f, runb = 0.f;
#pragma unroll
      for (int jj = 0; jj < 8; ++jj) {
        const int jf = seg * 8 + jj, jb = seg * 8 + 7 - jj;
        runf += Gf[jf * 68 + d]; Gf[jf * 68 + d] = runf;
        runb += Gb[jb * 68 + d]; Gb[jb * 68 + d] = runb;
      }
      red[seg * 64 + d] = runf;
      red[512 + seg * 64 + d] = runb;
      __syncthreads();
      float offf = 0.f, offb = 0.f;
#pragma unroll
      for (int s2 = 0; s2 < 8; ++s2) {
        if (s2 < seg) offf += red[s2 * 64 + d];
        if (s2 > seg) offb += red[512 + s2 * 64 + d];
      }
#pragma unroll
      for (int jj = 0; jj < 8; ++jj) {
        const int j = seg * 8 + jj;
        Gf[j * 68 + d] += offf;
        Gb[j * 68 + d] += offb;
      }
    }
    __syncthreads();
    for (int u = tid; u < 64 * 64; u += NTHR) {
      const int i = u >> 6, d = u & 63;
      const float qv = stg[i * FS + d];
      const float gf = Gf[i * 68 + d], gb = Gb[i * 68 + d];
      T0[i * QS + d] = f2bf(qv * __expf(gf - Gf[63 * 68 + d]));
      T2[i * QS + d] = f2bf(qv * __expf(gf));
      T4[i * QS + d] = f2bf(qv * __expf(gb - Gb[d]));
      T3[i * QS + d] = f2bf(qv * __expf(gb));
    }
    __syncthreads();
    load_rows_f32<64>(stg, FS, rowbase + C_GLK + h * 64, 1.f);
    __syncthreads();
    for (int u = tid; u < 64 * 64; u += NTHR) {
      const int j = u >> 6, d = u & 63;
      const float kv = stg[j * FS + d];
      T1[j * QS + d] = f2bf(kv * __expf(Gf[63 * 68 + d] - Gf[j * 68 + d]));
      T5[j * QS + d] = f2bf(kv * __expf(Gb[d] - Gb[j * 68 + d]));
    }
  } else {
    const float kscale = 0.08838834764831845f;
    lgf = p.ret_lg[layer * 8 + 0 + h];
    lgb = p.ret_lg[layer * 8 + 4 + h];
    load_rows_transposed<128>(Vt, rowbase + C_RTV + h * 128);
    {
      const int j = tid >> 3, A = (tid >> 2) & 1, fc = tid & 3;
      float cs[8], sn[8];
      if (g >= 4) {
        const int pos = A ? j : (g - 4);
        const float* cp = p.rope + 4096 + pos * 32 + fc * 8;
        const float4 c0 = *(const float4*)cp, c1 = *(const float4*)(cp + 4);
        const float4 s0 = *(const float4*)(cp + 4096), s1 = *(const float4*)(cp + 4100);
        cs[0] = c0.x; cs[1] = c0.y; cs[2] = c0.z; cs[3] = c0.w; cs[4] = c1.x; cs[5] = c1.y; cs[6] = c1.z; cs[7] = c1.w;
        sn[0] = s0.x; sn[1] = s0.y; sn[2] = s0.z; sn[3] = s0.w; sn[4] = s1.x; sn[5] = s1.y; sn[6] = s1.z; sn[7] = s1.w;
      } else {
#pragma unroll
        for (int e = 0; e < 8; ++e) { cs[e] = 1.f; sn[e] = 0.f; }
      }
      const int col = A * 64 + fc * 8;
      const bfr* qp = rowbase + (size_t)j * DINP + C_RTQ + h * 128 + col;
      const bfr* kp = rowbase + (size_t)j * DINP + C_RTK + h * 128 + col;
      const u4 q1 = *(const u4*)qp, q2 = *(const u4*)(qp + 32);
      const u4 k1 = *(const u4*)kp, k2w = *(const u4*)(kp + 32);
      float x1[8], x2[8], y1[8], y2[8];
      unpack8(q1, x1); unpack8(q2, x2);
#pragma unroll
      for (int e = 0; e < 8; ++e) { y1[e] = x1[e] * cs[e] - x2[e] * sn[e]; y2[e] = x2[e] * cs[e] + x1[e] * sn[e]; }
      const float ff = __expf(lgf * (float)(j + 1)), fb = __expf(lgb * (float)(64 - j));
      u4 o;
      o.x = pack2(y1[0], y1[1]); o.y = pack2(y1[2], y1[3]); o.z = pack2(y1[4], y1[5]); o.w = pack2(y1[6], y1[7]);
      *(u4*)(T0 + j * QS + col) = o;
      o.x = pack2(y2[0], y2[1]); o.y = pack2(y2[2], y2[3]); o.z = pack2(y2[4], y2[5]); o.w = pack2(y2[6], y2[7]);
      *(u4*)(T0 + j * QS + col + 32) = o;
      o.x = pack2(y1[0] * ff, y1[1] * ff); o.y = pack2(y1[2] * ff, y1[3] * ff); o.z = pack2(y1[4] * ff, y1[5] * ff); o.w = pack2(y1[6] * ff, y1[7] * ff);
      *(u4*)(T2 + j * QS + col) = o;
      o.x = pack2(y2[0] * ff, y2[1] * ff); o.y = pack2(y2[2] * ff, y2[3] * ff); o.z = pack2(y2[4] * ff, y2[5] * ff); o.w = pack2(y2[6] * ff, y2[7] * ff);
      *(u4*)(T2 + j * QS + col + 32) = o;
      o.x = pack2(y1[0] * fb, y1[1] * fb); o.y = pack2(y1[2] * fb, y1[3] * fb); o.z = pack2(y1[4] * fb, y1[5] * fb); o.w = pack2(y1[6] * fb, y1[7] * fb);
      *(u4*)(T3 + j * QS + col) = o;
      o.x = pack2(y2[0] * fb, y2[1] * fb); o.y = pack2(y2[2] * fb, y2[3] * fb); o.z = pack2(y2[4] * fb, y2[5] * fb); o.w = pack2(y2[6] * fb, y2[7] * fb);
      *(u4*)(T3 + j * QS + col + 32) = o;
      unpack8(k1, x1); unpack8(k2w, x2);
#pragma unroll
      for (int e = 0; e < 8; ++e) { y1[e] = (x1[e] * cs[e] - x2[e] * sn[e]) * kscale; y2[e] = (x2[e] * cs[e] + x1[e] * sn[e]) * kscale; }
      o.x = pack2(y1[0], y1[1]); o.y = pack2(y1[2], y1[3]); o.z = pack2(y1[4], y1[5]); o.w = pack2(y1[6], y1[7]);
      *(u4*)(T1 + j * QS + col) = o;
      o.x = pack2(y2[0], y2[1]); o.y = pack2(y2[2], y2[3]); o.z = pack2(y2[4], y2[5]); o.w = pack2(y2[6], y2[7]);
      *(u4*)(T1 + j * QS + col + 32) = o;
    }
  }
  __syncthreads();
  {
    const int ti = w >> 1;
#pragma unroll
    for (int tt = 0; tt < 2; ++tt) {
      const int tj = (w & 1) * 2 + tt;
      f32x4 af = (f32x4){0.f, 0.f, 0.f, 0.f}, ab = af;
#pragma unroll
      for (int k2 = 0; k2 < DK / 32; ++k2) {
        const bf16x8 a = *(const bf16x8*)(T0 + (ti * 16 + fr) * QS + k2 * 32 + q4 * 8);
        const bf16x8 bq = *(const bf16x8*)(T1 + (tj * 16 + fr) * QS + k2 * 32 + q4 * 8);
        af = MFMA16(a, bq, af);
        if (GLA) {
          const bf16x8 a2 = *(const bf16x8*)(T4 + (ti * 16 + fr) * QS + k2 * 32 + q4 * 8);
          const bf16x8 b2 = *(const bf16x8*)(T5 + (tj * 16 + fr) * QS + k2 * 32 + q4 * 8);
          ab = MFMA16(a2, b2, ab);
        }
      }
#pragma unroll
      for (int r = 0; r < 4; ++r) {
        const int i = ti * 16 + q4 * 4 + r, j = tj * 16 + fr;
        float v;
        if (GLA) v = (j <= i) ? af[r] : ab[r];
        else v = af[r] * ((j <= i) ? __expf(lgf * (float)(i - j)) : __expf(lgb * (float)(j - i)));
        Am[i * 72 + j] = f2bf(v);
      }
    }
  }
  __syncthreads();
  f32x4 acc[4];
#pragma unroll
  for (int rt = 0; rt < 4; ++rt) acc[rt] = (f32x4){0.f, 0.f, 0.f, 0.f};
#pragma unroll
  for (int k2 = 0; k2 < 2; ++k2) {
    const bf16x8 bq = *(const bf16x8*)(Vt + (w * 16 + fr) * 72 + k2 * 32 + q4 * 8);
#pragma unroll
    for (int rt = 0; rt < 4; ++rt) {
      const bf16x8 a = *(const bf16x8*)(Am + (rt * 16 + fr) * 72 + k2 * 32 + q4 * 8);
      acc[rt] = MFMA16(a, bq, acc[rt]);
    }
  }
#pragma unroll
  for (int dir = 0; dir < 2; ++dir) {
    const int scan = (b * 4 + h) * 2 + dir;
    const int pos = scan_pos(dir, g);
    const bfr* St = (GLA ? p.st_gla : p.st_ret) + (size_t)(scan * 132 + pos) * DK * 128 + (size_t)(w * 16 + fr) * DK + q4 * 8;
    const bfr* qt = dir == 0 ? T2 : T3;
#pragma unroll
    for (int k2 = 0; k2 < DK / 32; ++k2) {
      const bf16x8 bq = *(const bf16x8*)(St + k2 * 32);
#pragma unroll
      for (int rt = 0; rt < 4; ++rt) {
        const bf16x8 a = *(const bf16x8*)(qt + (rt * 16 + fr) * QS + k2 * 32 + q4 * 8);
        acc[rt] = MFMA16(a, bq, acc[rt]);
      }
    }
  }
#pragma unroll
  for (int rt = 0; rt < 4; ++rt)
#pragma unroll
    for (int r = 0; r < 4; ++r) {
      float s1 = acc[rt][r], s2 = s1 * s1;
#pragma unroll
      for (int of = 8; of; of >>= 1) { s1 += __shfl_xor(s1, of); s2 += __shfl_xor(s2, of); }
      if (fr == 0) {
        const int i = rt * 16 + q4 * 4 + r;
        red[(w * 64 + i) * 2 + 0] = s1;
        red[(w * 64 + i) * 2 + 1] = s2;
      }
    }
  __syncthreads();
  if (tid < 128) {
    const int i = tid >> 1, c = tid & 1;
    float t = 0.f;
#pragma unroll
    for (int ww = 0; ww < 8; ++ww) t += red[(ww * 64 + i) * 2 + c];
    red2[i * 2 + c] = t;
  }
  __syncthreads();
  const int gcol = GLA ? C_GLG : C_RTG;
  const int ocol = GLA ? 1024 : 512;
  const int vcol = h * 128 + w * 16 + fr;
  const float gg = GLA ? p.gla_g[layer * 128 + w * 16 + fr] : 1.f;
#pragma unroll
  for (int rt = 0; rt < 4; ++rt)
#pragma unroll
    for (int r = 0; r < 4; ++r) {
      const int i = rt * 16 + q4 * 4 + r;
      const float S1 = red2[i * 2 + 0], S2 = red2[i * 2 + 1];
      float y;
      if (GLA) {
        y = acc[rt][r] * rsqrtf(S2 * (1.f / 128.f) + EPS) * gg;
      } else {
        const float mu = S1 * (1.f / 128.f);
        const float var = fmaxf(S2 * (1.f / 128.f) - mu * mu, 0.f);
        y = (acc[rt][r] - mu) * rsqrtf(var + EPS);
      }
      const int row = row0 + i;
      const float gt = bf2f(p.proj[(size_t)row * DINP + gcol + vcol]);
      y *= silu_f(gt);
      p.mix[(size_t)row * D + ocol + vcol] = f2bf(y);
    }
}

__constant__ unsigned char c_cand_tab[64] = {0, 1, 2, 3, 4, 5, 6, 7, 8, 9, 10, 11, 12, 13, 14, 15, 16, 17, 18, 19, 20, 21, 22, 23, 32, 33, 34, 35, 36, 48, 49, 50, 51, 64, 65, 66, 80, 81, 96, 97, 112, 113, 128, 144, 160, 176, 192, 208, 224, 240, 255, 255, 255, 255, 255, 255, 255, 255, 255, 255, 255, 255, 255, 255};

template <int N>
__device__ __forceinline__ void bitonic_sort_desc(float (&v)[N]) {
#pragma unroll
  for (int k = 2; k <= N; k <<= 1)
#pragma unroll
    for (int j = k >> 1; j > 0; j >>= 1)
#pragma unroll
      for (int i = 0; i < N; ++i) {
        const int l = i ^ j;
        if (l > i) {
          const bool desc = ((i & k) == 0);
          const float x = v[i], y = v[l];
          const float hi = fmaxf(x, y), lo = fminf(x, y);
          v[i] = desc ? hi : lo;
          v[l] = desc ? lo : hi;
        }
      }
}
__device__ __forceinline__ void merge_top16(float (&v)[16], const int xl) {
  float o[16];
#pragma unroll
  for (int i = 0; i < 16; ++i) o[i] = __shfl_xor(v[15 - i], xl);
#pragma unroll
  for (int i = 0; i < 16; ++i) v[i] = fmaxf(v[i], o[i]);
#pragma unroll
  for (int j = 8; j > 0; j >>= 1)
#pragma unroll
    for (int i = 0; i < 16; ++i) {
      const int l = i ^ j;
      if (l > i) {
        const float x = v[i], y = v[l];
        v[i] = fmaxf(x, y);
        v[l] = fminf(x, y);
      }
    }
}
__device__ __forceinline__ float pack_key(float x, unsigned mask, unsigned key) {
  return __uint_as_float((__float_as_uint(x) & ~mask) | key);
}

__device__ void topk_phase(const Params& p, int layer, int ntok, char* smem) {
  float* sc = (float*)smem;
  const int tid = get_tid();
  const int lane = tid & 63, w = tid >> 6, fr = lane & 15, q4 = lane >> 4;
  const int nbatch = ntok >> 4;
  for (int bt = get_bid(); bt < nbatch; bt += gridDim.x) {
    __syncthreads();
#pragma unroll 1
    for (int pp = 0; pp < 2; ++pp) {
      const int pair = 2 * w + pp;
      const bfr* qrow = p.q + (size_t)(bt * 16 + fr) * D + pair * 128 + q4 * 8;
      const bfr* skb = p.sk_bf + (size_t)(((layer * 2 + (pair & 1)) * 8 + (pair >> 1))) * 128 * 128 + q4 * 8;
      bf16x8 af[4];
#pragma unroll
      for (int k2 = 0; k2 < 4; ++k2) af[k2] = *(const bf16x8*)(qrow + k2 * 32);
#pragma unroll 4
      for (int nt = 0; nt < 8; ++nt) {
        f32x4 acc = (f32x4){0.f, 0.f, 0.f, 0.f};
#pragma unroll
        for (int k2 = 0; k2 < 4; ++k2) {
          const bf16x8 bq = *(const bf16x8*)(skb + (size_t)(nt * 16 + fr) * 128 + k2 * 32);
          acc = MFMA16(af[k2], bq, acc);
        }
#pragma unroll
        for (int r = 0; r < 4; ++r) sc[((q4 * 4 + r) * 16 + pair) * 132 + nt * 16 + fr] = acc[r];
      }
    }
    __syncthreads();
#pragma unroll 1
    for (int ps = 0; ps < 2; ++ps) {
      const int list = ps * 128 + (tid >> 2), qd = tid & 3;
      float v[32];
#pragma unroll
      for (int j = 0; j < 8; ++j) {
        float4 t = *(const float4*)(sc + list * 132 + qd * 32 + j * 4);
        const unsigned kb = qd * 32 + j * 4;
        v[j * 4 + 0] = pack_key(t.x, 127u, kb + 0); v[j * 4 + 1] = pack_key(t.y, 127u, kb + 1);
        v[j * 4 + 2] = pack_key(t.z, 127u, kb + 2); v[j * 4 + 3] = pack_key(t.w, 127u, kb + 3);
      }
      bitonic_sort_desc<32>(v);
      float wv[16];
#pragma unroll
      for (int i = 0; i < 16; ++i) wv[i] = v[i];
      merge_top16(wv, 1);
      merge_top16(wv, 2);
      if (qd == 0) {
#pragma unroll
        for (int j = 0; j < 4; ++j)
          *(float4*)(sc + list * 132 + j * 4) = make_float4(wv[j * 4 + 0], wv[j * 4 + 1], wv[j * 4 + 2], wv[j * 4 + 3]);
      }
    }
    __syncthreads();
    {
      const int pair = tid >> 2, qd = tid & 3;
      const int tok = pair >> 3, hh = pair & 7;
      const float* o0 = sc + (tok * 16 + hh * 2) * 132;
      const float* o1 = o0 + 132;
      float c[16];
#pragma unroll
      for (int i = 0; i < 16; ++i) {
        const unsigned code = c_cand_tab[qd * 16 + i];
        const float sum = o0[code >> 4] + o1[code & 15];
        c[i] = (code == 255u) ? -INFINITY : pack_key(sum, 255u, code);
      }
      bitonic_sort_desc<16>(c);
      merge_top16(c, 1);
      merge_top16(c, 2);
      float e[16];
      float esum = 0.f;
#pragma unroll
      for (int i = 0; i < 16; ++i) { e[i] = __expf(c[i] - c[0]); esum += e[i]; }
      const float inv = 1.f / esum;
      const int m = bt * 16 + tok;
#pragma unroll
      for (int j = 0; j < 4; ++j) {
        const float ev = qd == 0 ? e[j] : (qd == 1 ? e[4 + j] : (qd == 2 ? e[8 + j] : e[12 + j]));
        const float cv = qd == 0 ? c[j] : (qd == 1 ? c[4 + j] : (qd == 2 ? c[8 + j] : c[12 + j]));
        const unsigned code = __float_as_uint(cv) & 255u;
        const unsigned k0 = __float_as_uint(o0[code >> 4]) & 127u;
        const unsigned k1 = __float_as_uint(o1[code & 15]) & 127u;
        p.pidx[(size_t)m * 128 + hh * 16 + qd * 4 + j] = (int)(k0 * 128u + k1);
        p.pgate[(size_t)m * 128 + hh * 16 + qd * 4 + j] = ev * inv;
      }
    }
  }
}

typedef __attribute__((ext_vector_type(2))) float f32x2;
__device__ __forceinline__ float dot16_fp8(const float* hf, const u4 w) {
  f32x2 a0 = __builtin_amdgcn_cvt_pk_f32_fp8((int)w.x, false), a1 = __builtin_amdgcn_cvt_pk_f32_fp8((int)w.x, true);
  f32x2 b0 = __builtin_amdgcn_cvt_pk_f32_fp8((int)w.y, false), b1 = __builtin_amdgcn_cvt_pk_f32_fp8((int)w.y, true);
  f32x2 c0 = __builtin_amdgcn_cvt_pk_f32_fp8((int)w.z, false), c1 = __builtin_amdgcn_cvt_pk_f32_fp8((int)w.z, true);
  f32x2 d0 = __builtin_amdgcn_cvt_pk_f32_fp8((int)w.w, false), d1 = __builtin_amdgcn_cvt_pk_f32_fp8((int)w.w, true);
  return hf[0] * a0.x + hf[1] * a0.y + hf[2] * a1.x + hf[3] * a1.y + hf[4] * b0.x + hf[5] * b0.y + hf[6] * b1.x + hf[7] * b1.y +
         hf[8] * c0.x + hf[9] * c0.y + hf[10] * c1.x + hf[11] * c1.y + hf[12] * d0.x + hf[13] * d0.y + hf[14] * d1.x + hf[15] * d1.y;
}
__device__ __forceinline__ void fma16_fp8(float* o, float c, const u4 w) {
  f32x2 a0 = __builtin_amdgcn_cvt_pk_f32_fp8((int)w.x, false), a1 = __builtin_amdgcn_cvt_pk_f32_fp8((int)w.x, true);
  f32x2 b0 = __builtin_amdgcn_cvt_pk_f32_fp8((int)w.y, false), b1 = __builtin_amdgcn_cvt_pk_f32_fp8((int)w.y, true);
  f32x2 c0 = __builtin_amdgcn_cvt_pk_f32_fp8((int)w.z, false), c1 = __builtin_amdgcn_cvt_pk_f32_fp8((int)w.z, true);
  f32x2 d0 = __builtin_amdgcn_cvt_pk_f32_fp8((int)w.w, false), d1 = __builtin_amdgcn_cvt_pk_f32_fp8((int)w.w, true);
  o[0] += c * a0.x; o[1] += c * a0.y; o[2] += c * a1.x; o[3] += c * a1.y;
  o[4] += c * b0.x; o[5] += c * b0.y; o[6] += c * b1.x; o[7] += c * b1.y;
  o[8] += c * c0.x; o[9] += c * c0.y; o[10] += c * c1.x; o[11] += c * c1.y;
  o[12] += c * d0.x; o[13] += c * d0.y; o[14] += c * d1.x; o[15] += c * d1.y;
}

__device__ void peer_phase(const Params& p, int layer, int ntok) {
  const int lane = get_tid() & 63;
  const int wave = get_bid() * 8 + (get_tid() >> 6), nw = gridDim.x * 8;
  const unsigned char* U = p.u8 + (size_t)layer * 16384 * D;
  const unsigned char* V = p.v8 + (size_t)layer * 16384 * D;
  const float* usc = p.uscl + layer * 16384;
  const float* vsc = p.vscl + layer * 16384;
  for (int m = wave; m < ntok; m += nw) {
    float hf[32];
    const bfr* hr = p.h + (size_t)m * D + lane * 16;
#pragma unroll
    for (int i = 0; i < 2; ++i) {
      u4 w0 = *(const u4*)(hr + i * 1024), w1 = *(const u4*)(hr + i * 1024 + 8);
      unpack8(w0, hf + i * 16);
      unpack8(w1, hf + i * 16 + 8);
    }
    const int idA = p.pidx[(size_t)m * 128 + lane], idB = p.pidx[(size_t)m * 128 + 64 + lane];
    const float gA = p.pgate[(size_t)m * 128 + lane] * vsc[idA], gB = p.pgate[(size_t)m * 128 + 64 + lane] * vsc[idB];
    const float usA = usc[idA], usB = usc[idB];
    float cA = 0.f, cB = 0.f;
#pragma unroll 1
    for (int e0 = 0; e0 < 128; e0 += 8) {
      u4 r[8][2];
#pragma unroll
      for (int u = 0; u < 8; ++u) {
        int e = e0 + u;
        int row = __shfl(e0 < 64 ? idA : idB, e & 63);
        const unsigned char* up = U + (size_t)row * D + lane * 16;
        r[u][0] = *(const u4*)(up);
        r[u][1] = *(const u4*)(up + 1024);
      }
      __builtin_amdgcn_sched_barrier(0);
#pragma unroll
      for (int u = 0; u < 8; ++u) {
        int e = e0 + u;
        float dsum = dot16_fp8(hf, r[u][0]) + dot16_fp8(hf + 16, r[u][1]);
        dsum = wave_sum(dsum);
        if (e0 < 64) { if (lane == e) cA = gA * gelu_f(dsum * usA); }
        else { if (lane == e - 64) cB = gB * gelu_f(dsum * usB); }
        __builtin_amdgcn_sched_barrier(0);
      }
    }
    float o[32];
#pragma unroll
    for (int i = 0; i < 32; ++i) o[i] = 0.f;
#pragma unroll 1
    for (int e0 = 0; e0 < 128; e0 += 4) {
      u4 r[4][2];
      float cf[4];
#pragma unroll
      for (int u = 0; u < 4; ++u) {
        int e = e0 + u;
        int row = __shfl(e0 < 64 ? idA : idB, e & 63);
        cf[u] = __shfl(e0 < 64 ? cA : cB, e & 63);
        const unsigned char* vp = V + (size_t)row * D + lane * 16;
        r[u][0] = *(const u4*)(vp);
        r[u][1] = *(const u4*)(vp + 1024);
      }
      __builtin_amdgcn_sched_barrier(0);
#pragma unroll
      for (int u = 0; u < 4; ++u) {
        fma16_fp8(o, cf[u], r[u][0]);
        fma16_fp8(o + 16, cf[u], r[u][1]);
        __builtin_amdgcn_sched_barrier(0);
      }
    }
    const int vec = m < S ? 0 : (m < MX ? 1 : 2);
    const float* modl = p.mod + (layer * 3 + vec) * 12288;
    float* xr = p.xcur + (size_t)m * D + lane * 16;
    float xn[32];
    float ss = 0.f;
#pragma unroll
    for (int i = 0; i < 2; ++i)
#pragma unroll
      for (int k = 0; k < 4; ++k) {
        int col = i * 1024 + lane * 16 + k * 4;
        float4 a = *(const float4*)(xr + i * 1024 + k * 4);
        float4 g0 = *(const float4*)(modl + 5 * D + col);
        float* xx = xn + i * 16 + k * 4;
        const float* oo = o + i * 16 + k * 4;
        xx[0] = a.x + g0.x * oo[0]; xx[1] = a.y + g0.y * oo[1]; xx[2] = a.z + g0.z * oo[2]; xx[3] = a.w + g0.w * oo[3];
        ss += xx[0] * xx[0] + xx[1] * xx[1] + xx[2] * xx[2] + xx[3] * xx[3];
      }
    ss = wave_sum(ss);
    const float rstd = rsqrtf(ss * (1.f / D) + EPS);
    if (layer == 1) {
      float* orow = p.out + (size_t)m * D;
#pragma unroll
      for (int i = 0; i < 2; ++i)
#pragma unroll
        for (int k = 0; k < 4; ++k) {
          int col = i * 1024 + lane * 16 + k * 4;
          float4 f0 = *(const float4*)(p.final_g + col);
          const float* xx = xn + i * 16 + k * 4;
          *(float4*)(orow + col) = make_float4(xx[0] * rstd * f0.x, xx[1] * rstd * f0.y, xx[2] * rstd * f0.z, xx[3] * rstd * f0.w);
        }
    } else {
      const float* modn = p.mod + ((layer + 1) * 3 + vec) * 12288;
      const float* gn = p.g_attn + (layer + 1) * D;
#pragma unroll
      for (int i = 0; i < 2; ++i) {
        float y[16];
#pragma unroll
        for (int k = 0; k < 4; ++k) {
          int col = i * 1024 + lane * 16 + k * 4;
          const float* xx = xn + i * 16 + k * 4;
          *(float4*)(xr + i * 1024 + k * 4) = make_float4(xx[0], xx[1], xx[2], xx[3]);
          float4 gv = *(const float4*)(gn + col), scv = *(const float4*)(modn + D + col), shv = *(const float4*)(modn + col);
          y[k * 4 + 0] = xx[0] * rstd * gv.x * (1.f + scv.x) + shv.x;
          y[k * 4 + 1] = xx[1] * rstd * gv.y * (1.f + scv.y) + shv.y;
          y[k * 4 + 2] = xx[2] * rstd * gv.z * (1.f + scv.z) + shv.z;
          y[k * 4 + 3] = xx[3] * rstd * gv.w * (1.f + scv.w) + shv.w;
        }
        u4 w0, w1;
        w0.x = pack2(y[0], y[1]); w0.y = pack2(y[2], y[3]); w0.z = pack2(y[4], y[5]); w0.w = pack2(y[6], y[7]);
        w1.x = pack2(y[8], y[9]); w1.y = pack2(y[10], y[11]); w1.z = pack2(y[12], y[13]); w1.w = pack2(y[14], y[15]);
        *(u4*)(p.h + (size_t)m * D + i * 1024 + lane * 16) = w0;
        *(u4*)(p.h + (size_t)m * D + i * 1024 + lane * 16 + 8) = w1;
      }
    }
  }
}

constexpr int PH_INIT = 0, PH_MOD_ATTN = 1, PH_INPROJ = 2, PH_MIX1 = 3, PH_SCANB = 4, PH_SCANC = 5, PH_OUTPROJ = 6,
              PH_MOD_FFN = 7, PH_QPROJ = 8, PH_SCORES = 9, PH_TOPK = 10, PH_PEER = 11;

template <int EPI, bool ALLOW_BIG>
__device__ __forceinline__ void gemm_phase(const Params& p, int layer, int vid, const bfr* A, const bfr* Bt, int MB, int MT,
                                           int NB, int N128, int small_nt, void* Cout, int ldc, char* smem) {
  const int nbig = MB * NB;
  const int nsm1 = small_nt >= 0 ? MB : 0;
  const int nsm2 = (MT - MB) * N128;
  const int total = nbig + nsm1 + nsm2;
  for (int t = vid; t < total; t += gridDim.x) {
    if (t < nbig) {
      if constexpr (ALLOW_BIG) {
        const int mt = t / NB, nt = t - mt * NB;
        gemm_tile<EPI, true>(A, D, Bt, D, D, mt * 256, nt * 256, Cout, ldc, p, layer, smem);
      }
    } else if (t < nbig + nsm1) {
      gemm_tile<EPI, false>(A, D, Bt, D, D, (t - nbig) * 256, small_nt * 128, Cout, ldc, p, layer, smem);
    } else {
      const int u = t - nbig - nsm1;
      const int mt = MB + u / N128, nt = u % N128;
      gemm_tile<EPI, false>(A, D, Bt, D, D, mt * 256, nt * 128, Cout, ldc, p, layer, smem);
    }
  }
}

__device__ void run_phase(const Params& p, int ph, int layer, char* smem, int vid) {
  const int bid = get_bid(), nb = gridDim.x;
  const bool last = (layer == 1);
  switch (ph) {
    case PH_INIT: phase0(p, smem); break;
    case PH_MOD_ATTN: modulate_phase(p, layer, 0, MT); break;
    case PH_INPROJ:
      gemm_phase<0, true>(p, layer, vid, p.h, p.wt_in + (size_t)layer * DINP * D, 66, 66, 23, 47, 46, p.proj, DINP, smem);
      break;
    case PH_MIX1: {
      const int n_swa = 256, n_na = 2048, n_sa = 1056, n_ctx = last ? 0 : 32;
      const int total = n_swa + n_na + 2 * n_sa + n_ctx;
      for (int it = bid; it < total; it += nb) {
        int t = it;
        if (t < n_swa) { swa_item(p, layer, t, smem); continue; }
        t -= n_swa;
        if (t < n_na) { na_item(p, layer, t, smem); continue; }
        t -= n_na;
        if (t < n_sa) { scan_a_item<128, false>(p, layer, t, smem); continue; }
        t -= n_sa;
        if (t < n_sa) { scan_a_item<64, true>(p, layer, t, smem); continue; }
        t -= n_sa;
        ctx_item(p, layer, t, smem);
      }
    } break;
    case PH_SCANB: scan_b_phase(p); break;
    case PH_SCANC:
      for (int it = bid; it < 2 * 1056; it += nb) {
        const bool gla = it < 1056;
        const int t = gla ? it : it - 1056;
        if (last && (t % 132) < 4) continue;
        if (gla) scan_c_item<64, true>(p, layer, t, smem);
        else scan_c_item<128, false>(p, layer, t, smem);
      }
      break;
    case PH_OUTPROJ: {
      gemm_phase<1, false>(p, layer, vid, p.mix, p.wt_out + (size_t)layer * D * D, 0, last ? 64 : 66, 8, 16, -1, nullptr, 0, smem);
    } break;
    case PH_MOD_FFN: modulate_phase(p, layer, 1, last ? MX : MT); break;
    case PH_QPROJ: {
      gemm_phase<0, true>(p, layer, vid, p.h, p.wt_q + (size_t)layer * D * D, 64, last ? 64 : 66, 8, 16, -1, p.q, D, smem);
    } break;
    case PH_SCORES: {
      const int mt = last ? 64 : 66;
      for (int t = bid; t < mt * 16; t += nb) {
        int j = t & 15;
        int hh = j >> 1, pp = j & 1;
        const bfr* bt = p.sk_bf + (size_t)(((layer * 2 + pp) * 8 + hh)) * 128 * 128;
        gemm_tile<2, false>(p.q + j * 128, D, bt, 128, 128, (t >> 4) * 256, 0, p.scores + j * 128, D, p, layer, smem);
      }
    } break;
    case PH_TOPK: topk_phase(p, layer, last ? MX : MT, smem); break;
    case PH_PEER: peer_phase(p, layer, last ? MX : MT); break;
  }
}

__device__ __forceinline__ void grid_barrier(unsigned* bar, unsigned& epoch) {
  asm volatile("s_waitcnt vmcnt(0)" ::: "memory");
  __syncthreads();
  epoch += gridDim.x;
  if (threadIdx.x == 0) {
    __builtin_amdgcn_fence(__ATOMIC_RELEASE, "agent");
    asm volatile("s_waitcnt vmcnt(0)" ::: "memory");
    (void)__hip_atomic_fetch_add(bar, 1u, __ATOMIC_RELAXED, __HIP_MEMORY_SCOPE_AGENT);
    unsigned spins = 0;
    while (__hip_atomic_load(bar, __ATOMIC_RELAXED, __HIP_MEMORY_SCOPE_AGENT) < epoch) {
      __builtin_amdgcn_s_sleep(1);
      if (++spins > (1u << 24)) break;
    }
    __builtin_amdgcn_fence(__ATOMIC_ACQUIRE, "agent");
    asm volatile("s_waitcnt vmcnt(0)" ::: "memory");
  }
  __syncthreads();
}

#if MULTI_LAUNCH
__global__ void __launch_bounds__(NTHR) phase_kernel(Params p, int ph, int layer) {
  extern __shared__ __attribute__((aligned(16))) char smem[];
  run_phase(p, ph, layer, smem, blockIdx.x);
}
#else
__global__ void __launch_bounds__(NTHR) mega_kernel(Params p) {
  extern __shared__ __attribute__((aligned(16))) char smem[];
  cg::grid_group grid = cg::this_grid();
  const unsigned xcd = (unsigned)__builtin_amdgcn_s_getreg((3 << 11) | 20) & 7u;
  run_phase(p, PH_INIT, 0, smem, 0);
  __syncthreads();
  if (threadIdx.x == 0) ((volatile unsigned*)smem)[0] = atomicAdd(&p.bar[16 + xcd], 1u);
  grid.sync();
  int vid = (int)((volatile unsigned*)smem)[0];
  for (unsigned x = 0; x < xcd; ++x) vid += (int)__hip_atomic_load(&p.bar[16 + x], __ATOMIC_RELAXED, __HIP_MEMORY_SCOPE_AGENT);
  vid = __builtin_amdgcn_readfirstlane(vid);
  __syncthreads();
  unsigned epoch = 0;
  for (int layer = 0; layer < 2; ++layer) {
    for (int ph = (layer == 0 ? PH_MOD_ATTN : PH_INPROJ); ph <= PH_PEER; ++ph) {
      if (ph == PH_SCORES) continue;
      run_phase(p, ph, layer, smem, vid);
      if (!(layer == 1 && ph == PH_PEER)) grid_barrier(p.bar, epoch);
    }
  }
}
#endif

static inline size_t align_up(size_t v) { return (v + 255) & ~(size_t)255; }

extern "C" void kernel_launch(void* const* d_in, const int* in_sizes, int n_in, void* d_out, int out_size, void* d_ws,
                              size_t ws_size, hipStream_t stream) {
  Params p{};
  p.x = (const float*)d_in[0]; p.c = (const float*)d_in[1]; p.ctx = (const float*)d_in[2]; p.c_ctx = (const float*)d_in[3];
  p.w_ada = (const float*)d_in[4]; p.b_ada = (const float*)d_in[5]; p.g_attn = (const float*)d_in[6]; p.g_ffn = (const float*)d_in[7];
  p.w_in = (const float*)d_in[8]; p.rpb = (const float*)d_in[9]; p.ret_lg = (const float*)d_in[10]; p.gla_wu = (const float*)d_in[11];
  p.gla_b = (const float*)d_in[12]; p.gla_g = (const float*)d_in[13]; p.sink = (const float*)d_in[14]; p.w_out = (const float*)d_in[15];
  p.w_q = (const float*)d_in[16]; p.sub_keys = (const float*)d_in[17]; p.pu = (const float*)d_in[18]; p.pv = (const float*)d_in[19];
  p.final_g = (const float*)d_in[20];
  p.out = (float*)d_out;
  char* ws = (char*)d_ws;
  size_t off = 0;
  auto take = [&](size_t bytes) { char* r = ws + off; off = align_up(off + bytes); return r; };
  p.mod = (float*)take((size_t)2 * 3 * 12288 * 4);
  p.bar = (unsigned*)take(256);
  p.rope = (float*)take((size_t)16384 * 4);
  p.wt_in = (bfr*)take((size_t)2 * DINP * D * 2);
  p.wt_out = (bfr*)take((size_t)2 * D * D * 2);
  p.wt_q = (bfr*)take((size_t)2 * D * D * 2);
  p.sk_bf = (bfr*)take((size_t)524288 * 2);
  p.u8 = (unsigned char*)take((size_t)2 * 16384 * D);
  p.v8 = (unsigned char*)take((size_t)2 * 16384 * D);
  p.uscl = (float*)take((size_t)2 * 16384 * 4);
  p.vscl = (float*)take((size_t)2 * 16384 * 4);
  p.xcur = (float*)take((size_t)MT * D * 4);
  p.h = (bfr*)take((size_t)MT * D * 2);
  p.proj = (bfr*)take((size_t)MT * DINP * 2);
  p.mix = (bfr*)take((size_t)MT * D * 2);
  p.st_ret = (bfr*)take((size_t)16 * 132 * 16384 * 4);
  p.dec_ret = (float*)take((size_t)16 * 132 * 128 * 4);
  p.dec_gla = (float*)take((size_t)16 * 132 * 64 * 4);
  p.pidx = (int*)take((size_t)MT * 128 * 4);
  p.pgate = (float*)take((size_t)MT * 128 * 4);
  p.st_gla = (bfr*)p.h;
  p.q = p.proj;
  p.scores = (float*)p.st_ret;
  if (off > ws_size) { fprintf(stderr, "workspace too small: need %zu have %zu\n", off, ws_size); return; }

  hipMemsetAsync(p.mod, 0, (size_t)2 * 3 * 12288 * 4 + 256, stream);
#if MULTI_LAUNCH
  hipFuncSetAttribute((const void*)phase_kernel, hipFuncAttributeMaxDynamicSharedMemorySize, SMEM_BYTES);
  const int grid = 256;
  hipLaunchKernelGGL(phase_kernel, dim3(grid), dim3(NTHR), SMEM_BYTES, stream, p, PH_INIT, 0);
  for (int layer = 0; layer < 2; ++layer)
    for (int ph = (layer == 0 ? PH_MOD_ATTN : PH_INPROJ); ph <= PH_PEER; ++ph)
      hipLaunchKernelGGL(phase_kernel, dim3(grid), dim3(NTHR), SMEM_BYTES, stream, p, ph, layer);
#else
  static int grid_blocks = 0;
  if (!grid_blocks) {
    hipFuncSetAttribute((const void*)mega_kernel, hipFuncAttributeMaxDynamicSharedMemorySize, SMEM_BYTES);
    int dev = 0, cus = 0, per_cu = 0;
    hipGetDevice(&dev);
    hipDeviceGetAttribute(&cus, hipDeviceAttributeMultiprocessorCount, dev);
    hipOccupancyMaxActiveBlocksPerMultiprocessor(&per_cu, mega_kernel, NTHR, SMEM_BYTES);
    if (per_cu < 1) per_cu = 1;
    grid_blocks = cus * per_cu;
    if (grid_blocks > 256) grid_blocks = 256;
  }
  void* args[] = {&p};
  hipError_t e = hipLaunchCooperativeKernel((void*)mega_kernel, dim3(grid_blocks), dim3(NTHR), args, SMEM_BYTES, stream);
  if (e != hipSuccess) fprintf(stderr, "cooperative launch failed: %s (grid %d)\n", hipGetErrorString(e), grid_blocks);
#endif
}
```

```cpp
#include <hip/hip_runtime.h>
#include <hip/hip_cooperative_groups.h>
#include <cstdio>
namespace cg = cooperative_groups;

#ifndef MULTI_LAUNCH
#define MULTI_LAUNCH 0
#endif

typedef unsigned short bfr;
typedef __attribute__((ext_vector_type(8))) short bf16x8;
typedef __attribute__((ext_vector_type(4))) float f32x4;
typedef __attribute__((ext_vector_type(4))) unsigned int u4;

constexpr int D = 2048;
constexpr int S = 8192;
constexpr int MX = 16384;
constexpr int MT = 16896;
constexpr int DIN = 5920;
constexpr int DINP = 6016;
constexpr int NTHR = 512;
constexpr float EPS = 1e-6f;
constexpr int SMEM_BYTES = 149504;

constexpr int C_NAQ = 0, C_NAK = 512, C_NAV = 1024;
constexpr int C_RTQ = 1536, C_RTK = 2048, C_RTV = 2560, C_RTG = 3072;
constexpr int C_GLQ = 3584, C_GLK = 3840, C_GLV = 4096, C_GLG = 4608, C_GLD = 5120;
constexpr int C_SWQ = 5152, C_SWK = 5664, C_SWV = 5792;

struct Params {
  const float *x, *c, *ctx, *c_ctx, *w_ada, *b_ada, *g_attn, *g_ffn, *w_in, *rpb, *ret_lg, *gla_wu, *gla_b,
      *gla_g, *sink, *w_out, *w_q, *sub_keys, *pu, *pv, *final_g;
  float* out;
  bfr *wt_in, *wt_out, *wt_q, *sk_bf;
  unsigned char *u8, *v8;
  float *uscl, *vscl;
  float *mod, *rope, *xcur;
  bfr *h, *proj, *mix;
  bfr *st_ret, *st_gla;
  float *dec_ret, *dec_gla;
  bfr* q;
  float* scores;
  int* pidx;
  float* pgate;
  unsigned* bar;
};

__device__ __forceinline__ int get_tid() { int t = threadIdx.x; asm volatile("" : "+v"(t)); return t; }
__device__ __forceinline__ int get_bid() { int t = blockIdx.x; asm volatile("" : "+s"(t)); return t; }
__device__ __forceinline__ float bf2f(bfr u) { return __uint_as_float(((unsigned)u) << 16); }
typedef __bf16 hwbf16x2 __attribute__((ext_vector_type(2)));
typedef float hwf32x2 __attribute__((ext_vector_type(2)));
__device__ __forceinline__ unsigned pack2(float a, float b) {
  hwf32x2 v = {a, b};
  hwbf16x2 r = __builtin_convertvector(v, hwbf16x2);
  return __builtin_bit_cast(unsigned, r);
}
__device__ __forceinline__ bfr f2bf(float f) { return (bfr)(pack2(f, 0.f) & 0xffffu); }
__device__ __forceinline__ float lo16(unsigned w) { return __uint_as_float(w << 16); }
__device__ __forceinline__ float hi16(unsigned w) { return __uint_as_float(w & 0xffff0000u); }
__device__ __forceinline__ float wave_sum(float v) {
#pragma unroll
  for (int o = 32; o; o >>= 1) v += __shfl_xor(v, o);
  return v;
}
__device__ __forceinline__ float wave_max(float v) {
#pragma unroll
  for (int o = 32; o; o >>= 1) v = fmaxf(v, __shfl_xor(v, o));
  return v;
}
__device__ __forceinline__ float silu_f(float x) { return x / (1.f + __expf(-x)); }
__device__ __forceinline__ float gelu_f(float x) { return 0.5f * x * (1.f + erff(x * 0.70710678118654752f)); }
__device__ __forceinline__ float logsig_f(float x) { return fminf(x, 0.f) - log1pf(__expf(-fabsf(x))); }
__device__ __forceinline__ void unpack8(const u4 w, float* f) {
  f[0] = lo16(w.x); f[1] = hi16(w.x); f[2] = lo16(w.y); f[3] = hi16(w.y);
  f[4] = lo16(w.z); f[5] = hi16(w.z); f[6] = lo16(w.w); f[7] = hi16(w.w);
}

__device__ void transpose_cvt(const float* __restrict__ W, int K, int N, int Npad, bfr* __restrict__ Wt, int item,
                              float* tile) {
  const int nkt = K >> 6;
  const int kt = item % nkt, nt = item / nkt;
  const int tid = get_tid();
  __syncthreads();
#pragma unroll
  for (int i = 0; i < 2; ++i) {
    int kk = (tid >> 4) + 32 * i, nn = (tid & 15) * 4;
    int n = nt * 64 + nn;
    float4 v = make_float4(0.f, 0.f, 0.f, 0.f);
    if (n < N) v = *(const float4*)(W + (size_t)(kt * 64 + kk) * N + n);
    tile[kk * 65 + nn + 0] = v.x; tile[kk * 65 + nn + 1] = v.y; tile[kk * 65 + nn + 2] = v.z; tile[kk * 65 + nn + 3] = v.w;
  }
  __syncthreads();
  {
    int nl = tid >> 3, kc = (tid & 7) * 8;
    u4 o;
    o.x = pack2(tile[(kc + 0) * 65 + nl], tile[(kc + 1) * 65 + nl]);
    o.y = pack2(tile[(kc + 2) * 65 + nl], tile[(kc + 3) * 65 + nl]);
    o.z = pack2(tile[(kc + 4) * 65 + nl], tile[(kc + 5) * 65 + nl]);
    o.w = pack2(tile[(kc + 6) * 65 + nl], tile[(kc + 7) * 65 + nl]);
    *(u4*)(Wt + (size_t)(nt * 64 + nl) * K + kt * 64 + kc) = o;
  }
}

__device__ void cvt_linear(const float* __restrict__ src, bfr* __restrict__ dst, size_t n8) {
  for (size_t i = (size_t)get_bid() * NTHR + get_tid(); i < n8; i += (size_t)gridDim.x * NTHR) {
    float4 a = *(const float4*)(src + i * 8), b = *(const float4*)(src + i * 8 + 4);
    u4 o;
    o.x = pack2(a.x, a.y); o.y = pack2(a.z, a.w); o.z = pack2(b.x, b.y); o.w = pack2(b.z, b.w);
    *(u4*)(dst + i * 8) = o;
  }
}

__device__ void cvt_fp8_rows(const float* __restrict__ src, unsigned char* __restrict__ dst, float* __restrict__ scl, int nrows) {
  const int lane = get_tid() & 63;
  const int wave = get_bid() * 8 + (get_tid() >> 6), nw = gridDim.x * 8;
  for (int row = wave; row < nrows; row += nw) {
    const float* sp = src + (size_t)row * D + lane * 16;
    float4 v[8];
    float amax = 0.f;
#pragma unroll
    for (int i = 0; i < 2; ++i)
#pragma unroll
      for (int k = 0; k < 4; ++k) {
        float4 t = *(const float4*)(sp + i * 1024 + k * 4);
        v[i * 4 + k] = t;
        amax = fmaxf(amax, fmaxf(fmaxf(fabsf(t.x), fabsf(t.y)), fmaxf(fabsf(t.z), fabsf(t.w))));
      }
    amax = wave_max(amax);
    const float sc = amax > 0.f ? 256.f / amax : 1.f;
#pragma unroll
    for (int i = 0; i < 2; ++i) {
      u4 o;
      int w;
      w = __builtin_amdgcn_cvt_pk_fp8_f32(v[i * 4 + 0].x * sc, v[i * 4 + 0].y * sc, 0, false);
      w = __builtin_amdgcn_cvt_pk_fp8_f32(v[i * 4 + 0].z * sc, v[i * 4 + 0].w * sc, w, true); o.x = (unsigned)w;
      w = __builtin_amdgcn_cvt_pk_fp8_f32(v[i * 4 + 1].x * sc, v[i * 4 + 1].y * sc, 0, false);
      w = __builtin_amdgcn_cvt_pk_fp8_f32(v[i * 4 + 1].z * sc, v[i * 4 + 1].w * sc, w, true); o.y = (unsigned)w;
      w = __builtin_amdgcn_cvt_pk_fp8_f32(v[i * 4 + 2].x * sc, v[i * 4 + 2].y * sc, 0, false);
      w = __builtin_amdgcn_cvt_pk_fp8_f32(v[i * 4 + 2].z * sc, v[i * 4 + 2].w * sc, w, true); o.z = (unsigned)w;
      w = __builtin_amdgcn_cvt_pk_fp8_f32(v[i * 4 + 3].x * sc, v[i * 4 + 3].y * sc, 0, false);
      w = __builtin_amdgcn_cvt_pk_fp8_f32(v[i * 4 + 3].z * sc, v[i * 4 + 3].w * sc, w, true); o.w = (unsigned)w;
      *(u4*)(dst + (size_t)row * D + i * 1024 + lane * 16) = o;
    }
    if (lane == 0) scl[row] = amax > 0.f ? amax * (1.f / 256.f) : 1.f;
  }
}

__device__ void sincos_d(double a, float& s, float& c) {
  double k = rint(a * 0.63661977236758134308);
  double r = a - k * 1.57079632679489661923;
  double r2 = r * r;
  double sn = r * (1.0 + r2 * (-1.0 / 6 + r2 * (1.0 / 120 + r2 * (-1.0 / 5040 + r2 * (1.0 / 362880 + r2 * (-1.0 / 39916800 + r2 * (1.0 / 6227020800.0)))))));
  double cs = 1.0 + r2 * (-0.5 + r2 * (1.0 / 24 + r2 * (-1.0 / 720 + r2 * (1.0 / 40320 + r2 * (-1.0 / 3628800 + r2 * (1.0 / 479001600.0))))));
  int q = ((int)k) & 3;
  double so = (q == 0) ? sn : (q == 1) ? cs : (q == 2) ? -sn : -cs;
  double co = (q == 0) ? cs : (q == 1) ? -sn : (q == 2) ? -cs : sn;
  s = (float)so; c = (float)co;
}

__device__ void phase0(const Params& p, char* smem) {
  const int tid = get_tid(), bid = get_bid(), nb = gridDim.x;
  float* fs = (float*)smem;
  if (bid == 0) {
    for (int e = tid; e < 128 * 16 + 128 * 32; e += NTHR) {
      int F, pos, f, base;
      if (e < 2048) { F = 16; pos = e >> 4; f = e & 15; base = 0; }
      else { int e2 = e - 2048; F = 32; pos = e2 >> 5; f = e2 & 31; base = 4096; }
      double bb = (F == 16) ? 0.56234132519034908 : 0.74989420933245582;
      double inv = 1.0;
      for (int i = 0; i < f; ++i) inv *= bb;
      float invf = (float)inv;
      float ang = (float)pos * invf;
      float sn, cs;
      sincos_d((double)ang, sn, cs);
      p.rope[base + pos * F + f] = cs;
      p.rope[base + 128 * F + pos * F + f] = sn;
    }
  }
  for (int it = bid; it < 384; it += nb) {
    int layer = it / 192, r = it % 192, kc = r / 6, nc = r % 6;
    __syncthreads();
    if (tid < 192) {
      int v = tid >> 6, kk = tid & 63;
      float cv = (v < 2) ? p.c[v * D + kc * 64 + kk] : p.c_ctx[kc * 64 + kk];
      fs[tid] = silu_f(cv);
    }
    __syncthreads();
    int n = nc * 2048 + tid * 4;
    float4 a0 = make_float4(0, 0, 0, 0), a1 = a0, a2 = a0;
    if (kc == 0) { a0 = *(const float4*)(p.b_ada + layer * 12288 + n); a1 = a0; a2 = a0; }
    const float* w = p.w_ada + (size_t)layer * D * 12288 + (size_t)(kc * 64) * 12288 + n;
#pragma unroll 8
    for (int kk = 0; kk < 64; ++kk) {
      float4 wv = *(const float4*)(w + (size_t)kk * 12288);
      float s0 = fs[kk], s1 = fs[64 + kk], s2 = fs[128 + kk];
      a0.x += s0 * wv.x; a0.y += s0 * wv.y; a0.z += s0 * wv.z; a0.w += s0 * wv.w;
      a1.x += s1 * wv.x; a1.y += s1 * wv.y; a1.z += s1 * wv.z; a1.w += s1 * wv.w;
      a2.x += s2 * wv.x; a2.y += s2 * wv.y; a2.z += s2 * wv.z; a2.w += s2 * wv.w;
    }
    float* m0 = p.mod + (layer * 3 + 0) * 12288 + n;
    float* m1 = p.mod + (layer * 3 + 1) * 12288 + n;
    float* m2 = p.mod + (layer * 3 + 2) * 12288 + n;
    atomicAdd(m0 + 0, a0.x); atomicAdd(m0 + 1, a0.y); atomicAdd(m0 + 2, a0.z); atomicAdd(m0 + 3, a0.w);
    atomicAdd(m1 + 0, a1.x); atomicAdd(m1 + 1, a1.y); atomicAdd(m1 + 2, a1.z); atomicAdd(m1 + 3, a1.w);
    atomicAdd(m2 + 0, a2.x); atomicAdd(m2 + 1, a2.y); atomicAdd(m2 + 2, a2.z); atomicAdd(m2 + 3, a2.w);
  }
  for (int layer = 0; layer < 2; ++layer) {
    for (int it = bid; it < 32 * 94; it += nb)
      transpose_cvt(p.w_in + (size_t)layer * D * DIN, D, DIN, DINP, p.wt_in + (size_t)layer * DINP * D, it, fs);
    for (int it = bid; it < 32 * 32; it += nb)
      transpose_cvt(p.w_out + (size_t)layer * D * D, D, D, D, p.wt_out + (size_t)layer * D * D, it, fs);
    for (int it = bid; it < 32 * 32; it += nb)
      transpose_cvt(p.w_q + (size_t)layer * D * D, D, D, D, p.wt_q + (size_t)layer * D * D, it, fs);
  }
  cvt_linear(p.sub_keys, p.sk_bf, (size_t)524288 / 8);
  cvt_fp8_rows(p.pu, p.u8, p.uscl, 2 * 16384);
  cvt_fp8_rows(p.pv, p.v8, p.vscl, 2 * 16384);
}

__device__ __forceinline__ const float* modulate_src(const Params& p, int layer, int which, int m) {
  if (layer == 0 && which == 0) return (m < MX) ? p.x + (size_t)m * D : p.ctx + (size_t)(m - MX) * D;
  return p.xcur + (size_t)m * D;
}
__device__ void modulate_phase(const Params& p, int layer, int which, int nrows) {
  const int lane = get_tid() & 63;
  const int wave = get_bid() * 8 + (get_tid() >> 6), nw = gridDim.x * 8;
  const float* g = (which == 0 ? p.g_attn : p.g_ffn) + layer * D;
  float4 vn[8];
  if (wave < nrows) {
    const float* src = modulate_src(p, layer, which, wave);
#pragma unroll
    for (int i = 0; i < 8; ++i) vn[i] = *(const float4*)(src + i * 256 + lane * 4);
  }
  for (int m = wave; m < nrows; m += nw) {
    float4 v[8];
#pragma unroll
    for (int i = 0; i < 8; ++i) v[i] = vn[i];
    if (m + nw < nrows) {
      const float* src = modulate_src(p, layer, which, m + nw);
#pragma unroll
      for (int i = 0; i < 8; ++i) vn[i] = *(const float4*)(src + i * 256 + lane * 4);
    }
    int vec = m < S ? 0 : (m < MX ? 1 : 2);
    const float* modl = p.mod + (layer * 3 + vec) * 12288 + which * 3 * D;
    float ss = 0.f;
#pragma unroll
    for (int i = 0; i < 8; ++i) ss += v[i].x * v[i].x + v[i].y * v[i].y + v[i].z * v[i].z + v[i].w * v[i].w;
    ss = wave_sum(ss);
    float rstd = rsqrtf(ss * (1.f / D) + EPS);
#pragma unroll
    for (int i = 0; i < 8; ++i) {
      int col = i * 256 + lane * 4;
      float4 gg = *(const float4*)(g + col);
      float4 sh = *(const float4*)(modl + col);
      float4 sc = *(const float4*)(modl + D + col);
      float y0 = v[i].x * rstd * gg.x * (1.f + sc.x) + sh.x;
      float y1 = v[i].y * rstd * gg.y * (1.f + sc.y) + sh.y;
      float y2 = v[i].z * rstd * gg.z * (1.f + sc.z) + sh.z;
      float y3 = v[i].w * rstd * gg.w * (1.f + sc.w) + sh.w;
      uint2 o; o.x = pack2(y0, y1); o.y = pack2(y2, y3);
      *(uint2*)(p.h + (size_t)m * D + col) = o;
    }
  }
}

template <int EPI, bool BIG>
__device__ void gemm_tile(const bfr* __restrict__ A, int lda, const bfr* __restrict__ Bt, int ldb, int K, int m0,
                          int n0, void* Cout, int ldc, const Params& p, int layer, char* smem) {
  constexpr int BN = BIG ? 256 : 128;
  constexpr int MI = BIG ? 8 : 4;
  constexpr int NBL = BN / 64;
  bfr* As0 = (bfr*)smem;
  bfr* Bs0 = As0 + 2 * 256 * 72;
  const int tid = get_tid(), lane = tid & 63, w = tid >> 6;
  const int wm = BIG ? (w >> 2) : (w >> 1), wn = BIG ? (w & 3) : (w & 1);
  const int fr = lane & 15, fq = lane >> 4;
  f32x4 acc[MI][4];
#pragma unroll
  for (int i = 0; i < MI; ++i)
#pragma unroll
    for (int j = 0; j < 4; ++j) acc[i][j] = (f32x4){0.f, 0.f, 0.f, 0.f};
  const int arow = tid >> 3, akc = (tid & 7) * 8;
  u4 rs[4];
  const bfr* Ap = A + (size_t)(m0 + arow) * lda + akc;
  const bfr* Bp = Bt + (size_t)(n0 + arow) * ldb + akc;
#pragma unroll
  for (int i = 0; i < 4; ++i) rs[i] = *(const u4*)(Ap + (size_t)(64 * i) * lda);
  __syncthreads();
#pragma unroll
  for (int i = 0; i < 4; ++i) *(u4*)(As0 + (arow + 64 * i) * 72 + akc) = rs[i];
#pragma unroll
  for (int i = 0; i < NBL; ++i) rs[i] = *(const u4*)(Bp + (size_t)(64 * i) * ldb);
#pragma unroll
  for (int i = 0; i < NBL; ++i) *(u4*)(Bs0 + (arow + 64 * i) * 72 + akc) = rs[i];
  const int nk = K >> 6;
  if (nk > 1) {
#pragma unroll
    for (int i = 0; i < 4; ++i) rs[i] = *(const u4*)(Ap + (size_t)(64 * i) * lda + 64);
  }
  __syncthreads();
  for (int kt = 0; kt < nk; ++kt) {
    const bfr* As = As0 + (kt & 1) * (256 * 72);
    const bfr* Bs = Bs0 + (kt & 1) * (BN * 72);
    bfr* Asn = As0 + ((kt + 1) & 1) * (256 * 72);
    bfr* Bsn = Bs0 + ((kt + 1) & 1) * (BN * 72);
#pragma unroll
    for (int kk = 0; kk < 2; ++kk) {
      bf16x8 b[4];
#pragma unroll
      for (int j = 0; j < 4; ++j) b[j] = *(const bf16x8*)(Bs + (wn * 64 + j * 16 + fr) * 72 + kk * 32 + fq * 8);
      {
        bf16x8 a_cur = *(const bf16x8*)(As + (wm * (MI * 16) + fr) * 72 + kk * 32 + fq * 8);
#pragma unroll
        for (int i = 0; i < MI; ++i) {
          bf16x8 a_nxt = a_cur;
          if (i + 1 < MI) a_nxt = *(const bf16x8*)(As + (wm * (MI * 16) + (i + 1) * 16 + fr) * 72 + kk * 32 + fq * 8);
#pragma unroll
          for (int j = 0; j < 4; ++j) acc[i][j] = __builtin_amdgcn_mfma_f32_16x16x32_bf16(b[j], a_cur, acc[i][j], 0, 0, 0);
          if (BIG) __builtin_amdgcn_sched_barrier(0);
          a_cur = a_nxt;
        }
      }
      if (kt + 1 < nk) {
        if (kk == 0) {
#pragma unroll
          for (int i = 0; i < 4; ++i) *(u4*)(Asn + (arow + 64 * i) * 72 + akc) = rs[i];
#pragma unroll
          for (int i = 0; i < NBL; ++i) rs[i] = *(const u4*)(Bp + (size_t)(64 * i) * ldb + (kt + 1) * 64);
        } else {
#pragma unroll
          for (int i = 0; i < NBL; ++i) *(u4*)(Bsn + (arow + 64 * i) * 72 + akc) = rs[i];
          if (kt + 2 < nk) {
#pragma unroll
            for (int i = 0; i < 4; ++i) rs[i] = *(const u4*)(Ap + (size_t)(64 * i) * lda + (kt + 2) * 64);
          }
        }
      }
    }
    __syncthreads();
  }
  const int nb0 = n0 + wn * 64 + fq * 4;
#pragma unroll
  for (int i = 0; i < MI; ++i) {
    const int m = m0 + wm * (MI * 16) + i * 16 + fr;
    if (EPI == 0) {
      bfr* crow = (bfr*)Cout + (size_t)m * ldc + nb0;
#pragma unroll
      for (int j = 0; j < 4; ++j) {
        uint2 o;
        o.x = pack2(acc[i][j][0], acc[i][j][1]); o.y = pack2(acc[i][j][2], acc[i][j][3]);
        *(uint2*)(crow + j * 16) = o;
      }
    } else if (EPI == 2) {
      float* crow = (float*)Cout + (size_t)m * ldc + nb0;
#pragma unroll
      for (int j = 0; j < 4; ++j) *(float4*)(crow + j * 16) = make_float4(acc[i][j][0], acc[i][j][1], acc[i][j][2], acc[i][j][3]);
    } else {
      const float* src;
      if (layer == 0) src = (m < MX) ? p.x + (size_t)m * D : p.ctx + (size_t)(m - MX) * D;
      else src = p.xcur + (size_t)m * D;
      src += nb0;
      const int vec = m < S ? 0 : (m < MX ? 1 : 2);
      const float* grow = p.mod + (layer * 3 + vec) * 12288 + 2 * D + nb0;
      float* orow = p.xcur + (size_t)m * D + nb0;
#pragma unroll
      for (int j = 0; j < 4; ++j) {
        const float4 gate = *(const float4*)(grow + j * 16);
        const float4 xs = *(const float4*)(src + j * 16);
        *(float4*)(orow + j * 16) = make_float4(xs.x + gate.x * acc[i][j][0], xs.y + gate.y * acc[i][j][1], xs.z + gate.z * acc[i][j][2], xs.w + gate.w * acc[i][j][3]);
      }
      __builtin_amdgcn_sched_barrier(0);
    }
  }
}

#define MFMA16(a, b, c) __builtin_amdgcn_mfma_f32_16x16x32_bf16((a), (b), (c), 0, 0, 0)
typedef __attribute__((ext_vector_type(4))) short s16x4;

__device__ __forceinline__ void load_kv_tile(bfr* dst, const bfr* src, int nrows, int tok0, int toklimit) {
  for (int c = get_tid(); c < nrows * 8; c += NTHR) {
    int r = c >> 3, ch = c & 7;
    int tok = tok0 + r;
    u4 v = (u4){0u, 0u, 0u, 0u};
    if (tok >= 0 && tok < toklimit) v = *(const u4*)(src + (ptrdiff_t)r * DINP + ch * 8);
    *(u4*)(dst + r * 72 + ch * 8) = v;
  }
}
__device__ __forceinline__ void load_vt_tile(bfr* Vt, int VS, const bfr* src, int nrows, int tok0, int toklimit) {
  for (int c = get_tid(); c < nrows * 8; c += NTHR) {
    int key = c % nrows, dch = c / nrows;
    int tok = tok0 + key;
    u4 v = (u4){0u, 0u, 0u, 0u};
    if (tok >= 0 && tok < toklimit) v = *(const u4*)(src + (ptrdiff_t)key * DINP + dch * 8);
    bfr* d = Vt + (dch * 8) * VS + key;
    d[0 * VS] = (bfr)(v.x & 0xffffu); d[1 * VS] = (bfr)(v.x >> 16);
    d[2 * VS] = (bfr)(v.y & 0xffffu); d[3 * VS] = (bfr)(v.y >> 16);
    d[4 * VS] = (bfr)(v.z & 0xffffu); d[5 * VS] = (bfr)(v.z >> 16);
    d[6 * VS] = (bfr)(v.w & 0xffffu); d[7 * VS] = (bfr)(v.w >> 16);
  }
}
__device__ __forceinline__ void load_kfrags(bf16x8 (&kf)[2][2], const bfr* Ks, int kt, int fr, int q4) {
#pragma unroll
  for (int blk = 0; blk < 2; ++blk)
#pragma unroll
    for (int ds = 0; ds < 2; ++ds) kf[blk][ds] = *(const bf16x8*)(Ks + (kt + blk * 16 + fr) * 72 + ds * 32 + q4 * 8);
}
__device__ __forceinline__ void load_vfrags(bf16x8 (&vf)[4], const bfr* Vt, int VS, int kt, int fr, int q4) {
#pragma unroll
  for (int db = 0; db < 4; ++db) {
    const bfr* vp = Vt + (db * 16 + fr) * VS + kt + q4 * 4;
    s16x4 lo = *(const s16x4*)vp, hi = *(const s16x4*)(vp + 16);
    vf[db] = __builtin_shufflevector(lo, hi, 0, 1, 2, 3, 4, 5, 6, 7);
  }
}
__device__ __forceinline__ void attn_tile_group(const bf16x8 (&kf)[2][2], const bf16x8 (&qf)[2], const bf16x8 (&vf)[4],
                                                f32x4 (&o)[4], float& m, float& l, const float (&badd)[8]) {
  f32x4 s0 = (f32x4){0.f, 0.f, 0.f, 0.f}, s1 = s0;
  s0 = MFMA16(kf[0][0], qf[0], s0); s0 = MFMA16(kf[0][1], qf[1], s0);
  s1 = MFMA16(kf[1][0], qf[0], s1); s1 = MFMA16(kf[1][1], qf[1], s1);
  float sv[8];
#pragma unroll
  for (int i = 0; i < 4; ++i) { sv[i] = s0[i] + badd[i]; sv[4 + i] = s1[i] + badd[4 + i]; }
  float mx = fmaxf(fmaxf(fmaxf(sv[0], sv[1]), fmaxf(sv[2], sv[3])), fmaxf(fmaxf(sv[4], sv[5]), fmaxf(sv[6], sv[7])));
  mx = fmaxf(mx, __shfl_xor(mx, 16));
  mx = fmaxf(mx, __shfl_xor(mx, 32));
  const float mn = fmaxf(m, mx);
  const float mref = (mn == -INFINITY) ? 0.f : mn;
  const float alpha = __expf(m - mref);
  float pv[8];
  float ls = 0.f;
#pragma unroll
  for (int i = 0; i < 8; ++i) { pv[i] = __expf(sv[i] - mref); ls += pv[i]; }
  l = l * alpha + ls;
  m = mn;
  u4 pk;
  pk.x = pack2(pv[0], pv[1]); pk.y = pack2(pv[2], pv[3]); pk.z = pack2(pv[4], pv[5]); pk.w = pack2(pv[6], pv[7]);
  const bf16x8 pb = __builtin_bit_cast(bf16x8, pk);
#pragma unroll
  for (int db = 0; db < 4; ++db) {
    o[db] *= alpha;
    o[db] = MFMA16(vf[db], pb, o[db]);
  }
}
__device__ __forceinline__ float attn_rowsum(float l) {
  l += __shfl_xor(l, 16);
  l += __shfl_xor(l, 32);
  return l;
}
__device__ __forceinline__ void load_qfrags(bf16x8 (&qf)[2], const bfr* qrow, int q4, float scale) {
#pragma unroll
  for (int ds = 0; ds < 2; ++ds) {
    u4 w = *(const u4*)(qrow + ds * 32 + q4 * 8);
    float f[8];
    unpack8(w, f);
    u4 o;
    o.x = pack2(f[0] * scale, f[1] * scale); o.y = pack2(f[2] * scale, f[3] * scale);
    o.z = pack2(f[4] * scale, f[5] * scale); o.w = pack2(f[6] * scale, f[7] * scale);
    qf[ds] = __builtin_bit_cast(bf16x8, o);
  }
}
__device__ __forceinline__ void store_ot(bfr* dst, const f32x4 (&o)[4], float inv, int q4) {
#pragma unroll
  for (int db = 0; db < 4; ++db) {
    uint2 w;
    w.x = pack2(o[db][0] * inv, o[db][1] * inv);
    w.y = pack2(o[db][2] * inv, o[db][3] * inv);
    *(uint2*)(dst + db * 16 + q4 * 4) = w;
  }
}

__device__ void swa_item(const Params& p, int layer, int item, char* smem) {
  const int b = item >> 7, kvh = (item >> 6) & 1, nbk = item & 63;
  bfr* Ks = (bfr*)smem;
  bfr* Vt = Ks + 384 * 72;
  constexpr int VS = 392;
  const int tid = get_tid();
  const int lane = tid & 63, w = tid >> 6, fr = lane & 15, q4 = lane >> 4;
  const float* cos16 = p.rope;
  const float* sin16 = p.rope + 2048;
  __syncthreads();
  const int tok0 = (nbk - 1) * 128;
  const bfr* rowbase = p.proj + (ptrdiff_t)(b * S + tok0) * DINP;
  load_vt_tile(Vt, VS, rowbase + C_SWV + kvh * 64, 384, tok0, S);
  for (int u = tid; u < 384 * 4; u += NTHR) {
    int r = u >> 2, A = (u >> 1) & 1, fc = u & 1;
    int tok = tok0 + r;
    u4 o1 = (u4){0u, 0u, 0u, 0u}, o2 = o1;
    if (tok >= 0 && tok < S) {
      const bfr* kp = rowbase + (ptrdiff_t)r * DINP + C_SWK + kvh * 64 + A * 32 + fc * 8;
      u4 w1 = *(const u4*)kp, w2 = *(const u4*)(kp + 16);
      float x1[8], x2[8], y1[8], y2[8];
      unpack8(w1, x1); unpack8(w2, x2);
      int pos = A ? (tok & 63) : (tok >> 6);
#pragma unroll
      for (int j = 0; j < 8; ++j) {
        float cs = cos16[pos * 16 + fc * 8 + j], sn = sin16[pos * 16 + fc * 8 + j];
        y1[j] = x1[j] * cs - x2[j] * sn;
        y2[j] = x2[j] * cs + x1[j] * sn;
      }
      o1.x = pack2(y1[0], y1[1]); o1.y = pack2(y1[2], y1[3]); o1.z = pack2(y1[4], y1[5]); o1.w = pack2(y1[6], y1[7]);
      o2.x = pack2(y2[0], y2[1]); o2.y = pack2(y2[2], y2[3]); o2.z = pack2(y2[4], y2[5]); o2.w = pack2(y2[6], y2[7]);
    }
    int ch1 = A * 4 + fc, ch2 = A * 4 + 2 + fc;
    *(u4*)(Ks + r * 72 + ch1 * 8) = o1;
    *(u4*)(Ks + r * 72 + ch2 * 8) = o2;
  }
  const int g = w >> 1, qhalf = w & 1;
  const int hq = kvh * 4 + g;
  bf16x8 qf[4][2];
  f32x4 oacc[4][4];
  float mm[4], ll[4];
#pragma unroll
  for (int grp = 0; grp < 4; ++grp) {
    const int tq = nbk * 128 + qhalf * 64 + grp * 16 + fr;
    const bfr* qrow = p.proj + (size_t)(b * S + tq) * DINP + C_SWQ + hq * 64;
#pragma unroll
    for (int ds = 0; ds < 2; ++ds) {
      u4 wq = *(const u4*)(qrow + ds * 32 + q4 * 8);
      float f[8], y[8];
      unpack8(wq, f);
      const int pos = ds ? (tq & 63) : (tq >> 6);
#pragma unroll
      for (int j = 0; j < 8; ++j) {
        const float other = __shfl_xor(f[j], 32);
        const int fi = (q4 & 1) * 8 + j;
        const float cs = cos16[pos * 16 + fi], sn = sin16[pos * 16 + fi];
        y[j] = ((q4 < 2) ? (f[j] * cs - other * sn) : (f[j] * cs + other * sn)) * 0.125f;
      }
      u4 o;
      o.x = pack2(y[0], y[1]); o.y = pack2(y[2], y[3]); o.z = pack2(y[4], y[5]); o.w = pack2(y[6], y[7]);
      qf[grp][ds] = __builtin_bit_cast(bf16x8, o);
    }
    mm[grp] = -INFINITY; ll[grp] = 0.f;
#pragma unroll
    for (int db = 0; db < 4; ++db) oacc[grp][db] = (f32x4){0.f, 0.f, 0.f, 0.f};
  }
  __syncthreads();
  float zb[8];
#pragma unroll
  for (int i = 0; i < 8; ++i) zb[i] = 0.f;
#pragma unroll 1
  for (int t = 0; t < 10; ++t) {
    const int kt = qhalf * 64 + 32 * t;
    if (tok0 + kt + 31 < 0 || tok0 + kt >= S) continue;
    bf16x8 kf[2][2], vf[4];
    load_kfrags(kf, Ks, kt, fr, q4);
    load_vfrags(vf, Vt, VS, kt, fr, q4);
#pragma unroll
    for (int grp = 0; grp < 4; ++grp) {
      const int qg0 = 128 + qhalf * 64 + grp * 16;
      if (kt > qg0 + 15 + 128 || kt + 31 < qg0 - 128) continue;
      const bool interior = (kt >= qg0 + 15 - 128) && (kt + 31 <= qg0 + 128) && (tok0 + kt >= 0) && (tok0 + kt + 31 < S);
      if (interior) {
        attn_tile_group(kf, qf[grp], vf, oacc[grp], mm[grp], ll[grp], zb);
      } else {
        const int qrow = qg0 + fr;
        float badd[8];
#pragma unroll
        for (int i = 0; i < 8; ++i) {
          const int lr = kt + (i >> 2) * 16 + q4 * 4 + (i & 3);
          const int dd = qrow - lr;
          const int tok = tok0 + lr;
          const bool ok = (dd <= 128) && (dd >= -128) && (tok >= 0) && (tok < S);
          badd[i] = ok ? 0.f : -INFINITY;
        }
        attn_tile_group(kf, qf[grp], vf, oacc[grp], mm[grp], ll[grp], badd);
      }
    }
  }
  __syncthreads();
  const bfr* zbase = p.proj + (size_t)(MX + b * 256) * DINP;
  load_kv_tile(Ks, zbase + C_SWK + kvh * 64, 256, 0, 256);
  load_vt_tile(Vt, VS, zbase + C_SWV + kvh * 64, 256, 0, 256);
  __syncthreads();
#pragma unroll 1
  for (int t = 0; t < 8; ++t) {
    const int kt = 32 * t;
    bf16x8 kf[2][2], vf[4];
    load_kfrags(kf, Ks, kt, fr, q4);
    load_vfrags(vf, Vt, VS, kt, fr, q4);
#pragma unroll
    for (int grp = 0; grp < 4; ++grp) attn_tile_group(kf, qf[grp], vf, oacc[grp], mm[grp], ll[grp], zb);
  }
  const float sk = p.sink[layer * 8 + hq];
#pragma unroll
  for (int grp = 0; grp < 4; ++grp) {
    const int tq = nbk * 128 + qhalf * 64 + grp * 16 + fr;
    const float mn = fmaxf(mm[grp], sk);
    const float alpha = __expf(mm[grp] - mn);
    const float lt = attn_rowsum(ll[grp]) * alpha + __expf(sk - mn);
    store_ot(p.mix + (size_t)(b * S + tq) * D + 1536 + hq * 64, oacc[grp], alpha / lt, q4);
  }
}

__device__ void na_item(const Params& p, int layer, int item, char* smem) {
  const int b = item >> 10, h = (item >> 7) & 7, r = item & 127;
  bfr* Ks = (bfr*)smem;
  bfr* Vt = Ks + 512 * 72;
  constexpr int VS = 520;
  float* rp = (float*)(Vt + 64 * VS);
  float* mg = (float*)smem;
  const int tid = get_tid();
  const int lane = tid & 63, w = tid >> 6, fr = lane & 15, q4 = lane >> 4;
  __syncthreads();
  int r0 = r - 4; r0 = r0 < 0 ? 0 : (r0 > 120 ? 120 : r0);
  const bfr* rowbase = p.proj + (size_t)(b * S + r0 * 64) * DINP;
  load_kv_tile(Ks, rowbase + C_NAK + h * 64, 512, 0, 512);
  load_vt_tile(Vt, VS, rowbase + C_NAV + h * 64, 512, 0, 512);
  if (tid < 15 * 31) rp[tid] = p.rpb[(layer * 8 + h) * 465 + tid];
  const int grp = w >> 1, half = w & 1;
  const int cq = grp * 16 + fr;
  const int tq = r * 64 + cq;
  bf16x8 qf[2];
  load_qfrags(qf, p.proj + (size_t)(b * S + tq) * DINP + C_NAQ + h * 64, q4, 0.125f);
  f32x4 oacc[4];
#pragma unroll
  for (int db = 0; db < 4; ++db) oacc[db] = (f32x4){0.f, 0.f, 0.f, 0.f};
  float m = -INFINITY, l = 0.f;
  __syncthreads();
  int cs = cq - 8; cs = cs < 0 ? 0 : (cs > 48 ? 48 : cs);
  const int tstart = grp == 0 ? 0 : (grp == 1 ? 8 : (grp == 2 ? 24 : 32));
#pragma unroll 1
  for (int jj = 0; jj < 4; ++jj) {
    const int jrow = half * 4 + jj;
    const int drow = (r0 + jrow) - r + 7;
    const int kt = jrow * 64 + tstart;
    bf16x8 kf[2][2], vf[4];
    load_kfrags(kf, Ks, kt, fr, q4);
    load_vfrags(vf, Vt, VS, kt, fr, q4);
    float badd[8];
#pragma unroll
    for (int i = 0; i < 8; ++i) {
      const int ck = tstart + (i >> 2) * 16 + q4 * 4 + (i & 3);
      const bool ok = (ck >= cs) && (ck < cs + 16);
      int dc = ck - cq + 15; dc = dc < 0 ? 0 : (dc > 30 ? 30 : dc);
      badd[i] = ok ? rp[drow * 31 + dc] : -INFINITY;
    }
    attn_tile_group(kf, qf, vf, oacc, m, l, badd);
  }
  __syncthreads();
  const bfr* zbase = p.proj + (size_t)(MX + b * 256) * DINP;
  load_kv_tile(Ks, zbase + C_NAK + h * 64, 256, 0, 256);
  load_vt_tile(Vt, VS, zbase + C_NAV + h * 64, 256, 0, 256);
  __syncthreads();
  float zb[8];
#pragma unroll
  for (int i = 0; i < 8; ++i) zb[i] = 0.f;
#pragma unroll 1
  for (int t = 0; t < 4; ++t) {
    const int kt = half * 128 + 32 * t;
    bf16x8 kf[2][2], vf[4];
    load_kfrags(kf, Ks, kt, fr, q4);
    load_vfrags(vf, Vt, VS, kt, fr, q4);
    attn_tile_group(kf, qf, vf, oacc, m, l, zb);
  }
  __syncthreads();
  l = attn_rowsum(l);
  float* mo = mg + grp * (16 * 64 + 64) ;
  if (half == 1) {
#pragma unroll
    for (int db = 0; db < 4; ++db)
#pragma unroll
      for (int i = 0; i < 4; ++i) mo[(db * 4 + i) * 64 + lane] = oacc[db][i];
    if (q4 == 0) { mo[16 * 64 + fr] = m; mo[16 * 64 + 16 + fr] = l; }
  }
  __syncthreads();
  if (half == 0) {
    const float m2 = mo[16 * 64 + fr], l2 = mo[16 * 64 + 16 + fr];
    const float mn = fmaxf(m, m2);
    const float a1 = __expf(m - mn), a2 = __expf(m2 - mn);
    const float lt = l * a1 + l2 * a2;
    const float i1 = a1 / lt, i2 = a2 / lt;
#pragma unroll
    for (int db = 0; db < 4; ++db)
#pragma unroll
      for (int i = 0; i < 4; ++i) oacc[db][i] = oacc[db][i] * i1 + mo[(db * 4 + i) * 64 + lane] * i2;
    store_ot(p.mix + (size_t)(b * S + tq) * D + h * 64, oacc, 1.f, q4);
  }
}

__device__ void ctx_item(const Params& p, int layer, int item, char* smem) {
  const int b = item >> 4, type = (item >> 3) & 1, h = item & 7;
  bfr* Ks = (bfr*)smem;
  bfr* Vt = Ks + 256 * 72;
  constexpr int VS = 264;
  const int tid = get_tid();
  const int lane = tid & 63, w = tid >> 6, fr = lane & 15, q4 = lane >> 4;
  __syncthreads();
  const bfr* zbase = p.proj + (size_t)(MX + b * 256) * DINP;
  const int kcol = type ? (C_SWK + (h >> 2) * 64) : (C_NAK + h * 64);
  const int vcol = type ? (C_SWV + (h >> 2) * 64) : (C_NAV + h * 64);
  const int qcol = type ? (C_SWQ + h * 64) : (C_NAQ + h * 64);
  load_kv_tile(Ks, zbase + kcol, 256, 0, 256);
  load_vt_tile(Vt, VS, zbase + vcol, 256, 0, 256);
  bf16x8 qf[2][2];
  f32x4 oacc[2][4];
  float mm[2], ll[2];
#pragma unroll
  for (int grp = 0; grp < 2; ++grp) {
    const int qz = w * 32 + grp * 16 + fr;
    load_qfrags(qf[grp], zbase + (size_t)qz * DINP + qcol, q4, 0.125f);
    mm[grp] = -INFINITY; ll[grp] = 0.f;
#pragma unroll
    for (int db = 0; db < 4; ++db) oacc[grp][db] = (f32x4){0.f, 0.f, 0.f, 0.f};
  }
  __syncthreads();
  float zb[8];
#pragma unroll
  for (int i = 0; i < 8; ++i) zb[i] = 0.f;
#pragma unroll 1
  for (int t = 0; t < 8; ++t) {
    const int kt = 32 * t;
    bf16x8 kf[2][2], vf[4];
    load_kfrags(kf, Ks, kt, fr, q4);
    load_vfrags(vf, Vt, VS, kt, fr, q4);
#pragma unroll
    for (int grp = 0; grp < 2; ++grp) attn_tile_group(kf, qf[grp], vf, oacc[grp], mm[grp], ll[grp], zb);
  }
#pragma unroll
  for (int grp = 0; grp < 2; ++grp) {
    const int qz = w * 32 + grp * 16 + fr;
    float inv;
    if (type == 1) {
      const float sk = p.sink[layer * 8 + h];
      const float mn = fmaxf(mm[grp], sk);
      const float a = __expf(mm[grp] - mn);
      inv = a / (attn_rowsum(ll[grp]) * a + __expf(sk - mn));
    } else {
      inv = 1.f / attn_rowsum(ll[grp]);
    }
    store_ot(p.mix + (size_t)(MX + b * 256 + qz) * D + (type ? 1536 : 0) + h * 64, oacc[grp], inv, q4);
  }
}

template <int W>
__device__ __forceinline__ void load_rows_f32(float* dst, int stride, const bfr* src, float scale) {
  constexpr int CPR = W / 8;
  for (int c = get_tid(); c < 64 * CPR; c += NTHR) {
    int j = c / CPR, ch = c % CPR;
    u4 w = *(const u4*)(src + (size_t)j * DINP + ch * 8);
    float f[8];
    unpack8(w, f);
    float4 a = make_float4(f[0] * scale, f[1] * scale, f[2] * scale, f[3] * scale);
    float4 bq = make_float4(f[4] * scale, f[5] * scale, f[6] * scale, f[7] * scale);
    *(float4*)(dst + j * stride + ch * 8) = a;
    *(float4*)(dst + j * stride + ch * 8 + 4) = bq;
  }
}

__device__ __forceinline__ void rope128_tile(float* t, int stride, int prow, const float* rope, float scale) {
  const float* cos32 = rope + 4096;
  const float* sin32 = rope + 8192;
  for (int u = get_tid(); u < 64 * 64; u += NTHR) {
    int j = u >> 6, A = (u >> 5) & 1, f = u & 31;
    int pos = A ? j : prow;
    float cs = cos32[pos * 32 + f], sn = sin32[pos * 32 + f];
    float x1 = t[j * stride + A * 64 + f], x2 = t[j * stride + A * 64 + 32 + f];
    t[j * stride + A * 64 + f] = (x1 * cs - x2 * sn) * scale;
    t[j * stride + A * 64 + 32 + f] = (x2 * cs + x1 * sn) * scale;
  }
}

__device__ __forceinline__ void gla_logdecay(const Params& p, int layer, int h, int dir, const bfr* rowbase, float* G) {
  const int tid = get_tid();
  const int j = tid >> 3, dg = tid & 7;
  const bfr* dl = rowbase + (size_t)j * DINP + C_GLD + dir * 16;
  u4 w0 = *(const u4*)dl, w1 = *(const u4*)(dl + 8);
  float x[16];
  unpack8(w0, x); unpack8(w1, x + 8);
  const float* wu = p.gla_wu + (size_t)layer * 8192 + dir * 4096 + h * 64;
  const float* bb = p.gla_b + layer * 512 + dir * 256 + h * 64;
#pragma unroll
  for (int dd = 0; dd < 8; ++dd) {
    int d = dg + 8 * dd;
    float pre = bb[d];
#pragma unroll
    for (int r = 0; r < 16; ++r) pre += x[r] * wu[r * 256 + d];
    G[j * 68 + d] = logsig_f(pre) * (1.f / 16.f);
  }
}

__device__ __forceinline__ void gla_logdecay2(const Params& p, int layer, int h, const bfr* rowbase, float* G0, float* G1) {
  const int tid = get_tid();
  const int w = tid >> 6, lane = tid & 63, fr = lane & 15, q4 = lane >> 4;
  const int dir = w >> 2, dt = w & 3;
  const int d = dt * 16 + fr;
  float* G = dir ? G1 : G0;
  u4 bw = (u4){0u, 0u, 0u, 0u};
  if (q4 < 2) {
    const float* wu = p.gla_wu + (size_t)layer * 8192 + dir * 4096 + (q4 * 8) * 256 + h * 64 + d;
    bw.x = pack2(wu[0 * 256], wu[1 * 256]); bw.y = pack2(wu[2 * 256], wu[3 * 256]);
    bw.z = pack2(wu[4 * 256], wu[5 * 256]); bw.w = pack2(wu[6 * 256], wu[7 * 256]);
  }
  const bf16x8 bq = __builtin_bit_cast(bf16x8, bw);
  const float bias = p.gla_b[layer * 512 + dir * 256 + h * 64 + d];
#pragma unroll
  for (int rt = 0; rt < 4; ++rt) {
    u4 aw = (u4){0u, 0u, 0u, 0u};
    if (q4 < 2) aw = *(const u4*)(rowbase + (size_t)(rt * 16 + fr) * DINP + C_GLD + dir * 16 + q4 * 8);
    f32x4 acc = (f32x4){0.f, 0.f, 0.f, 0.f};
    acc = MFMA16(__builtin_bit_cast(bf16x8, aw), bq, acc);
#pragma unroll
    for (int r = 0; r < 4; ++r) G[(rt * 16 + q4 * 4 + r) * 68 + d] = logsig_f(acc[r] + bias) * (1.f / 16.f);
  }
}

__device__ __forceinline__ int scan_pos(int dir, int g) { return dir == 0 ? g : (g < 4 ? 3 - g : 135 - g); }
__device__ __forceinline__ int group_row0(int b, int g) { return g < 4 ? (MX + b * 256 + g * 64) : (b * S + (g - 4) * 64); }

template <int W>
__device__ __forceinline__ void load_rows_transposed(bfr* T, const bfr* src) {
  for (int c = get_tid(); c < 64 * (W / 8); c += NTHR) {
    const int j = c & 63, dch = c >> 6;
    const u4 v = *(const u4*)(src + (size_t)j * DINP + dch * 8);
    bfr* d = T + (dch * 8) * 72 + j;
    d[0 * 72] = (bfr)(v.x & 0xffffu); d[1 * 72] = (bfr)(v.x >> 16);
    d[2 * 72] = (bfr)(v.y & 0xffffu); d[3 * 72] = (bfr)(v.y >> 16);
    d[4 * 72] = (bfr)(v.z & 0xffffu); d[5 * 72] = (bfr)(v.z >> 16);
    d[6 * 72] = (bfr)(v.w & 0xffffu); d[7 * 72] = (bfr)(v.w >> 16);
  }
}

template <int DK, bool GLA>
__device__ void scan_a_item(const Params& p, int layer, int item, char* smem) {
  const int g = item % 132;
  const int t2 = item / 132;
  const int h = t2 & 3, b = t2 >> 2;
  constexpr int KS = DK + 4;
  float* ks = (float*)smem;
  float* E0 = ks + 64 * KS;
  float* E1 = E0 + 64 * 68;
  bfr* Kt = (bfr*)(E1 + 64 * 68);
  bfr* Vt = Kt + DK * 72;
  const int tid = get_tid();
  const int w = tid >> 6, lane = tid & 63, fr = lane & 15, q4 = lane >> 4;
  const int row0 = group_row0(b, g);
  const bfr* rowbase = p.proj + (size_t)row0 * DINP;
  __syncthreads();
  if (GLA) {
    load_rows_transposed<128>(Vt, rowbase + C_GLV + h * 128);
    load_rows_f32<64>(ks, KS, rowbase + C_GLK + h * 64, 1.f);
    gla_logdecay2(p, layer, h, rowbase, E0, E1);
  } else {
    const float kscale = 0.08838834764831845f;
    load_rows_transposed<128>(Vt, rowbase + C_RTV + h * 128);
    load_rows_f32<128>(ks, KS, rowbase + C_RTK + h * 128, g < 4 ? kscale : 1.f);
    __syncthreads();
    if (g >= 4) rope128_tile(ks, KS, g - 4, p.rope, kscale);
  }
#pragma unroll 1
  for (int dir = 0; dir < 2; ++dir) {
    const int scan = ((b * 4 + h) * 2 + dir);
    const int pos = scan_pos(dir, g);
    float lg = 0.f;
    __syncthreads();
    float* E = dir ? E1 : E0;
    if (GLA) {
      if (tid < 64) {
        float run = 0.f;
        if (dir == 0) {
          for (int j = 63; j >= 0; --j) { float v = E[j * 68 + tid]; E[j * 68 + tid] = run; run += v; }
        } else {
          for (int j = 0; j < 64; ++j) { float v = E[j * 68 + tid]; E[j * 68 + tid] = run; run += v; }
        }
        p.dec_gla[(size_t)(scan * 132 + pos) * 64 + tid] = __expf(run);
      }
      __syncthreads();
    } else {
      lg = p.ret_lg[layer * 8 + dir * 4 + h];
      if (tid < 128) p.dec_ret[(size_t)(scan * 132 + pos) * 128 + tid] = __expf(lg * 64.f);
    }
    for (int u = tid; u < 64 * DK; u += NTHR) {
      const int j = u & 63, d = u >> 6;
      const float sc = GLA ? __expf(E[j * 68 + d]) : __expf(lg * (dir == 0 ? (float)(63 - j) : (float)j));
      Kt[d * 72 + j] = f2bf(ks[j * KS + d] * sc);
    }
    __syncthreads();
    bf16x8 vfr[2];
#pragma unroll
    for (int k2 = 0; k2 < 2; ++k2) vfr[k2] = *(const bf16x8*)(Vt + (w * 16 + fr) * 72 + k2 * 32 + q4 * 8);
    bfr* st = (GLA ? p.st_gla : p.st_ret) + (size_t)(scan * 132 + pos) * DK * 128;
#pragma unroll 2
    for (int dt = 0; dt < DK / 16; ++dt) {
      f32x4 acc = (f32x4){0.f, 0.f, 0.f, 0.f};
#pragma unroll
      for (int k2 = 0; k2 < 2; ++k2) {
        const bf16x8 kq = *(const bf16x8*)(Kt + (dt * 16 + fr) * 72 + k2 * 32 + q4 * 8);
        acc = MFMA16(kq, vfr[k2], acc);
      }
      uint2 o;
      o.x = pack2(acc[0], acc[1]); o.y = pack2(acc[2], acc[3]);
      *(uint2*)(st + (size_t)(w * 16 + fr) * DK + dt * 16 + q4 * 4) = o;
    }
  }
}

__device__ void scan_b_phase(const Params& p) {
  const int gt = get_bid() * NTHR + get_tid(), ntot = gridDim.x * NTHR;
  for (int ch = gt; ch < 98304; ch += ntot) {
    bfr* st; const float* dec; int DK, e4;
    if (ch < 65536) { int scan = ch >> 12; e4 = ch & 4095; DK = 128; st = p.st_ret + (size_t)scan * 132 * 16384; dec = p.dec_ret + (size_t)scan * 132 * 128; }
    else { int c2 = ch - 65536; int scan = c2 >> 11; e4 = c2 & 2047; DK = 64; st = p.st_gla + (size_t)scan * 132 * 8192; dec = p.dec_gla + (size_t)scan * 132 * 64; }
    const int d0 = (e4 * 4) & (DK - 1);
    const size_t cstride = (size_t)DK * 128;
    float4 s = make_float4(0.f, 0.f, 0.f, 0.f);
    bfr* ptr = st + e4 * 4;
    const float* dp = dec + d0;
    for (int pos = 0; pos < 132; pos += 4) {
      uint2 u[4];
      float4 dv[4];
#pragma unroll
      for (int q = 0; q < 4; ++q) {
        u[q] = *(const uint2*)(ptr + (size_t)(pos + q) * cstride);
        dv[q] = *(const float4*)(dp + (pos + q) * DK);
      }
#pragma unroll
      for (int q = 0; q < 4; ++q) {
        uint2 o;
        o.x = pack2(s.x, s.y); o.y = pack2(s.z, s.w);
        *(uint2*)(ptr + (size_t)(pos + q) * cstride) = o;
        s = make_float4(dv[q].x * s.x + lo16(u[q].x), dv[q].y * s.y + hi16(u[q].x), dv[q].z * s.z + lo16(u[q].y), dv[q].w * s.w + hi16(u[q].y));
      }
    }
  }
}

template <int DK, bool GLA>
__device__ void scan_c_item(const Params& p, int layer, int item, char* smem) {
  const int g = item % 132;
  const int t2 = item / 132;
  const int h = t2 & 3, b = t2 >> 2;
  constexpr int FS = DK + 4;
  constexpr int QS = DK + 8;
  float* stg = (float*)smem;
  float* Gf = stg + 64 * FS;
  float* Gb = Gf + (GLA ? 64 * 68 : 0);
  float* red = Gb + (GLA ? 64 * 68 : 0);
  float* red2 = red + 8 * 64 * 2;
  bfr* T0 = (bfr*)(red2 + 64 * 2);
  bfr* T1 = T0 + 64 * QS;
  bfr* T2 = T1 + 64 * QS;
  bfr* T3 = T2 + 64 * QS;
  bfr* T4 = T3 + 64 * QS;
  bfr* T5 = T4 + (GLA ? 64 * QS : 0);
  bfr* Vt = T5 + (GLA ? 64 * QS : 0);
  bfr* Am = Vt + 128 * 72;
  const int tid = get_tid();
  const int w = tid >> 6, lane = tid & 63, fr = lane & 15, q4 = lane >> 4;
  const int row0 = group_row0(b, g);
  const bfr* rowbase = p.proj + (size_t)row0 * DINP;
  float lgf = 0.f, lgb = 0.f;
  __syncthreads();
  if (GLA) {
    load_rows_transposed<128>(Vt, rowbase + C_GLV + h * 128);
    load_rows_f32<64>(stg, FS, rowbase + C_GLQ + h * 64, 0.125f);
    gla_logdecay2(p, layer, h, rowbase, Gf, Gb);
    __syncthreads();
    {
      const int d = tid & 63, seg = tid >> 6;
      float runf = 0.f, runb = 0.f;
#pragma unroll
      for (int jj = 0; jj < 8; ++jj) {
        const int jf = seg * 8 + jj, jb = seg * 8 + 7 - jj;
        runf += Gf[jf * 68 + d]; Gf[jf * 68 + d] = runf;
        runb += Gb[jb * 68 + d]; Gb[jb * 68 + d] = runb;
      }
      red[seg * 64 + d] = runf;
      red[512 + seg * 64 + d] = runb;
      __syncthreads();
      float offf = 0.f, offb = 0.f;
#pragma unroll
      for (int s2 = 0; s2 < 8; ++s2) {
        if (s2 < seg) offf += red[s2 * 64 + d];
        if (s2 > seg) offb += red[512 + s2 * 64 + d];
      }
#pragma unroll
      for (int jj = 0; jj < 8; ++jj) {
        const int j = seg * 8 + jj;
        Gf[j * 68 + d] += offf;
        Gb[j * 68 + d] += offb;
      }
    }
    __syncthreads();
    for (int u = tid; u < 64 * 64; u += NTHR) {
      const int i = u >> 6, d = u & 63;
      const float qv = stg[i * FS + d];
      const float gf = Gf[i * 68 + d], gb = Gb[i * 68 + d];
      T0[i * QS + d] = f2bf(qv * __expf(gf - Gf[63 * 68 + d]));
      T2[i * QS + d] = f2bf(qv * __expf(gf));
      T4[i * QS + d] = f2bf(qv * __expf(gb - Gb[d]));
      T3[i * QS + d] = f2bf(qv * __expf(gb));
    }
    __syncthreads();
    load_rows_f32<64>(stg, FS, rowbase + C_GLK + h * 64, 1.f);
    __syncthreads();
    for (int u = tid; u < 64 * 64; u += NTHR) {
      const int j = u >> 6, d = u & 63;
      const float kv = stg[j * FS + d];
      T1[j * QS + d] = f2bf(kv * __expf(Gf[63 * 68 + d] - Gf[j * 68 + d]));
      T5[j * QS + d] = f2bf(kv * __expf(Gb[d] - Gb[j * 68 + d]));
    }
  } else {
    const float kscale = 0.08838834764831845f;
    lgf = p.ret_lg[layer * 8 + 0 + h];
    lgb = p.ret_lg[layer * 8 + 4 + h];
    load_rows_transposed<128>(Vt, rowbase + C_RTV + h * 128);
    {
      const int j = tid >> 3, A = (tid >> 2) & 1, fc = tid & 3;
      float cs[8], sn[8];
      if (g >= 4) {
        const int pos = A ? j : (g - 4);
        const float* cp = p.rope + 4096 + pos * 32 + fc * 8;
        const float4 c0 = *(const float4*)cp, c1 = *(const float4*)(cp + 4);
        const float4 s0 = *(const float4*)(cp + 4096), s1 = *(const float4*)(cp + 4100);
        cs[0] = c0.x; cs[1] = c0.y; cs[2] = c0.z; cs[3] = c0.w; cs[4] = c1.x; cs[5] = c1.y; cs[6] = c1.z; cs[7] = c1.w;
        sn[0] = s0.x; sn[1] = s0.y; sn[2] = s0.z; sn[3] = s0.w; sn[4] = s1.x; sn[5] = s1.y; sn[6] = s1.z; sn[7] = s1.w;
      } else {
#pragma unroll
        for (int e = 0; e < 8; ++e) { cs[e] = 1.f; sn[e] = 0.f; }
      }
      const int col = A * 64 + fc * 8;
      const bfr* qp = rowbase + (size_t)j * DINP + C_RTQ + h * 128 + col;
      const bfr* kp = rowbase + (size_t)j * DINP + C_RTK + h * 128 + col;
      const u4 q1 = *(const u4*)qp, q2 = *(const u4*)(qp + 32);
      const u4 k1 = *(const u4*)kp, k2w = *(const u4*)(kp + 32);
      float x1[8], x2[8], y1[8], y2[8];
      unpack8(q1, x1); unpack8(q2, x2);
#pragma unroll
      for (int e = 0; e < 8; ++e) { y1[e] = x1[e] * cs[e] - x2[e] * sn[e]; y2[e] = x2[e] * cs[e] + x1[e] * sn[e]; }
      const float ff = __expf(lgf * (float)(j + 1)), fb = __expf(lgb * (float)(64 - j));
      u4 o;
      o.x = pack2(y1[0], y1[1]); o.y = pack2(y1[2], y1[3]); o.z = pack2(y1[4], y1[5]); o.w = pack2(y1[6], y1[7]);
      *(u4*)(T0 + j * QS + col) = o;
      o.x = pack2(y2[0], y2[1]); o.y = pack2(y2[2], y2[3]); o.z = pack2(y2[4], y2[5]); o.w = pack2(y2[6], y2[7]);
      *(u4*)(T0 + j * QS + col + 32) = o;
      o.x = pack2(y1[0] * ff, y1[1] * ff); o.y = pack2(y1[2] * ff, y1[3] * ff); o.z = pack2(y1[4] * ff, y1[5] * ff); o.w = pack2(y1[6] * ff, y1[7] * ff);
      *(u4*)(T2 + j * QS + col) = o;
      o.x = pack2(y2[0] * ff, y2[1] * ff); o.y = pack2(y2[2] * ff, y2[3] * ff); o.z = pack2(y2[4] * ff, y2[5] * ff); o.w = pack2(y2[6] * ff, y2[7] * ff);
      *(u4*)(T2 + j * QS + col + 32) = o;
      o.x = pack2(y1[0] * fb, y1[1] * fb); o.y = pack2(y1[2] * fb, y1[3] * fb); o.z = pack2(y1[4] * fb, y1[5] * fb); o.w = pack2(y1[6] * fb, y1[7] * fb);
      *(u4*)(T3 + j * QS + col) = o;
      o.x = pack2(y2[0] * fb, y2[1] * fb); o.y = pack2(y2[2] * fb, y2[3] * fb); o.z = pack2(y2[4] * fb, y2[5] * fb); o.w = pack2(y2[6] * fb, y2[7] * fb);
      *(u4*)(T3 + j * QS + col + 32) = o;
      unpack8(k1, x1); unpack8(k2w, x2);
#pragma unroll
      for (int e = 0; e < 8; ++e) { y1[e] = (x1[e] * cs[e] - x2[e] * sn[e]) * kscale; y2[e] = (x2[e] * cs[e] + x1[e] * sn[e]) * kscale; }
      o.x = pack2(y1[0], y1[1]); o.y = pack2(y1[2], y1[3]); o.z = pack2(y1[4], y1[5]); o.w = pack2(y1[6], y1[7]);
      *(u4*)(T1 + j * QS + col) = o;
      o.x = pack2(y2[0], y2[1]); o.y = pack2(y2[2], y2[3]); o.z = pack2(y2[4], y2[5]); o.w = pack2(y2[6], y2[7]);
      *(u4*)(T1 + j * QS + col + 32) = o;
    }
  }
  __syncthreads();
  {
    const int ti = w >> 1;
#pragma unroll
    for (int tt = 0; tt < 2; ++tt) {
      const int tj = (w & 1) * 2 + tt;
      f32x4 af = (f32x4){0.f, 0.f, 0.f, 0.f}, ab = af;
#pragma unroll
      for (int k2 = 0; k2 < DK / 32; ++k2) {
        const bf16x8 a = *(const bf16x8*)(T0 + (ti * 16 + fr) * QS + k2 * 32 + q4 * 8);
        const bf16x8 bq = *(const bf16x8*)(T1 + (tj * 16 + fr) * QS + k2 * 32 + q4 * 8);
        af = MFMA16(a, bq, af);
        if (GLA) {
          const bf16x8 a2 = *(const bf16x8*)(T4 + (ti * 16 + fr) * QS + k2 * 32 + q4 * 8);
          const bf16x8 b2 = *(const bf16x8*)(T5 + (tj * 16 + fr) * QS + k2 * 32 + q4 * 8);
          ab = MFMA16(a2, b2, ab);
        }
      }
#pragma unroll
      for (int r = 0; r < 4; ++r) {
        const int i = ti * 16 + q4 * 4 + r, j = tj * 16 + fr;
        float v;
        if (GLA) v = (j <= i) ? af[r] : ab[r];
        else v = af[r] * ((j <= i) ? __expf(lgf * (float)(i - j)) : __expf(lgb * (float)(j - i)));
        Am[i * 72 + j] = f2bf(v);
      }
    }
  }
  __syncthreads();
  f32x4 acc[4];
#pragma unroll
  for (int rt = 0; rt < 4; ++rt) acc[rt] = (f32x4){0.f, 0.f, 0.f, 0.f};
#pragma unroll
  for (int k2 = 0; k2 < 2; ++k2) {
    const bf16x8 bq = *(const bf16x8*)(Vt + (w * 16 + fr) * 72 + k2 * 32 + q4 * 8);
#pragma unroll
    for (int rt = 0; rt < 4; ++rt) {
      const bf16x8 a = *(const bf16x8*)(Am + (rt * 16 + fr) * 72 + k2 * 32 + q4 * 8);
      acc[rt] = MFMA16(a, bq, acc[rt]);
    }
  }
#pragma unroll
  for (int dir = 0; dir < 2; ++dir) {
    const int scan = (b * 4 + h) * 2 + dir;
    const int pos = scan_pos(dir, g);
    const bfr* St = (GLA ? p.st_gla : p.st_ret) + (size_t)(scan * 132 + pos) * DK * 128 + (size_t)(w * 16 + fr) * DK + q4 * 8;
    const bfr* qt = dir == 0 ? T2 : T3;
#pragma unroll
    for (int k2 = 0; k2 < DK / 32; ++k2) {
      const bf16x8 bq = *(const bf16x8*)(St + k2 * 32);
#pragma unroll
      for (int rt = 0; rt < 4; ++rt) {
        const bf16x8 a = *(const bf16x8*)(qt + (rt * 16 + fr) * QS + k2 * 32 + q4 * 8);
        acc[rt] = MFMA16(a, bq, acc[rt]);
      }
    }
  }
#pragma unroll
  for (int rt = 0; rt < 4; ++rt)
#pragma unroll
    for (int r = 0; r < 4; ++r) {
      float s1 = acc[rt][r], s2 = s1 * s1;
#pragma unroll
      for (int of = 8; of; of >>= 1) { s1 += __shfl_xor(s1, of); s2 += __shfl_xor(s2, of); }
      if (fr == 0) {
        const int i = rt * 16 + q4 * 4 + r;
        red[(w * 64 + i) * 2 + 0] = s1;
        red[(w * 64 + i) * 2 + 1] = s2;
      }
    }
  __syncthreads();
  if (tid < 128) {
    const int i = tid >> 1, c = tid & 1;
    float t = 0.f;
#pragma unroll
    for (int ww = 0; ww < 8; ++ww) t += red[(ww * 64 + i) * 2 + c];
    red2[i * 2 + c] = t;
  }
  __syncthreads();
  const int gcol = GLA ? C_GLG : C_RTG;
  const int ocol = GLA ? 1024 : 512;
  const int vcol = h * 128 + w * 16 + fr;
  const float gg = GLA ? p.gla_g[layer * 128 + w * 16 + fr] : 1.f;
#pragma unroll
  for (int rt = 0; rt < 4; ++rt)
#pragma unroll
    for (int r = 0; r < 4; ++r) {
      const int i = rt * 16 + q4 * 4 + r;
      const float S1 = red2[i * 2 + 0], S2 = red2[i * 2 + 1];
      float y;
      if (GLA) {
        y = acc[rt][r] * rsqrtf(S2 * (1.f / 128.f) + EPS) * gg;
      } else {
        const float mu = S1 * (1.f / 128.f);
        const float var = fmaxf(S2 * (1.f / 128.f) - mu * mu, 0.f);
        y = (acc[rt][r] - mu) * rsqrtf(var + EPS);
      }
      const int row = row0 + i;
      const float gt = bf2f(p.proj[(size_t)row * DINP + gcol + vcol]);
      y *= silu_f(gt);
      p.mix[(size_t)row * D + ocol + vcol] = f2bf(y);
    }
}

__constant__ unsigned char c_cand_tab[64] = {0, 1, 2, 3, 4, 5, 6, 7, 8, 9, 10, 11, 12, 13, 14, 15, 16, 17, 18, 19, 20, 21, 22, 23, 32, 33, 34, 35, 36, 48, 49, 50, 51, 64, 65, 66, 80, 81, 96, 97, 112, 113, 128, 144, 160, 176, 192, 208, 224, 240, 255, 255, 255, 255, 255, 255, 255, 255, 255, 255, 255, 255, 255, 255};

template <int N>
__device__ __forceinline__ void bitonic_sort_desc(float (&v)[N]) {
#pragma unroll
  for (int k = 2; k <= N; k <<= 1)
#pragma unroll
    for (int j = k >> 1; j > 0; j >>= 1)
#pragma unroll
      for (int i = 0; i < N; ++i) {
        const int l = i ^ j;
        if (l > i) {
          const bool desc = ((i & k) == 0);
          const float x = v[i], y = v[l];
          const float hi = fmaxf(x, y), lo = fminf(x, y);
          v[i] = desc ? hi : lo;
          v[l] = desc ? lo : hi;
        }
      }
}
__device__ __forceinline__ void merge_top16(float (&v)[16], const int xl) {
  float o[16];
#pragma unroll
  for (int i = 0; i < 16; ++i) o[i] = __shfl_xor(v[15 - i], xl);
#pragma unroll
  for (int i = 0; i < 16; ++i) v[i] = fmaxf(v[i], o[i]);
#pragma unroll
  for (int j = 8; j > 0; j >>= 1)
#pragma unroll
    for (int i = 0; i < 16; ++i) {
      const int l = i ^ j;
      if (l > i) {
        const float x = v[i], y = v[l];
        v[i] = fmaxf(x, y);
        v[l] = fminf(x, y);
      }
    }
}
__device__ __forceinline__ float pack_key(float x, unsigned mask, unsigned key) {
  return __uint_as_float((__float_as_uint(x) & ~mask) | key);
}

__device__ void topk_phase(const Params& p, int layer, int ntok, char* smem) {
  float* sc = (float*)smem;
  const int tid = get_tid();
  const int lane = tid & 63, w = tid >> 6, fr = lane & 15, q4 = lane >> 4;
  const int nbatch = ntok >> 4;
  for (int bt = get_bid(); bt < nbatch; bt += gridDim.x) {
    __syncthreads();
#pragma unroll 1
    for (int pp = 0; pp < 2; ++pp) {
      const int pair = 2 * w + pp;
      const bfr* qrow = p.q + (size_t)(bt * 16 + fr) * D + pair * 128 + q4 * 8;
      const bfr* skb = p.sk_bf + (size_t)(((layer * 2 + (pair & 1)) * 8 + (pair >> 1))) * 128 * 128 + q4 * 8;
      bf16x8 af[4];
#pragma unroll
      for (int k2 = 0; k2 < 4; ++k2) af[k2] = *(const bf16x8*)(qrow + k2 * 32);
#pragma unroll 4
      for (int nt = 0; nt < 8; ++nt) {
        f32x4 acc = (f32x4){0.f, 0.f, 0.f, 0.f};
#pragma unroll
        for (int k2 = 0; k2 < 4; ++k2) {
          const bf16x8 bq = *(const bf16x8*)(skb + (size_t)(nt * 16 + fr) * 128 + k2 * 32);
          acc = MFMA16(af[k2], bq, acc);
        }
#pragma unroll
        for (int r = 0; r < 4; ++r) sc[((q4 * 4 + r) * 16 + pair) * 132 + nt * 16 + fr] = acc[r];
      }
    }
    __syncthreads();
#pragma unroll 1
    for (int ps = 0; ps < 2; ++ps) {
      const int list = ps * 128 + (tid >> 2), qd = tid & 3;
      float v[32];
#pragma unroll
      for (int j = 0; j < 8; ++j) {
        float4 t = *(const float4*)(sc + list * 132 + qd * 32 + j * 4);
        const unsigned kb = qd * 32 + j * 4;
        v[j * 4 + 0] = pack_key(t.x, 127u, kb + 0); v[j * 4 + 1] = pack_key(t.y, 127u, kb + 1);
        v[j * 4 + 2] = pack_key(t.z, 127u, kb + 2); v[j * 4 + 3] = pack_key(t.w, 127u, kb + 3);
      }
      bitonic_sort_desc<32>(v);
      float wv[16];
#pragma unroll
      for (int i = 0; i < 16; ++i) wv[i] = v[i];
      merge_top16(wv, 1);
      merge_top16(wv, 2);
      if (qd == 0) {
#pragma unroll
        for (int j = 0; j < 4; ++j)
          *(float4*)(sc + list * 132 + j * 4) = make_float4(wv[j * 4 + 0], wv[j * 4 + 1], wv[j * 4 + 2], wv[j * 4 + 3]);
      }
    }
    __syncthreads();
    {
      const int pair = tid >> 2, qd = tid & 3;
      const int tok = pair >> 3, hh = pair & 7;
      const float* o0 = sc + (tok * 16 + hh * 2) * 132;
      const float* o1 = o0 + 132;
      float c[16];
#pragma unroll
      for (int i = 0; i < 16; ++i) {
        const unsigned code = c_cand_tab[qd * 16 + i];
        const float sum = o0[code >> 4] + o1[code & 15];
        c[i] = (code == 255u) ? -INFINITY : pack_key(sum, 255u, code);
      }
      bitonic_sort_desc<16>(c);
      merge_top16(c, 1);
      merge_top16(c, 2);
      float e[16];
      float esum = 0.f;
#pragma unroll
      for (int i = 0; i < 16; ++i) { e[i] = __expf(c[i] - c[0]); esum += e[i]; }
      const float inv = 1.f / esum;
      const int m = bt * 16 + tok;
#pragma unroll
      for (int j = 0; j < 4; ++j) {
        const float ev = qd == 0 ? e[j] : (qd == 1 ? e[4 + j] : (qd == 2 ? e[8 + j] : e[12 + j]));
        const float cv = qd == 0 ? c[j] : (qd == 1 ? c[4 + j] : (qd == 2 ? c[8 + j] : c[12 + j]));
        const unsigned code = __float_as_uint(cv) & 255u;
        const unsigned k0 = __float_as_uint(o0[code >> 4]) & 127u;
        const unsigned k1 = __float_as_uint(o1[code & 15]) & 127u;
        p.pidx[(size_t)m * 128 + hh * 16 + qd * 4 + j] = (int)(k0 * 128u + k1);
        p.pgate[(size_t)m * 128 + hh * 16 + qd * 4 + j] = ev * inv;
      }
    }
  }
}

typedef __attribute__((ext_vector_type(2))) float f32x2;
__device__ __forceinline__ float dot16_fp8(const float* hf, const u4 w) {
  f32x2 a0 = __builtin_amdgcn_cvt_pk_f32_fp8((int)w.x, false), a1 = __builtin_amdgcn_cvt_pk_f32_fp8((int)w.x, true);
  f32x2 b0 = __builtin_amdgcn_cvt_pk_f32_fp8((int)w.y, false), b1 = __builtin_amdgcn_cvt_pk_f32_fp8((int)w.y, true);
  f32x2 c0 = __builtin_amdgcn_cvt_pk_f32_fp8((int)w.z, false), c1 = __builtin_amdgcn_cvt_pk_f32_fp8((int)w.z, true);
  f32x2 d0 = __builtin_amdgcn_cvt_pk_f32_fp8((int)w.w, false), d1 = __builtin_amdgcn_cvt_pk_f32_fp8((int)w.w, true);
  return hf[0] * a0.x + hf[1] * a0.y + hf[2] * a1.x + hf[3] * a1.y + hf[4] * b0.x + hf[5] * b0.y + hf[6] * b1.x + hf[7] * b1.y +
         hf[8] * c0.x + hf[9] * c0.y + hf[10] * c1.x + hf[11] * c1.y + hf[12] * d0.x + hf[13] * d0.y + hf[14] * d1.x + hf[15] * d1.y;
}
__device__ __forceinline__ void fma16_fp8(float* o, float c, const u4 w) {
  f32x2 a0 = __builtin_amdgcn_cvt_pk_f32_fp8((int)w.x, false), a1 = __builtin_amdgcn_cvt_pk_f32_fp8((int)w.x, true);
  f32x2 b0 = __builtin_amdgcn_cvt_pk_f32_fp8((int)w.y, false), b1 = __builtin_amdgcn_cvt_pk_f32_fp8((int)w.y, true);
  f32x2 c0 = __builtin_amdgcn_cvt_pk_f32_fp8((int)w.z, false), c1 = __builtin_amdgcn_cvt_pk_f32_fp8((int)w.z, true);
  f32x2 d0 = __builtin_amdgcn_cvt_pk_f32_fp8((int)w.w, false), d1 = __builtin_amdgcn_cvt_pk_f32_fp8((int)w.w, true);
  o[0] += c * a0.x; o[1] += c * a0.y; o[2] += c * a1.x; o[3] += c * a1.y;
  o[4] += c * b0.x; o[5] += c * b0.y; o[6] += c * b1.x; o[7] += c * b1.y;
  o[8] += c * c0.x; o[9] += c * c0.y; o[10] += c * c1.x; o[11] += c * c1.y;
  o[12] += c * d0.x; o[13] += c * d0.y; o[14] += c * d1.x; o[15] += c * d1.y;
}

__device__ void peer_phase(const Params& p, int layer, int ntok) {
  const int lane = get_tid() & 63;
  const int wave = get_bid() * 8 + (get_tid() >> 6), nw = gridDim.x * 8;
  const unsigned char* U = p.u8 + (size_t)layer * 16384 * D;
  const unsigned char* V = p.v8 + (size_t)layer * 16384 * D;
  const float* usc = p.uscl + layer * 16384;
  const float* vsc = p.vscl + layer * 16384;
  int idA_n = 0, idB_n = 0;
  float pgA_n = 0.f, pgB_n = 0.f;
  u4 hn[4];
  if (wave < ntok) {
    idA_n = p.pidx[(size_t)wave * 128 + lane]; idB_n = p.pidx[(size_t)wave * 128 + 64 + lane];
    pgA_n = p.pgate[(size_t)wave * 128 + lane]; pgB_n = p.pgate[(size_t)wave * 128 + 64 + lane];
    const bfr* hr = p.h + (size_t)wave * D + lane * 16;
    hn[0] = *(const u4*)(hr); hn[1] = *(const u4*)(hr + 8); hn[2] = *(const u4*)(hr + 1024); hn[3] = *(const u4*)(hr + 1032);
  }
  for (int m = wave; m < ntok; m += nw) {
    float hf[32];
    unpack8(hn[0], hf); unpack8(hn[1], hf + 8); unpack8(hn[2], hf + 16); unpack8(hn[3], hf + 24);
    const int idA = idA_n, idB = idB_n;
    const float gA = pgA_n * vsc[idA], gB = pgB_n * vsc[idB];
    const float usA = usc[idA], usB = usc[idB];
    float cA = 0.f, cB = 0.f;
#pragma unroll 1
    for (int e0 = 0; e0 < 128; e0 += 8) {
      u4 r[8][2];
#pragma unroll
      for (int u = 0; u < 8; ++u) {
        int e = e0 + u;
        int row = __shfl(e0 < 64 ? idA : idB, e & 63);
        const unsigned char* up = U + (size_t)row * D + lane * 16;
        r[u][0] = *(const u4*)(up);
        r[u][1] = *(const u4*)(up + 1024);
      }
      __builtin_amdgcn_sched_barrier(0);
#pragma unroll
      for (int u = 0; u < 8; ++u) {
        int e = e0 + u;
        float dsum = dot16_fp8(hf, r[u][0]) + dot16_fp8(hf + 16, r[u][1]);
        dsum = wave_sum(dsum);
        if (e0 < 64) { if (lane == e) cA = gA * gelu_f(dsum * usA); }
        else { if (lane == e - 64) cB = gB * gelu_f(dsum * usB); }
        __builtin_amdgcn_sched_barrier(0);
      }
    }
    if (m + nw < ntok) {
      const int m2 = m + nw;
      idA_n = p.pidx[(size_t)m2 * 128 + lane]; idB_n = p.pidx[(size_t)m2 * 128 + 64 + lane];
      pgA_n = p.pgate[(size_t)m2 * 128 + lane]; pgB_n = p.pgate[(size_t)m2 * 128 + 64 + lane];
      const bfr* hr = p.h + (size_t)m2 * D + lane * 16;
      hn[0] = *(const u4*)(hr); hn[1] = *(const u4*)(hr + 8); hn[2] = *(const u4*)(hr + 1024); hn[3] = *(const u4*)(hr + 1032);
    }
    float o[32];
#pragma unroll
    for (int i = 0; i < 32; ++i) o[i] = 0.f;
#pragma unroll 1
    for (int e0 = 0; e0 < 128; e0 += 4) {
      u4 r[4][2];
      float cf[4];
#pragma unroll
      for (int u = 0; u < 4; ++u) {
        int e = e0 + u;
        int row = __shfl(e0 < 64 ? idA : idB, e & 63);
        cf[u] = __shfl(e0 < 64 ? cA : cB, e & 63);
        const unsigned char* vp = V + (size_t)row * D + lane * 16;
        r[u][0] = *(const u4*)(vp);
        r[u][1] = *(const u4*)(vp + 1024);
      }
      __builtin_amdgcn_sched_barrier(0);
#pragma unroll
      for (int u = 0; u < 4; ++u) {
        fma16_fp8(o, cf[u], r[u][0]);
        fma16_fp8(o + 16, cf[u], r[u][1]);
        __builtin_amdgcn_sched_barrier(0);
      }
    }
    const int vec = m < S ? 0 : (m < MX ? 1 : 2);
    const float* modl = p.mod + (layer * 3 + vec) * 12288;
    float* xr = p.xcur + (size_t)m * D + lane * 16;
    float xn[32];
    float ss = 0.f;
#pragma unroll
    for (int i = 0; i < 2; ++i)
#pragma unroll
      for (int k = 0; k < 4; ++k) {
        int col = i * 1024 + lane * 16 + k * 4;
        float4 a = *(const float4*)(xr + i * 1024 + k * 4);
        float4 g0 = *(const float4*)(modl + 5 * D + col);
        float* xx = xn + i * 16 + k * 4;
        const float* oo = o + i * 16 + k * 4;
        xx[0] = a.x + g0.x * oo[0]; xx[1] = a.y + g0.y * oo[1]; xx[2] = a.z + g0.z * oo[2]; xx[3] = a.w + g0.w * oo[3];
        ss += xx[0] * xx[0] + xx[1] * xx[1] + xx[2] * xx[2] + xx[3] * xx[3];
      }
    ss = wave_sum(ss);
    const float rstd = rsqrtf(ss * (1.f / D) + EPS);
    if (layer == 1) {
      float* orow = p.out + (size_t)m * D;
#pragma unroll
      for (int i = 0; i < 2; ++i)
#pragma unroll
        for (int k = 0; k < 4; ++k) {
          int col = i * 1024 + lane * 16 + k * 4;
          float4 f0 = *(const float4*)(p.final_g + col);
          const float* xx = xn + i * 16 + k * 4;
          *(float4*)(orow + col) = make_float4(xx[0] * rstd * f0.x, xx[1] * rstd * f0.y, xx[2] * rstd * f0.z, xx[3] * rstd * f0.w);
        }
    } else {
      const float* modn = p.mod + ((layer + 1) * 3 + vec) * 12288;
      const float* gn = p.g_attn + (layer + 1) * D;
#pragma unroll
      for (int i = 0; i < 2; ++i) {
        float y[16];
#pragma unroll
        for (int k = 0; k < 4; ++k) {
          int col = i * 1024 + lane * 16 + k * 4;
          const float* xx = xn + i * 16 + k * 4;
          *(float4*)(xr + i * 1024 + k * 4) = make_float4(xx[0], xx[1], xx[2], xx[3]);
          float4 gv = *(const float4*)(gn + col), scv = *(const float4*)(modn + D + col), shv = *(const float4*)(modn + col);
          y[k * 4 + 0] = xx[0] * rstd * gv.x * (1.f + scv.x) + shv.x;
          y[k * 4 + 1] = xx[1] * rstd * gv.y * (1.f + scv.y) + shv.y;
          y[k * 4 + 2] = xx[2] * rstd * gv.z * (1.f + scv.z) + shv.z;
          y[k * 4 + 3] = xx[3] * rstd * gv.w * (1.f + scv.w) + shv.w;
        }
        u4 w0, w1;
        w0.x = pack2(y[0], y[1]); w0.y = pack2(y[2], y[3]); w0.z = pack2(y[4], y[5]); w0.w = pack2(y[6], y[7]);
        w1.x = pack2(y[8], y[9]); w1.y = pack2(y[10], y[11]); w1.z = pack2(y[12], y[13]); w1.w = pack2(y[14], y[15]);
        *(u4*)(p.h + (size_t)m * D + i * 1024 + lane * 16) = w0;
        *(u4*)(p.h + (size_t)m * D + i * 1024 + lane * 16 + 8) = w1;
      }
    }
  }
}

constexpr int PH_INIT = 0, PH_MOD_ATTN = 1, PH_INPROJ = 2, PH_MIX1 = 3, PH_SCANB = 4, PH_SCANC = 5, PH_OUTPROJ = 6,
              PH_MOD_FFN = 7, PH_QPROJ = 8, PH_SCORES = 9, PH_TOPK = 10, PH_PEER = 11;

template <int EPI, bool ALLOW_BIG>
__device__ __forceinline__ void gemm_phase(const Params& p, int layer, int vid, const bfr* A, const bfr* Bt, int MB, int MT,
                                           int NB, int N128, int small_nt, void* Cout, int ldc, char* smem) {
  const int nbig = MB * NB;
  const int nsm1 = small_nt >= 0 ? MB : 0;
  const int nsm2 = (MT - MB) * N128;
  const int total = nbig + nsm1 + nsm2;
  for (int t = vid; t < total; t += gridDim.x) {
    if (t < nbig) {
      if constexpr (ALLOW_BIG) {
        const int mt = t / NB, nt = t - mt * NB;
        gemm_tile<EPI, true>(A, D, Bt, D, D, mt * 256, nt * 256, Cout, ldc, p, layer, smem);
      }
    } else if (t < nbig + nsm1) {
      gemm_tile<EPI, false>(A, D, Bt, D, D, (t - nbig) * 256, small_nt * 128, Cout, ldc, p, layer, smem);
    } else {
      const int u = t - nbig - nsm1;
      const int mt = MB + u / N128, nt = u % N128;
      gemm_tile<EPI, false>(A, D, Bt, D, D, mt * 256, nt * 128, Cout, ldc, p, layer, smem);
    }
  }
}

__device__ void run_phase(const Params& p, int ph, int layer, char* smem, int vid) {
  const int bid = get_bid(), nb = gridDim.x;
  const bool last = (layer == 1);
  switch (ph) {
    case PH_INIT: phase0(p, smem); break;
    case PH_MOD_ATTN: modulate_phase(p, layer, 0, MT); break;
    case PH_INPROJ:
      gemm_phase<0, true>(p, layer, vid, p.h, p.wt_in + (size_t)layer * DINP * D, 66, 66, 23, 47, 46, p.proj, DINP, smem);
      break;
    case PH_MIX1: {
      const int n_swa = 256, n_na = 2048, n_sa = 1056, n_ctx = last ? 0 : 32;
      const int total = n_swa + n_na + 2 * n_sa + n_ctx;
      for (int it = bid; it < total; it += nb) {
        int t = it;
        if (t < n_swa) { swa_item(p, layer, t, smem); continue; }
        t -= n_swa;
        if (t < n_na) { na_item(p, layer, t, smem); continue; }
        t -= n_na;
        if (t < n_sa) { scan_a_item<128, false>(p, layer, t, smem); continue; }
        t -= n_sa;
        if (t < n_sa) { scan_a_item<64, true>(p, layer, t, smem); continue; }
        t -= n_sa;
        ctx_item(p, layer, t, smem);
      }
    } break;
    case PH_SCANB: scan_b_phase(p); break;
    case PH_SCANC:
      for (int it = bid; it < 2 * 1056; it += nb) {
        const bool gla = it < 1056;
        const int t = gla ? it : it - 1056;
        if (last && (t % 132) < 4) continue;
        if (gla) scan_c_item<64, true>(p, layer, t, smem);
        else scan_c_item<128, false>(p, layer, t, smem);
      }
      break;
    case PH_OUTPROJ: {
      gemm_phase<1, false>(p, layer, vid, p.mix, p.wt_out + (size_t)layer * D * D, 0, last ? 64 : 66, 8, 16, -1, nullptr, 0, smem);
    } break;
    case PH_MOD_FFN: modulate_phase(p, layer, 1, last ? MX : MT); break;
    case PH_QPROJ: {
      gemm_phase<0, true>(p, layer, vid, p.h, p.wt_q + (size_t)layer * D * D, 64, last ? 64 : 66, 8, 16, -1, p.q, D, smem);
    } break;
    case PH_SCORES: {
      const int mt = last ? 64 : 66;
      for (int t = bid; t < mt * 16; t += nb) {
        int j = t & 15;
        int hh = j >> 1, pp = j & 1;
        const bfr* bt = p.sk_bf + (size_t)(((layer * 2 + pp) * 8 + hh)) * 128 * 128;
        gemm_tile<2, false>(p.q + j * 128, D, bt, 128, 128, (t >> 4) * 256, 0, p.scores + j * 128, D, p, layer, smem);
      }
    } break;
    case PH_TOPK: topk_phase(p, layer, last ? MX : MT, smem); break;
    case PH_PEER: peer_phase(p, layer, last ? MX : MT); break;
  }
}

__device__ __forceinline__ void grid_barrier(unsigned* bar, unsigned& epoch) {
  asm volatile("s_waitcnt vmcnt(0)" ::: "memory");
  __syncthreads();
  epoch += gridDim.x;
  if (threadIdx.x == 0) {
    __builtin_amdgcn_fence(__ATOMIC_RELEASE, "agent");
    asm volatile("s_waitcnt vmcnt(0)" ::: "memory");
    (void)__hip_atomic_fetch_add(bar, 1u, __ATOMIC_RELAXED, __HIP_MEMORY_SCOPE_AGENT);
    unsigned spins = 0;
    while (__hip_atomic_load(bar, __ATOMIC_RELAXED, __HIP_MEMORY_SCOPE_AGENT) < epoch) {
      __builtin_amdgcn_s_sleep(1);
      if (++spins > (1u << 24)) break;
    }
    __builtin_amdgcn_fence(__ATOMIC_ACQUIRE, "agent");
    asm volatile("s_waitcnt vmcnt(0)" ::: "memory");
  }
  __syncthreads();
}

#if MULTI_LAUNCH
__global__ void __launch_bounds__(NTHR) phase_kernel(Params p, int ph, int layer) {
  extern __shared__ __attribute__((aligned(16))) char smem[];
  run_phase(p, ph, layer, smem, blockIdx.x);
}
#else
__global__ void __launch_bounds__(NTHR) mega_kernel(Params p) {
  extern __shared__ __attribute__((aligned(16))) char smem[];
  cg::grid_group grid = cg::this_grid();
  const unsigned xcd = (unsigned)__builtin_amdgcn_s_getreg((3 << 11) | 20) & 7u;
  run_phase(p, PH_INIT, 0, smem, 0);
  __syncthreads();
  if (threadIdx.x == 0) ((volatile unsigned*)smem)[0] = atomicAdd(&p.bar[16 + xcd], 1u);
  grid.sync();
  int vid = (int)((volatile unsigned*)smem)[0];
  for (unsigned x = 0; x < xcd; ++x) vid += (int)__hip_atomic_load(&p.bar[16 + x], __ATOMIC_RELAXED, __HIP_MEMORY_SCOPE_AGENT);
  vid = __builtin_amdgcn_readfirstlane(vid);
  __syncthreads();
  unsigned epoch = 0;
  for (int layer = 0; layer < 2; ++layer) {
    for (int ph = (layer == 0 ? PH_MOD_ATTN : PH_INPROJ); ph <= PH_PEER; ++ph) {
      if (ph == PH_SCORES) continue;
      run_phase(p, ph, layer, smem, vid);
      if (!(layer == 1 && ph == PH_PEER)) grid_barrier(p.bar, epoch);
    }
  }
}
#endif

static inline size_t align_up(size_t v) { return (v + 255) & ~(size_t)255; }

extern "C" void kernel_launch(void* const* d_in, const int* in_sizes, int n_in, void* d_out, int out_size, void* d_ws,
                              size_t ws_size, hipStream_t stream) {
  Params p{};
  p.x = (const float*)d_in[0]; p.c = (const float*)d_in[1]; p.ctx = (const float*)d_in[2]; p.c_ctx = (const float*)d_in[3];
  p.w_ada = (const float*)d_in[4]; p.b_ada = (const float*)d_in[5]; p.g_attn = (const float*)d_in[6]; p.g_ffn = (const float*)d_in[7];
  p.w_in = (const float*)d_in[8]; p.rpb = (const float*)d_in[9]; p.ret_lg = (const float*)d_in[10]; p.gla_wu = (const float*)d_in[11];
  p.gla_b = (const float*)d_in[12]; p.gla_g = (const float*)d_in[13]; p.sink = (const float*)d_in[14]; p.w_out = (const float*)d_in[15];
  p.w_q = (const float*)d_in[16]; p.sub_keys = (const float*)d_in[17]; p.pu = (const float*)d_in[18]; p.pv = (const float*)d_in[19];
  p.final_g = (const float*)d_in[20];
  p.out = (float*)d_out;
  char* ws = (char*)d_ws;
  size_t off = 0;
  auto take = [&](size_t bytes) { char* r = ws + off; off = align_up(off + bytes); return r; };
  p.mod = (float*)take((size_t)2 * 3 * 12288 * 4);
  p.bar = (unsigned*)take(256);
  p.rope = (float*)take((size_t)16384 * 4);
  p.wt_in = (bfr*)take((size_t)2 * DINP * D * 2);
  p.wt_out = (bfr*)take((size_t)2 * D * D * 2);
  p.wt_q = (bfr*)take((size_t)2 * D * D * 2);
  p.sk_bf = (bfr*)take((size_t)524288 * 2);
  p.u8 = (unsigned char*)take((size_t)2 * 16384 * D);
  p.v8 = (unsigned char*)take((size_t)2 * 16384 * D);
  p.uscl = (float*)take((size_t)2 * 16384 * 4);
  p.vscl = (float*)take((size_t)2 * 16384 * 4);
  p.xcur = (float*)take((size_t)MT * D * 4);
  p.h = (bfr*)take((size_t)MT * D * 2);
  p.proj = (bfr*)take((size_t)MT * DINP * 2);
  p.mix = (bfr*)take((size_t)MT * D * 2);
  p.st_ret = (bfr*)take((size_t)16 * 132 * 16384 * 4);
  p.dec_ret = (float*)take((size_t)16 * 132 * 128 * 4);
  p.dec_gla = (float*)take((size_t)16 * 132 * 64 * 4);
  p.pidx = (int*)take((size_t)MT * 128 * 4);
  p.pgate = (float*)take((size_t)MT * 128 * 4);
  p.st_gla = (bfr*)p.h;
  p.q = p.proj;
  p.scores = (float*)p.st_ret;
  if (off > ws_size) { fprintf(stderr, "workspace too small: need %zu have %zu\n", off, ws_size); return; }

  hipMemsetAsync(p.mod, 0, (size_t)2 * 3 * 12288 * 4 + 256, stream);
#if MULTI_LAUNCH
  hipFuncSetAttribute((const void*)phase_kernel, hipFuncAttributeMaxDynamicSharedMemorySize, SMEM_BYTES);
  const int grid = 256;
  hipLaunchKernelGGL(phase_kernel, dim3(grid), dim3(NTHR), SMEM_BYTES, stream, p, PH_INIT, 0);
  for (int layer = 0; layer < 2; ++layer)
    for (int ph = (layer == 0 ? PH_MOD_ATTN : PH_INPROJ); ph <= PH_PEER; ++ph)
      hipLaunchKernelGGL(phase_kernel, dim3(grid), dim3(NTHR), SMEM_BYTES, stream, p, ph, layer);
#else
  static int grid_blocks = 0;
  if (!grid_blocks) {
    hipFuncSetAttribute((const void*)mega_kernel, hipFuncAttributeMaxDynamicSharedMemorySize, SMEM_BYTES);
    int dev = 0, cus = 0, per_cu = 0;
    hipGetDevice(&dev);
    hipDeviceGetAttribute(&cus, hipDeviceAttributeMultiprocessorCount, dev);
    hipOccupancyMaxActiveBlocksPerMultiprocessor(&per_cu, mega_kernel, NTHR, SMEM_BYTES);
    if (per_cu < 1) per_cu = 1;
    grid_blocks = cus * per_cu;
    if (grid_blocks > 256) grid_blocks = 256;
  }
  void* args[] = {&p};
  hipError_t e = hipLaunchCooperativeKernel((void*)mega_kernel, dim3(grid_blocks), dim3(NTHR), args, SMEM_BYTES, stream);
  if (e != hipSuccess) fprintf(stderr, "cooperative launch failed: %s (grid %d)\n", hipGetErrorString(e), grid_blocks);
#endif
}
```

```cpp
#include <hip/hip_runtime.h>
#include <hip/hip_cooperative_groups.h>
#include <cstdio>
namespace cg = cooperative_groups;

#ifndef MULTI_LAUNCH
#define MULTI_LAUNCH 0
#endif

typedef unsigned short bfr;
typedef __attribute__((ext_vector_type(8))) short bf16x8;
typedef __attribute__((ext_vector_type(4))) float f32x4;
typedef __attribute__((ext_vector_type(4))) unsigned int u4;

constexpr int D = 2048;
constexpr int S = 8192;
constexpr int MX = 16384;
constexpr int MT = 16896;
constexpr int DIN = 5920;
constexpr int DINP = 6016;
constexpr int NTHR = 512;
constexpr float EPS = 1e-6f;
constexpr int SMEM_BYTES = 149504;

constexpr int C_NAQ = 0, C_NAK = 512, C_NAV = 1024;
constexpr int C_RTQ = 1536, C_RTK = 2048, C_RTV = 2560, C_RTG = 3072;
constexpr int C_GLQ = 3584, C_GLK = 3840, C_GLV = 4096, C_GLG = 4608, C_GLD = 5120;
constexpr int C_SWQ = 5152, C_SWK = 5664, C_SWV = 5792;

struct Params {
  const float *x, *c, *ctx, *c_ctx, *w_ada, *b_ada, *g_attn, *g_ffn, *w_in, *rpb, *ret_lg, *gla_wu, *gla_b,
      *gla_g, *sink, *w_out, *w_q, *sub_keys, *pu, *pv, *final_g;
  float* out;
  bfr *wt_in, *wt_out, *wt_q, *sk_bf;
  unsigned char *u8, *v8;
  float *uscl, *vscl;
  float *mod, *rope, *xcur;
  bfr *h, *proj, *mix;
  bfr *st_ret, *st_gla;
  float *dec_ret, *dec_gla;
  bfr* q;
  float* scores;
  int* pidx;
  float* pgate;
  unsigned* bar;
};

__device__ __forceinline__ int get_tid() { int t = threadIdx.x; asm volatile("" : "+v"(t)); return t; }
__device__ __forceinline__ int get_bid() { int t = blockIdx.x; asm volatile("" : "+s"(t)); return t; }
__device__ __forceinline__ float bf2f(bfr u) { return __uint_as_float(((unsigned)u) << 16); }
typedef __bf16 hwbf16x2 __attribute__((ext_vector_type(2)));
typedef float hwf32x2 __attribute__((ext_vector_type(2)));
__device__ __forceinline__ unsigned pack2(float a, float b) {
  hwf32x2 v = {a, b};
  hwbf16x2 r = __builtin_convertvector(v, hwbf16x2);
  return __builtin_bit_cast(unsigned, r);
}
__device__ __forceinline__ bfr f2bf(float f) { return (bfr)(pack2(f, 0.f) & 0xffffu); }
__device__ __forceinline__ float lo16(unsigned w) { return __uint_as_float(w << 16); }
__device__ __forceinline__ float hi16(unsigned w) { return __uint_as_float(w & 0xffff0000u); }
__device__ __forceinline__ float wave_sum(float v) {
#pragma unroll
  for (int o = 32; o; o >>= 1) v += __shfl_xor(v, o);
  return v;
}
__device__ __forceinline__ float wave_max(float v) {
#pragma unroll
  for (int o = 32; o; o >>= 1) v = fmaxf(v, __shfl_xor(v, o));
  return v;
}
__device__ __forceinline__ float silu_f(float x) { return x / (1.f + __expf(-x)); }
__device__ __forceinline__ float gelu_f(float x) { return 0.5f * x * (1.f + erff(x * 0.70710678118654752f)); }
__device__ __forceinline__ float logsig_f(float x) { return fminf(x, 0.f) - log1pf(__expf(-fabsf(x))); }
__device__ __forceinline__ void unpack8(const u4 w, float* f) {
  f[0] = lo16(w.x); f[1] = hi16(w.x); f[2] = lo16(w.y); f[3] = hi16(w.y);
  f[4] = lo16(w.z); f[5] = hi16(w.z); f[6] = lo16(w.w); f[7] = hi16(w.w);
}

__device__ void transpose_cvt(const float* __restrict__ W, int K, int N, int Npad, bfr* __restrict__ Wt, int item,
                              float* tile) {
  const int nkt = K >> 6;
  const int kt = item % nkt, nt = item / nkt;
  const int tid = get_tid();
  __syncthreads();
#pragma unroll
  for (int i = 0; i < 2; ++i) {
    int kk = (tid >> 4) + 32 * i, nn = (tid & 15) * 4;
    int n = nt * 64 + nn;
    float4 v = make_float4(0.f, 0.f, 0.f, 0.f);
    if (n < N) v = *(const float4*)(W + (size_t)(kt * 64 + kk) * N + n);
    tile[kk * 65 + nn + 0] = v.x; tile[kk * 65 + nn + 1] = v.y; tile[kk * 65 + nn + 2] = v.z; tile[kk * 65 + nn + 3] = v.w;
  }
  __syncthreads();
  {
    int nl = tid >> 3, kc = (tid & 7) * 8;
    u4 o;
    o.x = pack2(tile[(kc + 0) * 65 + nl], tile[(kc + 1) * 65 + nl]);
    o.y = pack2(tile[(kc + 2) * 65 + nl], tile[(kc + 3) * 65 + nl]);
    o.z = pack2(tile[(kc + 4) * 65 + nl], tile[(kc + 5) * 65 + nl]);
    o.w = pack2(tile[(kc + 6) * 65 + nl], tile[(kc + 7) * 65 + nl]);
    *(u4*)(Wt + (size_t)(nt * 64 + nl) * K + kt * 64 + kc) = o;
  }
}

__device__ void cvt_linear(const float* __restrict__ src, bfr* __restrict__ dst, size_t n8) {
  for (size_t i = (size_t)get_bid() * NTHR + get_tid(); i < n8; i += (size_t)gridDim.x * NTHR) {
    float4 a = *(const float4*)(src + i * 8), b = *(const float4*)(src + i * 8 + 4);
    u4 o;
    o.x = pack2(a.x, a.y); o.y = pack2(a.z, a.w); o.z = pack2(b.x, b.y); o.w = pack2(b.z, b.w);
    *(u4*)(dst + i * 8) = o;
  }
}

__device__ void cvt_fp8_rows(const float* __restrict__ src, unsigned char* __restrict__ dst, float* __restrict__ scl, int nrows) {
  const int lane = get_tid() & 63;
  const int wave = get_bid() * 8 + (get_tid() >> 6), nw = gridDim.x * 8;
  for (int row = wave; row < nrows; row += nw) {
    const float* sp = src + (size_t)row * D + lane * 16;
    float4 v[8];
    float amax = 0.f;
#pragma unroll
    for (int i = 0; i < 2; ++i)
#pragma unroll
      for (int k = 0; k < 4; ++k) {
        float4 t = *(const float4*)(sp + i * 1024 + k * 4);
        v[i * 4 + k] = t;
        amax = fmaxf(amax, fmaxf(fmaxf(fabsf(t.x), fabsf(t.y)), fmaxf(fabsf(t.z), fabsf(t.w))));
      }
    amax = wave_max(amax);
    const float sc = amax > 0.f ? 256.f / amax : 1.f;
#pragma unroll
    for (int i = 0; i < 2; ++i) {
      u4 o;
      int w;
      w = __builtin_amdgcn_cvt_pk_fp8_f32(v[i * 4 + 0].x * sc, v[i * 4 + 0].y * sc, 0, false);
      w = __builtin_amdgcn_cvt_pk_fp8_f32(v[i * 4 + 0].z * sc, v[i * 4 + 0].w * sc, w, true); o.x = (unsigned)w;
      w = __builtin_amdgcn_cvt_pk_fp8_f32(v[i * 4 + 1].x * sc, v[i * 4 + 1].y * sc, 0, false);
      w = __builtin_amdgcn_cvt_pk_fp8_f32(v[i * 4 + 1].z * sc, v[i * 4 + 1].w * sc, w, true); o.y = (unsigned)w;
      w = __builtin_amdgcn_cvt_pk_fp8_f32(v[i * 4 + 2].x * sc, v[i * 4 + 2].y * sc, 0, false);
      w = __builtin_amdgcn_cvt_pk_fp8_f32(v[i * 4 + 2].z * sc, v[i * 4 + 2].w * sc, w, true); o.z = (unsigned)w;
      w = __builtin_amdgcn_cvt_pk_fp8_f32(v[i * 4 + 3].x * sc, v[i * 4 + 3].y * sc, 0, false);
      w = __builtin_amdgcn_cvt_pk_fp8_f32(v[i * 4 + 3].z * sc, v[i * 4 + 3].w * sc, w, true); o.w = (unsigned)w;
      *(u4*)(dst + (size_t)row * D + i * 1024 + lane * 16) = o;
    }
    if (lane == 0) scl[row] = amax > 0.f ? amax * (1.f / 256.f) : 1.f;
  }
}

__device__ void sincos_d(double a, float& s, float& c) {
  double k = rint(a * 0.63661977236758134308);
  double r = a - k * 1.57079632679489661923;
  double r2 = r * r;
  double sn = r * (1.0 + r2 * (-1.0 / 6 + r2 * (1.0 / 120 + r2 * (-1.0 / 5040 + r2 * (1.0 / 362880 + r2 * (-1.0 / 39916800 + r2 * (1.0 / 6227020800.0)))))));
  double cs = 1.0 + r2 * (-0.5 + r2 * (1.0 / 24 + r2 * (-1.0 / 720 + r2 * (1.0 / 40320 + r2 * (-1.0 / 3628800 + r2 * (1.0 / 479001600.0))))));
  int q = ((int)k) & 3;
  double so = (q == 0) ? sn : (q == 1) ? cs : (q == 2) ? -sn : -cs;
  double co = (q == 0) ? cs : (q == 1) ? -sn : (q == 2) ? -cs : sn;
  s = (float)so; c = (float)co;
}

__device__ void phase0(const Params& p, char* smem) {
  const int tid = get_tid(), bid = get_bid(), nb = gridDim.x;
  float* fs = (float*)smem;
  if (bid == 0) {
    for (int e = tid; e < 128 * 16 + 128 * 32; e += NTHR) {
      int F, pos, f, base;
      if (e < 2048) { F = 16; pos = e >> 4; f = e & 15; base = 0; }
      else { int e2 = e - 2048; F = 32; pos = e2 >> 5; f = e2 & 31; base = 4096; }
      double bb = (F == 16) ? 0.56234132519034908 : 0.74989420933245582;
      double inv = 1.0;
      for (int i = 0; i < f; ++i) inv *= bb;
      float invf = (float)inv;
      float ang = (float)pos * invf;
      float sn, cs;
      sincos_d((double)ang, sn, cs);
      p.rope[base + pos * F + f] = cs;
      p.rope[base + 128 * F + pos * F + f] = sn;
    }
  }
  for (int it = bid; it < 384; it += nb) {
    int layer = it / 192, r = it % 192, kc = r / 6, nc = r % 6;
    __syncthreads();
    if (tid < 192) {
      int v = tid >> 6, kk = tid & 63;
      float cv = (v < 2) ? p.c[v * D + kc * 64 + kk] : p.c_ctx[kc * 64 + kk];
      fs[tid] = silu_f(cv);
    }
    __syncthreads();
    int n = nc * 2048 + tid * 4;
    float4 a0 = make_float4(0, 0, 0, 0), a1 = a0, a2 = a0;
    if (kc == 0) { a0 = *(const float4*)(p.b_ada + layer * 12288 + n); a1 = a0; a2 = a0; }
    const float* w = p.w_ada + (size_t)layer * D * 12288 + (size_t)(kc * 64) * 12288 + n;
#pragma unroll 8
    for (int kk = 0; kk < 64; ++kk) {
      float4 wv = *(const float4*)(w + (size_t)kk * 12288);
      float s0 = fs[kk], s1 = fs[64 + kk], s2 = fs[128 + kk];
      a0.x += s0 * wv.x; a0.y += s0 * wv.y; a0.z += s0 * wv.z; a0.w += s0 * wv.w;
      a1.x += s1 * wv.x; a1.y += s1 * wv.y; a1.z += s1 * wv.z; a1.w += s1 * wv.w;
      a2.x += s2 * wv.x; a2.y += s2 * wv.y; a2.z += s2 * wv.z; a2.w += s2 * wv.w;
    }
    float* m0 = p.mod + (layer * 3 + 0) * 12288 + n;
    float* m1 = p.mod + (layer * 3 + 1) * 12288 + n;
    float* m2 = p.mod + (layer * 3 + 2) * 12288 + n;
    atomicAdd(m0 + 0, a0.x); atomicAdd(m0 + 1, a0.y); atomicAdd(m0 + 2, a0.z); atomicAdd(m0 + 3, a0.w);
    atomicAdd(m1 + 0, a1.x); atomicAdd(m1 + 1, a1.y); atomicAdd(m1 + 2, a1.z); atomicAdd(m1 + 3, a1.w);
    atomicAdd(m2 + 0, a2.x); atomicAdd(m2 + 1, a2.y); atomicAdd(m2 + 2, a2.z); atomicAdd(m2 + 3, a2.w);
  }
  for (int layer = 0; layer < 2; ++layer) {
    for (int it = bid; it < 32 * 94; it += nb)
      transpose_cvt(p.w_in + (size_t)layer * D * DIN, D, DIN, DINP, p.wt_in + (size_t)layer * DINP * D, it, fs);
    for (int it = bid; it < 32 * 32; it += nb)
      transpose_cvt(p.w_out + (size_t)layer * D * D, D, D, D, p.wt_out + (size_t)layer * D * D, it, fs);
    for (int it = bid; it < 32 * 32; it += nb)
      transpose_cvt(p.w_q + (size_t)layer * D * D, D, D, D, p.wt_q + (size_t)layer * D * D, it, fs);
  }
  cvt_linear(p.sub_keys, p.sk_bf, (size_t)524288 / 8);
  cvt_fp8_rows(p.pu, p.u8, p.uscl, 2 * 16384);
  cvt_fp8_rows(p.pv, p.v8, p.vscl, 2 * 16384);
}

__device__ __forceinline__ const float* modulate_src(const Params& p, int layer, int which, int m) {
  if (layer == 0 && which == 0) return (m < MX) ? p.x + (size_t)m * D : p.ctx + (size_t)(m - MX) * D;
  return p.xcur + (size_t)m * D;
}
__device__ void modulate_phase(const Params& p, int layer, int which, int nrows) {
  const int lane = get_tid() & 63;
  const int wave = get_bid() * 8 + (get_tid() >> 6), nw = gridDim.x * 8;
  const float* g = (which == 0 ? p.g_attn : p.g_ffn) + layer * D;
  float4 vn[8];
  if (wave < nrows) {
    const float* src = modulate_src(p, layer, which, wave);
#pragma unroll
    for (int i = 0; i < 8; ++i) vn[i] = *(const float4*)(src + i * 256 + lane * 4);
  }
  for (int m = wave; m < nrows; m += nw) {
    float4 v[8];
#pragma unroll
    for (int i = 0; i < 8; ++i) v[i] = vn[i];
    if (m + nw < nrows) {
      const float* src = modulate_src(p, layer, which, m + nw);
#pragma unroll
      for (int i = 0; i < 8; ++i) vn[i] = *(const float4*)(src + i * 256 + lane * 4);
    }
    int vec = m < S ? 0 : (m < MX ? 1 : 2);
    const float* modl = p.mod + (layer * 3 + vec) * 12288 + which * 3 * D;
    float ss = 0.f;
#pragma unroll
    for (int i = 0; i < 8; ++i) ss += v[i].x * v[i].x + v[i].y * v[i].y + v[i].z * v[i].z + v[i].w * v[i].w;
    ss = wave_sum(ss);
    float rstd = rsqrtf(ss * (1.f / D) + EPS);
#pragma unroll
    for (int i = 0; i < 8; ++i) {
      int col = i * 256 + lane * 4;
      float4 gg = *(const float4*)(g + col);
      float4 sh = *(const float4*)(modl + col);
      float4 sc = *(const float4*)(modl + D + col);
      float y0 = v[i].x * rstd * gg.x * (1.f + sc.x) + sh.x;
      float y1 = v[i].y * rstd * gg.y * (1.f + sc.y) + sh.y;
      float y2 = v[i].z * rstd * gg.z * (1.f + sc.z) + sh.z;
      float y3 = v[i].w * rstd * gg.w * (1.f + sc.w) + sh.w;
      uint2 o; o.x = pack2(y0, y1); o.y = pack2(y2, y3);
      *(uint2*)(p.h + (size_t)m * D + col) = o;
    }
  }
}

template <int EPI, bool BIG>
__device__ void gemm_tile(const bfr* __restrict__ A, int lda, const bfr* __restrict__ Bt, int ldb, int K, int m0,
                          int n0, void* Cout, int ldc, const Params& p, int layer, char* smem) {
  constexpr int BN = BIG ? 256 : 128;
  constexpr int MI = BIG ? 8 : 4;
  constexpr int NBL = BN / 64;
  bfr* As0 = (bfr*)smem;
  bfr* Bs0 = As0 + 2 * 256 * 72;
  const int tid = get_tid(), lane = tid & 63, w = tid >> 6;
  const int wm = BIG ? (w >> 2) : (w >> 1), wn = BIG ? (w & 3) : (w & 1);
  const int fr = lane & 15, fq = lane >> 4;
  f32x4 acc[MI][4];
#pragma unroll
  for (int i = 0; i < MI; ++i)
#pragma unroll
    for (int j = 0; j < 4; ++j) acc[i][j] = (f32x4){0.f, 0.f, 0.f, 0.f};
  const int arow = tid >> 3, akc = (tid & 7) * 8;
  u4 rs[4];
  const bfr* Ap = A + (size_t)(m0 + arow) * lda + akc;
  const bfr* Bp = Bt + (size_t)(n0 + arow) * ldb + akc;
#pragma unroll
  for (int i = 0; i < 4; ++i) rs[i] = *(const u4*)(Ap + (size_t)(64 * i) * lda);
  __syncthreads();
#pragma unroll
  for (int i = 0; i < 4; ++i) *(u4*)(As0 + (arow + 64 * i) * 72 + akc) = rs[i];
#pragma unroll
  for (int i = 0; i < NBL; ++i) rs[i] = *(const u4*)(Bp + (size_t)(64 * i) * ldb);
#pragma unroll
  for (int i = 0; i < NBL; ++i) *(u4*)(Bs0 + (arow + 64 * i) * 72 + akc) = rs[i];
  const int nk = K >> 6;
  if (nk > 1) {
#pragma unroll
    for (int i = 0; i < 4; ++i) rs[i] = *(const u4*)(Ap + (size_t)(64 * i) * lda + 64);
  }
  __syncthreads();
  for (int kt = 0; kt < nk; ++kt) {
    const bfr* As = As0 + (kt & 1) * (256 * 72);
    const bfr* Bs = Bs0 + (kt & 1) * (BN * 72);
    bfr* Asn = As0 + ((kt + 1) & 1) * (256 * 72);
    bfr* Bsn = Bs0 + ((kt + 1) & 1) * (BN * 72);
#pragma unroll
    for (int kk = 0; kk < 2; ++kk) {
      bf16x8 b[4];
#pragma unroll
      for (int j = 0; j < 4; ++j) b[j] = *(const bf16x8*)(Bs + (wn * 64 + j * 16 + fr) * 72 + kk * 32 + fq * 8);
      {
        bf16x8 a_cur = *(const bf16x8*)(As + (wm * (MI * 16) + fr) * 72 + kk * 32 + fq * 8);
#pragma unroll
        for (int i = 0; i < MI; ++i) {
          bf16x8 a_nxt = a_cur;
          if (i + 1 < MI) a_nxt = *(const bf16x8*)(As + (wm * (MI * 16) + (i + 1) * 16 + fr) * 72 + kk * 32 + fq * 8);
          __builtin_amdgcn_s_setprio(1);
#pragma unroll
          for (int j = 0; j < 4; ++j) acc[i][j] = __builtin_amdgcn_mfma_f32_16x16x32_bf16(b[j], a_cur, acc[i][j], 0, 0, 0);
          __builtin_amdgcn_s_setprio(0);
          if (BIG) __builtin_amdgcn_sched_barrier(0);
          a_cur = a_nxt;
        }
      }
      if (kt + 1 < nk) {
        if (kk == 0) {
#pragma unroll
          for (int i = 0; i < 4; ++i) *(u4*)(Asn + (arow + 64 * i) * 72 + akc) = rs[i];
#pragma unroll
          for (int i = 0; i < NBL; ++i) rs[i] = *(const u4*)(Bp + (size_t)(64 * i) * ldb + (kt + 1) * 64);
        } else {
#pragma unroll
          for (int i = 0; i < NBL; ++i) *(u4*)(Bsn + (arow + 64 * i) * 72 + akc) = rs[i];
          if (kt + 2 < nk) {
#pragma unroll
            for (int i = 0; i < 4; ++i) rs[i] = *(const u4*)(Ap + (size_t)(64 * i) * lda + (kt + 2) * 64);
          }
        }
      }
    }
    __syncthreads();
  }
  const int nb0 = n0 + wn * 64 + fq * 4;
#pragma unroll
  for (int i = 0; i < MI; ++i) {
    const int m = m0 + wm * (MI * 16) + i * 16 + fr;
    if (EPI == 0) {
      bfr* crow = (bfr*)Cout + (size_t)m * ldc + nb0;
#pragma unroll
      for (int j = 0; j < 4; ++j) {
        uint2 o;
        o.x = pack2(acc[i][j][0], acc[i][j][1]); o.y = pack2(acc[i][j][2], acc[i][j][3]);
        *(uint2*)(crow + j * 16) = o;
      }
    } else if (EPI == 2) {
      float* crow = (float*)Cout + (size_t)m * ldc + nb0;
#pragma unroll
      for (int j = 0; j < 4; ++j) *(float4*)(crow + j * 16) = make_float4(acc[i][j][0], acc[i][j][1], acc[i][j][2], acc[i][j][3]);
    } else {
      const float* src;
      if (layer == 0) src = (m < MX) ? p.x + (size_t)m * D : p.ctx + (size_t)(m - MX) * D;
      else src = p.xcur + (size_t)m * D;
      src += nb0;
      const int vec = m < S ? 0 : (m < MX ? 1 : 2);
      const float* grow = p.mod + (layer * 3 + vec) * 12288 + 2 * D + nb0;
      float* orow = p.xcur + (size_t)m * D + nb0;
#pragma unroll
      for (int j = 0; j < 4; ++j) {
        const float4 gate = *(const float4*)(grow + j * 16);
        const float4 xs = *(const float4*)(src + j * 16);
        *(float4*)(orow + j * 16) = make_float4(xs.x + gate.x * acc[i][j][0], xs.y + gate.y * acc[i][j][1], xs.z + gate.z * acc[i][j][2], xs.w + gate.w * acc[i][j][3]);
      }
      __builtin_amdgcn_sched_barrier(0);
    }
  }
}

#define MFMA16(a, b, c) __builtin_amdgcn_mfma_f32_16x16x32_bf16((a), (b), (c), 0, 0, 0)
typedef __attribute__((ext_vector_type(4))) short s16x4;

__device__ __forceinline__ void load_kv_tile(bfr* dst, const bfr* src, int nrows, int tok0, int toklimit) {
  for (int c = get_tid(); c < nrows * 8; c += NTHR) {
    int r = c >> 3, ch = c & 7;
    int tok = tok0 + r;
    u4 v = (u4){0u, 0u, 0u, 0u};
    if (tok >= 0 && tok < toklimit) v = *(const u4*)(src + (ptrdiff_t)r * DINP + ch * 8);
    *(u4*)(dst + r * 72 + ch * 8) = v;
  }
}
__device__ __forceinline__ void load_vt_tile(bfr* Vt, int VS, const bfr* src, int nrows, int tok0, int toklimit) {
  for (int c = get_tid(); c < nrows * 8; c += NTHR) {
    int key = c % nrows, dch = c / nrows;
    int tok = tok0 + key;
    u4 v = (u4){0u, 0u, 0u, 0u};
    if (tok >= 0 && tok < toklimit) v = *(const u4*)(src + (ptrdiff_t)key * DINP + dch * 8);
    bfr* d = Vt + (dch * 8) * VS + key;
    d[0 * VS] = (bfr)(v.x & 0xffffu); d[1 * VS] = (bfr)(v.x >> 16);
    d[2 * VS] = (bfr)(v.y & 0xffffu); d[3 * VS] = (bfr)(v.y >> 16);
    d[4 * VS] = (bfr)(v.z & 0xffffu); d[5 * VS] = (bfr)(v.z >> 16);
    d[6 * VS] = (bfr)(v.w & 0xffffu); d[7 * VS] = (bfr)(v.w >> 16);
  }
}
__device__ __forceinline__ void load_kfrags(bf16x8 (&kf)[2][2], const bfr* Ks, int kt, int fr, int q4) {
#pragma unroll
  for (int blk = 0; blk < 2; ++blk)
#pragma unroll
    for (int ds = 0; ds < 2; ++ds) kf[blk][ds] = *(const bf16x8*)(Ks + (kt + blk * 16 + fr) * 72 + ds * 32 + q4 * 8);
}
__device__ __forceinline__ void load_vfrags(bf16x8 (&vf)[4], const bfr* Vt, int VS, int kt, int fr, int q4) {
#pragma unroll
  for (int db = 0; db < 4; ++db) {
    const bfr* vp = Vt + (db * 16 + fr) * VS + kt + q4 * 4;
    s16x4 lo = *(const s16x4*)vp, hi = *(const s16x4*)(vp + 16);
    vf[db] = __builtin_shufflevector(lo, hi, 0, 1, 2, 3, 4, 5, 6, 7);
  }
}
__device__ __forceinline__ void attn_tile_group(const bf16x8 (&kf)[2][2], const bf16x8 (&qf)[2], const bf16x8 (&vf)[4],
                                                f32x4 (&o)[4], float& m, float& l, const float (&badd)[8]) {
  f32x4 s0 = (f32x4){0.f, 0.f, 0.f, 0.f}, s1 = s0;
  s0 = MFMA16(kf[0][0], qf[0], s0); s0 = MFMA16(kf[0][1], qf[1], s0);
  s1 = MFMA16(kf[1][0], qf[0], s1); s1 = MFMA16(kf[1][1], qf[1], s1);
  float sv[8];
#pragma unroll
  for (int i = 0; i < 4; ++i) { sv[i] = s0[i] + badd[i]; sv[4 + i] = s1[i] + badd[4 + i]; }
  float mx = fmaxf(fmaxf(fmaxf(sv[0], sv[1]), fmaxf(sv[2], sv[3])), fmaxf(fmaxf(sv[4], sv[5]), fmaxf(sv[6], sv[7])));
  mx = fmaxf(mx, __shfl_xor(mx, 16));
  mx = fmaxf(mx, __shfl_xor(mx, 32));
  const float mn = fmaxf(m, mx);
  const float mref = (mn == -INFINITY) ? 0.f : mn;
  const float alpha = __expf(m - mref);
  float pv[8];
  float ls = 0.f;
#pragma unroll
  for (int i = 0; i < 8; ++i) { pv[i] = __expf(sv[i] - mref); ls += pv[i]; }
  l = l * alpha + ls;
  m = mn;
  u4 pk;
  pk.x = pack2(pv[0], pv[1]); pk.y = pack2(pv[2], pv[3]); pk.z = pack2(pv[4], pv[5]); pk.w = pack2(pv[6], pv[7]);
  const bf16x8 pb = __builtin_bit_cast(bf16x8, pk);
#pragma unroll
  for (int db = 0; db < 4; ++db) {
    o[db] *= alpha;
    o[db] = MFMA16(vf[db], pb, o[db]);
  }
}
__device__ __forceinline__ float attn_rowsum(float l) {
  l += __shfl_xor(l, 16);
  l += __shfl_xor(l, 32);
  return l;
}
__device__ __forceinline__ void load_qfrags(bf16x8 (&qf)[2], const bfr* qrow, int q4, float scale) {
#pragma unroll
  for (int ds = 0; ds < 2; ++ds) {
    u4 w = *(const u4*)(qrow + ds * 32 + q4 * 8);
    float f[8];
    unpack8(w, f);
    u4 o;
    o.x = pack2(f[0] * scale, f[1] * scale); o.y = pack2(f[2] * scale, f[3] * scale);
    o.z = pack2(f[4] * scale, f[5] * scale); o.w = pack2(f[6] * scale, f[7] * scale);
    qf[ds] = __builtin_bit_cast(bf16x8, o);
  }
}
__device__ __forceinline__ void store_ot(bfr* dst, const f32x4 (&o)[4], float inv, int q4) {
#pragma unroll
  for (int db = 0; db < 4; ++db) {
    uint2 w;
    w.x = pack2(o[db][0] * inv, o[db][1] * inv);
    w.y = pack2(o[db][2] * inv, o[db][3] * inv);
    *(uint2*)(dst + db * 16 + q4 * 4) = w;
  }
}

__device__ void swa_item(const Params& p, int layer, int item, char* smem) {
  const int b = item >> 7, kvh = (item >> 6) & 1, nbk = item & 63;
  bfr* Ks = (bfr*)smem;
  bfr* Vt = Ks + 384 * 72;
  constexpr int VS = 392;
  const int tid = get_tid();
  const int lane = tid & 63, w = tid >> 6, fr = lane & 15, q4 = lane >> 4;
  const float* cos16 = p.rope;
  const float* sin16 = p.rope + 2048;
  __syncthreads();
  const int tok0 = (nbk - 1) * 128;
  const bfr* rowbase = p.proj + (ptrdiff_t)(b * S + tok0) * DINP;
  load_vt_tile(Vt, VS, rowbase + C_SWV + kvh * 64, 384, tok0, S);
  for (int u = tid; u < 384 * 4; u += NTHR) {
    int r = u >> 2, A = (u >> 1) & 1, fc = u & 1;
    int tok = tok0 + r;
    u4 o1 = (u4){0u, 0u, 0u, 0u}, o2 = o1;
    if (tok >= 0 && tok < S) {
      const bfr* kp = rowbase + (ptrdiff_t)r * DINP + C_SWK + kvh * 64 + A * 32 + fc * 8;
      u4 w1 = *(const u4*)kp, w2 = *(const u4*)(kp + 16);
      float x1[8], x2[8], y1[8], y2[8];
      unpack8(w1, x1); unpack8(w2, x2);
      int pos = A ? (tok & 63) : (tok >> 6);
#pragma unroll
      for (int j = 0; j < 8; ++j) {
        float cs = cos16[pos * 16 + fc * 8 + j], sn = sin16[pos * 16 + fc * 8 + j];
        y1[j] = x1[j] * cs - x2[j] * sn;
        y2[j] = x2[j] * cs + x1[j] * sn;
      }
      o1.x = pack2(y1[0], y1[1]); o1.y = pack2(y1[2], y1[3]); o1.z = pack2(y1[4], y1[5]); o1.w = pack2(y1[6], y1[7]);
      o2.x = pack2(y2[0], y2[1]); o2.y = pack2(y2[2], y2[3]); o2.z = pack2(y2[4], y2[5]); o2.w = pack2(y2[6], y2[7]);
    }
    int ch1 = A * 4 + fc, ch2 = A * 4 + 2 + fc;
    *(u4*)(Ks + r * 72 + ch1 * 8) = o1;
    *(u4*)(Ks + r * 72 + ch2 * 8) = o2;
  }
  const int g = w >> 1, qhalf = w & 1;
  const int hq = kvh * 4 + g;
  bf16x8 qf[4][2];
  f32x4 oacc[4][4];
  float mm[4], ll[4];
#pragma unroll
  for (int grp = 0; grp < 4; ++grp) {
    const int tq = nbk * 128 + qhalf * 64 + grp * 16 + fr;
    const bfr* qrow = p.proj + (size_t)(b * S + tq) * DINP + C_SWQ + hq * 64;
#pragma unroll
    for (int ds = 0; ds < 2; ++ds) {
      u4 wq = *(const u4*)(qrow + ds * 32 + q4 * 8);
      float f[8], y[8];
      unpack8(wq, f);
      const int pos = ds ? (tq & 63) : (tq >> 6);
#pragma unroll
      for (int j = 0; j < 8; ++j) {
        const float other = __shfl_xor(f[j], 32);
        const int fi = (q4 & 1) * 8 + j;
        const float cs = cos16[pos * 16 + fi], sn = sin16[pos * 16 + fi];
        y[j] = ((q4 < 2) ? (f[j] * cs - other * sn) : (f[j] * cs + other * sn)) * 0.125f;
      }
      u4 o;
      o.x = pack2(y[0], y[1]); o.y = pack2(y[2], y[3]); o.z = pack2(y[4], y[5]); o.w = pack2(y[6], y[7]);
      qf[grp][ds] = __builtin_bit_cast(bf16x8, o);
    }
    mm[grp] = -INFINITY; ll[grp] = 0.f;
#pragma unroll
    for (int db = 0; db < 4; ++db) oacc[grp][db] = (f32x4){0.f, 0.f, 0.f, 0.f};
  }
  __syncthreads();
  float zb[8];
#pragma unroll
  for (int i = 0; i < 8; ++i) zb[i] = 0.f;
#pragma unroll 1
  for (int t = 0; t < 10; ++t) {
    const int kt = qhalf * 64 + 32 * t;
    if (tok0 + kt + 31 < 0 || tok0 + kt >= S) continue;
    bf16x8 kf[2][2], vf[4];
    load_kfrags(kf, Ks, kt, fr, q4);
    load_vfrags(vf, Vt, VS, kt, fr, q4);
#pragma unroll
    for (int grp = 0; grp < 4; ++grp) {
      const int qg0 = 128 + qhalf * 64 + grp * 16;
      if (kt > qg0 + 15 + 128 || kt + 31 < qg0 - 128) continue;
      const bool interior = (kt >= qg0 + 15 - 128) && (kt + 31 <= qg0 + 128) && (tok0 + kt >= 0) && (tok0 + kt + 31 < S);
      if (interior) {
        attn_tile_group(kf, qf[grp], vf, oacc[grp], mm[grp], ll[grp], zb);
      } else {
        const int qrow = qg0 + fr;
        float badd[8];
#pragma unroll
        for (int i = 0; i < 8; ++i) {
          const int lr = kt + (i >> 2) * 16 + q4 * 4 + (i & 3);
          const int dd = qrow - lr;
          const int tok = tok0 + lr;
          const bool ok = (dd <= 128) && (dd >= -128) && (tok >= 0) && (tok < S);
          badd[i] = ok ? 0.f : -INFINITY;
        }
        attn_tile_group(kf, qf[grp], vf, oacc[grp], mm[grp], ll[grp], badd);
      }
    }
  }
  __syncthreads();
  const bfr* zbase = p.proj + (size_t)(MX + b * 256) * DINP;
  load_kv_tile(Ks, zbase + C_SWK + kvh * 64, 256, 0, 256);
  load_vt_tile(Vt, VS, zbase + C_SWV + kvh * 64, 256, 0, 256);
  __syncthreads();
#pragma unroll 1
  for (int t = 0; t < 8; ++t) {
    const int kt = 32 * t;
    bf16x8 kf[2][2], vf[4];
    load_kfrags(kf, Ks, kt, fr, q4);
    load_vfrags(vf, Vt, VS, kt, fr, q4);
#pragma unroll
    for (int grp = 0; grp < 4; ++grp) attn_tile_group(kf, qf[grp], vf, oacc[grp], mm[grp], ll[grp], zb);
  }
  const float sk = p.sink[layer * 8 + hq];
#pragma unroll
  for (int grp = 0; grp < 4; ++grp) {
    const int tq = nbk * 128 + qhalf * 64 + grp * 16 + fr;
    const float mn = fmaxf(mm[grp], sk);
    const float alpha = __expf(mm[grp] - mn);
    const float lt = attn_rowsum(ll[grp]) * alpha + __expf(sk - mn);
    store_ot(p.mix + (size_t)(b * S + tq) * D + 1536 + hq * 64, oacc[grp], alpha / lt, q4);
  }
}

__device__ void na_item(const Params& p, int layer, int item, char* smem) {
  const int b = item >> 10, h = (item >> 7) & 7, r = item & 127;
  bfr* Ks = (bfr*)smem;
  bfr* Vt = Ks + 512 * 72;
  constexpr int VS = 520;
  float* rp = (float*)(Vt + 64 * VS);
  float* mg = (float*)smem;
  const int tid = get_tid();
  const int lane = tid & 63, w = tid >> 6, fr = lane & 15, q4 = lane >> 4;
  __syncthreads();
  int r0 = r - 4; r0 = r0 < 0 ? 0 : (r0 > 120 ? 120 : r0);
  const bfr* rowbase = p.proj + (size_t)(b * S + r0 * 64) * DINP;
  load_kv_tile(Ks, rowbase + C_NAK + h * 64, 512, 0, 512);
  load_vt_tile(Vt, VS, rowbase + C_NAV + h * 64, 512, 0, 512);
  if (tid < 15 * 31) rp[tid] = p.rpb[(layer * 8 + h) * 465 + tid];
  const int grp = w >> 1, half = w & 1;
  const int cq = grp * 16 + fr;
  const int tq = r * 64 + cq;
  bf16x8 qf[2];
  load_qfrags(qf, p.proj + (size_t)(b * S + tq) * DINP + C_NAQ + h * 64, q4, 0.125f);
  f32x4 oacc[4];
#pragma unroll
  for (int db = 0; db < 4; ++db) oacc[db] = (f32x4){0.f, 0.f, 0.f, 0.f};
  float m = -INFINITY, l = 0.f;
  __syncthreads();
  int cs = cq - 8; cs = cs < 0 ? 0 : (cs > 48 ? 48 : cs);
  const int tstart = grp == 0 ? 0 : (grp == 1 ? 8 : (grp == 2 ? 24 : 32));
#pragma unroll 1
  for (int jj = 0; jj < 4; ++jj) {
    const int jrow = half * 4 + jj;
    const int drow = (r0 + jrow) - r + 7;
    const int kt = jrow * 64 + tstart;
    bf16x8 kf[2][2], vf[4];
    load_kfrags(kf, Ks, kt, fr, q4);
    load_vfrags(vf, Vt, VS, kt, fr, q4);
    float badd[8];
#pragma unroll
    for (int i = 0; i < 8; ++i) {
      const int ck = tstart + (i >> 2) * 16 + q4 * 4 + (i & 3);
      const bool ok = (ck >= cs) && (ck < cs + 16);
      int dc = ck - cq + 15; dc = dc < 0 ? 0 : (dc > 30 ? 30 : dc);
      badd[i] = ok ? rp[drow * 31 + dc] : -INFINITY;
    }
    attn_tile_group(kf, qf, vf, oacc, m, l, badd);
  }
  __syncthreads();
  const bfr* zbase = p.proj + (size_t)(MX + b * 256) * DINP;
  load_kv_tile(Ks, zbase + C_NAK + h * 64, 256, 0, 256);
  load_vt_tile(Vt, VS, zbase + C_NAV + h * 64, 256, 0, 256);
  __syncthreads();
  float zb[8];
#pragma unroll
  for (int i = 0; i < 8; ++i) zb[i] = 0.f;
#pragma unroll 1
  for (int t = 0; t < 4; ++t) {
    const int kt = half * 128 + 32 * t;
    bf16x8 kf[2][2], vf[4];
    load_kfrags(kf, Ks, kt, fr, q4);
    load_vfrags(vf, Vt, VS, kt, fr, q4);
    attn_tile_group(kf, qf, vf, oacc, m, l, zb);
  }
  __syncthreads();
  l = attn_rowsum(l);
  float* mo = mg + grp * (16 * 64 + 64) ;
  if (half == 1) {
#pragma unroll
    for (int db = 0; db < 4; ++db)
#pragma unroll
      for (int i = 0; i < 4; ++i) mo[(db * 4 + i) * 64 + lane] = oacc[db][i];
    if (q4 == 0) { mo[16 * 64 + fr] = m; mo[16 * 64 + 16 + fr] = l; }
  }
  __syncthreads();
  if (half == 0) {
    const float m2 = mo[16 * 64 + fr], l2 = mo[16 * 64 + 16 + fr];
    const float mn = fmaxf(m, m2);
    const float a1 = __expf(m - mn), a2 = __expf(m2 - mn);
    const float lt = l * a1 + l2 * a2;
    const float i1 = a1 / lt, i2 = a2 / lt;
#pragma unroll
    for (int db = 0; db < 4; ++db)
#pragma unroll
      for (int i = 0; i < 4; ++i) oacc[db][i] = oacc[db][i] * i1 + mo[(db * 4 + i) * 64 + lane] * i2;
    store_ot(p.mix + (size_t)(b * S + tq) * D + h * 64, oacc, 1.f, q4);
  }
}

__device__ void ctx_item(const Params& p, int layer, int item, char* smem) {
  const int b = item >> 4, type = (item >> 3) & 1, h = item & 7;
  bfr* Ks = (bfr*)smem;
  bfr* Vt = Ks + 256 * 72;
  constexpr int VS = 264;
  const int tid = get_tid();
  const int lane = tid & 63, w = tid >> 6, fr = lane & 15, q4 = lane >> 4;
  __syncthreads();
  const bfr* zbase = p.proj + (size_t)(MX + b * 256) * DINP;
  const int kcol = type ? (C_SWK + (h >> 2) * 64) : (C_NAK + h * 64);
  const int vcol = type ? (C_SWV + (h >> 2) * 64) : (C_NAV + h * 64);
  const int qcol = type ? (C_SWQ + h * 64) : (C_NAQ + h * 64);
  load_kv_tile(Ks, zbase + kcol, 256, 0, 256);
  load_vt_tile(Vt, VS, zbase + vcol, 256, 0, 256);
  bf16x8 qf[2][2];
  f32x4 oacc[2][4];
  float mm[2], ll[2];
#pragma unroll
  for (int grp = 0; grp < 2; ++grp) {
    const int qz = w * 32 + grp * 16 + fr;
    load_qfrags(qf[grp], zbase + (size_t)qz * DINP + qcol, q4, 0.125f);
    mm[grp] = -INFINITY; ll[grp] = 0.f;
#pragma unroll
    for (int db = 0; db < 4; ++db) oacc[grp][db] = (f32x4){0.f, 0.f, 0.f, 0.f};
  }
  __syncthreads();
  float zb[8];
#pragma unroll
  for (int i = 0; i < 8; ++i) zb[i] = 0.f;
#pragma unroll 1
  for (int t = 0; t < 8; ++t) {
    const int kt = 32 * t;
    bf16x8 kf[2][2], vf[4];
    load_kfrags(kf, Ks, kt, fr, q4);
    load_vfrags(vf, Vt, VS, kt, fr, q4);
#pragma unroll
    for (int grp = 0; grp < 2; ++grp) attn_tile_group(kf, qf[grp], vf, oacc[grp], mm[grp], ll[grp], zb);
  }
#pragma unroll
  for (int grp = 0; grp < 2; ++grp) {
    const int qz = w * 32 + grp * 16 + fr;
    float inv;
    if (type == 1) {
      const float sk = p.sink[layer * 8 + h];
      const float mn = fmaxf(mm[grp], sk);
      const float a = __expf(mm[grp] - mn);
      inv = a / (attn_rowsum(ll[grp]) * a + __expf(sk - mn));
    } else {
      inv = 1.f / attn_rowsum(ll[grp]);
    }
    store_ot(p.mix + (size_t)(MX + b * 256 + qz) * D + (type ? 1536 : 0) + h * 64, oacc[grp], inv, q4);
  }
}

template <int W>
__device__ __forceinline__ void load_rows_f32(float* dst, int stride, const bfr* src, float scale) {
  constexpr int CPR = W / 8;
  for (int c = get_tid(); c < 64 * CPR; c += NTHR) {
    int j = c / CPR, ch = c % CPR;
    u4 w = *(const u4*)(src + (size_t)j * DINP + ch * 8);
    float f[8];
    unpack8(w, f);
    float4 a = make_float4(f[0] * scale, f[1] * scale, f[2] * scale, f[3] * scale);
    float4 bq = make_float4(f[4] * scale, f[5] * scale, f[6] * scale, f[7] * scale);
    *(float4*)(dst + j * stride + ch * 8) = a;
    *(float4*)(dst + j * stride + ch * 8 + 4) = bq;
  }
}

__device__ __forceinline__ void rope128_tile(float* t, int stride, int prow, const float* rope, float scale) {
  const float* cos32 = rope + 4096;
  const float* sin32 = rope + 8192;
  for (int u = get_tid(); u < 64 * 64; u += NTHR) {
    int j = u >> 6, A = (u >> 5) & 1, f = u & 31;
    int pos = A ? j : prow;
    float cs = cos32[pos * 32 + f], sn = sin32[pos * 32 + f];
    float x1 = t[j * stride + A * 64 + f], x2 = t[j * stride + A * 64 + 32 + f];
    t[j * stride + A * 64 + f] = (x1 * cs - x2 * sn) * scale;
    t[j * stride + A * 64 + 32 + f] = (x2 * cs + x1 * sn) * scale;
  }
}

__device__ __forceinline__ void gla_logdecay(const Params& p, int layer, int h, int dir, const bfr* rowbase, float* G) {
  const int tid = get_tid();
  const int j = tid >> 3, dg = tid & 7;
  const bfr* dl = rowbase + (size_t)j * DINP + C_GLD + dir * 16;
  u4 w0 = *(const u4*)dl, w1 = *(const u4*)(dl + 8);
  float x[16];
  unpack8(w0, x); unpack8(w1, x + 8);
  const float* wu = p.gla_wu + (size_t)layer * 8192 + dir * 4096 + h * 64;
  const float* bb = p.gla_b + layer * 512 + dir * 256 + h * 64;
#pragma unroll
  for (int dd = 0; dd < 8; ++dd) {
    int d = dg + 8 * dd;
    float pre = bb[d];
#pragma unroll
    for (int r = 0; r < 16; ++r) pre += x[r] * wu[r * 256 + d];
    G[j * 68 + d] = logsig_f(pre) * (1.f / 16.f);
  }
}

__device__ __forceinline__ void gla_logdecay2(const Params& p, int layer, int h, const bfr* rowbase, float* G0, float* G1) {
  const int tid = get_tid();
  const int w = tid >> 6, lane = tid & 63, fr = lane & 15, q4 = lane >> 4;
  const int dir = w >> 2, dt = w & 3;
  const int d = dt * 16 + fr;
  float* G = dir ? G1 : G0;
  u4 bw = (u4){0u, 0u, 0u, 0u};
  if (q4 < 2) {
    const float* wu = p.gla_wu + (size_t)layer * 8192 + dir * 4096 + (q4 * 8) * 256 + h * 64 + d;
    bw.x = pack2(wu[0 * 256], wu[1 * 256]); bw.y = pack2(wu[2 * 256], wu[3 * 256]);
    bw.z = pack2(wu[4 * 256], wu[5 * 256]); bw.w = pack2(wu[6 * 256], wu[7 * 256]);
  }
  const bf16x8 bq = __builtin_bit_cast(bf16x8, bw);
  const float bias = p.gla_b[layer * 512 + dir * 256 + h * 64 + d];
#pragma unroll
  for (int rt = 0; rt < 4; ++rt) {
    u4 aw = (u4){0u, 0u, 0u, 0u};
    if (q4 < 2) aw = *(const u4*)(rowbase + (size_t)(rt * 16 + fr) * DINP + C_GLD + dir * 16 + q4 * 8);
    f32x4 acc = (f32x4){0.f, 0.f, 0.f, 0.f};
    acc = MFMA16(__builtin_bit_cast(bf16x8, aw), bq, acc);
#pragma unroll
    for (int r = 0; r < 4; ++r) G[(rt * 16 + q4 * 4 + r) * 68 + d] = logsig_f(acc[r] + bias) * (1.f / 16.f);
  }
}

__device__ __forceinline__ int scan_pos(int dir, int g) { return dir == 0 ? g : (g < 4 ? 3 - g : 135 - g); }
__device__ __forceinline__ int group_row0(int b, int g) { return g < 4 ? (MX + b * 256 + g * 64) : (b * S + (g - 4) * 64); }

template <int W>
__device__ __forceinline__ void load_rows_transposed(bfr* T, const bfr* src) {
  for (int c = get_tid(); c < 64 * (W / 8); c += NTHR) {
    const int j = c & 63, dch = c >> 6;
    const u4 v = *(const u4*)(src + (size_t)j * DINP + dch * 8);
    bfr* d = T + (dch * 8) * 72 + j;
    d[0 * 72] = (bfr)(v.x & 0xffffu); d[1 * 72] = (bfr)(v.x >> 16);
    d[2 * 72] = (bfr)(v.y & 0xffffu); d[3 * 72] = (bfr)(v.y >> 16);
    d[4 * 72] = (bfr)(v.z & 0xffffu); d[5 * 72] = (bfr)(v.z >> 16);
    d[6 * 72] = (bfr)(v.w & 0xffffu); d[7 * 72] = (bfr)(v.w >> 16);
  }
}

template <int DK, bool GLA>
__device__ void scan_a_item(const Params& p, int layer, int item, char* smem) {
  const int g = item % 132;
  const int t2 = item / 132;
  const int h = t2 & 3, b = t2 >> 2;
  constexpr int KS = DK + 4;
  float* ks = (float*)smem;
  float* E0 = ks + 64 * KS;
  float* E1 = E0 + 64 * 68;
  bfr* Kt = (bfr*)(E1 + 64 * 68);
  bfr* Vt = Kt + DK * 72;
  const int tid = get_tid();
  const int w = tid >> 6, lane = tid & 63, fr = lane & 15, q4 = lane >> 4;
  const int row0 = group_row0(b, g);
  const bfr* rowbase = p.proj + (size_t)row0 * DINP;
  __syncthreads();
  if (GLA) {
    load_rows_transposed<128>(Vt, rowbase + C_GLV + h * 128);
    load_rows_f32<64>(ks, KS, rowbase + C_GLK + h * 64, 1.f);
    gla_logdecay2(p, layer, h, rowbase, E0, E1);
  } else {
    const float kscale = 0.08838834764831845f;
    load_rows_transposed<128>(Vt, rowbase + C_RTV + h * 128);
    load_rows_f32<128>(ks, KS, rowbase + C_RTK + h * 128, g < 4 ? kscale : 1.f);
    __syncthreads();
    if (g >= 4) rope128_tile(ks, KS, g - 4, p.rope, kscale);
  }
#pragma unroll 1
  for (int dir = 0; dir < 2; ++dir) {
    const int scan = ((b * 4 + h) * 2 + dir);
    const int pos = scan_pos(dir, g);
    float lg = 0.f;
    __syncthreads();
    float* E = dir ? E1 : E0;
    if (GLA) {
      if (tid < 64) {
        float run = 0.f;
        if (dir == 0) {
          for (int j = 63; j >= 0; --j) { float v = E[j * 68 + tid]; E[j * 68 + tid] = run; run += v; }
        } else {
          for (int j = 0; j < 64; ++j) { float v = E[j * 68 + tid]; E[j * 68 + tid] = run; run += v; }
        }
        p.dec_gla[(size_t)(scan * 132 + pos) * 64 + tid] = __expf(run);
      }
      __syncthreads();
    } else {
      lg = p.ret_lg[layer * 8 + dir * 4 + h];
      if (tid < 128) p.dec_ret[(size_t)(scan * 132 + pos) * 128 + tid] = __expf(lg * 64.f);
    }
    for (int u = tid; u < 64 * DK; u += NTHR) {
      const int j = u & 63, d = u >> 6;
      const float sc = GLA ? __expf(E[j * 68 + d]) : __expf(lg * (dir == 0 ? (float)(63 - j) : (float)j));
      Kt[d * 72 + j] = f2bf(ks[j * KS + d] * sc);
    }
    __syncthreads();
    bf16x8 vfr[2];
#pragma unroll
    for (int k2 = 0; k2 < 2; ++k2) vfr[k2] = *(const bf16x8*)(Vt + (w * 16 + fr) * 72 + k2 * 32 + q4 * 8);
    bfr* st = (GLA ? p.st_gla : p.st_ret) + (size_t)(scan * 132 + pos) * DK * 128;
#pragma unroll 2
    for (int dt = 0; dt < DK / 16; ++dt) {
      f32x4 acc = (f32x4){0.f, 0.f, 0.f, 0.f};
#pragma unroll
      for (int k2 = 0; k2 < 2; ++k2) {
        const bf16x8 kq = *(const bf16x8*)(Kt + (dt * 16 + fr) * 72 + k2 * 32 + q4 * 8);
        acc = MFMA16(kq, vfr[k2], acc);
      }
      uint2 o;
      o.x = pack2(acc[0], acc[1]); o.y = pack2(acc[2], acc[3]);
      *(uint2*)(st + (size_t)(w * 16 + fr) * DK + dt * 16 + q4 * 4) = o;
    }
  }
}

__device__ void scan_b_phase(const Params& p) {
  const int gt = get_bid() * NTHR + get_tid(), ntot = gridDim.x * NTHR;
  for (int ch = gt; ch < 98304; ch += ntot) {
    bfr* st; const float* dec; int DK, e4;
    if (ch < 65536) { int scan = ch >> 12; e4 = ch & 4095; DK = 128; st = p.st_ret + (size_t)scan * 132 * 16384; dec = p.dec_ret + (size_t)scan * 132 * 128; }
    else { int c2 = ch - 65536; int scan = c2 >> 11; e4 = c2 & 2047; DK = 64; st = p.st_gla + (size_t)scan * 132 * 8192; dec = p.dec_gla + (size_t)scan * 132 * 64; }
    const int d0 = (e4 * 4) & (DK - 1);
    const size_t cstride = (size_t)DK * 128;
    float4 s = make_float4(0.f, 0.f, 0.f, 0.f);
    bfr* ptr = st + e4 * 4;
    const float* dp = dec + d0;
    for (int pos = 0; pos < 132; pos += 4) {
      uint2 u[4];
      float4 dv[4];
#pragma unroll
      for (int q = 0; q < 4; ++q) {
        u[q] = *(const uint2*)(ptr + (size_t)(pos + q) * cstride);
        dv[q] = *(const float4*)(dp + (pos + q) * DK);
      }
#pragma unroll
      for (int q = 0; q < 4; ++q) {
        uint2 o;
        o.x = pack2(s.x, s.y); o.y = pack2(s.z, s.w);
        *(uint2*)(ptr + (size_t)(pos + q) * cstride) = o;
        s = make_float4(dv[q].x * s.x + lo16(u[q].x), dv[q].y * s.y + hi16(u[q].x), dv[q].z * s.z + lo16(u[q].y), dv[q].w * s.w + hi16(u[q].y));
      }
    }
  }
}

template <int DK, bool GLA>
__device__ void scan_c_item(const Params& p, int layer, int item, char* smem) {
  const int g = item % 132;
  const int t2 = item / 132;
  const int h = t2 & 3, b = t2 >> 2;
  constexpr int FS = DK + 4;
  constexpr int QS = DK + 8;
  float* stg = (float*)smem;
  float* Gf = stg + 64 * FS;
  float* Gb = Gf + (GLA ? 64 * 68 : 0);
  float* red = Gb + (GLA ? 64 * 68 : 0);
  float* red2 = red + 8 * 64 * 2;
  bfr* T0 = (bfr*)(red2 + 64 * 2);
  bfr* T1 = T0 + 64 * QS;
  bfr* T2 = T1 + 64 * QS;
  bfr* T3 = T2 + 64 * QS;
  bfr* T4 = T3 + 64 * QS;
  bfr* T5 = T4 + (GLA ? 64 * QS : 0);
  bfr* Vt = T5 + (GLA ? 64 * QS : 0);
  bfr* Am = Vt + 128 * 72;
  const int tid = get_tid();
  const int w = tid >> 6, lane = tid & 63, fr = lane & 15, q4 = lane >> 4;
  const int row0 = group_row0(b, g);
  const bfr* rowbase = p.proj + (size_t)row0 * DINP;
  float lgf = 0.f, lgb = 0.f;
  __syncthreads();
  if (GLA) {
    load_rows_transposed<128>(Vt, rowbase + C_GLV + h * 128);
    load_rows_f32<64>(stg, FS, rowbase + C_GLQ + h * 64, 0.125f);
    gla_logdecay2(p, layer, h, rowbase, Gf, Gb);
    __syncthreads();
    {
      const int d = tid & 63, seg = tid >> 6;
      float runf = 0.f, runb = 0.f;
#pragma unroll
      for (int jj = 0; jj < 8; ++jj) {
        const int jf = seg * 8 + jj, jb = seg * 8 + 7 - jj;
        runf += Gf[jf * 68 + d]; Gf[jf * 68 + d] = runf;
        runb += Gb[jb * 68 + d]; Gb[jb * 68 + d] = runb;
      }
      red[seg * 64 + d] = runf;
      red[512 + seg * 64 + d] = runb;
      __syncthreads();
      float offf = 0.f, offb = 0.f;
#pragma unroll
      for (int s2 = 0; s2 < 8; ++s2) {
        if (s2 < seg) offf += red[s2 * 64 + d];
        if (s2 > seg) offb += red[512 + s2 * 64 + d];
      }
#pragma unroll
      for (int jj = 0; jj < 8; ++jj) {
        const int j = seg * 8 + jj;
        Gf[j * 68 + d] += offf;
        Gb[j * 68 + d] += offb;
      }
    }
    __syncthreads();
    for (int u = tid; u < 64 * 64; u += NTHR) {
      const int i = u >> 6, d = u & 63;
      const float qv = stg[i * FS + d];
      const float gf = Gf[i * 68 + d], gb = Gb[i * 68 + d];
      T0[i * QS + d] = f2bf(qv * __expf(gf - Gf[63 * 68 + d]));
      T2[i * QS + d] = f2bf(qv * __expf(gf));
      T4[i * QS + d] = f2bf(qv * __expf(gb - Gb[d]));
      T3[i * QS + d] = f2bf(qv * __expf(gb));
    }
    __syncthreads();
    load_rows_f32<64>(stg, FS, rowbase + C_GLK + h * 64, 1.f);
    __syncthreads();
    for (int u = tid; u < 64 * 64; u += NTHR) {
      const int j = u >> 6, d = u & 63;
      const float kv = stg[j * FS + d];
      T1[j * QS + d] = f2bf(kv * __expf(Gf[63 * 68 + d] - Gf[j * 68 + d]));
      T5[j * QS + d] = f2bf(kv * __expf(Gb[d] - Gb[j * 68 + d]));
    }
  } else {
    const float kscale = 0.08838834764831845f;
    lgf = p.ret_lg[layer * 8 + 0 + h];
    lgb = p.ret_lg[layer * 8 + 4 + h];
    load_rows_transposed<128>(Vt, rowbase + C_RTV + h * 128);
    {
      const int j = tid >> 3, A = (tid >> 2) & 1, fc = tid & 3;
      float cs[8], sn[8];
      if (g >= 4) {
        const int pos = A ? j : (g - 4);
        const float* cp = p.rope + 4096 + pos * 32 + fc * 8;
        const float4 c0 = *(const float4*)cp, c1 = *(const float4*)(cp + 4);
        const float4 s0 = *(const float4*)(cp + 4096), s1 = *(const float4*)(cp + 4100);
        cs[0] = c0.x; cs[1] = c0.y; cs[2] = c0.z; cs[3] = c0.w; cs[4] = c1.x; cs[5] = c1.y; cs[6] = c1.z; cs[7] = c1.w;
        sn[0] = s0.x; sn[1] = s0.y; sn[2] = s0.z; sn[3] = s0.w; sn[4] = s1.x; sn[5] = s1.y; sn[6] = s1.z; sn[7] = s1.w;
      } else {
#pragma unroll
        for (int e = 0; e < 8; ++e) { cs[e] = 1.f; sn[e] = 0.f; }
      }
      const int col = A * 64 + fc * 8;
      const bfr* qp = rowbase + (size_t)j * DINP + C_RTQ + h * 128 + col;
      const bfr* kp = rowbase + (size_t)j * DINP + C_RTK + h * 128 + col;
      const u4 q1 = *(const u4*)qp, q2 = *(const u4*)(qp + 32);
      const u4 k1 = *(const u4*)kp, k2w = *(const u4*)(kp + 32);
      float x1[8], x2[8], y1[8], y2[8];
      unpack8(q1, x1); unpack8(q2, x2);
#pragma unroll
      for (int e = 0; e < 8; ++e) { y1[e] = x1[e] * cs[e] - x2[e] * sn[e]; y2[e] = x2[e] * cs[e] + x1[e] * sn[e]; }
      const float ff = __expf(lgf * (float)(j + 1)), fb = __expf(lgb * (float)(64 - j));
      u4 o;
      o.x = pack2(y1[0], y1[1]); o.y = pack2(y1[2], y1[3]); o.z = pack2(y1[4], y1[5]); o.w = pack2(y1[6], y1[7]);
      *(u4*)(T0 + j * QS + col) = o;
      o.x = pack2(y2[0], y2[1]); o.y = pack2(y2[2], y2[3]); o.z = pack2(y2[4], y2[5]); o.w = pack2(y2[6], y2[7]);
      *(u4*)(T0 + j * QS + col + 32) = o;
      o.x = pack2(y1[0] * ff, y1[1] * ff); o.y = pack2(y1[2] * ff, y1[3] * ff); o.z = pack2(y1[4] * ff, y1[5] * ff); o.w = pack2(y1[6] * ff, y1[7] * ff);
      *(u4*)(T2 + j * QS + col) = o;
      o.x = pack2(y2[0] * ff, y2[1] * ff); o.y = pack2(y2[2] * ff, y2[3] * ff); o.z = pack2(y2[4] * ff, y2[5] * ff); o.w = pack2(y2[6] * ff, y2[7] * ff);
      *(u4*)(T2 + j * QS + col + 32) = o;
      o.x = pack2(y1[0] * fb, y1[1] * fb); o.y = pack2(y1[2] * fb, y1[3] * fb); o.z = pack2(y1[4] * fb, y1[5] * fb); o.w = pack2(y1[6] * fb, y1[7] * fb);
      *(u4*)(T3 + j * QS + col) = o;
      o.x = pack2(y2[0] * fb, y2[1] * fb); o.y = pack2(y2[2] * fb, y2[3] * fb); o.z = pack2(y2[4] * fb, y2[5] * fb); o.w = pack2(y2[6] * fb, y2[7] * fb);
      *(u4*)(T3 + j * QS + col + 32) = o;
      unpack8(k1, x1); unpack8(k2w, x2);
#pragma unroll
      for (int e = 0; e < 8; ++e) { y1[e] = (x1[e] * cs[e] - x2[e] * sn[e]) * kscale; y2[e] = (x2[e] * cs[e] + x1[e] * sn[e]) * kscale; }
      o.x = pack2(y1[0], y1[1]); o.y = pack2(y1[2], y1[3]); o.z = pack2(y1[4], y1[5]); o.w = pack2(y1[6], y1[7]);
      *(u4*)(T1 + j * QS + col) = o;
      o.x = pack2(y2[0], y2[1]); o.y = pack2(y2[2], y2[3]); o.z = pack2(y2[4], y2[5]); o.w = pack2(y2[6], y2[7]);
      *(u4*)(T1 + j * QS + col + 32) = o;
    }
  }
  __syncthreads();
  {
    const int ti = w >> 1;
#pragma unroll
    for (int tt = 0; tt < 2; ++tt) {
      const int tj = (w & 1) * 2 + tt;
      f32x4 af = (f32x4){0.f, 0.f, 0.f, 0.f}, ab = af;
#pragma unroll
      for (int k2 = 0; k2 < DK / 32; ++k2) {
        const bf16x8 a = *(const bf16x8*)(T0 + (ti * 16 + fr) * QS + k2 * 32 + q4 * 8);
        const bf16x8 bq = *(const bf16x8*)(T1 + (tj * 16 + fr) * QS + k2 * 32 + q4 * 8);
        af = MFMA16(a, bq, af);
        if (GLA) {
          const bf16x8 a2 = *(const bf16x8*)(T4 + (ti * 16 + fr) * QS + k2 * 32 + q4 * 8);
          const bf16x8 b2 = *(const bf16x8*)(T5 + (tj * 16 + fr) * QS + k2 * 32 + q4 * 8);
          ab = MFMA16(a2, b2, ab);
        }
      }
#pragma unroll
      for (int r = 0; r < 4; ++r) {
        const int i = ti * 16 + q4 * 4 + r, j = tj * 16 + fr;
        float v;
        if (GLA) v = (j <= i) ? af[r] : ab[r];
        else v = af[r] * ((j <= i) ? __expf(lgf * (float)(i - j)) : __expf(lgb * (float)(j - i)));
        Am[i * 72 + j] = f2bf(v);
      }
    }
  }
  __syncthreads();
  f32x4 acc[4];
#pragma unroll
  for (int rt = 0; rt < 4; ++rt) acc[rt] = (f32x4){0.f, 0.f, 0.f, 0.f};
#pragma unroll
  for (int k2 = 0; k2 < 2; ++k2) {
    const bf16x8 bq = *(const bf16x8*)(Vt + (w * 16 + fr) * 72 + k2 * 32 + q4 * 8);
#pragma unroll
    for (int rt = 0; rt < 4; ++rt) {
      const bf16x8 a = *(const bf16x8*)(Am + (rt * 16 + fr) * 72 + k2 * 32 + q4 * 8);
      acc[rt] = MFMA16(a, bq, acc[rt]);
    }
  }
#pragma unroll
  for (int dir = 0; dir < 2; ++dir) {
    const int scan = (b * 4 + h) * 2 + dir;
    const int pos = scan_pos(dir, g);
    const bfr* St = (GLA ? p.st_gla : p.st_ret) + (size_t)(scan * 132 + pos) * DK * 128 + (size_t)(w * 16 + fr) * DK + q4 * 8;
    const bfr* qt = dir == 0 ? T2 : T3;
#pragma unroll
    for (int k2 = 0; k2 < DK / 32; ++k2) {
      const bf16x8 bq = *(const bf16x8*)(St + k2 * 32);
#pragma unroll
      for (int rt = 0; rt < 4; ++rt) {
        const bf16x8 a = *(const bf16x8*)(qt + (rt * 16 + fr) * QS + k2 * 32 + q4 * 8);
        acc[rt] = MFMA16(a, bq, acc[rt]);
      }
    }
  }
#pragma unroll
  for (int rt = 0; rt < 4; ++rt)
#pragma unroll
    for (int r = 0; r < 4; ++r) {
      float s1 = acc[rt][r], s2 = s1 * s1;
#pragma unroll
      for (int of = 8; of; of >>= 1) { s1 += __shfl_xor(s1, of); s2 += __shfl_xor(s2, of); }
      if (fr == 0) {
        const int i = rt * 16 + q4 * 4 + r;
        red[(w * 64 + i) * 2 + 0] = s1;
        red[(w * 64 + i) * 2 + 1] = s2;
      }
    }
  __syncthreads();
  if (tid < 128) {
    const int i = tid >> 1, c = tid & 1;
    float t = 0.f;
#pragma unroll
    for (int ww = 0; ww < 8; ++ww) t += red[(ww * 64 + i) * 2 + c];
    red2[i * 2 + c] = t;
  }
  __syncthreads();
  const int gcol = GLA ? C_GLG : C_RTG;
  const int ocol = GLA ? 1024 : 512;
  const int vcol = h * 128 + w * 16 + fr;
  const float gg = GLA ? p.gla_g[layer * 128 + w * 16 + fr] : 1.f;
#pragma unroll
  for (int rt = 0; rt < 4; ++rt)
#pragma unroll
    for (int r = 0; r < 4; ++r) {
      const int i = rt * 16 + q4 * 4 + r;
      const float S1 = red2[i * 2 + 0], S2 = red2[i * 2 + 1];
      float y;
      if (GLA) {
        y = acc[rt][r] * rsqrtf(S2 * (1.f / 128.f) + EPS) * gg;
      } else {
        const float mu = S1 * (1.f / 128.f);
        const float var = fmaxf(S2 * (1.f / 128.f) - mu * mu, 0.f);
        y = (acc[rt][r] - mu) * rsqrtf(var + EPS);
      }
      const int row = row0 + i;
      const float gt = bf2f(p.proj[(size_t)row * DINP + gcol + vcol]);
      y *= silu_f(gt);
      p.mix[(size_t)row * D + ocol + vcol] = f2bf(y);
    }
}

__constant__ unsigned char c_cand_tab[64] = {0, 1, 2, 3, 4, 5, 6, 7, 8, 9, 10, 11, 12, 13, 14, 15, 16, 17, 18, 19, 20, 21, 22, 23, 32, 33, 34, 35, 36, 48, 49, 50, 51, 64, 65, 66, 80, 81, 96, 97, 112, 113, 128, 144, 160, 176, 192, 208, 224, 240, 255, 255, 255, 255, 255, 255, 255, 255, 255, 255, 255, 255, 255, 255};

template <int N>
__device__ __forceinline__ void bitonic_sort_desc(float (&v)[N]) {
#pragma unroll
  for (int k = 2; k <= N; k <<= 1)
#pragma unroll
    for (int j = k >> 1; j > 0; j >>= 1)
#pragma unroll
      for (int i = 0; i < N; ++i) {
        const int l = i ^ j;
        if (l > i) {
          const bool desc = ((i & k) == 0);
          const float x = v[i], y = v[l];
          const float hi = fmaxf(x, y), lo = fminf(x, y);
          v[i] = desc ? hi : lo;
          v[l] = desc ? lo : hi;
        }
      }
}
__device__ __forceinline__ void merge_top16(float (&v)[16], const int xl) {
  float o[16];
#pragma unroll
  for (int i = 0; i < 16; ++i) o[i] = __shfl_xor(v[15 - i], xl);
#pragma unroll
  for (int i = 0; i < 16; ++i) v[i] = fmaxf(v[i], o[i]);
#pragma unroll
  for (int j = 8; j > 0; j >>= 1)
#pragma unroll
    for (int i = 0; i < 16; ++i) {
      const int l = i ^ j;
      if (l > i) {
        const float x = v[i], y = v[l];
        v[i] = fmaxf(x, y);
        v[l] = fminf(x, y);
      }
    }
}
__device__ __forceinline__ float pack_key(float x, unsigned mask, unsigned key) {
  return __uint_as_float((__float_as_uint(x) & ~mask) | key);
}

__device__ void topk_phase(const Params& p, int layer, int ntok, char* smem) {
  float* sc = (float*)smem;
  const int tid = get_tid();
  const int lane = tid & 63, w = tid >> 6, fr = lane & 15, q4 = lane >> 4;
  const int nbatch = ntok >> 4;
  for (int bt = get_bid(); bt < nbatch; bt += gridDim.x) {
    __syncthreads();
#pragma unroll 1
    for (int pp = 0; pp < 2; ++pp) {
      const int pair = 2 * w + pp;
      const bfr* qrow = p.q + (size_t)(bt * 16 + fr) * D + pair * 128 + q4 * 8;
      const bfr* skb = p.sk_bf + (size_t)(((layer * 2 + (pair & 1)) * 8 + (pair >> 1))) * 128 * 128 + q4 * 8;
      bf16x8 af[4];
#pragma unroll
      for (int k2 = 0; k2 < 4; ++k2) af[k2] = *(const bf16x8*)(qrow + k2 * 32);
#pragma unroll 4
      for (int nt = 0; nt < 8; ++nt) {
        f32x4 acc = (f32x4){0.f, 0.f, 0.f, 0.f};
#pragma unroll
        for (int k2 = 0; k2 < 4; ++k2) {
          const bf16x8 bq = *(const bf16x8*)(skb + (size_t)(nt * 16 + fr) * 128 + k2 * 32);
          acc = MFMA16(af[k2], bq, acc);
        }
#pragma unroll
        for (int r = 0; r < 4; ++r) sc[((q4 * 4 + r) * 16 + pair) * 132 + nt * 16 + fr] = acc[r];
      }
    }
    __syncthreads();
#pragma unroll 1
    for (int ps = 0; ps < 2; ++ps) {
      const int list = ps * 128 + (tid >> 2), qd = tid & 3;
      float v[32];
#pragma unroll
      for (int j = 0; j < 8; ++j) {
        float4 t = *(const float4*)(sc + list * 132 + qd * 32 + j * 4);
        const unsigned kb = qd * 32 + j * 4;
        v[j * 4 + 0] = pack_key(t.x, 127u, kb + 0); v[j * 4 + 1] = pack_key(t.y, 127u, kb + 1);
        v[j * 4 + 2] = pack_key(t.z, 127u, kb + 2); v[j * 4 + 3] = pack_key(t.w, 127u, kb + 3);
      }
      bitonic_sort_desc<32>(v);
      float wv[16];
#pragma unroll
      for (int i = 0; i < 16; ++i) wv[i] = v[i];
      merge_top16(wv, 1);
      merge_top16(wv, 2);
      if (qd == 0) {
#pragma unroll
        for (int j = 0; j < 4; ++j)
          *(float4*)(sc + list * 132 + j * 4) = make_float4(wv[j * 4 + 0], wv[j * 4 + 1], wv[j * 4 + 2], wv[j * 4 + 3]);
      }
    }
    __syncthreads();
    {
      const int pair = tid >> 2, qd = tid & 3;
      const int tok = pair >> 3, hh = pair & 7;
      const float* o0 = sc + (tok * 16 + hh * 2) * 132;
      const float* o1 = o0 + 132;
      float c[16];
#pragma unroll
      for (int i = 0; i < 16; ++i) {
        const unsigned code = c_cand_tab[qd * 16 + i];
        const float sum = o0[code >> 4] + o1[code & 15];
        c[i] = (code == 255u) ? -INFINITY : pack_key(sum, 255u, code);
      }
      bitonic_sort_desc<16>(c);
      merge_top16(c, 1);
      merge_top16(c, 2);
      float e[16];
      float esum = 0.f;
#pragma unroll
      for (int i = 0; i < 16; ++i) { e[i] = __expf(c[i] - c[0]); esum += e[i]; }
      const float inv = 1.f / esum;
      const int m = bt * 16 + tok;
#pragma unroll
      for (int j = 0; j < 4; ++j) {
        const float ev = qd == 0 ? e[j] : (qd == 1 ? e[4 + j] : (qd == 2 ? e[8 + j] : e[12 + j]));
        const float cv = qd == 0 ? c[j] : (qd == 1 ? c[4 + j] : (qd == 2 ? c[8 + j] : c[12 + j]));
        const unsigned code = __float_as_uint(cv) & 255u;
        const unsigned k0 = __float_as_uint(o0[code >> 4]) & 127u;
        const unsigned k1 = __float_as_uint(o1[code & 15]) & 127u;
        p.pidx[(size_t)m * 128 + hh * 16 + qd * 4 + j] = (int)(k0 * 128u + k1);
        p.pgate[(size_t)m * 128 + hh * 16 + qd * 4 + j] = ev * inv;
      }
    }
  }
}

typedef __attribute__((ext_vector_type(2))) float f32x2;
__device__ __forceinline__ float dot16_fp8(const float* hf, const u4 w) {
  f32x2 a0 = __builtin_amdgcn_cvt_pk_f32_fp8((int)w.x, false), a1 = __builtin_amdgcn_cvt_pk_f32_fp8((int)w.x, true);
  f32x2 b0 = __builtin_amdgcn_cvt_pk_f32_fp8((int)w.y, false), b1 = __builtin_amdgcn_cvt_pk_f32_fp8((int)w.y, true);
  f32x2 c0 = __builtin_amdgcn_cvt_pk_f32_fp8((int)w.z, false), c1 = __builtin_amdgcn_cvt_pk_f32_fp8((int)w.z, true);
  f32x2 d0 = __builtin_amdgcn_cvt_pk_f32_fp8((int)w.w, false), d1 = __builtin_amdgcn_cvt_pk_f32_fp8((int)w.w, true);
  return hf[0] * a0.x + hf[1] * a0.y + hf[2] * a1.x + hf[3] * a1.y + hf[4] * b0.x + hf[5] * b0.y + hf[6] * b1.x + hf[7] * b1.y +
         hf[8] * c0.x + hf[9] * c0.y + hf[10] * c1.x + hf[11] * c1.y + hf[12] * d0.x + hf[13] * d0.y + hf[14] * d1.x + hf[15] * d1.y;
}
__device__ __forceinline__ void fma16_fp8(float* o, float c, const u4 w) {
  f32x2 a0 = __builtin_amdgcn_cvt_pk_f32_fp8((int)w.x, false), a1 = __builtin_amdgcn_cvt_pk_f32_fp8((int)w.x, true);
  f32x2 b0 = __builtin_amdgcn_cvt_pk_f32_fp8((int)w.y, false), b1 = __builtin_amdgcn_cvt_pk_f32_fp8((int)w.y, true);
  f32x2 c0 = __builtin_amdgcn_cvt_pk_f32_fp8((int)w.z, false), c1 = __builtin_amdgcn_cvt_pk_f32_fp8((int)w.z, true);
  f32x2 d0 = __builtin_amdgcn_cvt_pk_f32_fp8((int)w.w, false), d1 = __builtin_amdgcn_cvt_pk_f32_fp8((int)w.w, true);
  o[0] += c * a0.x; o[1] += c * a0.y; o[2] += c * a1.x; o[3] += c * a1.y;
  o[4] += c * b0.x; o[5] += c * b0.y; o[6] += c * b1.x; o[7] += c * b1.y;
  o[8] += c * c0.x; o[9] += c * c0.y; o[10] += c * c1.x; o[11] += c * c1.y;
  o[12] += c * d0.x; o[13] += c * d0.y; o[14] += c * d1.x; o[15] += c * d1.y;
}

__device__ void peer_phase(const Params& p, int layer, int ntok) {
  const int lane = get_tid() & 63;
  const int wave = get_bid() * 8 + (get_tid() >> 6), nw = gridDim.x * 8;
  const unsigned char* U = p.u8 + (size_t)layer * 16384 * D;
  const unsigned char* V = p.v8 + (size_t)layer * 16384 * D;
  const float* usc = p.uscl + layer * 16384;
  const float* vsc = p.vscl + layer * 16384;
  int idA_n = 0, idB_n = 0;
  float pgA_n = 0.f, pgB_n = 0.f;
  u4 hn[4];
  if (wave < ntok) {
    idA_n = p.pidx[(size_t)wave * 128 + lane]; idB_n = p.pidx[(size_t)wave * 128 + 64 + lane];
    pgA_n = p.pgate[(size_t)wave * 128 + lane]; pgB_n = p.pgate[(size_t)wave * 128 + 64 + lane];
    const bfr* hr = p.h + (size_t)wave * D + lane * 16;
    hn[0] = *(const u4*)(hr); hn[1] = *(const u4*)(hr + 8); hn[2] = *(const u4*)(hr + 1024); hn[3] = *(const u4*)(hr + 1032);
  }
  for (int m = wave; m < ntok; m += nw) {
    float hf[32];
    unpack8(hn[0], hf); unpack8(hn[1], hf + 8); unpack8(hn[2], hf + 16); unpack8(hn[3], hf + 24);
    const int idA = idA_n, idB = idB_n;
    const float gA = pgA_n * vsc[idA], gB = pgB_n * vsc[idB];
    const float usA = usc[idA], usB = usc[idB];
    float cA = 0.f, cB = 0.f;
#pragma unroll 1
    for (int e0 = 0; e0 < 128; e0 += 8) {
      u4 r[8][2];
#pragma unroll
      for (int u = 0; u < 8; ++u) {
        int e = e0 + u;
        int row = __shfl(e0 < 64 ? idA : idB, e & 63);
        const unsigned char* up = U + (size_t)row * D + lane * 16;
        r[u][0] = *(const u4*)(up);
        r[u][1] = *(const u4*)(up + 1024);
      }
      __builtin_amdgcn_sched_barrier(0);
#pragma unroll
      for (int u = 0; u < 8; ++u) {
        int e = e0 + u;
        float dsum = dot16_fp8(hf, r[u][0]) + dot16_fp8(hf + 16, r[u][1]);
        dsum = wave_sum(dsum);
        if (e0 < 64) { if (lane == e) cA = gA * gelu_f(dsum * usA); }
        else { if (lane == e - 64) cB = gB * gelu_f(dsum * usB); }
        __builtin_amdgcn_sched_barrier(0);
      }
    }
    if (m + nw < ntok) {
      const int m2 = m + nw;
      idA_n = p.pidx[(size_t)m2 * 128 + lane]; idB_n = p.pidx[(size_t)m2 * 128 + 64 + lane];
      pgA_n = p.pgate[(size_t)m2 * 128 + lane]; pgB_n = p.pgate[(size_t)m2 * 128 + 64 + lane];
      const bfr* hr = p.h + (size_t)m2 * D + lane * 16;
      hn[0] = *(const u4*)(hr); hn[1] = *(const u4*)(hr + 8); hn[2] = *(const u4*)(hr + 1024); hn[3] = *(const u4*)(hr + 1032);
    }
    float o[32];
#pragma unroll
    for (int i = 0; i < 32; ++i) o[i] = 0.f;
#pragma unroll 1
    for (int e0 = 0; e0 < 128; e0 += 4) {
      u4 r[4][2];
      float cf[4];
#pragma unroll
      for (int u = 0; u < 4; ++u) {
        int e = e0 + u;
        int row = __shfl(e0 < 64 ? idA : idB, e & 63);
        cf[u] = __shfl(e0 < 64 ? cA : cB, e & 63);
        const unsigned char* vp = V + (size_t)row * D + lane * 16;
        r[u][0] = *(const u4*)(vp);
        r[u][1] = *(const u4*)(vp + 1024);
      }
      __builtin_amdgcn_sched_barrier(0);
#pragma unroll
      for (int u = 0; u < 4; ++u) {
        fma16_fp8(o, cf[u], r[u][0]);
        fma16_fp8(o + 16, cf[u], r[u][1]);
        __builtin_amdgcn_sched_barrier(0);
      }
    }
    const int vec = m < S ? 0 : (m < MX ? 1 : 2);
    const float* modl = p.mod + (layer * 3 + vec) * 12288;
    float* xr = p.xcur + (size_t)m * D + lane * 16;
    float xn[32];
    float ss = 0.f;
#pragma unroll
    for (int i = 0; i < 2; ++i)
#pragma unroll
      for (int k = 0; k < 4; ++k) {
        int col = i * 1024 + lane * 16 + k * 4;
        float4 a = *(const float4*)(xr + i * 1024 + k * 4);
        float4 g0 = *(const float4*)(modl + 5 * D + col);
        float* xx = xn + i * 16 + k * 4;
        const float* oo = o + i * 16 + k * 4;
        xx[0] = a.x + g0.x * oo[0]; xx[1] = a.y + g0.y * oo[1]; xx[2] = a.z + g0.z * oo[2]; xx[3] = a.w + g0.w * oo[3];
        ss += xx[0] * xx[0] + xx[1] * xx[1] + xx[2] * xx[2] + xx[3] * xx[3];
      }
    ss = wave_sum(ss);
    const float rstd = rsqrtf(ss * (1.f / D) + EPS);
    if (layer == 1) {
      float* orow = p.out + (size_t)m * D;
#pragma unroll
      for (int i = 0; i < 2; ++i)
#pragma unroll
        for (int k = 0; k < 4; ++k) {
          int col = i * 1024 + lane * 16 + k * 4;
          float4 f0 = *(const float4*)(p.final_g + col);
          const float* xx = xn + i * 16 + k * 4;
          *(float4*)(orow + col) = make_float4(xx[0] * rstd * f0.x, xx[1] * rstd * f0.y, xx[2] * rstd * f0.z, xx[3] * rstd * f0.w);
        }
    } else {
      const float* modn = p.mod + ((layer + 1) * 3 + vec) * 12288;
      const float* gn = p.g_attn + (layer + 1) * D;
#pragma unroll
      for (int i = 0; i < 2; ++i) {
        float y[16];
#pragma unroll
        for (int k = 0; k < 4; ++k) {
          int col = i * 1024 + lane * 16 + k * 4;
          const float* xx = xn + i * 16 + k * 4;
          *(float4*)(xr + i * 1024 + k * 4) = make_float4(xx[0], xx[1], xx[2], xx[3]);
          float4 gv = *(const float4*)(gn + col), scv = *(const float4*)(modn + D + col), shv = *(const float4*)(modn + col);
          y[k * 4 + 0] = xx[0] * rstd * gv.x * (1.f + scv.x) + shv.x;
          y[k * 4 + 1] = xx[1] * rstd * gv.y * (1.f + scv.y) + shv.y;
          y[k * 4 + 2] = xx[2] * rstd * gv.z * (1.f + scv.z) + shv.z;
          y[k * 4 + 3] = xx[3] * rstd * gv.w * (1.f + scv.w) + shv.w;
        }
        u4 w0, w1;
        w0.x = pack2(y[0], y[1]); w0.y = pack2(y[2], y[3]); w0.z = pack2(y[4], y[5]); w0.w = pack2(y[6], y[7]);
        w1.x = pack2(y[8], y[9]); w1.y = pack2(y[10], y[11]); w1.z = pack2(y[12], y[13]); w1.w = pack2(y[14], y[15]);
        *(u4*)(p.h + (size_t)m * D + i * 1024 + lane * 16) = w0;
        *(u4*)(p.h + (size_t)m * D + i * 1024 + lane * 16 + 8) = w1;
      }
    }
  }
}

constexpr int PH_INIT = 0, PH_MOD_ATTN = 1, PH_INPROJ = 2, PH_MIX1 = 3, PH_SCANB = 4, PH_SCANC = 5, PH_OUTPROJ = 6,
              PH_MOD_FFN = 7, PH_QPROJ = 8, PH_SCORES = 9, PH_TOPK = 10, PH_PEER = 11;

template <int EPI, bool ALLOW_BIG>
__device__ __forceinline__ void gemm_phase(const Params& p, int layer, int vid, const bfr* A, const bfr* Bt, int MB, int MT,
                                           int NB, int N128, int small_nt, void* Cout, int ldc, char* smem) {
  const int nbig = MB * NB;
  const int nsm1 = small_nt >= 0 ? MB : 0;
  const int nsm2 = (MT - MB) * N128;
  const int total = nbig + nsm1 + nsm2;
  for (int t = vid; t < total; t += gridDim.x) {
    if (t < nbig) {
      if constexpr (ALLOW_BIG) {
        const int mt = t / NB, nt = t - mt * NB;
        gemm_tile<EPI, true>(A, D, Bt, D, D, mt * 256, nt * 256, Cout, ldc, p, layer, smem);
      }
    } else if (t < nbig + nsm1) {
      gemm_tile<EPI, false>(A, D, Bt, D, D, (t - nbig) * 256, small_nt * 128, Cout, ldc, p, layer, smem);
    } else {
      const int u = t - nbig - nsm1;
      const int mt = MB + u / N128, nt = u % N128;
      gemm_tile<EPI, false>(A, D, Bt, D, D, mt * 256, nt * 128, Cout, ldc, p, layer, smem);
    }
  }
}

__device__ void run_phase(const Params& p, int ph, int layer, char* smem, int vid) {
  const int bid = get_bid(), nb = gridDim.x;
  const bool last = (layer == 1);
  switch (ph) {
    case PH_INIT: phase0(p, smem); break;
    case PH_MOD_ATTN: modulate_phase(p, layer, 0, MT); break;
    case PH_INPROJ:
      gemm_phase<0, true>(p, layer, vid, p.h, p.wt_in + (size_t)layer * DINP * D, 66, 66, 23, 47, 46, p.proj, DINP, smem);
      break;
    case PH_MIX1: {
      const int n_swa = 256, n_na = 2048, n_sa = 1056, n_ctx = last ? 0 : 32;
      const int total = n_swa + n_na + 2 * n_sa + n_ctx;
      for (int it = bid; it < total; it += nb) {
        int t = it;
        if (t < n_swa) { swa_item(p, layer, t, smem); continue; }
        t -= n_swa;
        if (t < n_na) { na_item(p, layer, t, smem); continue; }
        t -= n_na;
        if (t < n_sa) { scan_a_item<128, false>(p, layer, t, smem); continue; }
        t -= n_sa;
        if (t < n_sa) { scan_a_item<64, true>(p, layer, t, smem); continue; }
        t -= n_sa;
        ctx_item(p, layer, t, smem);
      }
    } break;
    case PH_SCANB: scan_b_phase(p); break;
    case PH_SCANC:
      for (int it = bid; it < 2 * 1056; it += nb) {
        const bool gla = it < 1056;
        const int t = gla ? it : it - 1056;
        if (last && (t % 132) < 4) continue;
        if (gla) scan_c_item<64, true>(p, layer, t, smem);
        else scan_c_item<128, false>(p, layer, t, smem);
      }
      break;
    case PH_OUTPROJ: {
      gemm_phase<1, false>(p, layer, vid, p.mix, p.wt_out + (size_t)layer * D * D, 0, last ? 64 : 66, 8, 16, -1, nullptr, 0, smem);
    } break;
    case PH_MOD_FFN: modulate_phase(p, layer, 1, last ? MX : MT); break;
    case PH_QPROJ: {
      gemm_phase<0, true>(p, layer, vid, p.h, p.wt_q + (size_t)layer * D * D, 64, last ? 64 : 66, 8, 16, -1, p.q, D, smem);
    } break;
    case PH_SCORES: {
      const int mt = last ? 64 : 66;
      for (int t = bid; t < mt * 16; t += nb) {
        int j = t & 15;
        int hh = j >> 1, pp = j & 1;
        const bfr* bt = p.sk_bf + (size_t)(((layer * 2 + pp) * 8 + hh)) * 128 * 128;
        gemm_tile<2, false>(p.q + j * 128, D, bt, 128, 128, (t >> 4) * 256, 0, p.scores + j * 128, D, p, layer, smem);
      }
    } break;
    case PH_TOPK: topk_phase(p, layer, last ? MX : MT, smem); break;
    case PH_PEER: peer_phase(p, layer, last ? MX : MT); break;
  }
}

__device__ __forceinline__ void grid_barrier(unsigned* bar, unsigned& epoch) {
  asm volatile("s_waitcnt vmcnt(0)" ::: "memory");
  __syncthreads();
  epoch += gridDim.x;
  if (threadIdx.x == 0) {
    __builtin_amdgcn_fence(__ATOMIC_RELEASE, "agent");
    asm volatile("s_waitcnt vmcnt(0)" ::: "memory");
    (void)__hip_atomic_fetch_add(bar, 1u, __ATOMIC_RELAXED, __HIP_MEMORY_SCOPE_AGENT);
    unsigned spins = 0;
    while (__hip_atomic_load(bar, __ATOMIC_RELAXED, __HIP_MEMORY_SCOPE_AGENT) < epoch) {
      __builtin_amdgcn_s_sleep(1);
      if (++spins > (1u << 24)) break;
    }
    __builtin_amdgcn_fence(__ATOMIC_ACQUIRE, "agent");
    asm volatile("s_waitcnt vmcnt(0)" ::: "memory");
  }
  __syncthreads();
}

#if MULTI_LAUNCH
__global__ void __launch_bounds__(NTHR) phase_kernel(Params p, int ph, int layer) {
  extern __shared__ __attribute__((aligned(16))) char smem[];
  run_phase(p, ph, layer, smem, blockIdx.x);
}
#else
__global__ void __launch_bounds__(NTHR) mega_kernel(Params p) {
  extern __shared__ __attribute__((aligned(16))) char smem[];
  cg::grid_group grid = cg::this_grid();
  const unsigned xcd = (unsigned)__builtin_amdgcn_s_getreg((3 << 11) | 20) & 7u;
  run_phase(p, PH_INIT, 0, smem, 0);
  __syncthreads();
  if (threadIdx.x == 0) ((volatile unsigned*)smem)[0] = atomicAdd(&p.bar[16 + xcd], 1u);
  grid.sync();
  int vid = (int)((volatile unsigned*)smem)[0];
  for (unsigned x = 0; x < xcd; ++x) vid += (int)__hip_atomic_load(&p.bar[16 + x], __ATOMIC_RELAXED, __HIP_MEMORY_SCOPE_AGENT);
  vid = __builtin_amdgcn_readfirstlane(vid);
  __syncthreads();
  unsigned epoch = 0;
  for (int layer = 0; layer < 2; ++layer) {
    for (int ph = (layer == 0 ? PH_MOD_ATTN : PH_INPROJ); ph <= PH_PEER; ++ph) {
      if (ph == PH_SCORES) continue;
      run_phase(p, ph, layer, smem, vid);
      if (!(layer == 1 && ph == PH_PEER)) grid_barrier(p.bar, epoch);
    }
  }
}
#endif

static inline size_t align_up(size_t v) { return (v + 255) & ~(size_t)255; }

extern "C" void kernel_launch(void* const* d_in, const int* in_sizes, int n_in, void* d_out, int out_size, void* d_ws,
                              size_t ws_size, hipStream_t stream) {
  Params p{};
  p.x = (const float*)d_in[0]; p.c = (const float*)d_in[1]; p.ctx = (const float*)d_in[2]; p.c_ctx = (const float*)d_in[3];
  p.w_ada = (const float*)d_in[4]; p.b_ada = (const float*)d_in[5]; p.g_attn = (const float*)d_in[6]; p.g_ffn = (const float*)d_in[7];
  p.w_in = (const float*)d_in[8]; p.rpb = (const float*)d_in[9]; p.ret_lg = (const float*)d_in[10]; p.gla_wu = (const float*)d_in[11];
  p.gla_b = (const float*)d_in[12]; p.gla_g = (const float*)d_in[13]; p.sink = (const float*)d_in[14]; p.w_out = (const float*)d_in[15];
  p.w_q = (const float*)d_in[16]; p.sub_keys = (const float*)d_in[17]; p.pu = (const float*)d_in[18]; p.pv = (const float*)d_in[19];
  p.final_g = (const float*)d_in[20];
  p.out = (float*)d_out;
  char* ws = (char*)d_ws;
  size_t off = 0;
  auto take = [&](size_t bytes) { char* r = ws + off; off = align_up(off + bytes); return r; };
  p.mod = (float*)take((size_t)2 * 3 * 12288 * 4);
  p.bar = (unsigned*)take(256);
  p.rope = (float*)take((size_t)16384 * 4);
  p.wt_in = (bfr*)take((size_t)2 * DINP * D * 2);
  p.wt_out = (bfr*)take((size_t)2 * D * D * 2);
  p.wt_q = (bfr*)take((size_t)2 * D * D * 2);
  p.sk_bf = (bfr*)take((size_t)524288 * 2);
  p.u8 = (unsigned char*)take((size_t)2 * 16384 * D);
  p.v8 = (unsigned char*)take((size_t)2 * 16384 * D);
  p.uscl = (float*)take((size_t)2 * 16384 * 4);
  p.vscl = (float*)take((size_t)2 * 16384 * 4);
  p.xcur = (float*)take((size_t)MT * D * 4);
  p.h = (bfr*)take((size_t)MT * D * 2);
  p.proj = (bfr*)take((size_t)MT * DINP * 2);
  p.mix = (bfr*)take((size_t)MT * D * 2);
  p.st_ret = (bfr*)take((size_t)16 * 132 * 16384 * 4);
  p.dec_ret = (float*)take((size_t)16 * 132 * 128 * 4);
  p.dec_gla = (float*)take((size_t)16 * 132 * 64 * 4);
  p.pidx = (int*)take((size_t)MT * 128 * 4);
  p.pgate = (float*)take((size_t)MT * 128 * 4);
  p.st_gla = (bfr*)p.h;
  p.q = p.proj;
  p.scores = (float*)p.st_ret;
  if (off > ws_size) { fprintf(stderr, "workspace too small: need %zu have %zu\n", off, ws_size); return; }

  hipMemsetAsync(p.mod, 0, (size_t)2 * 3 * 12288 * 4 + 256, stream);
#if MULTI_LAUNCH
  hipFuncSetAttribute((const void*)phase_kernel, hipFuncAttributeMaxDynamicSharedMemorySize, SMEM_BYTES);
  const int grid = 256;
  hipLaunchKernelGGL(phase_kernel, dim3(grid), dim3(NTHR), SMEM_BYTES, stream, p, PH_INIT, 0);
  for (int layer = 0; layer < 2; ++layer)
    for (int ph = (layer == 0 ? PH_MOD_ATTN : PH_INPROJ); ph <= PH_PEER; ++ph)
      hipLaunchKernelGGL(phase_kernel, dim3(grid), dim3(NTHR), SMEM_BYTES, stream, p, ph, layer);
#else
  static int grid_blocks = 0;
  if (!grid_blocks) {
    hipFuncSetAttribute((const void*)mega_kernel, hipFuncAttributeMaxDynamicSharedMemorySize, SMEM_BYTES);
    int dev = 0, cus = 0, per_cu = 0;
    hipGetDevice(&dev);
    hipDeviceGetAttribute(&cus, hipDeviceAttributeMultiprocessorCount, dev);
    hipOccupancyMaxActiveBlocksPerMultiprocessor(&per_cu, mega_kernel, NTHR, SMEM_BYTES);
    if (per_cu < 1) per_cu = 1;
    grid_blocks = cus * per_cu;
    if (grid_blocks > 256) grid_blocks = 256;
  }
  void* args[] = {&p};
  hipError_t e = hipLaunchCooperativeKernel((void*)mega_kernel, dim3(grid_blocks), dim3(NTHR), args, SMEM_BYTES, stream);
  if (e != hipSuccess) fprintf(stderr, "cooperative launch failed: %s (grid %d)\n", hipGetErrorString(e), grid_blocks);
#endif
}
```

```cpp
#include <hip/hip_runtime.h>
#include <hip/hip_cooperative_groups.h>
#include <cstdio>
namespace cg = cooperative_groups;

#ifndef MULTI_LAUNCH
#define MULTI_LAUNCH 0
#endif

typedef unsigned short bfr;
typedef __attribute__((ext_vector_type(8))) short bf16x8;
typedef __attribute__((ext_vector_type(4))) float f32x4;
typedef __attribute__((ext_vector_type(4))) unsigned int u4;

constexpr int D = 2048;
constexpr int S = 8192;
constexpr int MX = 16384;
constexpr int MT = 16896;
constexpr int DIN = 5920;
constexpr int DINP = 6016;
constexpr int NTHR = 512;
constexpr float EPS = 1e-6f;
constexpr int SMEM_BYTES = 149504;

constexpr int C_NAQ = 0, C_NAK = 512, C_NAV = 1024;
constexpr int C_RTQ = 1536, C_RTK = 2048, C_RTV = 2560, C_RTG = 3072;
constexpr int C_GLQ = 3584, C_GLK = 3840, C_GLV = 4096, C_GLG = 4608, C_GLD = 5120;
constexpr int C_SWQ = 5152, C_SWK = 5664, C_SWV = 5792;

struct Params {
  const float *x, *c, *ctx, *c_ctx, *w_ada, *b_ada, *g_attn, *g_ffn, *w_in, *rpb, *ret_lg, *gla_wu, *gla_b,
      *gla_g, *sink, *w_out, *w_q, *sub_keys, *pu, *pv, *final_g;
  float* out;
  bfr *wt_in, *wt_out, *wt_q, *sk_bf;
  unsigned char *u8, *v8;
  float *uscl, *vscl;
  float *mod, *rope, *xcur;
  bfr *h, *proj, *mix;
  bfr *st_ret, *st_gla;
  float *dec_ret, *dec_gla;
  bfr* q;
  float* scores;
  int* pidx;
  float* pgate;
  unsigned* bar;
};

__device__ __forceinline__ int get_tid() { int t = threadIdx.x; asm volatile("" : "+v"(t)); return t; }
__device__ __forceinline__ int get_bid() { int t = blockIdx.x; asm volatile("" : "+s"(t)); return t; }
__device__ __forceinline__ float bf2f(bfr u) { return __uint_as_float(((unsigned)u) << 16); }
typedef __bf16 hwbf16x2 __attribute__((ext_vector_type(2)));
typedef float hwf32x2 __attribute__((ext_vector_type(2)));
__device__ __forceinline__ unsigned pack2(float a, float b) {
  hwf32x2 v = {a, b};
  hwbf16x2 r = __builtin_convertvector(v, hwbf16x2);
  return __builtin_bit_cast(unsigned, r);
}
__device__ __forceinline__ bfr f2bf(float f) { return (bfr)(pack2(f, 0.f) & 0xffffu); }
__device__ __forceinline__ float lo16(unsigned w) { return __uint_as_float(w << 16); }
__device__ __forceinline__ float hi16(unsigned w) { return __uint_as_float(w & 0xffff0000u); }
__device__ __forceinline__ float wave_sum(float v) {
#pragma unroll
  for (int o = 32; o; o >>= 1) v += __shfl_xor(v, o);
  return v;
}
__device__ __forceinline__ float wave_max(float v) {
#pragma unroll
  for (int o = 32; o; o >>= 1) v = fmaxf(v, __shfl_xor(v, o));
  return v;
}
__device__ __forceinline__ float silu_f(float x) { return x / (1.f + __expf(-x)); }
__device__ __forceinline__ float gelu_f(float x) { return 0.5f * x * (1.f + erff(x * 0.70710678118654752f)); }
__device__ __forceinline__ float logsig_f(float x) { return fminf(x, 0.f) - log1pf(__expf(-fabsf(x))); }
__device__ __forceinline__ void unpack8(const u4 w, float* f) {
  f[0] = lo16(w.x); f[1] = hi16(w.x); f[2] = lo16(w.y); f[3] = hi16(w.y);
  f[4] = lo16(w.z); f[5] = hi16(w.z); f[6] = lo16(w.w); f[7] = hi16(w.w);
}

__device__ void transpose_cvt(const float* __restrict__ W, int K, int N, int Npad, bfr* __restrict__ Wt, int item,
                              float* tile) {
  const int nkt = K >> 6;
  const int kt = item % nkt, nt = item / nkt;
  const int tid = get_tid();
  __syncthreads();
#pragma unroll
  for (int i = 0; i < 2; ++i) {
    int kk = (tid >> 4) + 32 * i, nn = (tid & 15) * 4;
    int n = nt * 64 + nn;
    float4 v = make_float4(0.f, 0.f, 0.f, 0.f);
    if (n < N) v = *(const float4*)(W + (size_t)(kt * 64 + kk) * N + n);
    tile[kk * 65 + nn + 0] = v.x; tile[kk * 65 + nn + 1] = v.y; tile[kk * 65 + nn + 2] = v.z; tile[kk * 65 + nn + 3] = v.w;
  }
  __syncthreads();
  {
    int nl = tid >> 3, kc = (tid & 7) * 8;
    u4 o;
    o.x = pack2(tile[(kc + 0) * 65 + nl], tile[(kc + 1) * 65 + nl]);
    o.y = pack2(tile[(kc + 2) * 65 + nl], tile[(kc + 3) * 65 + nl]);
    o.z = pack2(tile[(kc + 4) * 65 + nl], tile[(kc + 5) * 65 + nl]);
    o.w = pack2(tile[(kc + 6) * 65 + nl], tile[(kc + 7) * 65 + nl]);
    *(u4*)(Wt + (size_t)(nt * 64 + nl) * K + kt * 64 + kc) = o;
  }
}

__device__ void cvt_linear(const float* __restrict__ src, bfr* __restrict__ dst, size_t n8) {
  for (size_t i = (size_t)get_bid() * NTHR + get_tid(); i < n8; i += (size_t)gridDim.x * NTHR) {
    float4 a = *(const float4*)(src + i * 8), b = *(const float4*)(src + i * 8 + 4);
    u4 o;
    o.x = pack2(a.x, a.y); o.y = pack2(a.z, a.w); o.z = pack2(b.x, b.y); o.w = pack2(b.z, b.w);
    *(u4*)(dst + i * 8) = o;
  }
}

__device__ void cvt_fp8_rows(const float* __restrict__ src, unsigned char* __restrict__ dst, float* __restrict__ scl, int nrows) {
  const int lane = get_tid() & 63;
  const int wave = get_bid() * 8 + (get_tid() >> 6), nw = gridDim.x * 8;
  for (int row = wave; row < nrows; row += nw) {
    const float* sp = src + (size_t)row * D + lane * 16;
    float4 v[8];
    float amax = 0.f;
#pragma unroll
    for (int i = 0; i < 2; ++i)
#pragma unroll
      for (int k = 0; k < 4; ++k) {
        float4 t = *(const float4*)(sp + i * 1024 + k * 4);
        v[i * 4 + k] = t;
        amax = fmaxf(amax, fmaxf(fmaxf(fabsf(t.x), fabsf(t.y)), fmaxf(fabsf(t.z), fabsf(t.w))));
      }
    amax = wave_max(amax);
    const float sc = amax > 0.f ? 256.f / amax : 1.f;
#pragma unroll
    for (int i = 0; i < 2; ++i) {
      u4 o;
      int w;
      w = __builtin_amdgcn_cvt_pk_fp8_f32(v[i * 4 + 0].x * sc, v[i * 4 + 0].y * sc, 0, false);
      w = __builtin_amdgcn_cvt_pk_fp8_f32(v[i * 4 + 0].z * sc, v[i * 4 + 0].w * sc, w, true); o.x = (unsigned)w;
      w = __builtin_amdgcn_cvt_pk_fp8_f32(v[i * 4 + 1].x * sc, v[i * 4 + 1].y * sc, 0, false);
      w = __builtin_amdgcn_cvt_pk_fp8_f32(v[i * 4 + 1].z * sc, v[i * 4 + 1].w * sc, w, true); o.y = (unsigned)w;
      w = __builtin_amdgcn_cvt_pk_fp8_f32(v[i * 4 + 2].x * sc, v[i * 4 + 2].y * sc, 0, false);
      w = __builtin_amdgcn_cvt_pk_fp8_f32(v[i * 4 + 2].z * sc, v[i * 4 + 2].w * sc, w, true); o.z = (unsigned)w;
      w = __builtin_amdgcn_cvt_pk_fp8_f32(v[i * 4 + 3].x * sc, v[i * 4 + 3].y * sc, 0, false);
      w = __builtin_amdgcn_cvt_pk_fp8_f32(v[i * 4 + 3].z * sc, v[i * 4 + 3].w * sc, w, true); o.w = (unsigned)w;
      *(u4*)(dst + (size_t)row * D + i * 1024 + lane * 16) = o;
    }
    if (lane == 0) scl[row] = amax > 0.f ? amax * (1.f / 256.f) : 1.f;
  }
}

__device__ void sincos_d(double a, float& s, float& c) {
  double k = rint(a * 0.63661977236758134308);
  double r = a - k * 1.57079632679489661923;
  double r2 = r * r;
  double sn = r * (1.0 + r2 * (-1.0 / 6 + r2 * (1.0 / 120 + r2 * (-1.0 / 5040 + r2 * (1.0 / 362880 + r2 * (-1.0 / 39916800 + r2 * (1.0 / 6227020800.0)))))));
  double cs = 1.0 + r2 * (-0.5 + r2 * (1.0 / 24 + r2 * (-1.0 / 720 + r2 * (1.0 / 40320 + r2 * (-1.0 / 3628800 + r2 * (1.0 / 479001600.0))))));
  int q = ((int)k) & 3;
  double so = (q == 0) ? sn : (q == 1) ? cs : (q == 2) ? -sn : -cs;
  double co = (q == 0) ? cs : (q == 1) ? -sn : (q == 2) ? -cs : sn;
  s = (float)so; c = (float)co;
}

__device__ void phase0(const Params& p, char* smem) {
  const int tid = get_tid(), bid = get_bid(), nb = gridDim.x;
  float* fs = (float*)smem;
  if (bid == 0) {
    for (int e = tid; e < 128 * 16 + 128 * 32; e += NTHR) {
      int F, pos, f, base;
      if (e < 2048) { F = 16; pos = e >> 4; f = e & 15; base = 0; }
      else { int e2 = e - 2048; F = 32; pos = e2 >> 5; f = e2 & 31; base = 4096; }
      double bb = (F == 16) ? 0.56234132519034908 : 0.74989420933245582;
      double inv = 1.0;
      for (int i = 0; i < f; ++i) inv *= bb;
      float invf = (float)inv;
      float ang = (float)pos * invf;
      float sn, cs;
      sincos_d((double)ang, sn, cs);
      p.rope[base + pos * F + f] = cs;
      p.rope[base + 128 * F + pos * F + f] = sn;
    }
  }
  for (int it = bid; it < 384; it += nb) {
    int layer = it / 192, r = it % 192, kc = r / 6, nc = r % 6;
    __syncthreads();
    if (tid < 192) {
      int v = tid >> 6, kk = tid & 63;
      float cv = (v < 2) ? p.c[v * D + kc * 64 + kk] : p.c_ctx[kc * 64 + kk];
      fs[tid] = silu_f(cv);
    }
    __syncthreads();
    int n = nc * 2048 + tid * 4;
    float4 a0 = make_float4(0, 0, 0, 0), a1 = a0, a2 = a0;
    if (kc == 0) { a0 = *(const float4*)(p.b_ada + layer * 12288 + n); a1 = a0; a2 = a0; }
    const float* w = p.w_ada + (size_t)layer * D * 12288 + (size_t)(kc * 64) * 12288 + n;
#pragma unroll 8
    for (int kk = 0; kk < 64; ++kk) {
      float4 wv = *(const float4*)(w + (size_t)kk * 12288);
      float s0 = fs[kk], s1 = fs[64 + kk], s2 = fs[128 + kk];
      a0.x += s0 * wv.x; a0.y += s0 * wv.y; a0.z += s0 * wv.z; a0.w += s0 * wv.w;
      a1.x += s1 * wv.x; a1.y += s1 * wv.y; a1.z += s1 * wv.z; a1.w += s1 * wv.w;
      a2.x += s2 * wv.x; a2.y += s2 * wv.y; a2.z += s2 * wv.z; a2.w += s2 * wv.w;
    }
    float* m0 = p.mod + (layer * 3 + 0) * 12288 + n;
    float* m1 = p.mod + (layer * 3 + 1) * 12288 + n;
    float* m2 = p.mod + (layer * 3 + 2) * 12288 + n;
    atomicAdd(m0 + 0, a0.x); atomicAdd(m0 + 1, a0.y); atomicAdd(m0 + 2, a0.z); atomicAdd(m0 + 3, a0.w);
    atomicAdd(m1 + 0, a1.x); atomicAdd(m1 + 1, a1.y); atomicAdd(m1 + 2, a1.z); atomicAdd(m1 + 3, a1.w);
    atomicAdd(m2 + 0, a2.x); atomicAdd(m2 + 1, a2.y); atomicAdd(m2 + 2, a2.z); atomicAdd(m2 + 3, a2.w);
  }
  for (int layer = 0; layer < 2; ++layer) {
    for (int it = bid; it < 32 * 94; it += nb)
      transpose_cvt(p.w_in + (size_t)layer * D * DIN, D, DIN, DINP, p.wt_in + (size_t)layer * DINP * D, it, fs);
    for (int it = bid; it < 32 * 32; it += nb)
      transpose_cvt(p.w_out + (size_t)layer * D * D, D, D, D, p.wt_out + (size_t)layer * D * D, it, fs);
    for (int it = bid; it < 32 * 32; it += nb)
      transpose_cvt(p.w_q + (size_t)layer * D * D, D, D, D, p.wt_q + (size_t)layer * D * D, it, fs);
  }
  cvt_linear(p.sub_keys, p.sk_bf, (size_t)524288 / 8);
  cvt_fp8_rows(p.pu, p.u8, p.uscl, 2 * 16384);
  cvt_fp8_rows(p.pv, p.v8, p.vscl, 2 * 16384);
}

__device__ __forceinline__ const float* modulate_src(const Params& p, int layer, int which, int m) {
  if (layer == 0 && which == 0) return (m < MX) ? p.x + (size_t)m * D : p.ctx + (size_t)(m - MX) * D;
  return p.xcur + (size_t)m * D;
}
__device__ void modulate_phase(const Params& p, int layer, int which, int nrows) {
  const int lane = get_tid() & 63;
  const int wave = get_bid() * 8 + (get_tid() >> 6), nw = gridDim.x * 8;
  const float* g = (which == 0 ? p.g_attn : p.g_ffn) + layer * D;
  float4 vn[8];
  if (wave < nrows) {
    const float* src = modulate_src(p, layer, which, wave);
#pragma unroll
    for (int i = 0; i < 8; ++i) vn[i] = *(const float4*)(src + i * 256 + lane * 4);
  }
  for (int m = wave; m < nrows; m += nw) {
    float4 v[8];
#pragma unroll
    for (int i = 0; i < 8; ++i) v[i] = vn[i];
    if (m + nw < nrows) {
      const float* src = modulate_src(p, layer, which, m + nw);
#pragma unroll
      for (int i = 0; i < 8; ++i) vn[i] = *(const float4*)(src + i * 256 + lane * 4);
    }
    int vec = m < S ? 0 : (m < MX ? 1 : 2);
    const float* modl = p.mod + (layer * 3 + vec) * 12288 + which * 3 * D;
    float ss = 0.f;
#pragma unroll
    for (int i = 0; i < 8; ++i) ss += v[i].x * v[i].x + v[i].y * v[i].y + v[i].z * v[i].z + v[i].w * v[i].w;
    ss = wave_sum(ss);
    float rstd = rsqrtf(ss * (1.f / D) + EPS);
#pragma unroll
    for (int i = 0; i < 8; ++i) {
      int col = i * 256 + lane * 4;
      float4 gg = *(const float4*)(g + col);
      float4 sh = *(const float4*)(modl + col);
      float4 sc = *(const float4*)(modl + D + col);
      float y0 = v[i].x * rstd * gg.x * (1.f + sc.x) + sh.x;
      float y1 = v[i].y * rstd * gg.y * (1.f + sc.y) + sh.y;
      float y2 = v[i].z * rstd * gg.z * (1.f + sc.z) + sh.z;
      float y3 = v[i].w * rstd * gg.w * (1.f + sc.w) + sh.w;
      uint2 o; o.x = pack2(y0, y1); o.y = pack2(y2, y3);
      *(uint2*)(p.h + (size_t)m * D + col) = o;
    }
  }
}

template <int EPI, bool BIG>
__device__ void gemm_tile(const bfr* __restrict__ A, int lda, const bfr* __restrict__ Bt, int ldb, int K, int m0,
                          int n0, void* Cout, int ldc, const Params& p, int layer, char* smem) {
  constexpr int BN = BIG ? 256 : 128;
  constexpr int MI = BIG ? 8 : 4;
  constexpr int NBL = BN / 64;
  bfr* As0 = (bfr*)smem;
  bfr* Bs0 = As0 + 2 * 256 * 72;
  const int tid = get_tid(), lane = tid & 63, w = tid >> 6;
  const int wm = BIG ? (w >> 2) : (w >> 1), wn = BIG ? (w & 3) : (w & 1);
  const int fr = lane & 15, fq = lane >> 4;
  f32x4 acc[MI][4];
#pragma unroll
  for (int i = 0; i < MI; ++i)
#pragma unroll
    for (int j = 0; j < 4; ++j) acc[i][j] = (f32x4){0.f, 0.f, 0.f, 0.f};
  const int arow = tid >> 3, akc = (tid & 7) * 8;
  u4 rs[4];
  const bfr* Ap = A + (size_t)(m0 + arow) * lda + akc;
  const bfr* Bp = Bt + (size_t)(n0 + arow) * ldb + akc;
#pragma unroll
  for (int i = 0; i < 4; ++i) rs[i] = *(const u4*)(Ap + (size_t)(64 * i) * lda);
  __syncthreads();
#pragma unroll
  for (int i = 0; i < 4; ++i) *(u4*)(As0 + (arow + 64 * i) * 72 + akc) = rs[i];
#pragma unroll
  for (int i = 0; i < NBL; ++i) rs[i] = *(const u4*)(Bp + (size_t)(64 * i) * ldb);
#pragma unroll
  for (int i = 0; i < NBL; ++i) *(u4*)(Bs0 + (arow + 64 * i) * 72 + akc) = rs[i];
  const int nk = K >> 6;
  if (nk > 1) {
#pragma unroll
    for (int i = 0; i < 4; ++i) rs[i] = *(const u4*)(Ap + (size_t)(64 * i) * lda + 64);
  }
  __syncthreads();
  for (int kt = 0; kt < nk; ++kt) {
    const bfr* As = As0 + (kt & 1) * (256 * 72);
    const bfr* Bs = Bs0 + (kt & 1) * (BN * 72);
    bfr* Asn = As0 + ((kt + 1) & 1) * (256 * 72);
    bfr* Bsn = Bs0 + ((kt + 1) & 1) * (BN * 72);
#pragma unroll
    for (int kk = 0; kk < 2; ++kk) {
      bf16x8 b[4];
#pragma unroll
      for (int j = 0; j < 4; ++j) b[j] = *(const bf16x8*)(Bs + (wn * 64 + j * 16 + fr) * 72 + kk * 32 + fq * 8);
      {
        bf16x8 a_cur = *(const bf16x8*)(As + (wm * (MI * 16) + fr) * 72 + kk * 32 + fq * 8);
#pragma unroll
        for (int i = 0; i < MI; ++i) {
          bf16x8 a_nxt = a_cur;
          if (i + 1 < MI) a_nxt = *(const bf16x8*)(As + (wm * (MI * 16) + (i + 1) * 16 + fr) * 72 + kk * 32 + fq * 8);
          __builtin_amdgcn_s_setprio(1);
#pragma unroll
          for (int j = 0; j < 4; ++j) acc[i][j] = __builtin_amdgcn_mfma_f32_16x16x32_bf16(b[j], a_cur, acc[i][j], 0, 0, 0);
          __builtin_amdgcn_s_setprio(0);
          if (BIG && (i & 1)) __builtin_amdgcn_sched_barrier(0);
          a_cur = a_nxt;
        }
      }
      if (kt + 1 < nk) {
        if (kk == 0) {
#pragma unroll
          for (int i = 0; i < 4; ++i) *(u4*)(Asn + (arow + 64 * i) * 72 + akc) = rs[i];
#pragma unroll
          for (int i = 0; i < NBL; ++i) rs[i] = *(const u4*)(Bp + (size_t)(64 * i) * ldb + (kt + 1) * 64);
        } else {
#pragma unroll
          for (int i = 0; i < NBL; ++i) *(u4*)(Bsn + (arow + 64 * i) * 72 + akc) = rs[i];
          if (kt + 2 < nk) {
#pragma unroll
            for (int i = 0; i < 4; ++i) rs[i] = *(const u4*)(Ap + (size_t)(64 * i) * lda + (kt + 2) * 64);
          }
        }
      }
    }
    __syncthreads();
  }
  const int nb0 = n0 + wn * 64 + fq * 4;
#pragma unroll
  for (int i = 0; i < MI; ++i) {
    const int m = m0 + wm * (MI * 16) + i * 16 + fr;
    if (EPI == 0) {
      bfr* crow = (bfr*)Cout + (size_t)m * ldc + nb0;
#pragma unroll
      for (int j = 0; j < 4; ++j) {
        uint2 o;
        o.x = pack2(acc[i][j][0], acc[i][j][1]); o.y = pack2(acc[i][j][2], acc[i][j][3]);
        *(uint2*)(crow + j * 16) = o;
      }
    } else if (EPI == 2) {
      float* crow = (float*)Cout + (size_t)m * ldc + nb0;
#pragma unroll
      for (int j = 0; j < 4; ++j) *(float4*)(crow + j * 16) = make_float4(acc[i][j][0], acc[i][j][1], acc[i][j][2], acc[i][j][3]);
    } else {
      const float* src;
      if (layer == 0) src = (m < MX) ? p.x + (size_t)m * D : p.ctx + (size_t)(m - MX) * D;
      else src = p.xcur + (size_t)m * D;
      src += nb0;
      const int vec = m < S ? 0 : (m < MX ? 1 : 2);
      const float* grow = p.mod + (layer * 3 + vec) * 12288 + 2 * D + nb0;
      float* orow = p.xcur + (size_t)m * D + nb0;
#pragma unroll
      for (int j = 0; j < 4; ++j) {
        const float4 gate = *(const float4*)(grow + j * 16);
        const float4 xs = *(const float4*)(src + j * 16);
        *(float4*)(orow + j * 16) = make_float4(xs.x + gate.x * acc[i][j][0], xs.y + gate.y * acc[i][j][1], xs.z + gate.z * acc[i][j][2], xs.w + gate.w * acc[i][j][3]);
      }
      __builtin_amdgcn_sched_barrier(0);
    }
  }
}

#define MFMA16(a, b, c) __builtin_amdgcn_mfma_f32_16x16x32_bf16((a), (b), (c), 0, 0, 0)
typedef __attribute__((ext_vector_type(4))) short s16x4;

__device__ __forceinline__ void load_kv_tile(bfr* dst, const bfr* src, int nrows, int tok0, int toklimit) {
  for (int c = get_tid(); c < nrows * 8; c += NTHR) {
    int r = c >> 3, ch = c & 7;
    int tok = tok0 + r;
    u4 v = (u4){0u, 0u, 0u, 0u};
    if (tok >= 0 && tok < toklimit) v = *(const u4*)(src + (ptrdiff_t)r * DINP + ch * 8);
    *(u4*)(dst + r * 72 + ch * 8) = v;
  }
}
__device__ __forceinline__ void load_vt_tile(bfr* Vt, int VS, const bfr* src, int nrows, int tok0, int toklimit) {
  for (int c = get_tid(); c < nrows * 8; c += NTHR) {
    int key = c % nrows, dch = c / nrows;
    int tok = tok0 + key;
    u4 v = (u4){0u, 0u, 0u, 0u};
    if (tok >= 0 && tok < toklimit) v = *(const u4*)(src + (ptrdiff_t)key * DINP + dch * 8);
    bfr* d = Vt + (dch * 8) * VS + key;
    d[0 * VS] = (bfr)(v.x & 0xffffu); d[1 * VS] = (bfr)(v.x >> 16);
    d[2 * VS] = (bfr)(v.y & 0xffffu); d[3 * VS] = (bfr)(v.y >> 16);
    d[4 * VS] = (bfr)(v.z & 0xffffu); d[5 * VS] = (bfr)(v.z >> 16);
    d[6 * VS] = (bfr)(v.w & 0xffffu); d[7 * VS] = (bfr)(v.w >> 16);
  }
}
__device__ __forceinline__ void load_kfrags(bf16x8 (&kf)[2][2], const bfr* Ks, int kt, int fr, int q4) {
#pragma unroll
  for (int blk = 0; blk < 2; ++blk)
#pragma unroll
    for (int ds = 0; ds < 2; ++ds) kf[blk][ds] = *(const bf16x8*)(Ks + (kt + blk * 16 + fr) * 72 + ds * 32 + q4 * 8);
}
__device__ __forceinline__ void load_vfrags(bf16x8 (&vf)[4], const bfr* Vt, int VS, int kt, int fr, int q4) {
#pragma unroll
  for (int db = 0; db < 4; ++db) {
    const bfr* vp = Vt + (db * 16 + fr) * VS + kt + q4 * 4;
    s16x4 lo = *(const s16x4*)vp, hi = *(const s16x4*)(vp + 16);
    vf[db] = __builtin_shufflevector(lo, hi, 0, 1, 2, 3, 4, 5, 6, 7);
  }
}
__device__ __forceinline__ void attn_tile_group(const bf16x8 (&kf)[2][2], const bf16x8 (&qf)[2], const bf16x8 (&vf)[4],
                                                f32x4 (&o)[4], float& m, float& l, const float (&badd)[8]) {
  f32x4 s0 = (f32x4){0.f, 0.f, 0.f, 0.f}, s1 = s0;
  s0 = MFMA16(kf[0][0], qf[0], s0); s0 = MFMA16(kf[0][1], qf[1], s0);
  s1 = MFMA16(kf[1][0], qf[0], s1); s1 = MFMA16(kf[1][1], qf[1], s1);
  float sv[8];
#pragma unroll
  for (int i = 0; i < 4; ++i) { sv[i] = s0[i] + badd[i]; sv[4 + i] = s1[i] + badd[4 + i]; }
  float mx = fmaxf(fmaxf(fmaxf(sv[0], sv[1]), fmaxf(sv[2], sv[3])), fmaxf(fmaxf(sv[4], sv[5]), fmaxf(sv[6], sv[7])));
  mx = fmaxf(mx, __shfl_xor(mx, 16));
  mx = fmaxf(mx, __shfl_xor(mx, 32));
  const float mn = fmaxf(m, mx);
  const float mref = (mn == -INFINITY) ? 0.f : mn;
  const float alpha = __expf(m - mref);
  float pv[8];
  float ls = 0.f;
#pragma unroll
  for (int i = 0; i < 8; ++i) { pv[i] = __expf(sv[i] - mref); ls += pv[i]; }
  l = l * alpha + ls;
  m = mn;
  u4 pk;
  pk.x = pack2(pv[0], pv[1]); pk.y = pack2(pv[2], pv[3]); pk.z = pack2(pv[4], pv[5]); pk.w = pack2(pv[6], pv[7]);
  const bf16x8 pb = __builtin_bit_cast(bf16x8, pk);
#pragma unroll
  for (int db = 0; db < 4; ++db) {
    o[db] *= alpha;
    o[db] = MFMA16(vf[db], pb, o[db]);
  }
}
__device__ __forceinline__ float attn_rowsum(float l) {
  l += __shfl_xor(l, 16);
  l += __shfl_xor(l, 32);
  return l;
}
__device__ __forceinline__ void load_qfrags(bf16x8 (&qf)[2], const bfr* qrow, int q4, float scale) {
#pragma unroll
  for (int ds = 0; ds < 2; ++ds) {
    u4 w = *(const u4*)(qrow + ds * 32 + q4 * 8);
    float f[8];
    unpack8(w, f);
    u4 o;
    o.x = pack2(f[0] * scale, f[1] * scale); o.y = pack2(f[2] * scale, f[3] * scale);
    o.z = pack2(f[4] * scale, f[5] * scale); o.w = pack2(f[6] * scale, f[7] * scale);
    qf[ds] = __builtin_bit_cast(bf16x8, o);
  }
}
__device__ __forceinline__ void store_ot(bfr* dst, const f32x4 (&o)[4], float inv, int q4) {
#pragma unroll
  for (int db = 0; db < 4; ++db) {
    uint2 w;
    w.x = pack2(o[db][0] * inv, o[db][1] * inv);
    w.y = pack2(o[db][2] * inv, o[db][3] * inv);
    *(uint2*)(dst + db * 16 + q4 * 4) = w;
  }
}

__device__ void swa_item(const Params& p, int layer, int item, char* smem) {
  const int b = item >> 7, kvh = (item >> 6) & 1, nbk = item & 63;
  bfr* Ks = (bfr*)smem;
  bfr* Vt = Ks + 384 * 72;
  constexpr int VS = 392;
  const int tid = get_tid();
  const int lane = tid & 63, w = tid >> 6, fr = lane & 15, q4 = lane >> 4;
  const float* cos16 = p.rope;
  const float* sin16 = p.rope + 2048;
  __syncthreads();
  const int tok0 = (nbk - 1) * 128;
  const bfr* rowbase = p.proj + (ptrdiff_t)(b * S + tok0) * DINP;
  load_vt_tile(Vt, VS, rowbase + C_SWV + kvh * 64, 384, tok0, S);
  for (int u = tid; u < 384 * 4; u += NTHR) {
    int r = u >> 2, A = (u >> 1) & 1, fc = u & 1;
    int tok = tok0 + r;
    u4 o1 = (u4){0u, 0u, 0u, 0u}, o2 = o1;
    if (tok >= 0 && tok < S) {
      const bfr* kp = rowbase + (ptrdiff_t)r * DINP + C_SWK + kvh * 64 + A * 32 + fc * 8;
      u4 w1 = *(const u4*)kp, w2 = *(const u4*)(kp + 16);
      float x1[8], x2[8], y1[8], y2[8];
      unpack8(w1, x1); unpack8(w2, x2);
      int pos = A ? (tok & 63) : (tok >> 6);
#pragma unroll
      for (int j = 0; j < 8; ++j) {
        float cs = cos16[pos * 16 + fc * 8 + j], sn = sin16[pos * 16 + fc * 8 + j];
        y1[j] = x1[j] * cs - x2[j] * sn;
        y2[j] = x2[j] * cs + x1[j] * sn;
      }
      o1.x = pack2(y1[0], y1[1]); o1.y = pack2(y1[2], y1[3]); o1.z = pack2(y1[4], y1[5]); o1.w = pack2(y1[6], y1[7]);
      o2.x = pack2(y2[0], y2[1]); o2.y = pack2(y2[2], y2[3]); o2.z = pack2(y2[4], y2[5]); o2.w = pack2(y2[6], y2[7]);
    }
    int ch1 = A * 4 + fc, ch2 = A * 4 + 2 + fc;
    *(u4*)(Ks + r * 72 + ch1 * 8) = o1;
    *(u4*)(Ks + r * 72 + ch2 * 8) = o2;
  }
  const int g = w >> 1, qhalf = w & 1;
  const int hq = kvh * 4 + g;
  bf16x8 qf[4][2];
  f32x4 oacc[4][4];
  float mm[4], ll[4];
#pragma unroll
  for (int grp = 0; grp < 4; ++grp) {
    const int tq = nbk * 128 + qhalf * 64 + grp * 16 + fr;
    const bfr* qrow = p.proj + (size_t)(b * S + tq) * DINP + C_SWQ + hq * 64;
#pragma unroll
    for (int ds = 0; ds < 2; ++ds) {
      u4 wq = *(const u4*)(qrow + ds * 32 + q4 * 8);
      float f[8], y[8];
      unpack8(wq, f);
      const int pos = ds ? (tq & 63) : (tq >> 6);
#pragma unroll
      for (int j = 0; j < 8; ++j) {
        const float other = __shfl_xor(f[j], 32);
        const int fi = (q4 & 1) * 8 + j;
        const float cs = cos16[pos * 16 + fi], sn = sin16[pos * 16 + fi];
        y[j] = ((q4 < 2) ? (f[j] * cs - other * sn) : (f[j] * cs + other * sn)) * 0.125f;
      }
      u4 o;
      o.x = pack2(y[0], y[1]); o.y = pack2(y[2], y[3]); o.z = pack2(y[4], y[5]); o.w = pack2(y[6], y[7]);
      qf[grp][ds] = __builtin_bit_cast(bf16x8, o);
    }
    mm[grp] = -INFINITY; ll[grp] = 0.f;
#pragma unroll
    for (int db = 0; db < 4; ++db) oacc[grp][db] = (f32x4){0.f, 0.f, 0.f, 0.f};
  }
  __syncthreads();
  float zb[8];
#pragma unroll
  for (int i = 0; i < 8; ++i) zb[i] = 0.f;
#pragma unroll 1
  for (int t = 0; t < 10; ++t) {
    const int kt = qhalf * 64 + 32 * t;
    if (tok0 + kt + 31 < 0 || tok0 + kt >= S) continue;
    bf16x8 kf[2][2], vf[4];
    load_kfrags(kf, Ks, kt, fr, q4);
    load_vfrags(vf, Vt, VS, kt, fr, q4);
#pragma unroll
    for (int grp = 0; grp < 4; ++grp) {
      const int qg0 = 128 + qhalf * 64 + grp * 16;
      if (kt > qg0 + 15 + 128 || kt + 31 < qg0 - 128) continue;
      const bool interior = (kt >= qg0 + 15 - 128) && (kt + 31 <= qg0 + 128) && (tok0 + kt >= 0) && (tok0 + kt + 31 < S);
      if (interior) {
        attn_tile_group(kf, qf[grp], vf, oacc[grp], mm[grp], ll[grp], zb);
      } else {
        const int qrow = qg0 + fr;
        float badd[8];
#pragma unroll
        for (int i = 0; i < 8; ++i) {
          const int lr = kt + (i >> 2) * 16 + q4 * 4 + (i & 3);
          const int dd = qrow - lr;
          const int tok = tok0 + lr;
          const bool ok = (dd <= 128) && (dd >= -128) && (tok >= 0) && (tok < S);
          badd[i] = ok ? 0.f : -INFINITY;
        }
        attn_tile_group(kf, qf[grp], vf, oacc[grp], mm[grp], ll[grp], badd);
      }
    }
  }
  __syncthreads();
  const bfr* zbase = p.proj + (size_t)(MX + b * 256) * DINP;
  load_kv_tile(Ks, zbase + C_SWK + kvh * 64, 256, 0, 256);
  load_vt_tile(Vt, VS, zbase + C_SWV + kvh * 64, 256, 0, 256);
  __syncthreads();
#pragma unroll 1
  for (int t = 0; t < 8; ++t) {
    const int kt = 32 * t;
    bf16x8 kf[2][2], vf[4];
    load_kfrags(kf, Ks, kt, fr, q4);
    load_vfrags(vf, Vt, VS, kt, fr, q4);
#pragma unroll
    for (int grp = 0; grp < 4; ++grp) attn_tile_group(kf, qf[grp], vf, oacc[grp], mm[grp], ll[grp], zb);
  }
  const float sk = p.sink[layer * 8 + hq];
#pragma unroll
  for (int grp = 0; grp < 4; ++grp) {
    const int tq = nbk * 128 + qhalf * 64 + grp * 16 + fr;
    const float mn = fmaxf(mm[grp], sk);
    const float alpha = __expf(mm[grp] - mn);
    const float lt = attn_rowsum(ll[grp]) * alpha + __expf(sk - mn);
    store_ot(p.mix + (size_t)(b * S + tq) * D + 1536 + hq * 64, oacc[grp], alpha / lt, q4);
  }
}

__device__ void na_item(const Params& p, int layer, int item, char* smem) {
  const int b = item >> 10, h = (item >> 7) & 7, r = item & 127;
  bfr* Ks = (bfr*)smem;
  bfr* Vt = Ks + 512 * 72;
  constexpr int VS = 520;
  float* rp = (float*)(Vt + 64 * VS);
  float* mg = (float*)smem;
  const int tid = get_tid();
  const int lane = tid & 63, w = tid >> 6, fr = lane & 15, q4 = lane >> 4;
  __syncthreads();
  int r0 = r - 4; r0 = r0 < 0 ? 0 : (r0 > 120 ? 120 : r0);
  const bfr* rowbase = p.proj + (size_t)(b * S + r0 * 64) * DINP;
  load_kv_tile(Ks, rowbase + C_NAK + h * 64, 512, 0, 512);
  load_vt_tile(Vt, VS, rowbase + C_NAV + h * 64, 512, 0, 512);
  if (tid < 15 * 31) rp[tid] = p.rpb[(layer * 8 + h) * 465 + tid];
  const int grp = w >> 1, half = w & 1;
  const int cq = grp * 16 + fr;
  const int tq = r * 64 + cq;
  bf16x8 qf[2];
  load_qfrags(qf, p.proj + (size_t)(b * S + tq) * DINP + C_NAQ + h * 64, q4, 0.125f);
  f32x4 oacc[4];
#pragma unroll
  for (int db = 0; db < 4; ++db) oacc[db] = (f32x4){0.f, 0.f, 0.f, 0.f};
  float m = -INFINITY, l = 0.f;
  __syncthreads();
  int cs = cq - 8; cs = cs < 0 ? 0 : (cs > 48 ? 48 : cs);
  const int tstart = grp == 0 ? 0 : (grp == 1 ? 8 : (grp == 2 ? 24 : 32));
#pragma unroll 1
  for (int jj = 0; jj < 4; ++jj) {
    const int jrow = half * 4 + jj;
    const int drow = (r0 + jrow) - r + 7;
    const int kt = jrow * 64 + tstart;
    bf16x8 kf[2][2], vf[4];
    load_kfrags(kf, Ks, kt, fr, q4);
    load_vfrags(vf, Vt, VS, kt, fr, q4);
    float badd[8];
#pragma unroll
    for (int i = 0; i < 8; ++i) {
      const int ck = tstart + (i >> 2) * 16 + q4 * 4 + (i & 3);
      const bool ok = (ck >= cs) && (ck < cs + 16);
      int dc = ck - cq + 15; dc = dc < 0 ? 0 : (dc > 30 ? 30 : dc);
      badd[i] = ok ? rp[drow * 31 + dc] : -INFINITY;
    }
    attn_tile_group(kf, qf, vf, oacc, m, l, badd);
  }
  __syncthreads();
  const bfr* zbase = p.proj + (size_t)(MX + b * 256) * DINP;
  load_kv_tile(Ks, zbase + C_NAK + h * 64, 256, 0, 256);
  load_vt_tile(Vt, VS, zbase + C_NAV + h * 64, 256, 0, 256);
  __syncthreads();
  float zb[8];
#pragma unroll
  for (int i = 0; i < 8; ++i) zb[i] = 0.f;
#pragma unroll 1
  for (int t = 0; t < 4; ++t) {
    const int kt = half * 128 + 32 * t;
    bf16x8 kf[2][2], vf[4];
    load_kfrags(kf, Ks, kt, fr, q4);
    load_vfrags(vf, Vt, VS, kt, fr, q4);
    attn_tile_group(kf, qf, vf, oacc, m, l, zb);
  }
  __syncthreads();
  l = attn_rowsum(l);
  float* mo = mg + grp * (16 * 64 + 64) ;
  if (half == 1) {
#pragma unroll
    for (int db = 0; db < 4; ++db)
#pragma unroll
      for (int i = 0; i < 4; ++i) mo[(db * 4 + i) * 64 + lane] = oacc[db][i];
    if (q4 == 0) { mo[16 * 64 + fr] = m; mo[16 * 64 + 16 + fr] = l; }
  }
  __syncthreads();
  if (half == 0) {
    const float m2 = mo[16 * 64 + fr], l2 = mo[16 * 64 + 16 + fr];
    const float mn = fmaxf(m, m2);
    const float a1 = __expf(m - mn), a2 = __expf(m2 - mn);
    const float lt = l * a1 + l2 * a2;
    const float i1 = a1 / lt, i2 = a2 / lt;
#pragma unroll
    for (int db = 0; db < 4; ++db)
#pragma unroll
      for (int i = 0; i < 4; ++i) oacc[db][i] = oacc[db][i] * i1 + mo[(db * 4 + i) * 64 + lane] * i2;
    store_ot(p.mix + (size_t)(b * S + tq) * D + h * 64, oacc, 1.f, q4);
  }
}

__device__ void ctx_item(const Params& p, int layer, int item, char* smem) {
  const int b = item >> 4, type = (item >> 3) & 1, h = item & 7;
  bfr* Ks = (bfr*)smem;
  bfr* Vt = Ks + 256 * 72;
  constexpr int VS = 264;
  const int tid = get_tid();
  const int lane = tid & 63, w = tid >> 6, fr = lane & 15, q4 = lane >> 4;
  __syncthreads();
  const bfr* zbase = p.proj + (size_t)(MX + b * 256) * DINP;
  const int kcol = type ? (C_SWK + (h >> 2) * 64) : (C_NAK + h * 64);
  const int vcol = type ? (C_SWV + (h >> 2) * 64) : (C_NAV + h * 64);
  const int qcol = type ? (C_SWQ + h * 64) : (C_NAQ + h * 64);
  load_kv_tile(Ks, zbase + kcol, 256, 0, 256);
  load_vt_tile(Vt, VS, zbase + vcol, 256, 0, 256);
  bf16x8 qf[2][2];
  f32x4 oacc[2][4];
  float mm[2], ll[2];
#pragma unroll
  for (int grp = 0; grp < 2; ++grp) {
    const int qz = w * 32 + grp * 16 + fr;
    load_qfrags(qf[grp], zbase + (size_t)qz * DINP + qcol, q4, 0.125f);
    mm[grp] = -INFINITY; ll[grp] = 0.f;
#pragma unroll
    for (int db = 0; db < 4; ++db) oacc[grp][db] = (f32x4){0.f, 0.f, 0.f, 0.f};
  }
  __syncthreads();
  float zb[8];
#pragma unroll
  for (int i = 0; i < 8; ++i) zb[i] = 0.f;
#pragma unroll 1
  for (int t = 0; t < 8; ++t) {
    const int kt = 32 * t;
    bf16x8 kf[2][2], vf[4];
    load_kfrags(kf, Ks, kt, fr, q4);
    load_vfrags(vf, Vt, VS, kt, fr, q4);
#pragma unroll
    for (int grp = 0; grp < 2; ++grp) attn_tile_group(kf, qf[grp], vf, oacc[grp], mm[grp], ll[grp], zb);
  }
#pragma unroll
  for (int grp = 0; grp < 2; ++grp) {
    const int qz = w * 32 + grp * 16 + fr;
    float inv;
    if (type == 1) {
      const float sk = p.sink[layer * 8 + h];
      const float mn = fmaxf(mm[grp], sk);
      const float a = __expf(mm[grp] - mn);
      inv = a / (attn_rowsum(ll[grp]) * a + __expf(sk - mn));
    } else {
      inv = 1.f / attn_rowsum(ll[grp]);
    }
    store_ot(p.mix + (size_t)(MX + b * 256 + qz) * D + (type ? 1536 : 0) + h * 64, oacc[grp], inv, q4);
  }
}

template <int W>
__device__ __forceinline__ void load_rows_f32(float* dst, int stride, const bfr* src, float scale) {
  constexpr int CPR = W / 8;
  for (int c = get_tid(); c < 64 * CPR; c += NTHR) {
    int j = c / CPR, ch = c % CPR;
    u4 w = *(const u4*)(src + (size_t)j * DINP + ch * 8);
    float f[8];
    unpack8(w, f);
    float4 a = make_float4(f[0] * scale, f[1] * scale, f[2] * scale, f[3] * scale);
    float4 bq = make_float4(f[4] * scale, f[5] * scale, f[6] * scale, f[7] * scale);
    *(float4*)(dst + j * stride + ch * 8) = a;
    *(float4*)(dst + j * stride + ch * 8 + 4) = bq;
  }
}

__device__ __forceinline__ void rope128_tile(float* t, int stride, int prow, const float* rope, float scale) {
  const float* cos32 = rope + 4096;
  const float* sin32 = rope + 8192;
  for (int u = get_tid(); u < 64 * 64; u += NTHR) {
    int j = u >> 6, A = (u >> 5) & 1, f = u & 31;
    int pos = A ? j : prow;
    float cs = cos32[pos * 32 + f], sn = sin32[pos * 32 + f];
    float x1 = t[j * stride + A * 64 + f], x2 = t[j * stride + A * 64 + 32 + f];
    t[j * stride + A * 64 + f] = (x1 * cs - x2 * sn) * scale;
    t[j * stride + A * 64 + 32 + f] = (x2 * cs + x1 * sn) * scale;
  }
}

__device__ __forceinline__ void gla_logdecay(const Params& p, int layer, int h, int dir, const bfr* rowbase, float* G) {
  const int tid = get_tid();
  const int j = tid >> 3, dg = tid & 7;
  const bfr* dl = rowbase + (size_t)j * DINP + C_GLD + dir * 16;
  u4 w0 = *(const u4*)dl, w1 = *(const u4*)(dl + 8);
  float x[16];
  unpack8(w0, x); unpack8(w1, x + 8);
  const float* wu = p.gla_wu + (size_t)layer * 8192 + dir * 4096 + h * 64;
  const float* bb = p.gla_b + layer * 512 + dir * 256 + h * 64;
#pragma unroll
  for (int dd = 0; dd < 8; ++dd) {
    int d = dg + 8 * dd;
    float pre = bb[d];
#pragma unroll
    for (int r = 0; r < 16; ++r) pre += x[r] * wu[r * 256 + d];
    G[j * 68 + d] = logsig_f(pre) * (1.f / 16.f);
  }
}

__device__ __forceinline__ void gla_logdecay2(const Params& p, int layer, int h, const bfr* rowbase, float* G0, float* G1) {
  const int tid = get_tid();
  const int w = tid >> 6, lane = tid & 63, fr = lane & 15, q4 = lane >> 4;
  const int dir = w >> 2, dt = w & 3;
  const int d = dt * 16 + fr;
  float* G = dir ? G1 : G0;
  u4 bw = (u4){0u, 0u, 0u, 0u};
  if (q4 < 2) {
    const float* wu = p.gla_wu + (size_t)layer * 8192 + dir * 4096 + (q4 * 8) * 256 + h * 64 + d;
    bw.x = pack2(wu[0 * 256], wu[1 * 256]); bw.y = pack2(wu[2 * 256], wu[3 * 256]);
    bw.z = pack2(wu[4 * 256], wu[5 * 256]); bw.w = pack2(wu[6 * 256], wu[7 * 256]);
  }
  const bf16x8 bq = __builtin_bit_cast(bf16x8, bw);
  const float bias = p.gla_b[layer * 512 + dir * 256 + h * 64 + d];
#pragma unroll
  for (int rt = 0; rt < 4; ++rt) {
    u4 aw = (u4){0u, 0u, 0u, 0u};
    if (q4 < 2) aw = *(const u4*)(rowbase + (size_t)(rt * 16 + fr) * DINP + C_GLD + dir * 16 + q4 * 8);
    f32x4 acc = (f32x4){0.f, 0.f, 0.f, 0.f};
    acc = MFMA16(__builtin_bit_cast(bf16x8, aw), bq, acc);
#pragma unroll
    for (int r = 0; r < 4; ++r) G[(rt * 16 + q4 * 4 + r) * 68 + d] = logsig_f(acc[r] + bias) * (1.f / 16.f);
  }
}

__device__ __forceinline__ int scan_pos(int dir, int g) { return dir == 0 ? g : (g < 4 ? 3 - g : 135 - g); }
__device__ __forceinline__ int group_row0(int b, int g) { return g < 4 ? (MX + b * 256 + g * 64) : (b * S + (g - 4) * 64); }

template <int W>
__device__ __forceinline__ void load_rows_transposed(bfr* T, const bfr* src) {
  for (int c = get_tid(); c < 64 * (W / 8); c += NTHR) {
    const int j = c & 63, dch = c >> 6;
    const u4 v = *(const u4*)(src + (size_t)j * DINP + dch * 8);
    bfr* d = T + (dch * 8) * 72 + j;
    d[0 * 72] = (bfr)(v.x & 0xffffu); d[1 * 72] = (bfr)(v.x >> 16);
    d[2 * 72] = (bfr)(v.y & 0xffffu); d[3 * 72] = (bfr)(v.y >> 16);
    d[4 * 72] = (bfr)(v.z & 0xffffu); d[5 * 72] = (bfr)(v.z >> 16);
    d[6 * 72] = (bfr)(v.w & 0xffffu); d[7 * 72] = (bfr)(v.w >> 16);
  }
}

template <int DK, bool GLA>
__device__ void scan_a_item(const Params& p, int layer, int item, char* smem) {
  const int g = item % 132;
  const int t2 = item / 132;
  const int h = t2 & 3, b = t2 >> 2;
  constexpr int KS = DK + 4;
  float* ks = (float*)smem;
  float* E0 = ks + 64 * KS;
  float* E1 = E0 + 64 * 68;
  bfr* Kt = (bfr*)(E1 + 64 * 68);
  bfr* Vt = Kt + DK * 72;
  const int tid = get_tid();
  const int w = tid >> 6, lane = tid & 63, fr = lane & 15, q4 = lane >> 4;
  const int row0 = group_row0(b, g);
  const bfr* rowbase = p.proj + (size_t)row0 * DINP;
  __syncthreads();
  if (GLA) {
    load_rows_transposed<128>(Vt, rowbase + C_GLV + h * 128);
    load_rows_f32<64>(ks, KS, rowbase + C_GLK + h * 64, 1.f);
    gla_logdecay2(p, layer, h, rowbase, E0, E1);
  } else {
    const float kscale = 0.08838834764831845f;
    load_rows_transposed<128>(Vt, rowbase + C_RTV + h * 128);
    load_rows_f32<128>(ks, KS, rowbase + C_RTK + h * 128, g < 4 ? kscale : 1.f);
    __syncthreads();
    if (g >= 4) rope128_tile(ks, KS, g - 4, p.rope, kscale);
  }
#pragma unroll 1
  for (int dir = 0; dir < 2; ++dir) {
    const int scan = ((b * 4 + h) * 2 + dir);
    const int pos = scan_pos(dir, g);
    float lg = 0.f;
    __syncthreads();
    float* E = dir ? E1 : E0;
    if (GLA) {
      if (tid < 64) {
        float run = 0.f;
        if (dir == 0) {
          for (int j = 63; j >= 0; --j) { float v = E[j * 68 + tid]; E[j * 68 + tid] = run; run += v; }
        } else {
          for (int j = 0; j < 64; ++j) { float v = E[j * 68 + tid]; E[j * 68 + tid] = run; run += v; }
        }
        p.dec_gla[(size_t)(scan * 132 + pos) * 64 + tid] = __expf(run);
      }
      __syncthreads();
    } else {
      lg = p.ret_lg[layer * 8 + dir * 4 + h];
      if (tid < 128) p.dec_ret[(size_t)(scan * 132 + pos) * 128 + tid] = __expf(lg * 64.f);
    }
    for (int u = tid; u < 64 * DK; u += NTHR) {
      const int j = u & 63, d = u >> 6;
      const float sc = GLA ? __expf(E[j * 68 + d]) : __expf(lg * (dir == 0 ? (float)(63 - j) : (float)j));
      Kt[d * 72 + j] = f2bf(ks[j * KS + d] * sc);
    }
    __syncthreads();
    bf16x8 vfr[2];
#pragma unroll
    for (int k2 = 0; k2 < 2; ++k2) vfr[k2] = *(const bf16x8*)(Vt + (w * 16 + fr) * 72 + k2 * 32 + q4 * 8);
    bfr* st = (GLA ? p.st_gla : p.st_ret) + (size_t)(scan * 132 + pos) * DK * 128;
#pragma unroll 2
    for (int dt = 0; dt < DK / 16; ++dt) {
      f32x4 acc = (f32x4){0.f, 0.f, 0.f, 0.f};
#pragma unroll
      for (int k2 = 0; k2 < 2; ++k2) {
        const bf16x8 kq = *(const bf16x8*)(Kt + (dt * 16 + fr) * 72 + k2 * 32 + q4 * 8);
        acc = MFMA16(kq, vfr[k2], acc);
      }
      uint2 o;
      o.x = pack2(acc[0], acc[1]); o.y = pack2(acc[2], acc[3]);
      *(uint2*)(st + (size_t)(w * 16 + fr) * DK + dt * 16 + q4 * 4) = o;
    }
  }
}

__device__ void scan_b_phase(const Params& p) {
  const int gt = get_bid() * NTHR + get_tid(), ntot = gridDim.x * NTHR;
  for (int ch = gt; ch < 98304; ch += ntot) {
    bfr* st; const float* dec; int DK, e4;
    if (ch < 65536) { int scan = ch >> 12; e4 = ch & 4095; DK = 128; st = p.st_ret + (size_t)scan * 132 * 16384; dec = p.dec_ret + (size_t)scan * 132 * 128; }
    else { int c2 = ch - 65536; int scan = c2 >> 11; e4 = c2 & 2047; DK = 64; st = p.st_gla + (size_t)scan * 132 * 8192; dec = p.dec_gla + (size_t)scan * 132 * 64; }
    const int d0 = (e4 * 4) & (DK - 1);
    const size_t cstride = (size_t)DK * 128;
    float4 s = make_float4(0.f, 0.f, 0.f, 0.f);
    bfr* ptr = st + e4 * 4;
    const float* dp = dec + d0;
    for (int pos = 0; pos < 132; pos += 4) {
      uint2 u[4];
      float4 dv[4];
#pragma unroll
      for (int q = 0; q < 4; ++q) {
        u[q] = *(const uint2*)(ptr + (size_t)(pos + q) * cstride);
        dv[q] = *(const float4*)(dp + (pos + q) * DK);
      }
#pragma unroll
      for (int q = 0; q < 4; ++q) {
        uint2 o;
        o.x = pack2(s.x, s.y); o.y = pack2(s.z, s.w);
        *(uint2*)(ptr + (size_t)(pos + q) * cstride) = o;
        s = make_float4(dv[q].x * s.x + lo16(u[q].x), dv[q].y * s.y + hi16(u[q].x), dv[q].z * s.z + lo16(u[q].y), dv[q].w * s.w + hi16(u[q].y));
      }
    }
  }
}

template <int DK, bool GLA>
__device__ void scan_c_item(const Params& p, int layer, int item, char* smem) {
  const int g = item % 132;
  const int t2 = item / 132;
  const int h = t2 & 3, b = t2 >> 2;
  constexpr int FS = DK + 4;
  constexpr int QS = DK + 8;
  float* stg = (float*)smem;
  float* Gf = stg + 64 * FS;
  float* Gb = Gf + (GLA ? 64 * 68 : 0);
  float* red = Gb + (GLA ? 64 * 68 : 0);
  float* red2 = red + 8 * 64 * 2;
  bfr* T0 = (bfr*)(red2 + 64 * 2);
  bfr* T1 = T0 + 64 * QS;
  bfr* T2 = T1 + 64 * QS;
  bfr* T3 = T2 + 64 * QS;
  bfr* T4 = T3 + 64 * QS;
  bfr* T5 = T4 + (GLA ? 64 * QS : 0);
  bfr* Vt = T5 + (GLA ? 64 * QS : 0);
  bfr* Am = Vt + 128 * 72;
  const int tid = get_tid();
  const int w = tid >> 6, lane = tid & 63, fr = lane & 15, q4 = lane >> 4;
  const int row0 = group_row0(b, g);
  const bfr* rowbase = p.proj + (size_t)row0 * DINP;
  float lgf = 0.f, lgb = 0.f;
  __syncthreads();
  if (GLA) {
    load_rows_transposed<128>(Vt, rowbase + C_GLV + h * 128);
    load_rows_f32<64>(stg, FS, rowbase + C_GLQ + h * 64, 0.125f);
    gla_logdecay2(p, layer, h, rowbase, Gf, Gb);
    __syncthreads();
    {
      const int d = tid & 63, seg = tid >> 6;
      float runf = 0.f, runb = 0.f;
#pragma unroll
      for (int jj = 0; jj < 8; ++jj) {
        const int jf = seg * 8 + jj, jb = seg * 8 + 7 - jj;
        runf += Gf[jf * 68 + d]; Gf[jf * 68 + d] = runf;
        runb += Gb[jb * 68 + d]; Gb[jb * 68 + d] = runb;
      }
      red[seg * 64 + d] = runf;
      red[512 + seg * 64 + d] = runb;
      __syncthreads();
      float offf = 0.f, offb = 0.f;
#pragma unroll
      for (int s2 = 0; s2 < 8; ++s2) {
        if (s2 < seg) offf += red[s2 * 64 + d];
        if (s2 > seg) offb += red[512 + s2 * 64 + d];
      }
#pragma unroll
      for (int jj = 0; jj < 8; ++jj) {
        const int j = seg * 8 + jj;
        Gf[j * 68 + d] += offf;
        Gb[j * 68 + d] += offb;
      }
    }
    __syncthreads();
    for (int u = tid; u < 64 * 64; u += NTHR) {
      const int i = u >> 6, d = u & 63;
      const float qv = stg[i * FS + d];
      const float gf = Gf[i * 68 + d], gb = Gb[i * 68 + d];
      T0[i * QS + d] = f2bf(qv * __expf(gf - Gf[63 * 68 + d]));
      T2[i * QS + d] = f2bf(qv * __expf(gf));
      T4[i * QS + d] = f2bf(qv * __expf(gb - Gb[d]));
      T3[i * QS + d] = f2bf(qv * __expf(gb));
    }
    __syncthreads();
    load_rows_f32<64>(stg, FS, rowbase + C_GLK + h * 64, 1.f);
    __syncthreads();
    for (int u = tid; u < 64 * 64; u += NTHR) {
      const int j = u >> 6, d = u & 63;
      const float kv = stg[j * FS + d];
      T1[j * QS + d] = f2bf(kv * __expf(Gf[63 * 68 + d] - Gf[j * 68 + d]));
      T5[j * QS + d] = f2bf(kv * __expf(Gb[d] - Gb[j * 68 + d]));
    }
  } else {
    const float kscale = 0.08838834764831845f;
    lgf = p.ret_lg[layer * 8 + 0 + h];
    lgb = p.ret_lg[layer * 8 + 4 + h];
    load_rows_transposed<128>(Vt, rowbase + C_RTV + h * 128);
    {
      const int j = tid >> 3, A = (tid >> 2) & 1, fc = tid & 3;
      float cs[8], sn[8];
      if (g >= 4) {
        const int pos = A ? j : (g - 4);
        const float* cp = p.rope + 4096 + pos * 32 + fc * 8;
        const float4 c0 = *(const float4*)cp, c1 = *(const float4*)(cp + 4);
        const float4 s0 = *(const float4*)(cp + 4096), s1 = *(const float4*)(cp + 4100);
        cs[0] = c0.x; cs[1] = c0.y; cs[2] = c0.z; cs[3] = c0.w; cs[4] = c1.x; cs[5] = c1.y; cs[6] = c1.z; cs[7] = c1.w;
        sn[0] = s0.x; sn[1] = s0.y; sn[2] = s0.z; sn[3] = s0.w; sn[4] = s1.x; sn[5] = s1.y; sn[6] = s1.z; sn[7] = s1.w;
      } else {
#pragma unroll
        for (int e = 0; e < 8; ++e) { cs[e] = 1.f; sn[e] = 0.f; }
      }
      const int col = A * 64 + fc * 8;
      const bfr* qp = rowbase + (size_t)j * DINP + C_RTQ + h * 128 + col;
      const bfr* kp = rowbase + (size_t)j * DINP + C_RTK + h * 128 + col;
      const u4 q1 = *(const u4*)qp, q2 = *(const u4*)(qp + 32);
      const u4 k1 = *(const u4*)kp, k2w = *(const u4*)(kp + 32);
      float x1[8], x2[8], y1[8], y2[8];
      unpack8(q1, x1); unpack8(q2, x2);
#pragma unroll
      for (int e = 0; e < 8; ++e) { y1[e] = x1[e] * cs[e] - x2[e] * sn[e]; y2[e] = x2[e] * cs[e] + x1[e] * sn[e]; }
      const float ff = __expf(lgf * (float)(j + 1)), fb = __expf(lgb * (float)(64 - j));
      u4 o;
      o.x = pack2(y1[0], y1[1]); o.y = pack2(y1[2], y1[3]); o.z = pack2(y1[4], y1[5]); o.w = pack2(y1[6], y1[7]);
      *(u4*)(T0 + j * QS + col) = o;
      o.x = pack2(y2[0], y2[1]); o.y = pack2(y2[2], y2[3]); o.z = pack2(y2[4], y2[5]); o.w = pack2(y2[6], y2[7]);
      *(u4*)(T0 + j * QS + col + 32) = o;
      o.x = pack2(y1[0] * ff, y1[1] * ff); o.y = pack2(y1[2] * ff, y1[3] * ff); o.z = pack2(y1[4] * ff, y1[5] * ff); o.w = pack2(y1[6] * ff, y1[7] * ff);
      *(u4*)(T2 + j * QS + col) = o;
      o.x = pack2(y2[0] * ff, y2[1] * ff); o.y = pack2(y2[2] * ff, y2[3] * ff); o.z = pack2(y2[4] * ff, y2[5] * ff); o.w = pack2(y2[6] * ff, y2[7] * ff);
      *(u4*)(T2 + j * QS + col + 32) = o;
      o.x = pack2(y1[0] * fb, y1[1] * fb); o.y = pack2(y1[2] * fb, y1[3] * fb); o.z = pack2(y1[4] * fb, y1[5] * fb); o.w = pack2(y1[6] * fb, y1[7] * fb);
      *(u4*)(T3 + j * QS + col) = o;
      o.x = pack2(y2[0] * fb, y2[1] * fb); o.y = pack2(y2[2] * fb, y2[3] * fb); o.z = pack2(y2[4] * fb, y2[5] * fb); o.w = pack2(y2[6] * fb, y2[7] * fb);
      *(u4*)(T3 + j * QS + col + 32) = o;
      unpack8(k1, x1); unpack8(k2w, x2);
#pragma unroll
      for (int e = 0; e < 8; ++e) { y1[e] = (x1[e] * cs[e] - x2[e] * sn[e]) * kscale; y2[e] = (x2[e] * cs[e] + x1[e] * sn[e]) * kscale; }
      o.x = pack2(y1[0], y1[1]); o.y = pack2(y1[2], y1[3]); o.z = pack2(y1[4], y1[5]); o.w = pack2(y1[6], y1[7]);
      *(u4*)(T1 + j * QS + col) = o;
      o.x = pack2(y2[0], y2[1]); o.y = pack2(y2[2], y2[3]); o.z = pack2(y2[4], y2[5]); o.w = pack2(y2[6], y2[7]);
      *(u4*)(T1 + j * QS + col + 32) = o;
    }
  }
  __syncthreads();
  {
    const int ti = w >> 1;
#pragma unroll
    for (int tt = 0; tt < 2; ++tt) {
      const int tj = (w & 1) * 2 + tt;
      f32x4 af = (f32x4){0.f, 0.f, 0.f, 0.f}, ab = af;
#pragma unroll
      for (int k2 = 0; k2 < DK / 32; ++k2) {
        const bf16x8 a = *(const bf16x8*)(T0 + (ti * 16 + fr) * QS + k2 * 32 + q4 * 8);
        const bf16x8 bq = *(const bf16x8*)(T1 + (tj * 16 + fr) * QS + k2 * 32 + q4 * 8);
        af = MFMA16(a, bq, af);
        if (GLA) {
          const bf16x8 a2 = *(const bf16x8*)(T4 + (ti * 16 + fr) * QS + k2 * 32 + q4 * 8);
          const bf16x8 b2 = *(const bf16x8*)(T5 + (tj * 16 + fr) * QS + k2 * 32 + q4 * 8);
          ab = MFMA16(a2, b2, ab);
        }
      }
#pragma unroll
      for (int r = 0; r < 4; ++r) {
        const int i = ti * 16 + q4 * 4 + r, j = tj * 16 + fr;
        float v;
        if (GLA) v = (j <= i) ? af[r] : ab[r];
        else v = af[r] * ((j <= i) ? __expf(lgf * (float)(i - j)) : __expf(lgb * (float)(j - i)));
        Am[i * 72 + j] = f2bf(v);
      }
    }
  }
  __syncthreads();
  f32x4 acc[4];
#pragma unroll
  for (int rt = 0; rt < 4; ++rt) acc[rt] = (f32x4){0.f, 0.f, 0.f, 0.f};
#pragma unroll
  for (int k2 = 0; k2 < 2; ++k2) {
    const bf16x8 bq = *(const bf16x8*)(Vt + (w * 16 + fr) * 72 + k2 * 32 + q4 * 8);
#pragma unroll
    for (int rt = 0; rt < 4; ++rt) {
      const bf16x8 a = *(const bf16x8*)(Am + (rt * 16 + fr) * 72 + k2 * 32 + q4 * 8);
      acc[rt] = MFMA16(a, bq, acc[rt]);
    }
  }
#pragma unroll
  for (int dir = 0; dir < 2; ++dir) {
    const int scan = (b * 4 + h) * 2 + dir;
    const int pos = scan_pos(dir, g);
    const bfr* St = (GLA ? p.st_gla : p.st_ret) + (size_t)(scan * 132 + pos) * DK * 128 + (size_t)(w * 16 + fr) * DK + q4 * 8;
    const bfr* qt = dir == 0 ? T2 : T3;
#pragma unroll
    for (int k2 = 0; k2 < DK / 32; ++k2) {
      const bf16x8 bq = *(const bf16x8*)(St + k2 * 32);
#pragma unroll
      for (int rt = 0; rt < 4; ++rt) {
        const bf16x8 a = *(const bf16x8*)(qt + (rt * 16 + fr) * QS + k2 * 32 + q4 * 8);
        acc[rt] = MFMA16(a, bq, acc[rt]);
      }
    }
  }
#pragma unroll
  for (int rt = 0; rt < 4; ++rt)
#pragma unroll
    for (int r = 0; r < 4; ++r) {
      float s1 = acc[rt][r], s2 = s1 * s1;
#pragma unroll
      for (int of = 8; of; of >>= 1) { s1 += __shfl_xor(s1, of); s2 += __shfl_xor(s2, of); }
      if (fr == 0) {
        const int i = rt * 16 + q4 * 4 + r;
        red[(w * 64 + i) * 2 + 0] = s1;
        red[(w * 64 + i) * 2 + 1] = s2;
      }
    }
  __syncthreads();
  if (tid < 128) {
    const int i = tid >> 1, c = tid & 1;
    float t = 0.f;
#pragma unroll
    for (int ww = 0; ww < 8; ++ww) t += red[(ww * 64 + i) * 2 + c];
    red2[i * 2 + c] = t;
  }
  __syncthreads();
  const int gcol = GLA ? C_GLG : C_RTG;
  const int ocol = GLA ? 1024 : 512;
  const int vcol = h * 128 + w * 16 + fr;
  const float gg = GLA ? p.gla_g[layer * 128 + w * 16 + fr] : 1.f;
#pragma unroll
  for (int rt = 0; rt < 4; ++rt)
#pragma unroll
    for (int r = 0; r < 4; ++r) {
      const int i = rt * 16 + q4 * 4 + r;
      const float S1 = red2[i * 2 + 0], S2 = red2[i * 2 + 1];
      float y;
      if (GLA) {
        y = acc[rt][r] * rsqrtf(S2 * (1.f / 128.f) + EPS) * gg;
      } else {
        const float mu = S1 * (1.f / 128.f);
        const float var = fmaxf(S2 * (1.f / 128.f) - mu * mu, 0.f);
        y = (acc[rt][r] - mu) * rsqrtf(var + EPS);
      }
      const int row = row0 + i;
      const float gt = bf2f(p.proj[(size_t)row * DINP + gcol + vcol]);
      y *= silu_f(gt);
      p.mix[(size_t)row * D + ocol + vcol] = f2bf(y);
    }
}

__constant__ unsigned char c_cand_tab[64] = {0, 1, 2, 3, 4, 5, 6, 7, 8, 9, 10, 11, 12, 13, 14, 15, 16, 17, 18, 19, 20, 21, 22, 23, 32, 33, 34, 35, 36, 48, 49, 50, 51, 64, 65, 66, 80, 81, 96, 97, 112, 113, 128, 144, 160, 176, 192, 208, 224, 240, 255, 255, 255, 255, 255, 255, 255, 255, 255, 255, 255, 255, 255, 255};

template <int N>
__device__ __forceinline__ void bitonic_sort_desc(float (&v)[N]) {
#pragma unroll
  for (int k = 2; k <= N; k <<= 1)
#pragma unroll
    for (int j = k >> 1; j > 0; j >>= 1)
#pragma unroll
      for (int i = 0; i < N; ++i) {
        const int l = i ^ j;
        if (l > i) {
          const bool desc = ((i & k) == 0);
          const float x = v[i], y = v[l];
          const float hi = fmaxf(x, y), lo = fminf(x, y);
          v[i] = desc ? hi : lo;
          v[l] = desc ? lo : hi;
        }
      }
}
__device__ __forceinline__ void merge_top16(float (&v)[16], const int xl) {
  float o[16];
#pragma unroll
  for (int i = 0; i < 16; ++i) o[i] = __shfl_xor(v[15 - i], xl);
#pragma unroll
  for (int i = 0; i < 16; ++i) v[i] = fmaxf(v[i], o[i]);
#pragma unroll
  for (int j = 8; j > 0; j >>= 1)
#pragma unroll
    for (int i = 0; i < 16; ++i) {
      const int l = i ^ j;
      if (l > i) {
        const float x = v[i], y = v[l];
        v[i] = fmaxf(x, y);
        v[l] = fminf(x, y);
      }
    }
}
__device__ __forceinline__ float pack_key(float x, unsigned mask, unsigned key) {
  return __uint_as_float((__float_as_uint(x) & ~mask) | key);
}

__device__ void topk_phase(const Params& p, int layer, int ntok, char* smem) {
  float* sc = (float*)smem;
  const int tid = get_tid();
  const int lane = tid & 63, w = tid >> 6, fr = lane & 15, q4 = lane >> 4;
  const int nbatch = ntok >> 4;
  for (int bt = get_bid(); bt < nbatch; bt += gridDim.x) {
    __syncthreads();
#pragma unroll 1
    for (int pp = 0; pp < 2; ++pp) {
      const int pair = 2 * w + pp;
      const bfr* qrow = p.q + (size_t)(bt * 16 + fr) * D + pair * 128 + q4 * 8;
      const bfr* skb = p.sk_bf + (size_t)(((layer * 2 + (pair & 1)) * 8 + (pair >> 1))) * 128 * 128 + q4 * 8;
      bf16x8 af[4];
#pragma unroll
      for (int k2 = 0; k2 < 4; ++k2) af[k2] = *(const bf16x8*)(qrow + k2 * 32);
#pragma unroll 4
      for (int nt = 0; nt < 8; ++nt) {
        f32x4 acc = (f32x4){0.f, 0.f, 0.f, 0.f};
#pragma unroll
        for (int k2 = 0; k2 < 4; ++k2) {
          const bf16x8 bq = *(const bf16x8*)(skb + (size_t)(nt * 16 + fr) * 128 + k2 * 32);
          acc = MFMA16(af[k2], bq, acc);
        }
#pragma unroll
        for (int r = 0; r < 4; ++r) sc[((q4 * 4 + r) * 16 + pair) * 132 + nt * 16 + fr] = acc[r];
      }
    }
    __syncthreads();
#pragma unroll 1
    for (int ps = 0; ps < 2; ++ps) {
      const int list = ps * 128 + (tid >> 2), qd = tid & 3;
      float v[32];
#pragma unroll
      for (int j = 0; j < 8; ++j) {
        float4 t = *(const float4*)(sc + list * 132 + qd * 32 + j * 4);
        const unsigned kb = qd * 32 + j * 4;
        v[j * 4 + 0] = pack_key(t.x, 127u, kb + 0); v[j * 4 + 1] = pack_key(t.y, 127u, kb + 1);
        v[j * 4 + 2] = pack_key(t.z, 127u, kb + 2); v[j * 4 + 3] = pack_key(t.w, 127u, kb + 3);
      }
      bitonic_sort_desc<32>(v);
      float wv[16];
#pragma unroll
      for (int i = 0; i < 16; ++i) wv[i] = v[i];
      merge_top16(wv, 1);
      merge_top16(wv, 2);
      if (qd == 0) {
#pragma unroll
        for (int j = 0; j < 4; ++j)
          *(float4*)(sc + list * 132 + j * 4) = make_float4(wv[j * 4 + 0], wv[j * 4 + 1], wv[j * 4 + 2], wv[j * 4 + 3]);
      }
    }
    __syncthreads();
    {
      const int pair = tid >> 2, qd = tid & 3;
      const int tok = pair >> 3, hh = pair & 7;
      const float* o0 = sc + (tok * 16 + hh * 2) * 132;
      const float* o1 = o0 + 132;
      float c[16];
#pragma unroll
      for (int i = 0; i < 16; ++i) {
        const unsigned code = c_cand_tab[qd * 16 + i];
        const float sum = o0[code >> 4] + o1[code & 15];
        c[i] = (code == 255u) ? -INFINITY : pack_key(sum, 255u, code);
      }
      bitonic_sort_desc<16>(c);
      merge_top16(c, 1);
      merge_top16(c, 2);
      float e[16];
      float esum = 0.f;
#pragma unroll
      for (int i = 0; i < 16; ++i) { e[i] = __expf(c[i] - c[0]); esum += e[i]; }
      const float inv = 1.f / esum;
      const int m = bt * 16 + tok;
#pragma unroll
      for (int j = 0; j < 4; ++j) {
        const float ev = qd == 0 ? e[j] : (qd == 1 ? e[4 + j] : (qd == 2 ? e[8 + j] : e[12 + j]));
        const float cv = qd == 0 ? c[j] : (qd == 1 ? c[4 + j] : (qd == 2 ? c[8 + j] : c[12 + j]));
        const unsigned code = __float_as_uint(cv) & 255u;
        const unsigned k0 = __float_as_uint(o0[code >> 4]) & 127u;
        const unsigned k1 = __float_as_uint(o1[code & 15]) & 127u;
        p.pidx[(size_t)m * 128 + hh * 16 + qd * 4 + j] = (int)(k0 * 128u + k1);
        p.pgate[(size_t)m * 128 + hh * 16 + qd * 4 + j] = ev * inv;
      }
    }
  }
}

typedef __attribute__((ext_vector_type(2))) float f32x2;
__device__ __forceinline__ float dot16_fp8(const float* hf, const u4 w) {
  f32x2 a0 = __builtin_amdgcn_cvt_pk_f32_fp8((int)w.x, false), a1 = __builtin_amdgcn_cvt_pk_f32_fp8((int)w.x, true);
  f32x2 b0 = __builtin_amdgcn_cvt_pk_f32_fp8((int)w.y, false), b1 = __builtin_amdgcn_cvt_pk_f32_fp8((int)w.y, true);
  f32x2 c0 = __builtin_amdgcn_cvt_pk_f32_fp8((int)w.z, false), c1 = __builtin_amdgcn_cvt_pk_f32_fp8((int)w.z, true);
  f32x2 d0 = __builtin_amdgcn_cvt_pk_f32_fp8((int)w.w, false), d1 = __builtin_amdgcn_cvt_pk_f32_fp8((int)w.w, true);
  return hf[0] * a0.x + hf[1] * a0.y + hf[2] * a1.x + hf[3] * a1.y + hf[4] * b0.x + hf[5] * b0.y + hf[6] * b1.x + hf[7] * b1.y +
         hf[8] * c0.x + hf[9] * c0.y + hf[10] * c1.x + hf[11] * c1.y + hf[12] * d0.x + hf[13] * d0.y + hf[14] * d1.x + hf[15] * d1.y;
}
__device__ __forceinline__ void fma16_fp8(float* o, float c, const u4 w) {
  f32x2 a0 = __builtin_amdgcn_cvt_pk_f32_fp8((int)w.x, false), a1 = __builtin_amdgcn_cvt_pk_f32_fp8((int)w.x, true);
  f32x2 b0 = __builtin_amdgcn_cvt_pk_f32_fp8((int)w.y, false), b1 = __builtin_amdgcn_cvt_pk_f32_fp8((int)w.y, true);
  f32x2 c0 = __builtin_amdgcn_cvt_pk_f32_fp8((int)w.z, false), c1 = __builtin_amdgcn_cvt_pk_f32_fp8((int)w.z, true);
  f32x2 d0 = __builtin_amdgcn_cvt_pk_f32_fp8((int)w.w, false), d1 = __builtin_amdgcn_cvt_pk_f32_fp8((int)w.w, true);
  o[0] += c * a0.x; o[1] += c * a0.y; o[2] += c * a1.x; o[3] += c * a1.y;
  o[4] += c * b0.x; o[5] += c * b0.y; o[6] += c * b1.x; o[7] += c * b1.y;
  o[8] += c * c0.x; o[9] += c * c0.y; o[10] += c * c1.x; o[11] += c * c1.y;
  o[12] += c * d0.x; o[13] += c * d0.y; o[14] += c * d1.x; o[15] += c * d1.y;
}

__device__ void peer_phase(const Params& p, int layer, int ntok) {
  const int lane = get_tid() & 63;
  const int wave = get_bid() * 8 + (get_tid() >> 6), nw = gridDim.x * 8;
  const unsigned char* U = p.u8 + (size_t)layer * 16384 * D;
  const unsigned char* V = p.v8 + (size_t)layer * 16384 * D;
  const float* usc = p.uscl + layer * 16384;
  const float* vsc = p.vscl + layer * 16384;
  int idA_n = 0, idB_n = 0;
  float pgA_n = 0.f, pgB_n = 0.f;
  u4 hn[4];
  if (wave < ntok) {
    idA_n = p.pidx[(size_t)wave * 128 + lane]; idB_n = p.pidx[(size_t)wave * 128 + 64 + lane];
    pgA_n = p.pgate[(size_t)wave * 128 + lane]; pgB_n = p.pgate[(size_t)wave * 128 + 64 + lane];
    const bfr* hr = p.h + (size_t)wave * D + lane * 16;
    hn[0] = *(const u4*)(hr); hn[1] = *(const u4*)(hr + 8); hn[2] = *(const u4*)(hr + 1024); hn[3] = *(const u4*)(hr + 1032);
  }
  for (int m = wave; m < ntok; m += nw) {
    float hf[32];
    unpack8(hn[0], hf); unpack8(hn[1], hf + 8); unpack8(hn[2], hf + 16); unpack8(hn[3], hf + 24);
    const int idA = idA_n, idB = idB_n;
    const float gA = pgA_n * vsc[idA], gB = pgB_n * vsc[idB];
    const float usA = usc[idA], usB = usc[idB];
    float cA = 0.f, cB = 0.f;
#pragma unroll 1
    for (int e0 = 0; e0 < 128; e0 += 8) {
      u4 r[8][2];
#pragma unroll
      for (int u = 0; u < 8; ++u) {
        int e = e0 + u;
        int row = __shfl(e0 < 64 ? idA : idB, e & 63);
        const unsigned char* up = U + (size_t)row * D + lane * 16;
        r[u][0] = *(const u4*)(up);
        r[u][1] = *(const u4*)(up + 1024);
      }
      __builtin_amdgcn_sched_barrier(0);
#pragma unroll
      for (int u = 0; u < 8; ++u) {
        int e = e0 + u;
        float dsum = dot16_fp8(hf, r[u][0]) + dot16_fp8(hf + 16, r[u][1]);
        dsum = wave_sum(dsum);
        if (e0 < 64) { if (lane == e) cA = gA * gelu_f(dsum * usA); }
        else { if (lane == e - 64) cB = gB * gelu_f(dsum * usB); }
        __builtin_amdgcn_sched_barrier(0);
      }
    }
    if (m + nw < ntok) {
      const int m2 = m + nw;
      idA_n = p.pidx[(size_t)m2 * 128 + lane]; idB_n = p.pidx[(size_t)m2 * 128 + 64 + lane];
      pgA_n = p.pgate[(size_t)m2 * 128 + lane]; pgB_n = p.pgate[(size_t)m2 * 128 + 64 + lane];
      const bfr* hr = p.h + (size_t)m2 * D + lane * 16;
      hn[0] = *(const u4*)(hr); hn[1] = *(const u4*)(hr + 8); hn[2] = *(const u4*)(hr + 1024); hn[3] = *(const u4*)(hr + 1032);
    }
    float o[32];
#pragma unroll
    for (int i = 0; i < 32; ++i) o[i] = 0.f;
#pragma unroll 1
    for (int e0 = 0; e0 < 128; e0 += 4) {
      u4 r[4][2];
      float cf[4];
#pragma unroll
      for (int u = 0; u < 4; ++u) {
        int e = e0 + u;
        int row = __shfl(e0 < 64 ? idA : idB, e & 63);
        cf[u] = __shfl(e0 < 64 ? cA : cB, e & 63);
        const unsigned char* vp = V + (size_t)row * D + lane * 16;
        r[u][0] = *(const u4*)(vp);
        r[u][1] = *(const u4*)(vp + 1024);
      }
      __builtin_amdgcn_sched_barrier(0);
#pragma unroll
      for (int u = 0; u < 4; ++u) {
        fma16_fp8(o, cf[u], r[u][0]);
        fma16_fp8(o + 16, cf[u], r[u][1]);
        __builtin_amdgcn_sched_barrier(0);
      }
    }
    const int vec = m < S ? 0 : (m < MX ? 1 : 2);
    const float* modl = p.mod + (layer * 3 + vec) * 12288;
    float* xr = p.xcur + (size_t)m * D + lane * 16;
    float xn[32];
    float ss = 0.f;
#pragma unroll
    for (int i = 0; i < 2; ++i)
#pragma unroll
      for (int k = 0; k < 4; ++k) {
        int col = i * 1024 + lane * 16 + k * 4;
        float4 a = *(const float4*)(xr + i * 1024 + k * 4);
        float4 g0 = *(const float4*)(modl + 5 * D + col);
        float* xx = xn + i * 16 + k * 4;
        const float* oo = o + i * 16 + k * 4;
        xx[0] = a.x + g0.x * oo[0]; xx[1] = a.y + g0.y * oo[1]; xx[2] = a.z + g0.z * oo[2]; xx[3] = a.w + g0.w * oo[3];
        ss += xx[0] * xx[0] + xx[1] * xx[1] + xx[2] * xx[2] + xx[3] * xx[3];
      }
    ss = wave_sum(ss);
    const float rstd = rsqrtf(ss * (1.f / D) + EPS);
    if (layer == 1) {
      float* orow = p.out + (size_t)m * D;
#pragma unroll
      for (int i = 0; i < 2; ++i)
#pragma unroll
        for (int k = 0; k < 4; ++k) {
          int col = i * 1024 + lane * 16 + k * 4;
          float4 f0 = *(const float4*)(p.final_g + col);
          const float* xx = xn + i * 16 + k * 4;
          *(float4*)(orow + col) = make_float4(xx[0] * rstd * f0.x, xx[1] * rstd * f0.y, xx[2] * rstd * f0.z, xx[3] * rstd * f0.w);
        }
    } else {
      const float* modn = p.mod + ((layer + 1) * 3 + vec) * 12288;
      const float* gn = p.g_attn + (layer + 1) * D;
#pragma unroll
      for (int i = 0; i < 2; ++i) {
        float y[16];
#pragma unroll
        for (int k = 0; k < 4; ++k) {
          int col = i * 1024 + lane * 16 + k * 4;
          const float* xx = xn + i * 16 + k * 4;
          *(float4*)(xr + i * 1024 + k * 4) = make_float4(xx[0], xx[1], xx[2], xx[3]);
          float4 gv = *(const float4*)(gn + col), scv = *(const float4*)(modn + D + col), shv = *(const float4*)(modn + col);
          y[k * 4 + 0] = xx[0] * rstd * gv.x * (1.f + scv.x) + shv.x;
          y[k * 4 + 1] = xx[1] * rstd * gv.y * (1.f + scv.y) + shv.y;
          y[k * 4 + 2] = xx[2] * rstd * gv.z * (1.f + scv.z) + shv.z;
          y[k * 4 + 3] = xx[3] * rstd * gv.w * (1.f + scv.w) + shv.w;
        }
        u4 w0, w1;
        w0.x = pack2(y[0], y[1]); w0.y = pack2(y[2], y[3]); w0.z = pack2(y[4], y[5]); w0.w = pack2(y[6], y[7]);
        w1.x = pack2(y[8], y[9]); w1.y = pack2(y[10], y[11]); w1.z = pack2(y[12], y[13]); w1.w = pack2(y[14], y[15]);
        *(u4*)(p.h + (size_t)m * D + i * 1024 + lane * 16) = w0;
        *(u4*)(p.h + (size_t)m * D + i * 1024 + lane * 16 + 8) = w1;
      }
    }
  }
}

constexpr int PH_INIT = 0, PH_MOD_ATTN = 1, PH_INPROJ = 2, PH_MIX1 = 3, PH_SCANB = 4, PH_SCANC = 5, PH_OUTPROJ = 6,
              PH_MOD_FFN = 7, PH_QPROJ = 8, PH_SCORES = 9, PH_TOPK = 10, PH_PEER = 11;

template <int EPI, bool ALLOW_BIG>
__device__ __forceinline__ void gemm_phase(const Params& p, int layer, int vid, const bfr* A, const bfr* Bt, int MB, int MT,
                                           int NB, int N128, int small_nt, void* Cout, int ldc, char* smem) {
  const int nbig = MB * NB;
  const int nsm1 = small_nt >= 0 ? MB : 0;
  const int nsm2 = (MT - MB) * N128;
  const int total = nbig + nsm1 + nsm2;
  for (int t = vid; t < total; t += gridDim.x) {
    if (t < nbig) {
      if constexpr (ALLOW_BIG) {
        const int mt = t / NB, nt = t - mt * NB;
        gemm_tile<EPI, true>(A, D, Bt, D, D, mt * 256, nt * 256, Cout, ldc, p, layer, smem);
      }
    } else if (t < nbig + nsm1) {
      gemm_tile<EPI, false>(A, D, Bt, D, D, (t - nbig) * 256, small_nt * 128, Cout, ldc, p, layer, smem);
    } else {
      const int u = t - nbig - nsm1;
      const int mt = MB + u / N128, nt = u % N128;
      gemm_tile<EPI, false>(A, D, Bt, D, D, mt * 256, nt * 128, Cout, ldc, p, layer, smem);
    }
  }
}

__device__ void run_phase(const Params& p, int ph, int layer, char* smem, int vid) {
  const int bid = get_bid(), nb = gridDim.x;
  const bool last = (layer == 1);
  switch (ph) {
    case PH_INIT: phase0(p, smem); break;
    case PH_MOD_ATTN: modulate_phase(p, layer, 0, MT); break;
    case PH_INPROJ:
      gemm_phase<0, true>(p, layer, vid, p.h, p.wt_in + (size_t)layer * DINP * D, 66, 66, 23, 47, 46, p.proj, DINP, smem);
      break;
    case PH_MIX1: {
      const int n_swa = 256, n_na = 2048, n_sa = 1056, n_ctx = last ? 0 : 32;
      const int total = n_swa + n_na + 2 * n_sa + n_ctx;
      for (int it = bid; it < total; it += nb) {
        int t = it;
        if (t < n_swa) { swa_item(p, layer, t, smem); continue; }
        t -= n_swa;
        if (t < n_na) { na_item(p, layer, t, smem); continue; }
        t -= n_na;
        if (t < n_sa) { scan_a_item<128, false>(p, layer, t, smem); continue; }
        t -= n_sa;
        if (t < n_sa) { scan_a_item<64, true>(p, layer, t, smem); continue; }
        t -= n_sa;
        ctx_item(p, layer, t, smem);
      }
    } break;
    case PH_SCANB: scan_b_phase(p); break;
    case PH_SCANC:
      for (int it = bid; it < 2 * 1056; it += nb) {
        const bool gla = it < 1056;
        const int t = gla ? it : it - 1056;
        if (last && (t % 132) < 4) continue;
        if (gla) scan_c_item<64, true>(p, layer, t, smem);
        else scan_c_item<128, false>(p, layer, t, smem);
      }
      break;
    case PH_OUTPROJ: {
      gemm_phase<1, false>(p, layer, vid, p.mix, p.wt_out + (size_t)layer * D * D, 0, last ? 64 : 66, 8, 16, -1, nullptr, 0, smem);
    } break;
    case PH_MOD_FFN: modulate_phase(p, layer, 1, last ? MX : MT); break;
    case PH_QPROJ: {
      gemm_phase<0, true>(p, layer, vid, p.h, p.wt_q + (size_t)layer * D * D, 64, last ? 64 : 66, 8, 16, -1, p.q, D, smem);
    } break;
    case PH_SCORES: {
      const int mt = last ? 64 : 66;
      for (int t = bid; t < mt * 16; t += nb) {
        int j = t & 15;
        int hh = j >> 1, pp = j & 1;
        const bfr* bt = p.sk_bf + (size_t)(((layer * 2 + pp) * 8 + hh)) * 128 * 128;
        gemm_tile<2, false>(p.q + j * 128, D, bt, 128, 128, (t >> 4) * 256, 0, p.scores + j * 128, D, p, layer, smem);
      }
    } break;
    case PH_TOPK: topk_phase(p, layer, last ? MX : MT, smem); break;
    case PH_PEER: peer_phase(p, layer, last ? MX : MT); break;
  }
}

__device__ __forceinline__ void grid_barrier(unsigned* bar, unsigned& epoch) {
  asm volatile("s_waitcnt vmcnt(0)" ::: "memory");
  __syncthreads();
  epoch += gridDim.x;
  if (threadIdx.x == 0) {
    __builtin_amdgcn_fence(__ATOMIC_RELEASE, "agent");
    asm volatile("s_waitcnt vmcnt(0)" ::: "memory");
    (void)__hip_atomic_fetch_add(bar, 1u, __ATOMIC_RELAXED, __HIP_MEMORY_SCOPE_AGENT);
    unsigned spins = 0;
    while (__hip_atomic_load(bar, __ATOMIC_RELAXED, __HIP_MEMORY_SCOPE_AGENT) < epoch) {
      __builtin_amdgcn_s_sleep(1);
      if (++spins > (1u << 24)) break;
    }
    __builtin_amdgcn_fence(__ATOMIC_ACQUIRE, "agent");
    asm volatile("s_waitcnt vmcnt(0)" ::: "memory");
  }
  __syncthreads();
}

#if MULTI_LAUNCH
__global__ void __launch_bounds__(NTHR) phase_kernel(Params p, int ph, int layer) {
  extern __shared__ __attribute__((aligned(16))) char smem[];
  run_phase(p, ph, layer, smem, blockIdx.x);
}
#else
__global__ void __launch_bounds__(NTHR) mega_kernel(Params p) {
  extern __shared__ __attribute__((aligned(16))) char smem[];
  cg::grid_group grid = cg::this_grid();
  const unsigned xcd = (unsigned)__builtin_amdgcn_s_getreg((3 << 11) | 20) & 7u;
  run_phase(p, PH_INIT, 0, smem, 0);
  __syncthreads();
  if (threadIdx.x == 0) ((volatile unsigned*)smem)[0] = atomicAdd(&p.bar[16 + xcd], 1u);
  grid.sync();
  int vid = (int)((volatile unsigned*)smem)[0];
  for (unsigned x = 0; x < xcd; ++x) vid += (int)__hip_atomic_load(&p.bar[16 + x], __ATOMIC_RELAXED, __HIP_MEMORY_SCOPE_AGENT);
  vid = __builtin_amdgcn_readfirstlane(vid);
  __syncthreads();
  unsigned epoch = 0;
  for (int layer = 0; layer < 2; ++layer) {
    for (int ph = (layer == 0 ? PH_MOD_ATTN : PH_INPROJ); ph <= PH_PEER; ++ph) {
      if (ph == PH_SCORES) continue;
      run_phase(p, ph, layer, smem, vid);
      if (!(layer == 1 && ph == PH_PEER)) grid_barrier(p.bar, epoch);
    }
  }
}
#endif

static inline size_t align_up(size_t v) { return (v + 255) & ~(size_t)255; }

extern "C" void kernel_launch(void* const* d_in, const int* in_sizes, int n_in, void* d_out, int out_size, void* d_ws,
                              size_t ws_size, hipStream_t stream) {
  Params p{};
  p.x = (const float*)d_in[0]; p.c = (const float*)d_in[1]; p.ctx = (const float*)d_in[2]; p.c_ctx = (const float*)d_in[3];
  p.w_ada = (const float*)d_in[4]; p.b_ada = (const float*)d_in[5]; p.g_attn = (const float*)d_in[6]; p.g_ffn = (const float*)d_in[7];
  p.w_in = (const float*)d_in[8]; p.rpb = (const float*)d_in[9]; p.ret_lg = (const float*)d_in[10]; p.gla_wu = (const float*)d_in[11];
  p.gla_b = (const float*)d_in[12]; p.gla_g = (const float*)d_in[13]; p.sink = (const float*)d_in[14]; p.w_out = (const float*)d_in[15];
  p.w_q = (const float*)d_in[16]; p.sub_keys = (const float*)d_in[17]; p.pu = (const float*)d_in[18]; p.pv = (const float*)d_in[19];
  p.final_g = (const float*)d_in[20];
  p.out = (float*)d_out;
  char* ws = (char*)d_ws;
  size_t off = 0;
  auto take = [&](size_t bytes) { char* r = ws + off; off = align_up(off + bytes); return r; };
  p.mod = (float*)take((size_t)2 * 3 * 12288 * 4);
  p.bar = (unsigned*)take(256);
  p.rope = (float*)take((size_t)16384 * 4);
  p.wt_in = (bfr*)take((size_t)2 * DINP * D * 2);
  p.wt_out = (bfr*)take((size_t)2 * D * D * 2);
  p.wt_q = (bfr*)take((size_t)2 * D * D * 2);
  p.sk_bf = (bfr*)take((size_t)524288 * 2);
  p.u8 = (unsigned char*)take((size_t)2 * 16384 * D);
  p.v8 = (unsigned char*)take((size_t)2 * 16384 * D);
  p.uscl = (float*)take((size_t)2 * 16384 * 4);
  p.vscl = (float*)take((size_t)2 * 16384 * 4);
  p.xcur = (float*)take((size_t)MT * D * 4);
  p.h = (bfr*)take((size_t)MT * D * 2);
  p.proj = (bfr*)take((size_t)MT * DINP * 2);
  p.mix = (bfr*)take((size_t)MT * D * 2);
  p.st_ret = (bfr*)take((size_t)16 * 132 * 16384 * 4);
  p.dec_ret = (float*)take((size_t)16 * 132 * 128 * 4);
  p.dec_gla = (float*)take((size_t)16 * 132 * 64 * 4);
  p.pidx = (int*)take((size_t)MT * 128 * 4);
  p.pgate = (float*)take((size_t)MT * 128 * 4);
  p.st_gla = (bfr*)p.h;
  p.q = p.proj;
  p.scores = (float*)p.st_ret;
  if (off > ws_size) { fprintf(stderr, "workspace too small: need %zu have %zu\n", off, ws_size); return; }

  hipMemsetAsync(p.mod, 0, (size_t)2 * 3 * 12288 * 4 + 256, stream);
#if MULTI_LAUNCH
  hipFuncSetAttribute((const void*)phase_kernel, hipFuncAttributeMaxDynamicSharedMemorySize, SMEM_BYTES);
  const int grid = 256;
  hipLaunchKernelGGL(phase_kernel, dim3(grid), dim3(NTHR), SMEM_BYTES, stream, p, PH_INIT, 0);
  for (int layer = 0; layer < 2; ++layer)
    for (int ph = (layer == 0 ? PH_MOD_ATTN : PH_INPROJ); ph <= PH_PEER; ++ph)
      hipLaunchKernelGGL(phase_kernel, dim3(grid), dim3(NTHR), SMEM_BYTES, stream, p, ph, layer);
#else
  static int grid_blocks = 0;
  if (!grid_blocks) {
    hipFuncSetAttribute((const void*)mega_kernel, hipFuncAttributeMaxDynamicSharedMemorySize, SMEM_BYTES);
    int dev = 0, cus = 0, per_cu = 0;
    hipGetDevice(&dev);
    hipDeviceGetAttribute(&cus, hipDeviceAttributeMultiprocessorCount, dev);
    hipOccupancyMaxActiveBlocksPerMultiprocessor(&per_cu, mega_kernel, NTHR, SMEM_BYTES);
    if (per_cu < 1) per_cu = 1;
    grid_blocks = cus * per_cu;
    if (grid_blocks > 256) grid_blocks = 256;
  }
  void* args[] = {&p};
  hipError_t e = hipLaunchCooperativeKernel((void*)mega_kernel, dim3(grid_blocks), dim3(NTHR), args, SMEM_BYTES, stream);
  if (e != hipSuccess) fprintf(stderr, "cooperative launch failed: %s (grid %d)\n", hipGetErrorString(e), grid_blocks);
#endif
}
```
